# Optimizing an MI355X kernel written in HIP

```python
import jax
import jax.numpy as jnp
from jax import lax
import numpy as np

D_MODEL = 1024
BATCH = 2
SEQ = 8192
DEPTH = 1

EPS = 1e-6
HG_HEADS = 4
HG_DK = 128
HG_DV = 128
HG_QF = HG_HEADS * HG_DK
HG_WIDTH = HG_HEADS * HG_DV
HG_CHUNK = 64
SSM_HEADS = 8
SSM_HEAD_DIM = 64
SSM_WIDTH = SSM_HEADS * SSM_HEAD_DIM
SSM_GROUPS = 2
SSM_STATE = 128
SSM_CONV = 4
SSM_CONV_CH = SSM_WIDTH + 2 * SSM_GROUPS * SSM_STATE
SSM_CHUNK = 128
DT_MIN = 1e-3
DT_MAX = 1e-1
D_MIX = HG_WIDTH + SSM_WIDTH
IN_SPLITS = (HG_QF, HG_QF, HG_WIDTH, HG_WIDTH, SSM_WIDTH, SSM_CONV_CH, SSM_HEADS)
IN_COLS = sum(IN_SPLITS)
N_EXPERTS = 32
TOP_K = 4
D_FF = 1024
SWIGLU_LIMIT = 7.0
SWIGLU_ALPHA = 1.702
MOE_BLOCK = 128
N_MOD = 6

kernel_name = "hgrn2_mamba2_parallel_moe_adaln"


def rmsnorm(x, w):
    xf = x.astype(jnp.float32)
    y = xf * lax.rsqrt(jnp.mean(xf * xf, axis=-1, keepdims=True) + EPS)
    return (y * w.astype(jnp.float32)).astype(x.dtype)


def modulate(h, shift, scale):
    return h * (1.0 + scale[:, None, :]) + shift[:, None, :]


def scan_chunk_states(decay, d_state):
    def step(s, inp):
        dec, ds = inp
        return dec * s + ds, s
    s0 = jnp.zeros_like(d_state[:, 0])
    _, prev = lax.scan(step, s0, (jnp.moveaxis(decay, 1, 0), jnp.moveaxis(d_state, 1, 0)))
    return jnp.moveaxis(prev, 0, 1)


def hgrn2_chunked(q, k, v, log_f):
    bsz, seqlen, nh, _ = q.shape
    c = HG_CHUNK
    n = seqlen // c
    r = lambda t: t.reshape(bsz, n, c, nh, t.shape[-1])
    q, k, v, log_f = r(q), r(k), r(v), r(log_f)
    b = jnp.cumsum(log_f, axis=2)
    b_mid = b[:, :, c // 2 - 1:c // 2]
    b_last = b[:, :, -1]
    causal = jnp.tril(jnp.ones((c, c), dtype=bool))
    att = jnp.einsum('bnthk,bnshk->bnhts', q * jnp.exp(b - b_mid), k * jnp.exp(b_mid - b))
    att = jnp.where(causal, att, 0.0)
    o_intra = jnp.einsum('bnhts,bnshv->bnthv', att, v)
    d_state = jnp.einsum('bnshk,bnshv->bnhkv', k * jnp.exp(b_last[:, :, None] - b), v)
    s_prev = scan_chunk_states(jnp.exp(b_last)[..., None], d_state)
    o_inter = jnp.einsum('bnthk,bnhkv->bnthv', q * jnp.exp(b), s_prev)
    return (o_intra + o_inter).reshape(bsz, seqlen, nh, v.shape[-1])


def ssd_chunked(x, dt, a, bm, cm):
    bsz, seqlen, nh, p = x.shape
    g = bm.shape[2]
    hg = nh // g
    c = SSM_CHUNK
    n = seqlen // c
    x = x.reshape(bsz, n, c, g, hg, p)
    dt = dt.reshape(bsz, n, c, g, hg)
    bm = bm.reshape(bsz, n, c, g, -1)
    cm = cm.reshape(bsz, n, c, g, -1)
    a_cum = jnp.cumsum(dt * a.reshape(g, hg), axis=2)
    a_last = a_cum[:, :, -1]
    xdt = x * dt[..., None]
    a_t = jnp.moveaxis(a_cum, 2, -1)
    causal = jnp.tril(jnp.ones((c, c), dtype=bool))
    seg = jnp.exp(jnp.where(causal, a_t[..., :, None] - a_t[..., None, :], -jnp.inf))
    cb = jnp.einsum('bntgd,bnsgd->bngts', cm, bm)
    scores = cb[:, :, :, None] * seg
    y_intra = jnp.einsum('bnghts,bnsghp->bntghp', scores, xdt)
    d_state = jnp.einsum('bnsgd,bnsgh,bnsghp->bnghpd', bm, jnp.exp(a_last[:, :, None] - a_cum), xdt)
    s_prev = scan_chunk_states(jnp.exp(a_last)[..., None, None], d_state)
    y_inter = jnp.einsum('bntgd,bntgh,bnghpd->bntghp', cm, jnp.exp(a_cum), s_prev)
    return (y_intra + y_inter).reshape(bsz, seqlen, nh, p)


def causal_depthwise_conv(x, w, b):
    y = lax.conv_general_dilated(x, w[:, None, :], window_strides=(1,), padding=[(SSM_CONV - 1, 0)],
                                 dimension_numbers=('NWC', 'WIO', 'NWC'), feature_group_count=x.shape[-1])
    return y + b


def hybrid_mixer(u, w_in, lb, hg_norm_w, a_log, dt_bias, d_skip, conv_w, conv_b, ssm_norm_w, w_out):
    bsz, seqlen, _ = u.shape
    f32 = jnp.float32
    proj = u @ w_in
    q, f, i, g, z, xbc, dt_raw = jnp.split(proj, np.cumsum(IN_SPLITS[:-1]).tolist(), axis=-1)
    hd = lambda t, d: t.reshape(bsz, seqlen, HG_HEADS, d)
    fg = lb + (1.0 - lb) * jax.nn.sigmoid(f.astype(f32))
    o_hg = hgrn2_chunked(hd(jax.nn.silu(q.astype(f32)), HG_DK), hd(1.0 - fg, HG_DK),
                         hd(i.astype(f32), HG_DV), hd(jnp.log(fg), HG_DK))
    o_hg = rmsnorm(o_hg, hg_norm_w) * jax.nn.silu(hd(g.astype(f32), HG_DV))
    o_hg = o_hg.reshape(bsz, seqlen, HG_WIDTH)
    xbc = jax.nn.silu(causal_depthwise_conv(xbc, conv_w, conv_b)).astype(f32)
    xs, bm, cm = jnp.split(xbc, [SSM_WIDTH, SSM_WIDTH + SSM_GROUPS * SSM_STATE], axis=-1)
    xs = xs.reshape(bsz, seqlen, SSM_HEADS, SSM_HEAD_DIM)
    dt = jax.nn.softplus(dt_raw.astype(f32) + dt_bias.astype(f32))
    a = -jnp.exp(a_log.astype(f32))
    y = ssd_chunked(xs, dt, a, bm.reshape(bsz, seqlen, SSM_GROUPS, SSM_STATE),
                    cm.reshape(bsz, seqlen, SSM_GROUPS, SSM_STATE))
    y = y + d_skip.astype(f32)[:, None] * xs
    y = y.reshape(bsz, seqlen, SSM_WIDTH) * jax.nn.silu(z.astype(f32))
    y = rmsnorm(y.reshape(bsz, seqlen, SSM_GROUPS, SSM_WIDTH // SSM_GROUPS),
                ssm_norm_w.reshape(SSM_GROUPS, SSM_WIDTH // SSM_GROUPS)).reshape(bsz, seqlen, SSM_WIDTH)
    mixed = jnp.concatenate([o_hg, y], axis=-1).astype(u.dtype)
    return mixed @ w_out


def moe_ffn(h, router_w, router_b, w1, b1, w2, b2):
    bsz, seqlen, d = h.shape
    t = bsz * seqlen
    n_assign = t * TOP_K
    hf = h.reshape(t, d)
    logits = (hf @ router_w).astype(jnp.float32) + router_b.astype(jnp.float32)
    top_logits, top_idx = lax.top_k(logits, TOP_K)
    gates = jax.nn.softmax(top_logits, axis=-1)
    flat_e = top_idx.reshape(n_assign)
    order = jnp.argsort(flat_e).astype(jnp.int32)
    sorted_e = flat_e[order]
    counts = jnp.bincount(flat_e, length=N_EXPERTS)
    padded = (counts + MOE_BLOCK - 1) // MOE_BLOCK * MOE_BLOCK
    start = jnp.cumsum(counts) - counts
    pend = jnp.cumsum(padded)
    pstart = pend - padded
    dest = pstart[sorted_e] + jnp.arange(n_assign, dtype=jnp.int32) - start[sorted_e]
    n_rows = (n_assign + MOE_BLOCK - 1) // MOE_BLOCK * MOE_BLOCK + N_EXPERTS * MOE_BLOCK
    n_blocks = n_rows // MOE_BLOCK
    row_assign = jnp.full((n_rows,), n_assign, jnp.int32).at[dest].set(order)
    row_tok = row_assign // TOP_K
    block_e = jnp.minimum(jnp.searchsorted(pend, jnp.arange(n_blocks) * MOE_BLOCK, side='right'),
                          N_EXPERTS - 1)
    h_pad = jnp.concatenate([hf, jnp.zeros((1, d), hf.dtype)], axis=0)
    xin = h_pad[row_tok].reshape(n_blocks, MOE_BLOCK, d)

    def expert_block(args):
        xb, e = args
        hb = xb @ w1[e] + b1[e]
        glu, lin = jnp.split(hb, 2, axis=-1)
        glu = jnp.minimum(glu, SWIGLU_LIMIT)
        lin = jnp.clip(lin, -SWIGLU_LIMIT, SWIGLU_LIMIT)
        act = glu * jax.nn.sigmoid(SWIGLU_ALPHA * glu) * (lin + 1.0)
        return act @ w2[e] + b2[e]

    yout = lax.map(expert_block, (xin, block_e)).reshape(n_rows, d)
    gate_rows = jnp.concatenate([gates.reshape(n_assign), jnp.zeros((1,), gates.dtype)])[row_assign]
    out = jax.ops.segment_sum(yout * gate_rows[:, None].astype(yout.dtype), row_tok, num_segments=t + 1)[:t]
    return out.reshape(bsz, seqlen, d)


def setup_inputs(seed: int = 0) -> dict:
    key = jax.random.key(seed)
    ks = jax.random.split(key, 24)
    nrm = lambda k, shape, s: jax.random.normal(k, shape, jnp.float32) * s
    dt0 = jnp.exp(jax.random.uniform(ks[9], (DEPTH, SSM_HEADS), jnp.float32,
                                     jnp.log(DT_MIN), jnp.log(DT_MAX)))
    return {
        'x': nrm(ks[0], (BATCH, SEQ, D_MODEL), 1.0),
        'c': nrm(ks[1], (BATCH, D_MODEL), 1.0),
        'ada_w': nrm(ks[2], (DEPTH, D_MODEL, N_MOD * D_MODEL), 0.5 * D_MODEL ** -0.5),
        'ada_b': nrm(ks[3], (DEPTH, N_MOD * D_MODEL), 0.02),
        'norm1_w': 1.0 + nrm(ks[4], (DEPTH, D_MODEL), 0.02),
        'w_in': nrm(ks[5], (DEPTH, D_MODEL, IN_COLS), D_MODEL ** -0.5),
        'hg_lb_logits': nrm(ks[6], (DEPTH + 1, HG_QF), 0.1),
        'hg_norm_w': 1.0 + nrm(ks[7], (DEPTH, HG_DV), 0.02),
        'ssm_a_log': jnp.log(jax.random.uniform(ks[8], (DEPTH, SSM_HEADS), jnp.float32, 1.0, 16.0)),
        'ssm_dt_bias': dt0 + jnp.log(-jnp.expm1(-dt0)),
        'ssm_d': 1.0 + nrm(ks[10], (DEPTH, SSM_HEADS), 0.02),
        'ssm_conv_w': nrm(ks[11], (DEPTH, SSM_CONV, SSM_CONV_CH), SSM_CONV ** -0.5),
        'ssm_conv_b': nrm(ks[12], (DEPTH, SSM_CONV_CH), 0.02),
        'ssm_norm_w': 1.0 + nrm(ks[13], (DEPTH, SSM_WIDTH), 0.02),
        'w_out': nrm(ks[14], (DEPTH, D_MIX, D_MODEL), D_MIX ** -0.5),
        'norm2_w': 1.0 + nrm(ks[15], (DEPTH, D_MODEL), 0.02),
        'router_w': nrm(ks[16], (DEPTH, D_MODEL, N_EXPERTS), D_MODEL ** -0.5),
        'router_b': nrm(ks[17], (DEPTH, N_EXPERTS), 0.01),
        'exp_w1': nrm(ks[18], (DEPTH, N_EXPERTS, D_MODEL, 2 * D_FF), D_MODEL ** -0.5),
        'exp_b1': nrm(ks[19], (DEPTH, N_EXPERTS, 2 * D_FF), 0.01),
        'exp_w2': nrm(ks[20], (DEPTH, N_EXPERTS, D_FF, D_MODEL), D_FF ** -0.5),
        'exp_b2': nrm(ks[21], (DEPTH, N_EXPERTS, D_MODEL), 0.01),
        'final_norm_w': 1.0 + nrm(ks[22], (D_MODEL,), 0.02),
    }


def reference(x, c, ada_w, ada_b, norm1_w, w_in, hg_lb_logits, hg_norm_w, ssm_a_log, ssm_dt_bias,
              ssm_d, ssm_conv_w, ssm_conv_b, ssm_norm_w, w_out, norm2_w, router_w, router_b,
              exp_w1, exp_b1, exp_w2, exp_b2, final_norm_w):
    lb_all = jnp.cumsum(jax.nn.softmax(hg_lb_logits.astype(jnp.float32), axis=0), axis=0)
    c_act = jax.nn.silu(c)
    for l in range(DEPTH):
        mod = c_act @ ada_w[l] + ada_b[l]
        sh1, sc1, g1, sh2, sc2, g2 = jnp.split(mod, N_MOD, axis=-1)
        h = modulate(rmsnorm(x, norm1_w[l]), sh1, sc1)
        x = x + g1[:, None, :] * hybrid_mixer(h, w_in[l], lb_all[l], hg_norm_w[l], ssm_a_log[l],
                                              ssm_dt_bias[l], ssm_d[l], ssm_conv_w[l], ssm_conv_b[l],
                                              ssm_norm_w[l], w_out[l])
        h = modulate(rmsnorm(x, norm2_w[l]), sh2, sc2)
        x = x + g2[:, None, :] * moe_ffn(h, router_w[l], router_b[l], exp_w1[l], exp_b1[l],
                                         exp_w2[l], exp_b2[l])
    return rmsnorm(x, final_norm_w)
```

```cpp
#include <hip/hip_runtime.h>
#include <cstdio>
#include <cstdint>
namespace pg8 {
#define PG8_LAS __attribute__((address_space(3)))
typedef unsigned short bf16_t;
typedef short bf16x8 __attribute__((ext_vector_type(8)));
typedef float f32x4 __attribute__((ext_vector_type(4)));
typedef unsigned u32x4 __attribute__((ext_vector_type(4)));
constexpr int BM = 256, BK = 64, HALF = 128, HTB = HALF * BK * 2  , STAGE_BYTES = 8 * HTB, NXCD = 8, WGM = 8;

__host__ __device__ __forceinline__ int lds_byte(int r, int c) { const int st = (r >> 4) * 2 + (c >> 5), rr = r & 15, cc = c & 31, ob = rr * 64 + cc * 2; return st * 1024 + (ob ^ (((ob >> 9) & 1) << 5)); }
__host__ __device__ __forceinline__ void stage_rc(int b, int& R, int& C) { const int st = b / 1024, sb = b % 1024, swz = sb ^ (((sb >> 9) & 1) << 5); R = (st >> 1) * 16 + swz / 64; C = (st & 1) * 32 + (swz % 64) / 2; }
__host__ __device__ __forceinline__ int perm32(int rho) { const int n = rho >> 4, i = rho & 15; return 8 * (i >> 2) + 4 * n + (i & 3); }

struct Unit { int pm, pn; };
struct Gemm { const bf16_t* A; const bf16_t* Bt; int M, N, K; };

struct StaticOrder {
    int nM, nN, nwg, G, c;
    __host__ __device__ void init(int M, int N, int G_, int c_) { nM = M / BM; nN = N / BM; nwg = nM * nN; G = G_; c = c_; }
    __host__ __device__ bool next(int i, Unit& u) const {
        const long L = (long)i * G + c; if (L >= nwg) return false;
        int wgid = (int)L; { const int q = nwg / NXCD, r = nwg % NXCD, xcd = wgid % NXCD, off = wgid / NXCD; wgid = (xcd < r ? xcd * (q + 1) : r * (q + 1) + (xcd - r) * q) + off; }
        const int nig = WGM * nN, gid = wgid / nig, fm = gid * WGM, gsz = (nM - fm) < WGM ? (nM - fm) : WGM;
        u.pm = fm + ((wgid % nig) % gsz); u.pn = (wgid % nig) / gsz; return true;
    }
    __device__ __forceinline__ void a_ready(const Unit&) const {}
    __device__ __forceinline__ void done(const Unit&) const {}
};

__device__ __forceinline__ unsigned cvt_pk_bf16(float lo, float hi) { unsigned r; asm volatile("v_cvt_pk_bf16_f32 %0, %1, %2" : "=v"(r) : "v"(lo), "v"(hi)); return r; }
typedef float f32x2 __attribute__((ext_vector_type(2)));
template <class Epi, class Sched, bool ALIGN_EPI = false, bool SP2 = false>
__device__ __forceinline__ void gemm_phase(PG8_LAS unsigned char* lds, const Gemm g, const Sched& S, const Epi& E) {
    const int tid = threadIdx.x, wid = __builtin_amdgcn_readfirstlane(tid >> 6), lane = tid & 63, wr = wid >> 2, wc = wid & 3, fr = lane & 15, fq = lane >> 4;
    const int K = g.K, nt = K / BK;
    unsigned voffA[2], voffB[2];
#pragma unroll
    for (int i = 0; i < 2; ++i) { int R, C; stage_rc(tid * 16 + i * 8192, R, C); const int Rb = Epi::PERM ? ((R & ~31) + perm32(R & 31)) : R;
        voffA[i] = (unsigned)(R * K + C) * 2u; voffB[i] = (unsigned)(Rb * K + C) * 2u; }
    const size_t kstep = (size_t)(BK * 2);
    const size_t hstep = (size_t)HALF * K * 2;
    const size_t tstep = 2 * hstep;
    const unsigned ldsw = (unsigned)wid * 1024u;
    const int aoff = lds_byte(wr * 64 + fr, fq * 8), boff = lds_byte(wc * 32 + fr, fq * 8);
#define PG8_SA(b, h) (((b) * 2 + (h)) * HTB)
#define PG8_SB(b, h) ((4 + (b) * 2 + (h)) * HTB)
#define PG8_STAGE(bufoff, gbase, voff) do { _Pragma("unroll") for (int _i = 0; _i < 2; ++_i) \
        __builtin_amdgcn_global_load_lds((const unsigned*)((const char*)(gbase) + (voff)[_i]), (PG8_LAS unsigned*)(lds + (bufoff) + ldsw + _i * 8192), 16, 0, 0); } while (0)
#define PG8_LDA(dst, b, h) do { _Pragma("unroll") for (int m = 0; m < 4; ++m) _Pragma("unroll") for (int k = 0; k < 2; ++k) dst[m][k] = *(const PG8_LAS bf16x8*)(lds + PG8_SA(b, h) + aoff + m * 2048 + k * 1024); } while (0)
#define PG8_LDB(dst, b, h) do { _Pragma("unroll") for (int n = 0; n < 2; ++n) _Pragma("unroll") for (int k = 0; k < 2; ++k) dst[n][k] = *(const PG8_LAS bf16x8*)(lds + PG8_SB(b, h) + boff + n * 2048 + k * 1024); } while (0)
#define PG8_MMA(ai, bj, At, Bt) do { __builtin_amdgcn_s_setprio(1); _Pragma("unroll") for (int m = 0; m < 4; ++m) _Pragma("unroll") for (int n = 0; n < 2; ++n) _Pragma("unroll") for (int k = 0; k < 2; ++k) \
        acc[ai][bj][m][n] = __builtin_amdgcn_mfma_f32_16x16x32_bf16(Bt[n][k], At[m][k], acc[ai][bj][m][n], 0, 0, 0); __builtin_amdgcn_s_setprio(0); } while (0)
#define PG8_WAIT_V(n) asm volatile("s_waitcnt vmcnt(" #n ")" ::: "memory")
#define PG8_WAIT_L(n) asm volatile("s_waitcnt lgkmcnt(" #n ")" ::: "memory")
#define PG8_BAR __builtin_amdgcn_s_barrier()
#define PG8_SCHED __builtin_amdgcn_sched_barrier(0)
    Unit cur, nxt; int ui = 0;
    if (!S.next(0, cur)) return;
    f32x4 acc[2][2][4][2];
#pragma unroll
    for (int a = 0; a < 2; ++a)
#pragma unroll
        for (int b = 0; b < 2; ++b)
#pragma unroll
            for (int m = 0; m < 4; ++m)
#pragma unroll
                for (int n = 0; n < 2; ++n) acc[a][b][m][n] = (f32x4){0.f, 0.f, 0.f, 0.f};
    bf16x8 At[4][2], B0[2][2], B1[2][2];
    const char* cA = (const char*)g.A + (size_t)cur.pm * tstep; const char* cB = (const char*)g.Bt + (size_t)cur.pn * tstep;
    S.a_ready(cur);
    if constexpr (SP2) {
        PG8_STAGE(PG8_SB(0, 0), cB, voffB); PG8_STAGE(PG8_SB(0, 1), cB + hstep, voffB); PG8_STAGE(PG8_SA(0, 0), cA, voffA); PG8_STAGE(PG8_SA(0, 1), cA + hstep, voffA);
        if (wr == 1) PG8_BAR;
        PG8_WAIT_V(2); PG8_BAR;
        PG8_STAGE(PG8_SB(1, 0), cB + kstep, voffB); PG8_STAGE(PG8_SA(1, 0), cA + kstep, voffA); PG8_STAGE(PG8_SB(1, 1), cB + hstep + kstep, voffB);
        PG8_WAIT_V(6); PG8_BAR;
    } else {
        PG8_STAGE(PG8_SB(0, 0), cB, voffB); PG8_STAGE(PG8_SA(0, 0), cA, voffA); PG8_STAGE(PG8_SB(0, 1), cB + hstep, voffB); PG8_STAGE(PG8_SA(0, 1), cA + hstep, voffA);
        if (wr == 1) PG8_BAR;
        PG8_WAIT_V(4); PG8_BAR;
        PG8_STAGE(PG8_SB(1, 0), cB + kstep, voffB); PG8_STAGE(PG8_SA(1, 0), cA + kstep, voffA); PG8_STAGE(PG8_SB(1, 1), cB + hstep + kstep, voffB);
        PG8_WAIT_V(6); PG8_BAR;
    }
    for (;;) {
        const bool has_next = S.next(ui + 1, nxt);
        const char* nA = has_next ? (const char*)g.A + (size_t)nxt.pm * tstep : cA; const char* nB = has_next ? (const char*)g.Bt + (size_t)nxt.pn * tstep : cB;
        for (int t = 0; t < nt; t += 2) {
            const bool last = (t == nt - 2);
            const char* a1 = cA + (size_t)(t + 1) * kstep;
            const char* a2 = last ? nA : cA + (size_t)(t + 2) * kstep; const char* b2 = last ? nB : cB + (size_t)(t + 2) * kstep;
            const char* a3 = a2 + kstep; const char* b3 = b2 + kstep;
            if (last && has_next) S.a_ready(nxt);
            if constexpr (SP2) {
            PG8_LDB(B0, 0, 0); PG8_LDB(B1, 0, 1); PG8_SCHED; PG8_LDA(At, 0, 0); PG8_STAGE(PG8_SA(1, 1), a1 + hstep, voffA);
            PG8_WAIT_V(8); PG8_WAIT_L(0); PG8_BAR; PG8_MMA(0, 0, At, B0); PG8_MMA(0, 1, At, B1); PG8_BAR; PG8_SCHED;
            PG8_LDA(At, 0, 1); PG8_STAGE(PG8_SB(0, 0), b2, voffB); PG8_STAGE(PG8_SB(0, 1), b2 + hstep, voffB); PG8_STAGE(PG8_SA(0, 0), a2, voffA);
            PG8_WAIT_V(8); PG8_WAIT_L(0); PG8_BAR; PG8_MMA(1, 0, At, B0); PG8_MMA(1, 1, At, B1); PG8_BAR; PG8_SCHED;
            PG8_LDB(B0, 1, 0); PG8_LDB(B1, 1, 1); PG8_SCHED; PG8_LDA(At, 1, 0); PG8_STAGE(PG8_SA(0, 1), a2 + hstep, voffA);
            PG8_WAIT_V(8); PG8_WAIT_L(0); PG8_BAR; PG8_MMA(0, 0, At, B0); PG8_MMA(0, 1, At, B1); PG8_BAR; PG8_SCHED;
            PG8_LDA(At, 1, 1); PG8_STAGE(PG8_SB(1, 0), b3, voffB); PG8_STAGE(PG8_SB(1, 1), b3 + hstep, voffB); PG8_STAGE(PG8_SA(1, 0), a3, voffA);
            PG8_WAIT_V(8); PG8_WAIT_L(0); PG8_BAR; PG8_MMA(1, 0, At, B0); PG8_MMA(1, 1, At, B1); PG8_BAR; PG8_SCHED;
            } else {
            PG8_LDB(B0, 0, 0); PG8_SCHED; PG8_LDA(At, 0, 0); PG8_STAGE(PG8_SA(1, 1), a1 + hstep, voffA);
            PG8_WAIT_L(8); PG8_BAR; PG8_WAIT_L(0); PG8_MMA(0, 0, At, B0); PG8_BAR; PG8_SCHED;
            PG8_LDB(B1, 0, 1); PG8_STAGE(PG8_SB(0, 0), b2, voffB);
            PG8_BAR; PG8_WAIT_L(0); PG8_MMA(0, 1, At, B1); PG8_BAR;
            PG8_LDA(At, 0, 1); PG8_STAGE(PG8_SA(0, 0), a2, voffA);
            PG8_BAR; PG8_WAIT_L(0); PG8_MMA(1, 0, At, B0); PG8_BAR; PG8_SCHED;
            PG8_STAGE(PG8_SB(0, 1), b2 + hstep, voffB);
            PG8_WAIT_V(6); PG8_BAR; PG8_MMA(1, 1, At, B1); PG8_BAR;
            PG8_LDB(B0, 1, 0); PG8_SCHED; PG8_LDA(At, 1, 0); PG8_STAGE(PG8_SA(0, 1), a2 + hstep, voffA);
            PG8_WAIT_L(8); PG8_BAR; PG8_WAIT_L(0); PG8_MMA(0, 0, At, B0); PG8_BAR; PG8_SCHED;
            PG8_LDB(B1, 1, 1); PG8_STAGE(PG8_SB(1, 0), b3, voffB);
            PG8_BAR; PG8_WAIT_L(0); PG8_MMA(0, 1, At, B1); PG8_BAR;
            PG8_LDA(At, 1, 1); PG8_STAGE(PG8_SA(1, 0), a3, voffA);
            PG8_BAR; PG8_WAIT_L(0); PG8_MMA(1, 0, At, B0); PG8_BAR; PG8_SCHED;
            PG8_STAGE(PG8_SB(1, 1), b3 + hstep, voffB);
            PG8_WAIT_V(6); PG8_BAR; PG8_MMA(1, 1, At, B1); PG8_BAR;
            }
        }
        if constexpr (ALIGN_EPI) { if (wr == 0) PG8_BAR; }
        if constexpr (!Epi::AFTER_DRAIN) { E(acc, cur, wr, wc, fr, fq); S.done(cur); }
        if (!has_next) break;
#pragma unroll
        for (int a = 0; a < 2; ++a)
#pragma unroll
            for (int b = 0; b < 2; ++b)
#pragma unroll
                for (int m = 0; m < 4; ++m)
#pragma unroll
                    for (int n = 0; n < 2; ++n) acc[a][b][m][n] = (f32x4){0.f, 0.f, 0.f, 0.f};
        cur = nxt; cA = nA; cB = nB; ++ui;
        if constexpr (ALIGN_EPI) { if (wr == 1) PG8_BAR; }
    }
    PG8_WAIT_V(0);
    if constexpr (!ALIGN_EPI) { if (wr == 0) PG8_BAR; }
    PG8_BAR;
    if constexpr (Epi::AFTER_DRAIN) { E.fused(acc, cur, wr, wc, fr, fq, lds, wid, lane); S.done(cur); }
#undef PG8_SA
#undef PG8_SB
#undef PG8_STAGE
#undef PG8_LDA
#undef PG8_LDB
#undef PG8_MMA
#undef PG8_WAIT_V
#undef PG8_WAIT_L
#undef PG8_BAR
#undef PG8_SCHED
}
}
#define GAS __attribute__((address_space(1)))
#define LAS __attribute__((address_space(3)))
typedef unsigned short bf16;
typedef unsigned v4u __attribute__((ext_vector_type(4)));
typedef float f32x4 __attribute__((ext_vector_type(4)));
typedef short bf16x8 __attribute__((ext_vector_type(8)));
typedef GAS unsigned gu32;
typedef GAS unsigned long long gu64;
#define RLX_AGENT __ATOMIC_RELAXED, __HIP_MEMORY_SCOPE_AGENT
#define LDS_WAIT() asm volatile("s_waitcnt lgkmcnt(0)" ::: "memory")
#define VM_WAIT() asm volatile("s_waitcnt vmcnt(0)" ::: "memory")
__device__ __forceinline__ unsigned long long rt() { return __builtin_amdgcn_s_memrealtime(); }
__device__ __forceinline__ unsigned f2bf(float f) { unsigned u = __builtin_bit_cast(unsigned, f); return (u + 0x7fffu + ((u >> 16) & 1u)) >> 16; }
__device__ __forceinline__ unsigned pk2(float lo, float hi) { return f2bf(lo) | (f2bf(hi) << 16); }
#define XB_TMO      128
#define XB_XCNT(j)  (256  + 64 * (j))
#define XB_XSUB(j)  (1280 + 64 * (j))
#define XB_XGEN(j)  (2304 + 64 * (j))
#define XB_TOP      3328
#define XB_TOPGEN   3392
#define XCD_BAR_WORDS 3456
#define XB_SPIN_CAP (1u << 18)

__device__ __forceinline__ unsigned xb_ld(unsigned* p)              { return __hip_atomic_load(p, __ATOMIC_RELAXED, __HIP_MEMORY_SCOPE_AGENT); }
__device__ __forceinline__ unsigned xb_add(unsigned* p, unsigned v) { return __hip_atomic_fetch_add(p, v, __ATOMIC_RELAXED, __HIP_MEMORY_SCOPE_AGENT); }
__device__ __forceinline__ unsigned xb_xcc_id() { return (unsigned)__builtin_amdgcn_s_getreg((3 << 11) | 20) & 0xFu; }
#define XB_SPIN(cond, bar) do { unsigned _sp = 0; while (cond) { __builtin_amdgcn_s_sleep(1); \
    if ((++_sp & 255u) == 0u) { if (xb_ld(&(bar)[XB_TMO])) break; if (_sp > XB_SPIN_CAP) { atomicAdd(&(bar)[XB_TMO], 1u); break; } } } } while (0)

struct XcdBarrier {
    unsigned* bar; unsigned x;
    volatile LAS unsigned* st;
};

__device__ __forceinline__ XcdBarrier xcd_barrier_post(unsigned* bar, volatile LAS unsigned* st) {
    XcdBarrier b; b.bar = bar; b.x = xb_xcc_id(); b.st = st;
    if (threadIdx.x == 0) (void)xb_add(&bar[XB_XCNT(b.x)], 1u);
    return b;
}
__device__ __forceinline__ void xcd_barrier_complete(unsigned* bar, unsigned x, unsigned& nloc, unsigned& nx) {
    const unsigned G = gridDim.x * gridDim.y * gridDim.z;
    unsigned sum, cnt, mine, sp = 0u;
    for (;;) {
        sum = 0u; cnt = 0u; mine = 0u;
#pragma unroll
        for (unsigned j = 0; j < 16; ++j) { const unsigned c = xb_ld(&bar[XB_XCNT(j)]); sum += c; cnt += (c > 0u) ? 1u : 0u; mine = (j == x) ? c : mine; }
        if (sum == G) break;
        __builtin_amdgcn_s_sleep(1);
        if ((++sp & 255u) == 0u) { if (xb_ld(&bar[XB_TMO])) break; if (sp > XB_SPIN_CAP) { atomicAdd(&bar[XB_TMO], 1u); break; } }
    }
    nloc = mine > 0u ? mine : 1u; nx = cnt > 0u ? cnt : 1u;
}

__device__ __forceinline__ void xcd_barrier(const XcdBarrier& b) {
    asm volatile("s_waitcnt vmcnt(0)" ::: "memory");
    __syncthreads();
    if (threadIdx.x == 0) {
        unsigned* bar = b.bar;
        __builtin_amdgcn_s_waitcnt(0);
        unsigned nloc = b.st[0], nx = b.st[1];
        if (nloc == 0u) { xcd_barrier_complete(bar, b.x, nloc, nx); b.st[0] = nloc; b.st[1] = nx; }
        const unsigned old = xb_add(&bar[XB_XSUB(b.x)], 1u);
        const unsigned gen = old / nloc;
        if (old + 1u == (gen + 1u) * nloc) {
            __builtin_amdgcn_fence(__ATOMIC_RELEASE, "agent");
            asm volatile("s_waitcnt vmcnt(0)" ::: "memory");
            const unsigned og = xb_add(&bar[XB_TOP], 1u);
            const unsigned tg = og / nx;
            if (og + 1u == (tg + 1u) * nx) xb_add(&bar[XB_TOPGEN], 1u);
            else XB_SPIN(xb_ld(&bar[XB_TOPGEN]) == tg, bar);
            __builtin_amdgcn_fence(__ATOMIC_ACQUIRE, "agent");
            xb_add(&bar[XB_XGEN(b.x)], 1u);
            asm volatile("s_waitcnt vmcnt(0)" ::: "memory");
        } else {
            XB_SPIN(xb_ld(&bar[XB_XGEN(b.x)]) == gen, bar);
            __builtin_amdgcn_fence(__ATOMIC_ACQUIRE, "agent");
            asm volatile("s_waitcnt vmcnt(0)" ::: "memory");
        }
    }
    __syncthreads();
}

constexpr int NB = 2, SEQ = 8192, D = 1024, M = NB * SEQ;
constexpr int NPROJ = 3584, IN_COLS = 3592;
constexpr int NE = 32, TOPK = 4, DFF = 1024;
constexpr int NROWS_MAX = M * TOPK + NE * 256;
constexpr int MAXRT = NROWS_MAX / 256;
constexpr float EPS = 1e-6f;
constexpr int PC_Q = 0, PC_K = 512, PC_V = 1024, PC_G = 1536, PC_Z = 2048, PC_X = 2560;
constexpr int NCHUNK = M / 64;
constexpr int NWAVES = 8, NTHR = 512;

constexpr size_t MiB = 1u << 20;
constexpr size_t WS_CTL = 0, CTL_ZERO_BYTES = 1 * MiB;
constexpr size_t WS_MODP = 1 * MiB;
constexpr size_t WS_MODF = WS_MODP + 512 * 1024;
constexpr size_t WS_BLKCNT = WS_MODF + 256 * 1024;
constexpr size_t WS_DT = 2 * MiB;
constexpr size_t WS_TOK = 3 * MiB;
constexpr size_t WS_WIN = 4 * MiB, WS_WOUT = 11 * MiB, WS_W1 = 16 * MiB, WS_W2 = 144 * MiB;
constexpr size_t WS_H = 208 * MiB, WS_P = 240 * MiB, WS_LF = 352 * MiB, WS_MIX = 384 * MiB, WS_X1 = 416 * MiB;
constexpr size_t WS_XG = 480 * MiB, WS_ACT = 624 * MiB, WS_END = 768 * MiB;
constexpr int CW_TMO = 0, CW_BAR = 4096;

constexpr int RING_BYTES = 131072, AUX_OFF = RING_BYTES  , MISC_OFF = 147456, LDS_BYTES = 151552;

struct Args { const float* in[23]; float* out; unsigned char* ws; int ph_lo, ph_hi; };
enum { I_X = 0, I_C, I_ADAW, I_ADAB, I_N1W, I_WIN, I_LBL, I_HGNW, I_ALOG, I_DTB, I_SSMD, I_CONVW, I_CONVB, I_SSMNW, I_WOUT, I_N2W, I_RW, I_RB, I_W1, I_B1, I_W2, I_B2, I_FNW };

__device__ __forceinline__ float bf2f(bf16 v) { return __uint_as_float(((unsigned)v) << 16); }
__device__ __forceinline__ float wave_sum(float v) {
#pragma unroll
    for (int o = 1; o < 64; o <<= 1) v += __shfl_xor(v, o);
    return v;
}
__device__ __forceinline__ float wave_max(float v) {
#pragma unroll
    for (int o = 1; o < 64; o <<= 1) v = fmaxf(v, __shfl_xor(v, o));
    return v;
}
__device__ __forceinline__ float sigmoid_f(float x) { return __builtin_amdgcn_rcpf(1.0f + __expf(-x)); }
__device__ __forceinline__ float silu_f(float x) { return x * sigmoid_f(x); }

namespace pg8 {
struct EpiIn {
    static constexpr bool PERM = true, AFTER_DRAIN = false;
    bf16_t* P; float* LF; const float* lbl;
    __device__ __forceinline__ void operator()(const f32x4 (&acc)[2][2][4][2], const Unit& u, int wr, int wc, int fr, int fq) const {
        const int row0 = u.pm * BM + wr * 64 + fr, col0 = u.pn * BM + wc * 32 + 8 * fq;
        const int mode = (u.pn < 2) ? 1 : (u.pn < 4) ? 2 : (u.pn < 6) ? 0 : (u.pn < 10) ? 1 : 0;
        if (mode == 2) {
            float oml[2][8];
#pragma unroll
            for (int bj = 0; bj < 2; ++bj)
#pragma unroll
                for (int j = 0; j < 8; ++j) { const int cf = col0 + bj * HALF + j - 512; const float l0 = lbl[cf], l1 = lbl[512 + cf]; oml[bj][j] = 1.0f - 1.0f / (1.0f + __expf(l1 - l0)); }
#pragma unroll
            for (int ai = 0; ai < 2; ++ai)
#pragma unroll
                for (int m = 0; m < 4; ++m) { const size_t r = (size_t)(row0 + ai * HALF + m * 16);
#pragma unroll
                    for (int bj = 0; bj < 2; ++bj) { float kv[8], lf[8];
#pragma unroll
                        for (int j = 0; j < 8; ++j) { const float f = acc[ai][bj][m][j >> 2][j & 3]; const float k = oml[bj][j] * sigmoid_f(-f); kv[j] = k; lf[j] = __logf(1.0f - k); }
                        u32x4 w; w.x = cvt_pk_bf16(kv[0], kv[1]); w.y = cvt_pk_bf16(kv[2], kv[3]); w.z = cvt_pk_bf16(kv[4], kv[5]); w.w = cvt_pk_bf16(kv[6], kv[7]);
                        *(u32x4*)(P + r * NPROJ + col0 + bj * HALF) = w;
                        float* lp = LF + r * 512 + (col0 + bj * HALF - 512);
                        *(f32x4*)lp = (f32x4){lf[0], lf[1], lf[2], lf[3]}; *(f32x4*)(lp + 4) = (f32x4){lf[4], lf[5], lf[6], lf[7]}; } }
        } else {
#pragma unroll
            for (int ai = 0; ai < 2; ++ai)
#pragma unroll
                for (int m = 0; m < 4; ++m) { bf16_t* rowp = P + (size_t)(row0 + ai * HALF + m * 16) * NPROJ + col0;
#pragma unroll
                    for (int bj = 0; bj < 2; ++bj) { f32x4 v0 = acc[ai][bj][m][0], v1 = acc[ai][bj][m][1];
                        if (mode == 1) {
#pragma unroll
                            for (int j = 0; j < 4; ++j) { v0[j] = silu_f(v0[j]); v1[j] = silu_f(v1[j]); } }
                        u32x4 w; w.x = cvt_pk_bf16(v0[0], v0[1]); w.y = cvt_pk_bf16(v0[2], v0[3]); w.z = cvt_pk_bf16(v1[0], v1[1]); w.w = cvt_pk_bf16(v1[2], v1[3]);
                        *(u32x4*)(rowp + bj * HALF) = w; } }
        }
    }
};
struct EpiOut {
    static constexpr bool PERM = false, AFTER_DRAIN = false;
    const float* x; float* x1; const float* g1;
    __device__ __forceinline__ void operator()(const f32x4 (&acc)[2][2][4][2], const Unit& u, int wr, int wc, int fr, int fq) const {
        const int row0 = u.pm * BM + wr * 64 + fr, col0 = u.pn * BM + wc * 32 + 4 * fq;
        const float* gb = g1 + ((u.pm * BM) >> 13) * 6144 + col0;
        f32x4 gv[2][2];
#pragma unroll
        for (int bj = 0; bj < 2; ++bj)
#pragma unroll
            for (int n = 0; n < 2; ++n) gv[bj][n] = *(const f32x4*)(gb + bj * HALF + n * 16);
#pragma unroll
        for (int ai = 0; ai < 2; ++ai)
#pragma unroll
            for (int m = 0; m < 4; ++m) { const size_t off = (size_t)(row0 + ai * HALF + m * 16) * D + col0;
#pragma unroll
                for (int bj = 0; bj < 2; ++bj)
#pragma unroll
                    for (int n = 0; n < 2; ++n) { const f32x4 xv = *(const f32x4*)(x + off + bj * HALF + n * 16); *(f32x4*)(x1 + off + bj * HALF + n * 16) = xv + gv[bj][n] * acc[ai][bj][m][n]; } }
    }
};
struct EpiW1 {
    static constexpr bool PERM = true, AFTER_DRAIN = false;
    bf16_t* ACT; const float* b1;
    __device__ __forceinline__ void operator()(const f32x4 (&acc)[2][2][4][2], const Unit& u, int wr, int wc, int fr, int fq) const {
        const int e = u.pn >> 3, pn = u.pn & 7;
        const int row0 = u.pm * BM + wr * 64 + fr, cj = pn * 128 + wc * 32 + 8 * fq;
        const float* bg = b1 + e * 2048 + cj;
        const f32x4 bg0 = *(const f32x4*)bg, bg1 = *(const f32x4*)(bg + 4), bl0 = *(const f32x4*)(bg + 1024), bl1 = *(const f32x4*)(bg + 1028);
#pragma unroll
        for (int ai = 0; ai < 2; ++ai)
#pragma unroll
            for (int m = 0; m < 4; ++m) {
                f32x4 g0 = acc[ai][0][m][0] + bg0, g1 = acc[ai][0][m][1] + bg1, l0 = acc[ai][1][m][0] + bl0, l1 = acc[ai][1][m][1] + bl1;
                float o[8];
#pragma unroll
                for (int j = 0; j < 4; ++j) {
                    float g = fminf(g0[j], 7.0f), l = fminf(fmaxf(l0[j], -7.0f), 7.0f); o[j] = g * sigmoid_f(1.702f * g) * (l + 1.0f);
                    g = fminf(g1[j], 7.0f); l = fminf(fmaxf(l1[j], -7.0f), 7.0f); o[4 + j] = g * sigmoid_f(1.702f * g) * (l + 1.0f); }
                u32x4 w; w.x = cvt_pk_bf16(o[0], o[1]); w.y = cvt_pk_bf16(o[2], o[3]); w.z = cvt_pk_bf16(o[4], o[5]); w.w = cvt_pk_bf16(o[6], o[7]);
                *(u32x4*)(ACT + (size_t)(row0 + ai * HALF + m * 16) * DFF + cj) = w; }
    }
};
struct EpiW2 {
    static constexpr bool PERM = true, AFTER_DRAIN = false;
    bf16_t* Y; const float* b2;
    __device__ __forceinline__ void operator()(const f32x4 (&acc)[2][2][4][2], const Unit& u, int wr, int wc, int fr, int fq) const {
        const int e = u.pn >> 2, pn = u.pn & 3;
        const int row0 = u.pm * BM + wr * 64 + fr, col0 = pn * BM + wc * 32 + 8 * fq;
        const float* bb = b2 + e * 1024 + col0;
        f32x4 bv[2][2];
#pragma unroll
        for (int bj = 0; bj < 2; ++bj) { bv[bj][0] = *(const f32x4*)(bb + bj * HALF); bv[bj][1] = *(const f32x4*)(bb + bj * HALF + 4); }
#pragma unroll
        for (int ai = 0; ai < 2; ++ai)
#pragma unroll
            for (int m = 0; m < 4; ++m) { bf16_t* rowp = Y + (size_t)(row0 + ai * HALF + m * 16) * D + col0;
#pragma unroll
                for (int bj = 0; bj < 2; ++bj) { const f32x4 v0 = acc[ai][bj][m][0] + bv[bj][0], v1 = acc[ai][bj][m][1] + bv[bj][1];
                    u32x4 w; w.x = cvt_pk_bf16(v0[0], v0[1]); w.y = cvt_pk_bf16(v0[2], v0[3]); w.z = cvt_pk_bf16(v1[0], v1[1]); w.w = cvt_pk_bf16(v1[2], v1[3]);
                    *(u32x4*)(rowp + bj * HALF) = w; } }
    }
};
struct MoeOrder {
    const PG8_LAS int* rt2e; int NT, nwg, G, c;
    __device__ __forceinline__ bool next(int i, Unit& u) const {
        const long L = (long)i * G + c; if (L >= nwg) return false;
        int wgid = (int)L; { const int q = nwg / NXCD, r = nwg % NXCD, xcd = wgid % NXCD, off = wgid / NXCD; wgid = (xcd < r ? xcd * (q + 1) : r * (q + 1) + (xcd - r) * q) + off; }
        const int rt = wgid / NT, pn = wgid % NT; const int e = __builtin_amdgcn_readfirstlane(rt2e[rt]);
        u.pm = rt; u.pn = e * NT + pn; return true;
    }
    __device__ __forceinline__ void a_ready(const Unit&) const {}
    __device__ __forceinline__ void done(const Unit&) const {}
};
}

__device__ __forceinline__ void transpose_item(const float* __restrict__ W, int ldw, int k0, int c0, bf16* WT, int drow0, LAS float* scr, int lane) {
#pragma unroll 8
    for (int i = 0; i < 32; ++i) { const int kk = 2 * i + (lane >> 5); scr[kk * 33 + (lane & 31)] = W[(size_t)(k0 + kk) * ldw + c0 + (lane & 31)]; }
    LDS_WAIT(); asm volatile("" ::: "memory");
    const int c = lane & 7;
#pragma unroll
    for (int j = 0; j < 4; ++j) { const int n = (lane >> 3) + 8 * j; const LAS float* s = scr + (8 * c) * 33 + n;
        v4u o; o.x = pk2(s[0 * 33], s[1 * 33]); o.y = pk2(s[2 * 33], s[3 * 33]); o.z = pk2(s[4 * 33], s[5 * 33]); o.w = pk2(s[6 * 33], s[7 * 33]);
        *(GAS v4u*)(WT + (size_t)(drow0 + n) * 1024 + k0 + 8 * c) = o; }
    LDS_WAIT(); asm volatile("" ::: "memory");
}
__device__ __forceinline__ void p0_prologue(const Args& a, LAS unsigned char* lds, int bid, int G, int wave, int lane) {
    unsigned char* ws = a.ws;
    const int gw = bid * NWAVES + wave, NGW = G * NWAVES;
    for (int it = gw; it < 192; it += NGW) {
        const int nc = it % 24, kc = it / 24, n = nc * 256 + 4 * lane;
        const float* W = a.in[I_ADAW]; const float* c = a.in[I_C];
        f32x4 a0 = {0.f, 0.f, 0.f, 0.f}, a1 = {0.f, 0.f, 0.f, 0.f};
#pragma unroll 8
        for (int kk = 0; kk < 128; ++kk) { const int k = kc * 128 + kk; const f32x4 w = *(const f32x4*)(W + (size_t)k * 6144 + n);
            const float c0 = silu_f(c[k]), c1 = silu_f(c[1024 + k]); a0 += c0 * w; a1 += c1 * w; }
        float* mp = (float*)(ws + WS_MODP);
        *(f32x4*)(mp + (size_t)(kc * 2 + 0) * 6144 + n) = a0; *(f32x4*)(mp + (size_t)(kc * 2 + 1) * 6144 + n) = a1;
    }
    LAS float* scr = (LAS float*)(lds + wave * 16384);
    constexpr int I_IN = 16 * 112, I_OUT = 16 * 32, I_E1 = NE * 16 * 64, I_E2 = NE * 16 * 32, NITEMS = I_IN + I_OUT + I_E1 + I_E2;
    for (int it = gw; it < NITEMS; it += NGW) {
        int r = it;
        if (r < I_IN) { const int kb = r / 112, nb = r % 112; transpose_item(a.in[I_WIN], IN_COLS, 64 * kb, 32 * nb, (bf16*)(ws + WS_WIN), 32 * nb, scr, lane); continue; } r -= I_IN;
        if (r < I_OUT) { const int kb = r / 32, nb = r % 32; transpose_item(a.in[I_WOUT], D, 64 * kb, 32 * nb, (bf16*)(ws + WS_WOUT), 32 * nb, scr, lane); continue; } r -= I_OUT;
        if (r < I_E1) { const int e = r >> 10, r2 = r & 1023, kb = r2 >> 6, nb = r2 & 63, c0 = 32 * nb;
            const int drow = (c0 < 1024) ? (256 * (c0 >> 7) + (c0 & 127)) : (256 * ((c0 - 1024) >> 7) + 128 + (c0 & 127));
            transpose_item(a.in[I_W1] + (size_t)e * 1024 * 2048, 2048, 64 * kb, c0, (bf16*)(ws + WS_W1), e * 2048 + drow, scr, lane); continue; } r -= I_E1;
        { const int e = r >> 9, r2 = r & 511, kb = r2 >> 5, nb = r2 & 31;
            transpose_item(a.in[I_W2] + (size_t)e * 1024 * 1024, 1024, 64 * kb, 32 * nb, (bf16*)(ws + WS_W2), e * 1024 + 32 * nb, scr, lane); }
    }
}

__device__ __forceinline__ void load_mod_AS(LAS float* A, LAS float* S, const float* normw, const float* src, int nparts, const float* bias, int b, int shift_off, int tid) {
    for (int k = tid; k < 1024; k += NTHR) {
        float sh = bias ? bias[shift_off + k] : 0.f, sc = bias ? bias[shift_off + 1024 + k] : 0.f;
        for (int p = 0; p < nparts; ++p) { const float* q = src + (size_t)(p * 2 + b) * 6144 + shift_off; sh += q[k]; sc += q[1024 + k]; }
        A[k] = normw[k] * (1.0f + sc); S[k] = sh;
    }
}
__device__ __forceinline__ float softplus_f(float x) { return fmaxf(x, 0.f) + log1pf(__expf(-fabsf(x))); }

__device__ __forceinline__ void p1_norm(const Args& a, LAS unsigned char* lds, int bid, int G, int tid, int wave, int lane) {
    unsigned char* ws = a.ws;
    LAS float* A1 = (LAS float*)(lds); LAS float* S1 = A1 + 1024; LAS float* WDT = S1 + 1024;
    const float* modp = (const float*)(ws + WS_MODP);
    for (int idx = bid * NTHR + tid; idx < 2 * 6144; idx += G * NTHR) { const int b = idx / 6144, n = idx % 6144; float s = a.in[I_ADAB][n];
        for (int p = 0; p < 8; ++p) s += modp[(size_t)(p * 2 + b) * 6144 + n];
        ((float*)(ws + WS_MODF))[idx] = s; }
    for (int idx = tid; idx < 8192; idx += NTHR) { const int k = idx >> 3, jj = idx & 7; WDT[jj * 1024 + k] = a.in[I_WIN][(size_t)k * IN_COLS + NPROJ + jj]; }
    const float* x = a.in[I_X]; bf16* H = (bf16*)(ws + WS_H); float* DT = (float*)(ws + WS_DT);
    for (int c = bid; c < NCHUNK; c += G) {
        const int b = c >> 7;
        __syncthreads();
        load_mod_AS(A1, S1, a.in[I_N1W], modp, 8, a.in[I_ADAB], b, 0, tid);
        __syncthreads();
        for (int r = 0; r < 8; ++r) {
            const int m = c * 64 + wave * 8 + r;
            const GAS f32x4* xr = (const GAS f32x4*)(x + (size_t)m * D) + lane;
            f32x4 v[4]; float ss = 0.f;
#pragma unroll
            for (int j = 0; j < 4; ++j) { v[j] = xr[64 * j]; ss += (v[j].x * v[j].x + v[j].y * v[j].y) + (v[j].z * v[j].z + v[j].w * v[j].w); }
            const float rstd = rsqrtf(wave_sum(ss) * (1.0f / D) + EPS);
            float dacc[8];
#pragma unroll
            for (int jj = 0; jj < 8; ++jj) dacc[jj] = 0.f;
            GAS unsigned long long* o8 = (GAS unsigned long long*)(H + (size_t)m * D) + lane;
#pragma unroll
            for (int j = 0; j < 4; ++j) {
                const f32x4 av = *(const LAS f32x4*)(A1 + 256 * j + 4 * lane), sv = *(const LAS f32x4*)(S1 + 256 * j + 4 * lane);
                const f32x4 h = v[j] * rstd * av + sv;
                o8[64 * j] = (unsigned long long)pk2(h.x, h.y) | ((unsigned long long)pk2(h.z, h.w) << 32);
#pragma unroll
                for (int jj = 0; jj < 8; ++jj) { const f32x4 w = *(const LAS f32x4*)(WDT + jj * 1024 + 256 * j + 4 * lane); dacc[jj] += (h.x * w.x + h.y * w.y) + (h.z * w.z + h.w * w.w); }
            }
            float mine = 0.f;
#pragma unroll
            for (int jj = 0; jj < 8; ++jj) { const float s = wave_sum(dacc[jj]); mine = (lane == jj) ? s : mine; }
            if (lane < 8) DT[(size_t)m * 8 + lane] = softplus_f(mine + a.in[I_DTB][lane]);
        }
    }
}

__device__ __forceinline__ void hgrn_naive(const Args& a, LAS unsigned char* lds, int bh, int tid, int wave, int lane) {
    unsigned char* ws = a.ws;
    const int b = bh >> 2, h = bh & 3, j = tid & 127, kq = tid >> 7;
    LAS float* FE = (LAS float*)lds; LAS float* KK = FE + 2048; LAS float* QQ = KK + 2048; LAS float* VV = QQ + 2048; LAS float* RED = VV + 2048;
    const bf16* P = (const bf16*)(ws + WS_P); const float* LF = (const float*)(ws + WS_LF); bf16* MIX = (bf16*)(ws + WS_MIX);
    const float* nw = a.in[I_HGNW];
    float S[32];
#pragma unroll
    for (int i = 0; i < 32; ++i) S[i] = 0.f;
    for (int t0 = 0; t0 < SEQ; t0 += 16) {
        for (int idx = tid; idx < 2048; idx += NTHR) { const int tt = idx >> 7, k = idx & 127; const size_t row = (size_t)b * SEQ + t0 + tt;
            FE[idx] = __expf(LF[row * 512 + h * 128 + k]); KK[idx] = bf2f(P[row * NPROJ + PC_K + h * 128 + k]);
            QQ[idx] = bf2f(P[row * NPROJ + PC_Q + h * 128 + k]); VV[idx] = bf2f(P[row * NPROJ + PC_V + h * 128 + k]); }
        __syncthreads();
#pragma unroll 2
        for (int tt = 0; tt < 16; ++tt) {
            const float vj = VV[tt * 128 + j]; float p = 0.f;
#pragma unroll
            for (int i4 = 0; i4 < 8; ++i4) {
                const f32x4 f4 = *(const LAS f32x4*)(FE + tt * 128 + 32 * kq + 4 * i4), k4 = *(const LAS f32x4*)(KK + tt * 128 + 32 * kq + 4 * i4), q4 = *(const LAS f32x4*)(QQ + tt * 128 + 32 * kq + 4 * i4);
#pragma unroll
                for (int c = 0; c < 4; ++c) { S[4 * i4 + c] = f4[c] * S[4 * i4 + c] + k4[c] * vj; p += S[4 * i4 + c] * q4[c]; }
            }
            RED[(kq * 16 + tt) * 128 + j] = p;
        }
        __syncthreads();
#pragma unroll
        for (int r = 0; r < 2; ++r) { const int tt = 2 * wave + r; const size_t row = (size_t)b * SEQ + t0 + tt;
            float o0 = 0.f, o1 = 0.f;
#pragma unroll
            for (int q = 0; q < 4; ++q) { o0 += RED[(q * 16 + tt) * 128 + lane]; o1 += RED[(q * 16 + tt) * 128 + 64 + lane]; }
            const float rstd = rsqrtf(wave_sum(o0 * o0 + o1 * o1) * (1.0f / 128.0f) + EPS);
            MIX[row * D + h * 128 + lane] = (bf16)f2bf(o0 * rstd * nw[lane] * bf2f(P[row * NPROJ + PC_G + h * 128 + lane]));
            MIX[row * D + h * 128 + 64 + lane] = (bf16)f2bf(o1 * rstd * nw[64 + lane] * bf2f(P[row * NPROJ + PC_G + h * 128 + 64 + lane])); }
    }
}
__device__ __forceinline__ void ssd_naive(const Args& a, LAS unsigned char* lds, int bg, int tid, int wave, int lane) {
    unsigned char* ws = a.ws;
    const int b = bg >> 1, g = bg & 1, p = tid & 63, hl = wave >> 1, nh = wave & 1;
    LAS float* XS = (LAS float*)lds; LAS float* BM = XS + 4096; LAS float* CM = BM + 2048; LAS float* DTL = CM + 2048; LAS float* DEC = DTL + 64; LAS float* RED = DEC + 64;
    const bf16* P = (const bf16*)(ws + WS_P); const float* DT = (const float*)(ws + WS_DT); bf16* MIX = (bf16*)(ws + WS_MIX);
    const float* cw = a.in[I_CONVW]; const float* cb = a.in[I_CONVB];
    float hS[64];
#pragma unroll
    for (int i = 0; i < 64; ++i) hS[i] = 0.f;
    for (int t0 = 0; t0 < SEQ; t0 += 16) {
        for (int idx = tid; idx < 16 * 512; idx += NTHR) { const int tt = idx >> 9, cc = idx & 511, t = t0 + tt;
            const int ch = (cc < 256) ? (g * 256 + cc) : (cc < 384) ? (512 + g * 128 + (cc - 256)) : (768 + g * 128 + (cc - 384));
            float v = cb[ch];
#pragma unroll
            for (int w = 0; w < 4; ++w) { const int ts = t - 3 + w; if (ts >= 0) v += bf2f(P[((size_t)b * SEQ + ts) * NPROJ + PC_X + ch]) * cw[w * 1024 + ch]; }
            v = silu_f(v);
            if (cc < 256) XS[tt * 256 + cc] = v; else if (cc < 384) BM[tt * 128 + cc - 256] = v; else CM[tt * 128 + cc - 384] = v; }
        if (tid < 64) { const int tt = tid >> 2, hh = tid & 3; const float dtv = DT[((size_t)b * SEQ + t0 + tt) * 8 + g * 4 + hh]; DTL[tid] = dtv; DEC[tid] = __expf(-dtv * __expf(a.in[I_ALOG][g * 4 + hh])); }
        __syncthreads();
#pragma unroll 2
        for (int tt = 0; tt < 16; ++tt) {
            const float dec = DEC[tt * 4 + hl], xdt = XS[tt * 256 + hl * 64 + p] * DTL[tt * 4 + hl]; float y = 0.f;
#pragma unroll
            for (int i4 = 0; i4 < 16; ++i4) { const f32x4 B4 = *(const LAS f32x4*)(BM + tt * 128 + nh * 64 + 4 * i4), C4 = *(const LAS f32x4*)(CM + tt * 128 + nh * 64 + 4 * i4);
#pragma unroll
                for (int c = 0; c < 4; ++c) { hS[4 * i4 + c] = dec * hS[4 * i4 + c] + xdt * B4[c]; y += hS[4 * i4 + c] * C4[c]; } }
            RED[(nh * 16 + tt) * 256 + hl * 64 + p] = y;
        }
        __syncthreads();
#pragma unroll
        for (int r = 0; r < 2; ++r) { const int tt = 2 * wave + r; const size_t row = (size_t)b * SEQ + t0 + tt;
            float yv[4], ss = 0.f;
#pragma unroll
            for (int i = 0; i < 4; ++i) { const int c = lane + 64 * i; float y = RED[tt * 256 + c] + RED[(16 + tt) * 256 + c] + a.in[I_SSMD][g * 4 + i] * XS[tt * 256 + c];
                y *= bf2f(P[row * NPROJ + PC_Z + g * 256 + c]); yv[i] = y; ss += y * y; }
            const float rstd = rsqrtf(wave_sum(ss) * (1.0f / 256.0f) + EPS);
#pragma unroll
            for (int i = 0; i < 4; ++i) { const int c = lane + 64 * i; MIX[row * D + 512 + g * 256 + c] = (bf16)f2bf(yv[i] * rstd * a.in[I_SSMNW][g * 256 + c]); }
        }
        __syncthreads();
    }
}

__device__ __forceinline__ void p5_router(const Args& a, LAS unsigned char* lds, int bid, int G, int tid, int wave, int lane) {
    unsigned char* ws = a.ws;
    LAS float* RWT = (LAS float*)lds;
    LAS float* A2 = (LAS float*)(lds + AUX_OFF); LAS float* S2 = A2 + 1024;
    LAS int* SEL = (LAS int*)(S2 + 1024); LAS float* SELG = (LAS float*)(SEL + 256); LAS int* LSL = (LAS int*)(SELG + 256);
    const float* modf = (const float*)(ws + WS_MODF);
    for (int idx = tid; idx < 32768; idx += NTHR) { const int k = idx >> 5, e = idx & 31; RWT[e * 1024 + k] = a.in[I_RW][idx]; }
    const float* x1 = (const float*)(ws + WS_X1); bf16* H = (bf16*)(ws + WS_H);
    int* tok_e = (int*)(ws + WS_TOK); int* tok_ls = tok_e + M * 4; float* tok_g = (float*)(tok_ls + M * 4);
    int* blkcnt = (int*)(ws + WS_BLKCNT);
    for (int c = bid; c < NCHUNK; c += G) {
        const int b = c >> 7;
        __syncthreads();
        load_mod_AS(A2, S2, a.in[I_N2W], modf, 1, nullptr, b, 3 * 1024, tid);
        __syncthreads();
        for (int r = 0; r < 8; ++r) {
            const int m = c * 64 + wave * 8 + r;
            const GAS f32x4* xr = (const GAS f32x4*)(x1 + (size_t)m * D) + lane;
            f32x4 v[4]; float ss = 0.f;
#pragma unroll
            for (int j = 0; j < 4; ++j) { v[j] = xr[64 * j]; ss += (v[j].x * v[j].x + v[j].y * v[j].y) + (v[j].z * v[j].z + v[j].w * v[j].w); }
            const float rstd = rsqrtf(wave_sum(ss) * (1.0f / D) + EPS);
            GAS unsigned long long* o8 = (GAS unsigned long long*)(H + (size_t)m * D) + lane;
#pragma unroll
            for (int j = 0; j < 4; ++j) {
                const f32x4 av = *(const LAS f32x4*)(A2 + 256 * j + 4 * lane), sv = *(const LAS f32x4*)(S2 + 256 * j + 4 * lane);
                v[j] = v[j] * rstd * av + sv;
                o8[64 * j] = (unsigned long long)pk2(v[j].x, v[j].y) | ((unsigned long long)pk2(v[j].z, v[j].w) << 32);
            }
            float mine = -INFINITY;
#pragma unroll 4
            for (int e = 0; e < 32; ++e) { float d = 0.f;
#pragma unroll
                for (int j = 0; j < 4; ++j) { const f32x4 w = *(const LAS f32x4*)(RWT + e * 1024 + 256 * j + 4 * lane); d += (v[j].x * w.x + v[j].y * w.y) + (v[j].z * w.z + v[j].w * w.w); }
                d = wave_sum(d); mine = (lane == e) ? d : mine; }
            if (lane < 32) mine += a.in[I_RB][lane];
            float tv[4]; int ti[4];
#pragma unroll
            for (int k = 0; k < 4; ++k) { const float mx = wave_max(mine); const unsigned long long bal = __ballot(mine == mx); const int idx = __builtin_ctzll(bal);
                tv[k] = mx; ti[k] = idx; mine = (lane == idx) ? -INFINITY : mine; }
            const float e1 = __expf(tv[1] - tv[0]), e2 = __expf(tv[2] - tv[0]), e3 = __expf(tv[3] - tv[0]), inv = 1.0f / (1.0f + e1 + e2 + e3);
            if (lane < 4) { const int ent = (wave * 8 + r) * 4 + lane;
                SEL[ent] = (lane == 0) ? ti[0] : (lane == 1) ? ti[1] : (lane == 2) ? ti[2] : ti[3];
                SELG[ent] = ((lane == 0) ? 1.0f : (lane == 1) ? e1 : (lane == 2) ? e2 : e3) * inv; }
        }
        __syncthreads();
        if (wave == 0 && lane < 32) { int cnt = 0;
            for (int i = 0; i < 256; ++i) { if (SEL[i] == lane) { LSL[i] = cnt; ++cnt; } }
            blkcnt[c * 32 + lane] = cnt; }
        __syncthreads();
        if (tid < 256) { const size_t o = (size_t)c * 256 + tid; tok_e[o] = SEL[tid]; tok_ls[o] = LSL[tid]; tok_g[o] = SELG[tid]; }
    }
}

__device__ __forceinline__ void moe_tables(const Args& a, LAS unsigned char* lds, int c, int wave, int lane) {
    LAS int* TS = (LAS int*)(lds + MISC_OFF + 256); LAS int* RT2E = TS + 64; LAS int* BASE = (LAS int*)(lds + AUX_OFF);
    const int* blkcnt = (const int*)(a.ws + WS_BLKCNT);
    if (wave == 0) {
        int total = 0, base = 0;
        if (lane < 32) for (int cc = 0; cc < NCHUNK; ++cc) { const int v = blkcnt[cc * 32 + lane]; base += (cc < c) ? v : 0; total += v; }
        const int tiles = (lane < 32) ? ((total + 255) >> 8) : 0;
        int incl = tiles;
#pragma unroll
        for (int o = 1; o < 32; o <<= 1) { const int t = __shfl_up(incl, o); if (lane >= o) incl += t; }
        const int start = incl - tiles;
        if (lane < 32) { TS[lane] = start; BASE[lane] = start * 256 + base; for (int t = start; t < incl; ++t) RT2E[t] = lane; }
        if (lane == 31) TS[32] = incl;
    }
}
__device__ __forceinline__ void p6_gather(const Args& a, LAS unsigned char* lds, int bid, int G, int tid, int wave, int lane) {
    unsigned char* ws = a.ws;
    LAS int* BASE = (LAS int*)(lds + AUX_OFF);
    const int* tok_e = (const int*)(ws + WS_TOK); const int* tok_ls = tok_e + M * 4; int* tok_pos = (int*)(ws + WS_TOK) + 3 * M * 4;
    const bf16* H = (const bf16*)(ws + WS_H); bf16* XG = (bf16*)(ws + WS_XG);
    if (bid >= NCHUNK) { moe_tables(a, lds, NCHUNK, wave, lane); __syncthreads(); }
    for (int c = bid; c < NCHUNK; c += G) {
        __syncthreads();
        moe_tables(a, lds, c, wave, lane);
        __syncthreads();
        for (int i = wave; i < 256; i += NWAVES) {
            const size_t o = (size_t)c * 256 + i; const int e = tok_e[o]; const int pos = BASE[e] + tok_ls[o];
            if (lane == 0) tok_pos[o] = pos;
            const GAS v4u* src = (const GAS v4u*)(H + (size_t)(c * 64 + (i >> 2)) * D); GAS v4u* dst = (GAS v4u*)(XG + (size_t)pos * D);
            dst[lane] = src[lane]; dst[64 + lane] = src[64 + lane];
        }
    }
}

__device__ __forceinline__ void p9_final(const Args& a, int bid, int G, int wave, int lane) {
    unsigned char* ws = a.ws;
    const float* x1 = (const float*)(ws + WS_X1); const bf16* Y = (const bf16*)(ws + WS_XG);
    const float* tok_g = (const float*)(ws + WS_TOK) + 2 * M * 4; const int* tok_pos = (const int*)(ws + WS_TOK) + 3 * M * 4;
    const float* modf = (const float*)(ws + WS_MODF); const float* fnw = a.in[I_FNW]; float* out = a.out;
    const int gw = bid * NWAVES + wave, NGW = G * NWAVES;
    for (int m = gw; m < M; m += NGW) {
        const int b = m >> 13; const float* g2 = modf + b * 6144 + 5 * 1024;
        f32x4 mo[4];
#pragma unroll
        for (int j = 0; j < 4; ++j) mo[j] = (f32x4){0.f, 0.f, 0.f, 0.f};
#pragma unroll
        for (int k = 0; k < 4; ++k) { const float gk = tok_g[(size_t)m * 4 + k]; const int pos = tok_pos[(size_t)m * 4 + k];
            const GAS unsigned long long* yr = (const GAS unsigned long long*)(Y + (size_t)pos * D) + lane;
#pragma unroll
            for (int j = 0; j < 4; ++j) { const unsigned long long w = yr[64 * j]; const unsigned lo = (unsigned)w, hi = (unsigned)(w >> 32);
                mo[j].x += gk * __uint_as_float(lo << 16); mo[j].y += gk * __uint_as_float(lo & 0xffff0000u); mo[j].z += gk * __uint_as_float(hi << 16); mo[j].w += gk * __uint_as_float(hi & 0xffff0000u); } }
        const GAS f32x4* xr = (const GAS f32x4*)(x1 + (size_t)m * D) + lane;
        f32x4 v[4]; float ss = 0.f;
#pragma unroll
        for (int j = 0; j < 4; ++j) { const f32x4 gv = *(const f32x4*)(g2 + 256 * j + 4 * lane); v[j] = xr[64 * j] + gv * mo[j]; ss += (v[j].x * v[j].x + v[j].y * v[j].y) + (v[j].z * v[j].z + v[j].w * v[j].w); }
        const float rstd = rsqrtf(wave_sum(ss) * (1.0f / D) + EPS);
        GAS f32x4* orow = (GAS f32x4*)(out + (size_t)m * D) + lane;
#pragma unroll
        for (int j = 0; j < 4; ++j) { const f32x4 wv = *(const f32x4*)(fnw + 256 * j + 4 * lane); orow[64 * j] = v[j] * rstd * wv; }
    }
}

constexpr int NPHASE = 10;
__global__ void __launch_bounds__(NTHR, 2) mk_fwd(Args args) {
    extern __shared__ __attribute__((aligned(16))) unsigned char lds_raw[];
    LAS unsigned char* lds = (LAS unsigned char*)lds_raw;
    const int tid = threadIdx.x, lane = tid & 63, wave = __builtin_amdgcn_readfirstlane(tid >> 6);
    const int G = gridDim.x, bid = blockIdx.x;
    unsigned char* ws = args.ws;
    gu32* ctl = (gu32*)(ws + WS_CTL);
    volatile LAS unsigned* MISC = (volatile LAS unsigned*)(lds + MISC_OFF);
    if (tid < 64) MISC[tid] = 0u;
    __syncthreads();
    const int lo = args.ph_lo, hi = args.ph_hi;
    const bool multi = (hi - lo) > 1;
    XcdBarrier bar; bar.bar = (unsigned*)(ctl + CW_BAR); bar.x = 0; bar.st = nullptr;
    if (multi) bar = xcd_barrier_post((unsigned*)(ctl + CW_BAR), MISC + 8);
#define IN(k) (lo <= (k) && (k) < hi)
#define SEAM(k) do { if (IN(k) && IN((k) + 1)) xcd_barrier(bar); } while (0)

    if (IN(0)) { p0_prologue(args, lds, bid, G, wave, lane); } SEAM(0);
    if (IN(1)) { p1_norm(args, lds, bid, G, tid, wave, lane); } SEAM(1);
    if (IN(2)) {
        pg8::Gemm g{(const pg8::bf16_t*)(ws + WS_H), (const pg8::bf16_t*)(ws + WS_WIN), M, NPROJ, D}; pg8::StaticOrder S; S.init(M, NPROJ, G, bid);
        pg8::EpiIn E{(pg8::bf16_t*)(ws + WS_P), (float*)(ws + WS_LF), args.in[I_LBL]};
        pg8::gemm_phase<pg8::EpiIn, pg8::StaticOrder, true, true>(lds, g, S, E);
    } SEAM(2);
    if (IN(3)) {
        for (int u = bid; u < 12; u += G) { __syncthreads(); if (u < 8) hgrn_naive(args, lds, u, tid, wave, lane); else ssd_naive(args, lds, u - 8, tid, wave, lane); }
    } SEAM(3);
    if (IN(4)) {
        pg8::Gemm g{(const pg8::bf16_t*)(ws + WS_MIX), (const pg8::bf16_t*)(ws + WS_WOUT), M, D, D}; pg8::StaticOrder S; S.init(M, D, G, bid);
        pg8::EpiOut E{args.in[I_X], (float*)(ws + WS_X1), (const float*)(ws + WS_MODF) + 2 * 1024};
        pg8::gemm_phase<pg8::EpiOut, pg8::StaticOrder, true, true>(lds, g, S, E);
    } SEAM(4);
    if (IN(5)) { p5_router(args, lds, bid, G, tid, wave, lane); } SEAM(5);
    if (IN(6)) { p6_gather(args, lds, bid, G, tid, wave, lane); } SEAM(6);
    if (IN(7) || IN(8)) {
        if (!IN(6)) { moe_tables(args, lds, NCHUNK, wave, lane); __syncthreads(); }
        const PG8_LAS int* TS = (const PG8_LAS int*)(lds + MISC_OFF + 256);
        const int R = __builtin_amdgcn_readfirstlane(TS[32]);
        if (IN(7)) {
            pg8::Gemm g{(const pg8::bf16_t*)(ws + WS_XG), (const pg8::bf16_t*)(ws + WS_W1), R * 256, 2048, D};
            pg8::MoeOrder S{TS + 64, 8, R * 8, G, bid};
            pg8::EpiW1 E{(pg8::bf16_t*)(ws + WS_ACT), args.in[I_B1]};
            pg8::gemm_phase<pg8::EpiW1, pg8::MoeOrder, true, true>(lds, g, S, E);
        }
        SEAM(7);
        if (IN(8)) {
            pg8::Gemm g{(const pg8::bf16_t*)(ws + WS_ACT), (const pg8::bf16_t*)(ws + WS_W2), R * 256, 1024, D};
            pg8::MoeOrder S{TS + 64, 4, R * 4, G, bid};
            pg8::EpiW2 E{(pg8::bf16_t*)(ws + WS_XG), args.in[I_B2]};
            pg8::gemm_phase<pg8::EpiW2, pg8::MoeOrder, true, true>(lds, g, S, E);
        }
    }
    SEAM(8);
    if (IN(9)) { p9_final(args, bid, G, wave, lane); }
#undef IN
#undef SEAM
}

#ifndef MK_N_LAUNCHES
#define MK_N_LAUNCHES 1
#endif
extern "C" void kernel_launch(void* const* d_in, const int* in_sizes, int n_in, void* d_out, int out_size, void* d_ws, size_t ws_size, hipStream_t stream) {
    static int grid = 0;
    if (grid == 0) {
        if (n_in != 23 || out_size != M * D || ws_size < WS_END) { fprintf(stderr, "kernel_launch: unexpected shapes (n_in %d out %d ws %zu)\n", n_in, out_size, ws_size); grid = -1; return; }
        int dev = 0, cus = 0;
        if (hipGetDevice(&dev) != hipSuccess || hipDeviceGetAttribute(&cus, hipDeviceAttributeMultiprocessorCount, dev) != hipSuccess) { grid = -1; return; }
        if (hipFuncSetAttribute((const void*)mk_fwd, hipFuncAttributeMaxDynamicSharedMemorySize, LDS_BYTES) != hipSuccess) { fprintf(stderr, "kernel_launch: hipFuncSetAttribute failed\n"); grid = -1; return; }
        int per_cu = 0;
        if (hipOccupancyMaxActiveBlocksPerMultiprocessor(&per_cu, (const void*)mk_fwd, NTHR, LDS_BYTES) != hipSuccess || per_cu < 1) fprintf(stderr, "kernel_launch: occupancy query says %d\n", per_cu);
        (void)hipGetLastError();
        grid = cus;
    }
    if (grid < 0) return;
    (void)hipMemsetAsync((char*)d_ws + WS_CTL, 0, CTL_ZERO_BYTES, stream);
    Args a{};
    for (int i = 0; i < 23; ++i) a.in[i] = (const float*)d_in[i];
    a.out = (float*)d_out; a.ws = (unsigned char*)d_ws;
    if (MK_N_LAUNCHES == 1) { a.ph_lo = 0; a.ph_hi = NPHASE; hipLaunchKernelGGL(mk_fwd, dim3(grid), dim3(NTHR), LDS_BYTES, stream, a); }
    else for (int p = 0; p < NPHASE; ++p) { a.ph_lo = p; a.ph_hi = p + 1; hipLaunchKernelGGL(mk_fwd, dim3(grid), dim3(NTHR), LDS_BYTES, stream, a); }
}
```

```cpp
#include <hip/hip_runtime.h>
#include <cstdio>
#include <cstdint>
namespace pg8 {
#define PG8_LAS __attribute__((address_space(3)))
typedef unsigned short bf16_t;
typedef short bf16x8 __attribute__((ext_vector_type(8)));
typedef float f32x4 __attribute__((ext_vector_type(4)));
typedef unsigned u32x4 __attribute__((ext_vector_type(4)));
constexpr int BM = 256, BK = 64, HALF = 128, HTB = HALF * BK * 2  , STAGE_BYTES = 8 * HTB, NXCD = 8, WGM = 8;

__host__ __device__ __forceinline__ int lds_byte(int r, int c) { const int st = (r >> 4) * 2 + (c >> 5), rr = r & 15, cc = c & 31, ob = rr * 64 + cc * 2; return st * 1024 + (ob ^ (((ob >> 9) & 1) << 5)); }
__host__ __device__ __forceinline__ void stage_rc(int b, int& R, int& C) { const int st = b / 1024, sb = b % 1024, swz = sb ^ (((sb >> 9) & 1) << 5); R = (st >> 1) * 16 + swz / 64; C = (st & 1) * 32 + (swz % 64) / 2; }
__host__ __device__ __forceinline__ int perm32(int rho) { const int n = rho >> 4, i = rho & 15; return 8 * (i >> 2) + 4 * n + (i & 3); }

struct Unit { int pm, pn; };
struct Gemm { const bf16_t* A; const bf16_t* Bt; int M, N, K; };

struct StaticOrder {
    int nM, nN, nwg, G, c;
    __host__ __device__ void init(int M, int N, int G_, int c_) { nM = M / BM; nN = N / BM; nwg = nM * nN; G = G_; c = c_; }
    __host__ __device__ bool next(int i, Unit& u) const {
        const int L = i * G + c; if (L >= nwg) return false;
        int wgid = L; { const int q = nwg / NXCD, r = nwg % NXCD, xcd = wgid % NXCD, off = wgid / NXCD; wgid = (xcd < r ? xcd * (q + 1) : r * (q + 1) + (xcd - r) * q) + off; }
        const int nig = WGM * nN, gid = wgid / nig, fm = gid * WGM, gsz = (nM - fm) < WGM ? (nM - fm) : WGM;
        u.pm = fm + ((wgid % nig) % gsz); u.pn = (wgid % nig) / gsz; return true;
    }
    __device__ __forceinline__ void a_ready(const Unit&) const {}
    __device__ __forceinline__ void done(const Unit&) const {}
};

__device__ __forceinline__ unsigned cvt_pk_bf16(float lo, float hi) { unsigned r; asm volatile("v_cvt_pk_bf16_f32 %0, %1, %2" : "=v"(r) : "v"(lo), "v"(hi)); return r; }
typedef float f32x2 __attribute__((ext_vector_type(2)));
typedef int v8i32 __attribute__((ext_vector_type(8)));
__device__ __forceinline__ v8i32 cat8(bf16x8 lo, bf16x8 hi) { typedef short s16x16 __attribute__((ext_vector_type(16))); return __builtin_bit_cast(v8i32, __builtin_shufflevector(lo, hi, 0, 1, 2, 3, 4, 5, 6, 7, 8, 9, 10, 11, 12, 13, 14, 15)); }
template <class Epi, class Sched, bool ALIGN_EPI = false, bool SP2 = false, bool F8 = false>
__device__ __forceinline__ void gemm_phase(PG8_LAS unsigned char* lds, const Gemm g, const Sched& S, const Epi& E, int wid) {
    int lane; asm volatile("v_mbcnt_lo_u32_b32 %0, -1, 0\n\tv_mbcnt_hi_u32_b32 %0, -1, %0" : "=v"(lane)); __builtin_assume(lane >= 0 && lane < 64); __builtin_assume(wid >= 0 && wid < 8);
    const int tid = wid * 64 + lane, wr = wid >> 2, wc = wid & 3, fr = lane & 15, fq = lane >> 4;
    const int K = g.K, nt = K / BK;
    unsigned voffA[2], voffB[2];
#pragma unroll
    for (int i = 0; i < 2; ++i) { int R, C; stage_rc(tid * 16 + i * 8192, R, C); const int Rb = Epi::PERM ? ((R & ~31) + perm32(R & 31)) : R;
        voffA[i] = (unsigned)(R * K + C) * 2u; voffB[i] = (unsigned)(Rb * K + C) * 2u; }
    const unsigned kstep = (unsigned)(BK * 2);
    const unsigned hstep = (unsigned)HALF * (unsigned)K * 2u;
    const unsigned tstep = 2u * hstep;
    const unsigned ldsw = (unsigned)wid * 1024u;
    const int aoff = lds_byte(wr * 64 + fr, fq * 8), boff = lds_byte(wc * 32 + fr, fq * 8);
#define PG8_SA(b, h) (((b) * 2 + (h)) * HTB)
#define PG8_SB(b, h) ((4 + (b) * 2 + (h)) * HTB)
#define PG8_STAGE(bufoff, gbase, voff) do { _Pragma("unroll") for (int _i = 0; _i < 2; ++_i) \
        __builtin_amdgcn_global_load_lds((const unsigned*)((const char*)(gbase) + (voff)[_i]), (PG8_LAS unsigned*)(lds + (bufoff) + ldsw + _i * 8192), 16, 0, 0); } while (0)
#define PG8_LDA(dst, b, h) do { _Pragma("unroll") for (int m = 0; m < 4; ++m) _Pragma("unroll") for (int k = 0; k < 2; ++k) dst[m][k] = *(const PG8_LAS bf16x8*)(lds + PG8_SA(b, h) + aoff + m * 2048 + k * 1024); } while (0)
#define PG8_LDB(dst, b, h) do { _Pragma("unroll") for (int n = 0; n < 2; ++n) _Pragma("unroll") for (int k = 0; k < 2; ++k) dst[n][k] = *(const PG8_LAS bf16x8*)(lds + PG8_SB(b, h) + boff + n * 2048 + k * 1024); } while (0)
#define PG8_MMA(ai, bj, At, Bt) do { __builtin_amdgcn_s_setprio(1); _Pragma("unroll") for (int m = 0; m < 4; ++m) _Pragma("unroll") for (int n = 0; n < 2; ++n) { \
        if constexpr (F8) acc[ai][bj][m][n] = __builtin_amdgcn_mfma_scale_f32_16x16x128_f8f6f4(cat8(Bt[n][0], Bt[n][1]), cat8(At[m][0], At[m][1]), acc[ai][bj][m][n], 0, 0, 0, 0, 0, 0); \
        else { _Pragma("unroll") for (int k = 0; k < 2; ++k) acc[ai][bj][m][n] = __builtin_amdgcn_mfma_f32_16x16x32_bf16(Bt[n][k], At[m][k], acc[ai][bj][m][n], 0, 0, 0); } } __builtin_amdgcn_s_setprio(0); } while (0)
#define PG8_WAIT_V(n) asm volatile("s_waitcnt vmcnt(" #n ")" ::: "memory")
#define PG8_WAIT_L(n) asm volatile("s_waitcnt lgkmcnt(" #n ")" ::: "memory")
#define PG8_BAR __builtin_amdgcn_s_barrier()
#define PG8_SCHED __builtin_amdgcn_sched_barrier(0)
    Unit cur, nxt; int ui = 0;
    if (!S.next(0, cur)) return;
    f32x4 acc[2][2][4][2];
#pragma unroll
    for (int a = 0; a < 2; ++a)
#pragma unroll
        for (int b = 0; b < 2; ++b)
#pragma unroll
            for (int m = 0; m < 4; ++m)
#pragma unroll
                for (int n = 0; n < 2; ++n) acc[a][b][m][n] = (f32x4){0.f, 0.f, 0.f, 0.f};
    bf16x8 At[4][2], B0[2][2], B1[2][2];
    const char* cA = (const char*)g.A + (size_t)((unsigned)cur.pm * tstep); const char* cB = (const char*)g.Bt + (size_t)((unsigned)cur.pn * tstep);
    S.a_ready(cur);
    if constexpr (SP2) {
        PG8_STAGE(PG8_SB(0, 0), cB, voffB); PG8_STAGE(PG8_SB(0, 1), cB + hstep, voffB); PG8_STAGE(PG8_SA(0, 0), cA, voffA); PG8_STAGE(PG8_SA(0, 1), cA + hstep, voffA);
        if (wr == 1) PG8_BAR;
        PG8_WAIT_V(2); PG8_BAR;
        PG8_STAGE(PG8_SB(1, 0), cB + kstep, voffB); PG8_STAGE(PG8_SA(1, 0), cA + kstep, voffA); PG8_STAGE(PG8_SB(1, 1), cB + hstep + kstep, voffB);
        PG8_WAIT_V(6); PG8_BAR;
    } else {
        PG8_STAGE(PG8_SB(0, 0), cB, voffB); PG8_STAGE(PG8_SA(0, 0), cA, voffA); PG8_STAGE(PG8_SB(0, 1), cB + hstep, voffB); PG8_STAGE(PG8_SA(0, 1), cA + hstep, voffA);
        if (wr == 1) PG8_BAR;
        PG8_WAIT_V(4); PG8_BAR;
        PG8_STAGE(PG8_SB(1, 0), cB + kstep, voffB); PG8_STAGE(PG8_SA(1, 0), cA + kstep, voffA); PG8_STAGE(PG8_SB(1, 1), cB + hstep + kstep, voffB);
        PG8_WAIT_V(6); PG8_BAR;
    }
    for (;;) {
        const bool has_next = S.next(ui + 1, nxt);
        const char* nA = has_next ? (const char*)g.A + (size_t)((unsigned)nxt.pm * tstep) : cA; const char* nB = has_next ? (const char*)g.Bt + (size_t)((unsigned)nxt.pn * tstep) : cB;
        _Pragma("unroll 1") for (int t = 0; t < nt; t += 2) {
            const bool last = (t == nt - 2);
            const char* a1 = cA + (size_t)((unsigned)(t + 1) * kstep);
            const char* a2 = last ? nA : cA + (size_t)((unsigned)(t + 2) * kstep); const char* b2 = last ? nB : cB + (size_t)((unsigned)(t + 2) * kstep);
            const char* a3 = a2 + kstep; const char* b3 = b2 + kstep;
            const char* a1h = a1 + hstep; const char* a2h = a2 + hstep; const char* b2h = b2 + hstep; const char* b3h = b3 + hstep;
            asm volatile("" : "+s"(a1h), "+s"(a2), "+s"(a2h), "+s"(b2), "+s"(b2h), "+s"(a3), "+s"(b3), "+s"(b3h));
            if (last && has_next) S.a_ready(nxt);
            if constexpr (SP2) {
            PG8_LDB(B0, 0, 0); PG8_LDB(B1, 0, 1); PG8_SCHED; PG8_LDA(At, 0, 0); PG8_STAGE(PG8_SA(1, 1), a1h, voffA);
            PG8_WAIT_V(8); PG8_WAIT_L(0); PG8_BAR; PG8_MMA(0, 0, At, B0); PG8_MMA(0, 1, At, B1); PG8_BAR; PG8_SCHED;
            PG8_LDA(At, 0, 1); PG8_STAGE(PG8_SB(0, 0), b2, voffB); PG8_STAGE(PG8_SB(0, 1), b2h, voffB); PG8_STAGE(PG8_SA(0, 0), a2, voffA);
            PG8_WAIT_V(8); PG8_WAIT_L(0); PG8_BAR; PG8_MMA(1, 0, At, B0); PG8_MMA(1, 1, At, B1); PG8_BAR; PG8_SCHED;
            PG8_LDB(B0, 1, 0); PG8_LDB(B1, 1, 1); PG8_SCHED; PG8_LDA(At, 1, 0); PG8_STAGE(PG8_SA(0, 1), a2h, voffA);
            PG8_WAIT_V(8); PG8_WAIT_L(0); PG8_BAR; PG8_MMA(0, 0, At, B0); PG8_MMA(0, 1, At, B1); PG8_BAR; PG8_SCHED;
            PG8_LDA(At, 1, 1); PG8_STAGE(PG8_SB(1, 0), b3, voffB); PG8_STAGE(PG8_SB(1, 1), b3h, voffB); PG8_STAGE(PG8_SA(1, 0), a3, voffA);
            PG8_WAIT_V(8); PG8_WAIT_L(0); PG8_BAR; PG8_MMA(1, 0, At, B0); PG8_MMA(1, 1, At, B1); PG8_BAR; PG8_SCHED;
            } else {
            PG8_LDB(B0, 0, 0); PG8_SCHED; PG8_LDA(At, 0, 0); PG8_STAGE(PG8_SA(1, 1), a1h, voffA);
            PG8_WAIT_L(8); PG8_BAR; PG8_WAIT_L(0); PG8_MMA(0, 0, At, B0); PG8_BAR; PG8_SCHED;
            PG8_LDB(B1, 0, 1); PG8_STAGE(PG8_SB(0, 0), b2, voffB);
            PG8_BAR; PG8_WAIT_L(0); PG8_MMA(0, 1, At, B1); PG8_BAR;
            PG8_LDA(At, 0, 1); PG8_STAGE(PG8_SA(0, 0), a2, voffA);
            PG8_BAR; PG8_WAIT_L(0); PG8_MMA(1, 0, At, B0); PG8_BAR; PG8_SCHED;
            PG8_STAGE(PG8_SB(0, 1), b2h, voffB);
            PG8_WAIT_V(6); PG8_BAR; PG8_MMA(1, 1, At, B1); PG8_BAR;
            PG8_LDB(B0, 1, 0); PG8_SCHED; PG8_LDA(At, 1, 0); PG8_STAGE(PG8_SA(0, 1), a2h, voffA);
            PG8_WAIT_L(8); PG8_BAR; PG8_WAIT_L(0); PG8_MMA(0, 0, At, B0); PG8_BAR; PG8_SCHED;
            PG8_LDB(B1, 1, 1); PG8_STAGE(PG8_SB(1, 0), b3, voffB);
            PG8_BAR; PG8_WAIT_L(0); PG8_MMA(0, 1, At, B1); PG8_BAR;
            PG8_LDA(At, 1, 1); PG8_STAGE(PG8_SA(1, 0), a3, voffA);
            PG8_BAR; PG8_WAIT_L(0); PG8_MMA(1, 0, At, B0); PG8_BAR; PG8_SCHED;
            PG8_STAGE(PG8_SB(1, 1), b3h, voffB);
            PG8_WAIT_V(6); PG8_BAR; PG8_MMA(1, 1, At, B1); PG8_BAR;
            }
        }
        if constexpr (ALIGN_EPI) { if (wr == 0) PG8_BAR; }
        if constexpr (!Epi::AFTER_DRAIN) { int l2_; asm volatile("v_mbcnt_lo_u32_b32 %0, -1, 0\n\tv_mbcnt_hi_u32_b32 %0, -1, %0" : "=v"(l2_)); const int fr_o = l2_ & 15, fq_o = l2_ >> 4;
            Unit cu_ = cur; asm volatile("" : "+s"(cu_.pm), "+s"(cu_.pn));
            E(acc, cu_, wr, wc, fr_o, fq_o); S.done(cur); }
        if (!has_next) break;
#pragma unroll
        for (int a = 0; a < 2; ++a)
#pragma unroll
            for (int b = 0; b < 2; ++b)
#pragma unroll
                for (int m = 0; m < 4; ++m)
#pragma unroll
                    for (int n = 0; n < 2; ++n) acc[a][b][m][n] = (f32x4){0.f, 0.f, 0.f, 0.f};
        cur = nxt; cA = nA; cB = nB; ++ui;
        if constexpr (ALIGN_EPI) { if (wr == 1) PG8_BAR; }
    }
    PG8_WAIT_V(0);
    if constexpr (!ALIGN_EPI) { if (wr == 0) PG8_BAR; }
    PG8_BAR;
    if constexpr (Epi::AFTER_DRAIN) { E.fused(acc, cur, wr, wc, fr, fq, lds, wid, lane); S.done(cur); }
#undef PG8_SA
#undef PG8_SB
#undef PG8_STAGE
#undef PG8_LDA
#undef PG8_LDB
#undef PG8_MMA
#undef PG8_WAIT_V
#undef PG8_WAIT_L
#undef PG8_BAR
#undef PG8_SCHED
}
}
#define GAS __attribute__((address_space(1)))
#define LAS __attribute__((address_space(3)))
typedef unsigned short bf16;
typedef unsigned v4u __attribute__((ext_vector_type(4)));
typedef float f32x4 __attribute__((ext_vector_type(4)));
typedef short bf16x8 __attribute__((ext_vector_type(8)));
typedef GAS unsigned gu32;
typedef GAS unsigned long long gu64;
#define RLX_AGENT __ATOMIC_RELAXED, __HIP_MEMORY_SCOPE_AGENT
#define LDS_WAIT() asm volatile("s_waitcnt lgkmcnt(0)" ::: "memory")
#define VM_WAIT() asm volatile("s_waitcnt vmcnt(0)" ::: "memory")
__device__ __forceinline__ unsigned long long rt() { return __builtin_amdgcn_s_memrealtime(); }
__device__ __forceinline__ unsigned f2bf(float f) { unsigned u = __builtin_bit_cast(unsigned, f); return (u + 0x7fffu + ((u >> 16) & 1u)) >> 16; }
__device__ __forceinline__ unsigned pk2(float lo, float hi) { return f2bf(lo) | (f2bf(hi) << 16); }
#define XB_TMO      128
#define XB_XCNT(j)  (256  + 64 * (j))
#define XB_XSUB(j)  (1280 + 64 * (j))
#define XB_XGEN(j)  (2304 + 64 * (j))
#define XB_TOP      3328
#define XB_TOPGEN   3392
#define XCD_BAR_WORDS 3456
#define XB_SPIN_CAP (1u << 18)

__device__ __forceinline__ unsigned xb_ld(unsigned* p)              { return __hip_atomic_load(p, __ATOMIC_RELAXED, __HIP_MEMORY_SCOPE_AGENT); }
__device__ __forceinline__ unsigned xb_add(unsigned* p, unsigned v) { return __hip_atomic_fetch_add(p, v, __ATOMIC_RELAXED, __HIP_MEMORY_SCOPE_AGENT); }
__device__ __forceinline__ unsigned xb_xcc_id() { return (unsigned)__builtin_amdgcn_s_getreg((3 << 11) | 20) & 0xFu; }
#define XB_SPIN(cond, bar) do { unsigned _sp = 0; while (cond) { __builtin_amdgcn_s_sleep(1); \
    if ((++_sp & 255u) == 0u) { if (xb_ld(&(bar)[XB_TMO])) break; if (_sp > XB_SPIN_CAP) { atomicAdd(&(bar)[XB_TMO], 1u); break; } } } } while (0)

struct XcdBarrier {
    unsigned* bar; unsigned x;
    volatile LAS unsigned* st;
};

__device__ __forceinline__ XcdBarrier xcd_barrier_post(unsigned* bar, volatile LAS unsigned* st, bool t0) {
    XcdBarrier b; b.bar = bar; b.x = xb_xcc_id(); b.st = st;
    if (t0) (void)xb_add(&bar[XB_XCNT(b.x)], 1u);
    return b;
}
__device__ __forceinline__ void xcd_barrier_complete(unsigned* bar, unsigned x, unsigned& nloc, unsigned& nx) {
    const unsigned G = gridDim.x * gridDim.y * gridDim.z;
    unsigned sum, cnt, mine, sp = 0u;
    for (;;) {
        sum = 0u; cnt = 0u; mine = 0u;
#pragma unroll
        for (unsigned j = 0; j < 16; ++j) { const unsigned c = xb_ld(&bar[XB_XCNT(j)]); sum += c; cnt += (c > 0u) ? 1u : 0u; mine = (j == x) ? c : mine; }
        if (sum == G) break;
        __builtin_amdgcn_s_sleep(1);
        if ((++sp & 255u) == 0u) { if (xb_ld(&bar[XB_TMO])) break; if (sp > XB_SPIN_CAP) { atomicAdd(&bar[XB_TMO], 1u); break; } }
    }
    nloc = mine > 0u ? mine : 1u; nx = cnt > 0u ? cnt : 1u;
}

__device__ __forceinline__ void xcd_barrier(const XcdBarrier& b, bool t0) {
    asm volatile("s_waitcnt vmcnt(0)" ::: "memory");
    __syncthreads();
    if (t0) {
        unsigned* bar = b.bar;
        __builtin_amdgcn_s_waitcnt(0);
        unsigned nloc = b.st[0], nx = b.st[1];
        if (nloc == 0u) { xcd_barrier_complete(bar, b.x, nloc, nx); b.st[0] = nloc; b.st[1] = nx; }
        const unsigned old = xb_add(&bar[XB_XSUB(b.x)], 1u);
        const unsigned gen = old / nloc;
        if (old + 1u == (gen + 1u) * nloc) {
            __builtin_amdgcn_fence(__ATOMIC_RELEASE, "agent");
            asm volatile("s_waitcnt vmcnt(0)" ::: "memory");
            const unsigned og = xb_add(&bar[XB_TOP], 1u);
            const unsigned tg = og / nx;
            if (og + 1u == (tg + 1u) * nx) xb_add(&bar[XB_TOPGEN], 1u);
            else XB_SPIN(xb_ld(&bar[XB_TOPGEN]) == tg, bar);
            __builtin_amdgcn_fence(__ATOMIC_ACQUIRE, "agent");
            xb_add(&bar[XB_XGEN(b.x)], 1u);
            asm volatile("s_waitcnt vmcnt(0)" ::: "memory");
        } else {
            XB_SPIN(xb_ld(&bar[XB_XGEN(b.x)]) == gen, bar);
            __builtin_amdgcn_fence(__ATOMIC_ACQUIRE, "agent");
            asm volatile("s_waitcnt vmcnt(0)" ::: "memory");
        }
    }
    __syncthreads();
}
#ifndef Y_FP8
#define Y_FP8 1
#endif
#ifndef MOE_FP8_G1
#define MOE_FP8_G1 1
#endif
#ifndef MOE_FP8_G2
#define MOE_FP8_G2 1
#endif

constexpr int NB = 2, SEQ = 8192, D = 1024, M = NB * SEQ;
constexpr int NPROJ = 3584, IN_COLS = 3592;
constexpr int NE = 32, TOPK = 4, DFF = 1024;
constexpr int NROWS_MAX = M * TOPK + NE * 256;
constexpr int MAXRT = NROWS_MAX / 256;
constexpr float EPS = 1e-6f;
constexpr int PC_Q = 0, PC_K = 512, PC_V = 1024, PC_G = 1536, PC_Z = 2048, PC_X = 2560;
constexpr int NCHUNK = M / 64;
constexpr int NWAVES = 8, NTHR = 512;

constexpr size_t MiB = 1u << 20;
constexpr size_t WS_CTL = 0, CTL_ZERO_BYTES = 32768;
constexpr size_t WS_MODP = 1 * MiB;
constexpr size_t WS_MODF = WS_MODP + 512 * 1024;
constexpr size_t WS_BLKCNT = WS_MODF + 256 * 1024;
constexpr size_t WS_DT = 2 * MiB;
constexpr size_t WS_TOK = 3 * MiB;
constexpr size_t WS_WIN = 4 * MiB, WS_WOUT = 11 * MiB, WS_W1 = 16 * MiB, WS_W2 = 144 * MiB;
constexpr size_t WS_H = 208 * MiB, WS_P = 240 * MiB, WS_LF = 352 * MiB, WS_MIX = 384 * MiB, WS_X1 = 416 * MiB;
constexpr size_t WS_XG = 480 * MiB, WS_ACT = 624 * MiB, WS_END = 768 * MiB;
constexpr int CW_TMO = 0, CW_BAR = 4096;

constexpr int RING_BYTES = 131072, AUX_OFF = RING_BYTES  , MISC_OFF = 147456, LDS_BYTES = 151552;

struct Args { const float* in[23]; float* out; unsigned char* ws; int ph_lo, ph_hi; };
enum { I_X = 0, I_C, I_ADAW, I_ADAB, I_N1W, I_WIN, I_LBL, I_HGNW, I_ALOG, I_DTB, I_SSMD, I_CONVW, I_CONVB, I_SSMNW, I_WOUT, I_N2W, I_RW, I_RB, I_W1, I_B1, I_W2, I_B2, I_FNW };

__device__ __forceinline__ float bf2f(bf16 v) { return __uint_as_float(((unsigned)v) << 16); }
__device__ __forceinline__ float wave_sum(float v) {
#pragma unroll
    for (int o = 1; o < 64; o <<= 1) v += __shfl_xor(v, o);
    return v;
}
__device__ __forceinline__ float wave_max(float v) {
#pragma unroll
    for (int o = 1; o < 64; o <<= 1) v = fmaxf(v, __shfl_xor(v, o));
    return v;
}
__device__ __forceinline__ float sigmoid_f(float x) { return __builtin_amdgcn_rcpf(1.0f + __expf(-x)); }
__device__ __forceinline__ float silu_f(float x) { return x * sigmoid_f(x); }

namespace pg8 {
struct EpiIn {
    static constexpr bool PERM = true, AFTER_DRAIN = false;
    bf16_t* P; float* LF; const float* lbl;
    __device__ __forceinline__ void operator()(const f32x4 (&acc)[2][2][4][2], const Unit& u, int wr, int wc, int fr, int fq) const {
        const int row0 = u.pm * BM + wr * 64 + fr, col0 = u.pn * BM + wc * 32 + 8 * fq;
        const int mode = (u.pn < 2) ? 1 : (u.pn < 4) ? 2 : (u.pn < 6) ? 0 : (u.pn < 10) ? 1 : 0;
        if (mode == 2) {
            float oml[2][8];
#pragma unroll
            for (int bj = 0; bj < 2; ++bj)
#pragma unroll
                for (int j = 0; j < 8; ++j) { const int cf = col0 + bj * HALF + j - 512; const float l0 = lbl[cf], l1 = lbl[512 + cf]; oml[bj][j] = 1.0f - 1.0f / (1.0f + __expf(l1 - l0)); }
#pragma unroll
            for (int ai = 0; ai < 2; ++ai)
#pragma unroll
                for (int m = 0; m < 4; ++m) { const size_t r = (size_t)(row0 + ai * HALF + m * 16);
#pragma unroll
                    for (int bj = 0; bj < 2; ++bj) { float kv[8], lf[8];
#pragma unroll
                        for (int j = 0; j < 8; ++j) { const float f = acc[ai][bj][m][j >> 2][j & 3]; const float k = oml[bj][j] * sigmoid_f(-f); kv[j] = k; lf[j] = __logf(1.0f - k); }
                        u32x4 w; w.x = cvt_pk_bf16(kv[0], kv[1]); w.y = cvt_pk_bf16(kv[2], kv[3]); w.z = cvt_pk_bf16(kv[4], kv[5]); w.w = cvt_pk_bf16(kv[6], kv[7]);
                        *(u32x4*)(P + r * NPROJ + col0 + bj * HALF) = w;
                        float* lp = LF + r * 512 + (col0 + bj * HALF - 512);
                        *(f32x4*)lp = (f32x4){lf[0], lf[1], lf[2], lf[3]}; *(f32x4*)(lp + 4) = (f32x4){lf[4], lf[5], lf[6], lf[7]}; } }
        } else {
#pragma unroll
            for (int ai = 0; ai < 2; ++ai)
#pragma unroll
                for (int m = 0; m < 4; ++m) { bf16_t* rowp = P + (size_t)(row0 + ai * HALF + m * 16) * NPROJ + col0;
#pragma unroll
                    for (int bj = 0; bj < 2; ++bj) { f32x4 v0 = acc[ai][bj][m][0], v1 = acc[ai][bj][m][1];
                        if (mode == 1) {
#pragma unroll
                            for (int j = 0; j < 4; ++j) { v0[j] = silu_f(v0[j]); v1[j] = silu_f(v1[j]); } }
                        u32x4 w; w.x = cvt_pk_bf16(v0[0], v0[1]); w.y = cvt_pk_bf16(v0[2], v0[3]); w.z = cvt_pk_bf16(v1[0], v1[1]); w.w = cvt_pk_bf16(v1[2], v1[3]);
                        *(u32x4*)(rowp + bj * HALF) = w; } }
        }
    }
};
struct EpiOut {
    static constexpr bool PERM = true, AFTER_DRAIN = false;
    const float* x; bf16_t* x1; const float* g1;
    __device__ __forceinline__ void operator()(const f32x4 (&acc)[2][2][4][2], const Unit& u, int wr, int wc, int fr, int fq) const {
        const int row0 = u.pm * BM + wr * 64 + fr, col0 = u.pn * BM + wc * 32 + 8 * fq;
        const float* gb = g1 + ((u.pm * BM) >> 13) * 6144 + col0;
        f32x4 gv[2][2];
#pragma unroll
        for (int bj = 0; bj < 2; ++bj)
#pragma unroll
            for (int n = 0; n < 2; ++n) gv[bj][n] = *(const f32x4*)(gb + bj * HALF + 4 * n);
#pragma unroll
        for (int ai = 0; ai < 2; ++ai)
#pragma unroll
            for (int m = 0; m < 4; ++m) { const size_t off = (size_t)(row0 + ai * HALF + m * 16) * D + col0;
#pragma unroll
                for (int bj = 0; bj < 2; ++bj) { const f32x4 x0 = *(const f32x4*)(x + off + bj * HALF), x1v = *(const f32x4*)(x + off + bj * HALF + 4);
                    const f32x4 v0 = x0 + gv[bj][0] * acc[ai][bj][m][0], v1 = x1v + gv[bj][1] * acc[ai][bj][m][1];
                    u32x4 w; w.x = cvt_pk_bf16(v0[0], v0[1]); w.y = cvt_pk_bf16(v0[2], v0[3]); w.z = cvt_pk_bf16(v1[0], v1[1]); w.w = cvt_pk_bf16(v1[2], v1[3]);
                    *(u32x4*)(x1 + off + bj * HALF) = w; } }
    }
};
__device__ __forceinline__ float sat8(float x) { return fminf(fmaxf(x, -448.0f), 448.0f); }
__device__ __forceinline__ unsigned pk4_fp8(float a, float b, float c, float d) { int w = 0; w = __builtin_amdgcn_cvt_pk_fp8_f32(sat8(a), sat8(b), w, false); w = __builtin_amdgcn_cvt_pk_fp8_f32(sat8(c), sat8(d), w, true); return (unsigned)w; }
template <bool F8IN, bool F8> struct EpiW1 {
    static constexpr bool PERM = true, AFTER_DRAIN = false;
    void* ACT; const float* b1;
    __device__ __forceinline__ void operator()(const f32x4 (&acc)[2][2][4][2], const Unit& u, int wr, int wc, int fr, int fq) const {
        const int e = u.pn >> 3, pn = u.pn & 7;
        const int row0 = u.pm * BM + wr * 64 + fr, cj = pn * 128 + wc * 32 + 8 * fq;
        const float* bg = b1 + e * 2048 + cj; const float sc = F8IN ? (1.0f / 1024.0f) : 1.0f;
#pragma unroll
        for (int ai = 0; ai < 2; ++ai)
#pragma unroll
            for (int m = 0; m < 4; ++m) {
                asm volatile("" ::: "memory");
                const f32x4 bg0 = *(const f32x4*)bg, bg1 = *(const f32x4*)(bg + 4), bl0 = *(const f32x4*)(bg + 1024), bl1 = *(const f32x4*)(bg + 1028);
                f32x4 g0 = acc[ai][0][m][0] * sc + bg0, g1 = acc[ai][0][m][1] * sc + bg1, l0 = acc[ai][1][m][0] * sc + bl0, l1 = acc[ai][1][m][1] * sc + bl1;
                float o[8];
                const float osc = F8 ? 4.0f : 1.0f;
#pragma unroll
                for (int j = 0; j < 4; ++j) {
                    float g = fminf(g0[j], 7.0f), l = __builtin_amdgcn_fmed3f(l0[j], -7.0f, 7.0f); o[j] = (g * osc) * __builtin_amdgcn_rcpf(1.0f + __builtin_amdgcn_exp2f(g * (-1.702f * 1.44269504f))) * (l + 1.0f);
                    g = fminf(g1[j], 7.0f); l = __builtin_amdgcn_fmed3f(l1[j], -7.0f, 7.0f); o[4 + j] = (g * osc) * __builtin_amdgcn_rcpf(1.0f + __builtin_amdgcn_exp2f(g * (-1.702f * 1.44269504f))) * (l + 1.0f); }
                const size_t off = (size_t)(row0 + ai * HALF + m * 16) * DFF + cj;
                if (F8) { typedef unsigned u32x2 __attribute__((ext_vector_type(2))); u32x2 w; int w0 = 0, w1 = 0;
                    w0 = __builtin_amdgcn_cvt_pk_fp8_f32(o[0], o[1], w0, false); w0 = __builtin_amdgcn_cvt_pk_fp8_f32(o[2], o[3], w0, true); w1 = __builtin_amdgcn_cvt_pk_fp8_f32(o[4], o[5], w1, false); w1 = __builtin_amdgcn_cvt_pk_fp8_f32(o[6], o[7], w1, true);
                    w.x = (unsigned)w0; w.y = (unsigned)w1; *(u32x2*)((unsigned char*)ACT + off) = w; }
                else { u32x4 w; w.x = cvt_pk_bf16(o[0], o[1]); w.y = cvt_pk_bf16(o[2], o[3]); w.z = cvt_pk_bf16(o[4], o[5]); w.w = cvt_pk_bf16(o[6], o[7]);
                    *(u32x4*)((bf16_t*)ACT + off) = w; } }
    }
};
template <bool Y8> struct EpiW2 {
    static constexpr bool PERM = true, AFTER_DRAIN = false;
    void* Y; const float* b2; float sc;
    __device__ __forceinline__ void operator()(const f32x4 (&acc)[2][2][4][2], const Unit& u, int wr, int wc, int fr, int fq) const {
        const int e = u.pn >> 2, pn = u.pn & 3;
        const int row0 = u.pm * BM + wr * 64 + fr, col0 = pn * BM + wc * 32 + 8 * fq;
        const float* bb = b2 + e * 1024 + col0;
        f32x4 bv[2][2];
#pragma unroll
        for (int bj = 0; bj < 2; ++bj) { bv[bj][0] = *(const f32x4*)(bb + bj * HALF); bv[bj][1] = *(const f32x4*)(bb + bj * HALF + 4); }
#pragma unroll
        for (int ai = 0; ai < 2; ++ai)
#pragma unroll
            for (int m = 0; m < 4; ++m) { const size_t off = (size_t)(row0 + ai * HALF + m * 16) * D + col0;
#pragma unroll
                for (int bj = 0; bj < 2; ++bj) { const f32x4 v0 = acc[ai][bj][m][0] * sc + bv[bj][0], v1 = acc[ai][bj][m][1] * sc + bv[bj][1];
                    if (Y8) { typedef unsigned u32x2 __attribute__((ext_vector_type(2))); u32x2 w; w.x = pk4_fp8(v0[0] * 8.f, v0[1] * 8.f, v0[2] * 8.f, v0[3] * 8.f); w.y = pk4_fp8(v1[0] * 8.f, v1[1] * 8.f, v1[2] * 8.f, v1[3] * 8.f);
                        *(u32x2*)((unsigned char*)Y + off + bj * HALF) = w; }
                    else { u32x4 w; w.x = cvt_pk_bf16(v0[0], v0[1]); w.y = cvt_pk_bf16(v0[2], v0[3]); w.z = cvt_pk_bf16(v1[0], v1[1]); w.w = cvt_pk_bf16(v1[2], v1[3]);
                        *(u32x4*)((bf16_t*)Y + off + bj * HALF) = w; } } }
    }
};
struct InProjOrder {
    int c;
    __device__ __forceinline__ bool next(int i, Unit& u) const { const int pn = (c >> 6) + 4 * i; if (pn >= NPROJ / BM) return false; u.pm = c & 63; u.pn = pn; return true; }
    __device__ __forceinline__ void a_ready(const Unit&) const {}
    __device__ __forceinline__ void done(const Unit&) const {}
};
struct MoeOrder {
    const PG8_LAS int* rt2e; int NT, nwg, G, c;
    __device__ __forceinline__ bool next(int i, Unit& u) const {
        const int L = i * G + c; if (L >= nwg) return false;
        int wgid = L; { const int q = nwg / NXCD, r = nwg % NXCD, xcd = wgid % NXCD, off = wgid / NXCD; wgid = (xcd < r ? xcd * (q + 1) : r * (q + 1) + (xcd - r) * q) + off; }
        const int rt = wgid / NT, pn = wgid % NT; const int e = __builtin_amdgcn_readfirstlane(rt2e[rt]);
        u.pm = rt; u.pn = e * NT + pn; return true;
    }
    __device__ __forceinline__ void a_ready(const Unit&) const {}
    __device__ __forceinline__ void done(const Unit&) const {}
};
}

using pg8::pk4_fp8;
__device__ __forceinline__ void transpose_item(const float* __restrict__ W, int ldw, int k0, int c0, bf16* WT, int drow0, LAS float* scr, int lane) {
#pragma unroll 8
    for (int i = 0; i < 32; ++i) { const int kk = 2 * i + (lane >> 5); scr[kk * 33 + (lane & 31)] = W[(size_t)(k0 + kk) * ldw + c0 + (lane & 31)]; }
    LDS_WAIT(); asm volatile("" ::: "memory");
    const int c = lane & 7;
#pragma unroll
    for (int j = 0; j < 4; ++j) { const int n = (lane >> 3) + 8 * j; const LAS float* s = scr + (8 * c) * 33 + n;
        v4u o; o.x = pk2(s[0 * 33], s[1 * 33]); o.y = pk2(s[2 * 33], s[3 * 33]); o.z = pk2(s[4 * 33], s[5 * 33]); o.w = pk2(s[6 * 33], s[7 * 33]);
        *(GAS v4u*)(WT + (size_t)(drow0 + n) * 1024 + k0 + 8 * c) = o; }
    LDS_WAIT(); asm volatile("" ::: "memory");
}
__device__ __forceinline__ void transpose_item8(const float* __restrict__ W, int ldw, int k0, int c0, unsigned char* WT, int drow0, float scale, LAS float* scr, int lane) {
#pragma unroll 8
    for (int i = 0; i < 32; ++i) { const int kk = 2 * i + (lane >> 5); scr[kk * 33 + (lane & 31)] = W[(size_t)(k0 + kk) * ldw + c0 + (lane & 31)]; }
    LDS_WAIT(); asm volatile("" ::: "memory");
    const int n = lane >> 1, hf = lane & 1; const LAS float* s = scr + (32 * hf) * 33 + n;
    v4u o0, o1;
    o0.x = pk4_fp8(s[0 * 33] * scale, s[1 * 33] * scale, s[2 * 33] * scale, s[3 * 33] * scale); o0.y = pk4_fp8(s[4 * 33] * scale, s[5 * 33] * scale, s[6 * 33] * scale, s[7 * 33] * scale);
    o0.z = pk4_fp8(s[8 * 33] * scale, s[9 * 33] * scale, s[10 * 33] * scale, s[11 * 33] * scale); o0.w = pk4_fp8(s[12 * 33] * scale, s[13 * 33] * scale, s[14 * 33] * scale, s[15 * 33] * scale);
    o1.x = pk4_fp8(s[16 * 33] * scale, s[17 * 33] * scale, s[18 * 33] * scale, s[19 * 33] * scale); o1.y = pk4_fp8(s[20 * 33] * scale, s[21 * 33] * scale, s[22 * 33] * scale, s[23 * 33] * scale);
    o1.z = pk4_fp8(s[24 * 33] * scale, s[25 * 33] * scale, s[26 * 33] * scale, s[27 * 33] * scale); o1.w = pk4_fp8(s[28 * 33] * scale, s[29 * 33] * scale, s[30 * 33] * scale, s[31 * 33] * scale);
    GAS v4u* dst = (GAS v4u*)(WT + (size_t)(drow0 + n) * 1024 + k0 + 32 * hf); dst[0] = o0; dst[1] = o1;
    LDS_WAIT(); asm volatile("" ::: "memory");
}
template <bool F8> __device__ __forceinline__ void p0_item(const float* __restrict__ W, int ldw, int k0, int c0, unsigned char* WT, int drow0, int rowb, float scale, LAS unsigned char* T, int tid, int wave, int lane) {
    constexpr int NB = F8 ? 2 : 1, TS = 516;
    const int l32 = lane & 31, hf = lane >> 5;
#pragma unroll 1
    for (int batch = 0; batch < NB; ++batch) {
        const int kb = batch * 256 + wave * 32;
        f32x4 v[4][4];
#pragma unroll
        for (int i = 0; i < 4; ++i)
#pragma unroll
            for (int j = 0; j < 4; ++j) v[i][j] = __builtin_nontemporal_load((const f32x4*)(W + (size_t)(k0 + kb + 4 * (2 * i + hf) + j) * ldw + c0 + 4 * l32));
#pragma unroll
        for (int i = 0; i < 4; ++i) { const int kk = kb + 4 * (2 * i + hf);
#pragma unroll
            for (int c = 0; c < 4; ++c) { LAS unsigned char* tp = T + (4 * l32 + c) * TS + (F8 ? kk : 2 * kk);
                if (F8) *(LAS unsigned*)tp = pk4_fp8(v[i][0][c] * scale, v[i][1][c] * scale, v[i][2][c] * scale, v[i][3][c] * scale);
                else { *(LAS unsigned*)tp = pk2(v[i][0][c], v[i][1][c]); *(LAS unsigned*)(tp + 4) = pk2(v[i][2][c], v[i][3][c]); } } }
    }
    __syncthreads();
#pragma unroll
    for (int i = 0; i < 8; ++i) { const int piece = tid + NTHR * i, n = piece >> 5, c = piece & 31; const LAS unsigned* tp = (const LAS unsigned*)(T + n * TS + 16 * c);
        v4u o; o.x = tp[0]; o.y = tp[1]; o.z = tp[2]; o.w = tp[3];
        *(GAS v4u*)(WT + (size_t)(drow0 + n) * rowb + (F8 ? k0 : 2 * k0) + 16 * c) = o; }
    __syncthreads();
}
constexpr int KB1 = MOE_FP8_G1 ? 2 : 4, KB2 = MOE_FP8_G2 ? 2 : 4, I_E1 = NE * 16 * KB1, I_E2 = NE * 8 * KB2, N_EXP_ITEMS = I_E1 + I_E2;
constexpr int N_BG_ITEMS = 0;
__device__ __forceinline__ void p0_expert_item(const Args& a, LAS unsigned char* lds, int it, int tid, int wave, int lane) {
    unsigned char* ws = a.ws;
    if (it < I_E1) { const int e = it / (16 * KB1), r2 = it % (16 * KB1), nb = r2 / KB1, kb = r2 % KB1, c0 = 128 * nb;
        const int drow = e * 2048 + ((c0 < 1024) ? (256 * (c0 >> 7)) : (256 * ((c0 - 1024) >> 7) + 128));
        p0_item<MOE_FP8_G1 != 0>(a.in[I_W1] + (size_t)e * 1024 * 2048, 2048, (MOE_FP8_G1 ? 512 : 256) * kb, c0, ws + WS_W1, drow, MOE_FP8_G1 ? 1024 : 2048, 128.0f, lds, tid, wave, lane); }
    else { const int r = it - I_E1, e = r / (8 * KB2), r2 = r % (8 * KB2), nb = r2 / KB2, kb = r2 % KB2;
        p0_item<MOE_FP8_G2 != 0>(a.in[I_W2] + (size_t)e * 1024 * 1024, 1024, (MOE_FP8_G2 ? 512 : 256) * kb, 128 * nb, ws + WS_W2, e * 1024 + 128 * nb, MOE_FP8_G2 ? 1024 : 2048, 128.0f, lds, tid, wave, lane); }
}
struct P0Src { const float* W; int ldw, k0, c0, drow; unsigned char* WT; };
__device__ __forceinline__ P0Src p0_expert_src(const Args& a, int it) {
    P0Src s;
    if (it < I_E1) { const int e = it / (16 * KB1), r2 = it % (16 * KB1), nb = r2 / KB1, kb = r2 % KB1, c0 = 128 * nb;
        s.W = a.in[I_W1] + (size_t)e * 1024 * 2048; s.ldw = 2048; s.k0 = 512 * kb; s.c0 = c0; s.drow = e * 2048 + ((c0 < 1024) ? (256 * (c0 >> 7)) : (256 * ((c0 - 1024) >> 7) + 128)); s.WT = a.ws + WS_W1; }
    else { const int r = it - I_E1, e = r / (8 * KB2), r2 = r % (8 * KB2), nb = r2 / KB2, kb = r2 % KB2;
        s.W = a.in[I_W2] + (size_t)e * 1024 * 1024; s.ldw = 1024; s.k0 = 512 * kb; s.c0 = 128 * nb; s.drow = e * 1024 + 128 * nb; s.WT = a.ws + WS_W2; }
    return s;
}
__device__ __forceinline__ void p0_load_batch(f32x4 (&v)[4][4], const P0Src& s, int batch, int wave, int lane) {
    const int l32 = lane & 31, hf = lane >> 5, kb = batch * 256 + wave * 32;
#pragma unroll
    for (int i = 0; i < 4; ++i)
#pragma unroll
        for (int j = 0; j < 4; ++j) v[i][j] = __builtin_nontemporal_load((const f32x4*)(s.W + (size_t)(s.k0 + kb + 4 * (2 * i + hf) + j) * s.ldw + s.c0 + 4 * l32));
}
__device__ __forceinline__ void p0_pack_batch8(const f32x4 (&v)[4][4], int batch, LAS unsigned char* T, int wave, int lane) {
    const int l32 = lane & 31, hf = lane >> 5, kb = batch * 256 + wave * 32;
#pragma unroll
    for (int i = 0; i < 4; ++i) { const int kk = kb + 4 * (2 * i + hf);
#pragma unroll
        for (int c = 0; c < 4; ++c) *(LAS unsigned*)(T + (4 * l32 + c) * 516 + kk) = pk4_fp8(v[i][0][c] * 128.0f, v[i][1][c] * 128.0f, v[i][2][c] * 128.0f, v[i][3][c] * 128.0f); }
}
__device__ __forceinline__ void p0_expert_items_pipelined(const Args& a, LAS unsigned char* T, int bid, int G, int n_items, int tid, int wave, int lane) {
    if (bid >= n_items) return;
    f32x4 vA[4][4], vB[4][4];
    P0Src cur = p0_expert_src(a, bid);
    p0_load_batch(vA, cur, 0, wave, lane);
#pragma unroll 1
    for (int it = bid; it < n_items; it += G) {
        p0_load_batch(vB, cur, 1, wave, lane);
        p0_pack_batch8(vA, 0, T, wave, lane);
        const int nx = it + G; const P0Src nxt = p0_expert_src(a, nx < n_items ? nx : it);
        if (nx < n_items) p0_load_batch(vA, nxt, 0, wave, lane);
        p0_pack_batch8(vB, 1, T, wave, lane);
        __syncthreads();
#pragma unroll
        for (int i = 0; i < 8; ++i) { const int piece = tid + NTHR * i, n = piece >> 5, c = piece & 31; const LAS unsigned* tp = (const LAS unsigned*)(T + n * 516 + 16 * c);
            v4u o; o.x = tp[0]; o.y = tp[1]; o.z = tp[2]; o.w = tp[3];
            *(GAS v4u*)(cur.WT + (size_t)(cur.drow + n) * 1024 + cur.k0 + 16 * c) = o; }
        __syncthreads();
        cur = nxt;
    }
}
__device__ __forceinline__ void p0_bg_items(const Args& a, LAS unsigned char* lds, int bid, int G, int tid, int wave, int lane) {
    if (G == 256 && bid >= 128) { for (int j = 0; j < N_BG_ITEMS / 128; ++j) p0_expert_item(a, lds, N_EXP_ITEMS - N_BG_ITEMS + (bid - 128) + 128 * j, tid, wave, lane); }
}
__device__ __forceinline__ void p0_prologue(const Args& a, LAS unsigned char* lds, int bid, int G, int tid, int wave, int lane) {
    unsigned char* ws = a.ws;
    { const int gw = (G - 1 - bid) * NWAVES + wave, NGW = G * NWAVES;
      for (int it = gw; it < 192; it += NGW) {
        const int nc = it % 24, kc = it / 24, n = nc * 256 + 4 * lane;
        const float* W = a.in[I_ADAW]; const float* c = a.in[I_C];
        f32x4 a0 = {0.f, 0.f, 0.f, 0.f}, a1 = {0.f, 0.f, 0.f, 0.f};
#pragma unroll 8
        for (int kk = 0; kk < 128; ++kk) { const int k = kc * 128 + kk; const f32x4 w = __builtin_nontemporal_load((const f32x4*)(W + (size_t)k * 6144 + n));
            const float c0 = silu_f(c[k]), c1 = silu_f(c[1024 + k]); a0 += c0 * w; a1 += c1 * w; }
        float* mp = (float*)(ws + WS_MODP);
        *(f32x4*)(mp + (size_t)(kc * 2 + 0) * 6144 + n) = a0; *(f32x4*)(mp + (size_t)(kc * 2 + 1) * 6144 + n) = a1;
      } }
    constexpr int I_IN = 28 * 4, I_OUT = 8 * 4;
    const int n_p0 = (G == 256) ? (N_EXP_ITEMS - N_BG_ITEMS) : N_EXP_ITEMS;
    if (MOE_FP8_G1 && MOE_FP8_G2) p0_expert_items_pipelined(a, lds, bid, G, n_p0, tid, wave, lane);
    else for (int it = bid; it < n_p0; it += G) p0_expert_item(a, lds, it, tid, wave, lane);
    for (int it = bid; it < I_IN + I_OUT; it += G) {
        if (it < I_IN) { const int nb = it >> 2, kb = it & 3; p0_item<false>(a.in[I_WIN], IN_COLS, 256 * kb, 128 * nb, ws + WS_WIN, 128 * nb, 2048, 1.0f, lds, tid, wave, lane); }
        else { const int r = it - I_IN, nb = r >> 2, kb = r & 3; p0_item<false>(a.in[I_WOUT], D, 256 * kb, 128 * nb, ws + WS_WOUT, 128 * nb, 2048, 1.0f, lds, tid, wave, lane); }
    }
}

__device__ __forceinline__ void load_mod_AS(LAS float* A, LAS float* S, const float* normw, const float* src, int nparts, const float* bias, int b, int shift_off, int tid) {
    for (int k = tid; k < 1024; k += NTHR) {
        float sh = bias ? bias[shift_off + k] : 0.f, sc = bias ? bias[shift_off + 1024 + k] : 0.f;
        for (int p = 0; p < nparts; ++p) { const float* q = src + (size_t)(p * 2 + b) * 6144 + shift_off; sh += q[k]; sc += q[1024 + k]; }
        A[k] = normw[k] * (1.0f + sc); S[k] = sh;
    }
}
__device__ __forceinline__ float softplus_f(float x) { return fmaxf(x, 0.f) + log1pf(__expf(-fabsf(x))); }

__device__ __forceinline__ void p1_norm(const Args& a, LAS unsigned char* lds, int bid, int G, int tid, int wave, int lane) {
    unsigned char* ws = a.ws;
    LAS float* A1 = (LAS float*)(lds); LAS float* S1 = A1 + 1024; LAS float* WDT = S1 + 1024;
    const float* modp = (const float*)(ws + WS_MODP);
    for (int idx = bid * NTHR + tid; idx < 2 * 6144; idx += G * NTHR) { const int b = idx / 6144, n = idx % 6144; float s = a.in[I_ADAB][n];
        for (int p = 0; p < 8; ++p) s += modp[(size_t)(p * 2 + b) * 6144 + n];
        ((float*)(ws + WS_MODF))[idx] = s; }
    for (int idx = tid; idx < 8192; idx += NTHR) { const int k = idx >> 3, jj = idx & 7; WDT[jj * 1024 + k] = a.in[I_WIN][(size_t)k * IN_COLS + NPROJ + jj]; }
    const float* x = a.in[I_X]; bf16* H = (bf16*)(ws + WS_H); float* DT = (float*)(ws + WS_DT);
    for (int c = bid; c < NCHUNK; c += G) {
        const int b = c >> 7;
        __syncthreads();
        load_mod_AS(A1, S1, a.in[I_N1W], modp, 8, a.in[I_ADAB], b, 0, tid);
        __syncthreads();
        f32x4 vn[4];
        { const GAS f32x4* xr = (const GAS f32x4*)(x + (size_t)(c * 64 + wave * 8) * D) + lane;
#pragma unroll
          for (int j = 0; j < 4; ++j) vn[j] = __builtin_nontemporal_load((const f32x4*)xr + 64 * j); }
#pragma unroll 1
        for (int r = 0; r < 8; ++r) {
            const int m = c * 64 + wave * 8 + r;
            f32x4 v[4]; float ss = 0.f;
#pragma unroll
            for (int j = 0; j < 4; ++j) { v[j] = vn[j]; ss += (v[j].x * v[j].x + v[j].y * v[j].y) + (v[j].z * v[j].z + v[j].w * v[j].w); }
            if (r < 7) { const GAS f32x4* xr = (const GAS f32x4*)(x + (size_t)(m + 1) * D) + lane;
#pragma unroll
                for (int j = 0; j < 4; ++j) vn[j] = __builtin_nontemporal_load((const f32x4*)xr + 64 * j); }
            const float rstd = rsqrtf(wave_sum(ss) * (1.0f / D) + EPS);
            float dacc[8];
#pragma unroll
            for (int jj = 0; jj < 8; ++jj) dacc[jj] = 0.f;
            GAS unsigned long long* o8 = (GAS unsigned long long*)(H + (size_t)m * D) + lane;
#pragma unroll
            for (int j = 0; j < 4; ++j) {
                const f32x4 av = *(const LAS f32x4*)(A1 + 256 * j + 4 * lane), sv = *(const LAS f32x4*)(S1 + 256 * j + 4 * lane);
                const f32x4 h = v[j] * rstd * av + sv;
                o8[64 * j] = (unsigned long long)pk2(h.x, h.y) | ((unsigned long long)pk2(h.z, h.w) << 32);
#pragma unroll
                for (int jj = 0; jj < 8; ++jj) { const f32x4 w = *(const LAS f32x4*)(WDT + jj * 1024 + 256 * j + 4 * lane); dacc[jj] += (h.x * w.x + h.y * w.y) + (h.z * w.z + h.w * w.w); }
            }
            { const bool u5 = (lane & 32) != 0, u4 = (lane & 16) != 0, u3 = (lane & 8) != 0; float p4[4], p2[2], p1;
#pragma unroll
              for (int i = 0; i < 4; ++i) { const float lo = dacc[i], hi = dacc[i + 4]; p4[i] = (u5 ? hi : lo) + __shfl_xor(u5 ? lo : hi, 32); }
#pragma unroll
              for (int i = 0; i < 2; ++i) { const float lo = p4[i], hi = p4[i + 2]; p2[i] = (u4 ? hi : lo) + __shfl_xor(u4 ? lo : hi, 16); }
              { const float lo = p2[0], hi = p2[1]; p1 = (u3 ? hi : lo) + __shfl_xor(u3 ? lo : hi, 8); }
              p1 += __shfl_xor(p1, 4); p1 += __shfl_xor(p1, 2); p1 += __shfl_xor(p1, 1);
              const int col = lane >> 3;
              if ((lane & 7) == 0) DT[(size_t)m * 8 + col] = softplus_f(p1 + a.in[I_DTB][col]); }
        }
    }
}

__device__ __forceinline__ void hgrn_naive(const Args& a, LAS unsigned char* lds, int bh, int tid, int wave, int lane) {
    unsigned char* ws = a.ws;
    const int b = bh >> 2, h = bh & 3, j = tid & 127, kq = tid >> 7;
    LAS float* FE = (LAS float*)lds; LAS float* KK = FE + 2048; LAS float* QQ = KK + 2048; LAS float* VV = QQ + 2048; LAS float* RED = VV + 2048;
    const bf16* P = (const bf16*)(ws + WS_P); const float* LF = (const float*)(ws + WS_LF); bf16* MIX = (bf16*)(ws + WS_MIX);
    const float* nw = a.in[I_HGNW];
    float S[32];
#pragma unroll
    for (int i = 0; i < 32; ++i) S[i] = 0.f;
    for (int t0 = 0; t0 < SEQ; t0 += 16) {
        for (int idx = tid; idx < 2048; idx += NTHR) { const int tt = idx >> 7, k = idx & 127; const size_t row = (size_t)b * SEQ + t0 + tt;
            FE[idx] = __expf(LF[row * 512 + h * 128 + k]); KK[idx] = bf2f(P[row * NPROJ + PC_K + h * 128 + k]);
            QQ[idx] = bf2f(P[row * NPROJ + PC_Q + h * 128 + k]); VV[idx] = bf2f(P[row * NPROJ + PC_V + h * 128 + k]); }
        __syncthreads();
#pragma unroll 1
        for (int tt = 0; tt < 16; ++tt) {
            const float vj = VV[tt * 128 + j]; float p = 0.f;
#pragma unroll
            for (int i4 = 0; i4 < 8; ++i4) {
                const f32x4 f4 = *(const LAS f32x4*)(FE + tt * 128 + 32 * kq + 4 * i4), k4 = *(const LAS f32x4*)(KK + tt * 128 + 32 * kq + 4 * i4), q4 = *(const LAS f32x4*)(QQ + tt * 128 + 32 * kq + 4 * i4);
#pragma unroll
                for (int c = 0; c < 4; ++c) { S[4 * i4 + c] = f4[c] * S[4 * i4 + c] + k4[c] * vj; p += S[4 * i4 + c] * q4[c]; }
            }
            RED[(kq * 16 + tt) * 128 + j] = p;
        }
        __syncthreads();
#pragma unroll
        for (int r = 0; r < 2; ++r) { const int tt = 2 * wave + r; const size_t row = (size_t)b * SEQ + t0 + tt;
            float o0 = 0.f, o1 = 0.f;
#pragma unroll
            for (int q = 0; q < 4; ++q) { o0 += RED[(q * 16 + tt) * 128 + lane]; o1 += RED[(q * 16 + tt) * 128 + 64 + lane]; }
            const float rstd = rsqrtf(wave_sum(o0 * o0 + o1 * o1) * (1.0f / 128.0f) + EPS);
            MIX[row * D + h * 128 + lane] = (bf16)f2bf(o0 * rstd * nw[lane] * bf2f(P[row * NPROJ + PC_G + h * 128 + lane]));
            MIX[row * D + h * 128 + 64 + lane] = (bf16)f2bf(o1 * rstd * nw[64 + lane] * bf2f(P[row * NPROJ + PC_G + h * 128 + 64 + lane])); }
    }
}
__device__ __forceinline__ void ssd_naive(const Args& a, LAS unsigned char* lds, int bg, int tid, int wave, int lane) {
    unsigned char* ws = a.ws;
    const int b = bg >> 1, g = bg & 1, p = tid & 63, hl = wave >> 1, nh = wave & 1;
    LAS float* XS = (LAS float*)lds; LAS float* BM = XS + 4096; LAS float* CM = BM + 2048; LAS float* DTL = CM + 2048; LAS float* DEC = DTL + 64; LAS float* RED = DEC + 64;
    const bf16* P = (const bf16*)(ws + WS_P); const float* DT = (const float*)(ws + WS_DT); bf16* MIX = (bf16*)(ws + WS_MIX);
    const float* cw = a.in[I_CONVW]; const float* cb = a.in[I_CONVB];
    float hS[64];
#pragma unroll
    for (int i = 0; i < 64; ++i) hS[i] = 0.f;
    for (int t0 = 0; t0 < SEQ; t0 += 16) {
        for (int idx = tid; idx < 16 * 512; idx += NTHR) { const int tt = idx >> 9, cc = idx & 511, t = t0 + tt;
            const int ch = (cc < 256) ? (g * 256 + cc) : (cc < 384) ? (512 + g * 128 + (cc - 256)) : (768 + g * 128 + (cc - 384));
            float v = cb[ch];
#pragma unroll
            for (int w = 0; w < 4; ++w) { const int ts = t - 3 + w; if (ts >= 0) v += bf2f(P[((size_t)b * SEQ + ts) * NPROJ + PC_X + ch]) * cw[w * 1024 + ch]; }
            v = silu_f(v);
            if (cc < 256) XS[tt * 256 + cc] = v; else if (cc < 384) BM[tt * 128 + cc - 256] = v; else CM[tt * 128 + cc - 384] = v; }
        if (tid < 64) { const int tt = tid >> 2, hh = tid & 3; const float dtv = DT[((size_t)b * SEQ + t0 + tt) * 8 + g * 4 + hh]; DTL[tid] = dtv; DEC[tid] = __expf(-dtv * __expf(a.in[I_ALOG][g * 4 + hh])); }
        __syncthreads();
#pragma unroll 1
        for (int tt = 0; tt < 16; ++tt) {
            const float dec = DEC[tt * 4 + hl], xdt = XS[tt * 256 + hl * 64 + p] * DTL[tt * 4 + hl]; float y = 0.f;
#pragma unroll
            for (int i4 = 0; i4 < 16; ++i4) { const f32x4 B4 = *(const LAS f32x4*)(BM + tt * 128 + nh * 64 + 4 * i4), C4 = *(const LAS f32x4*)(CM + tt * 128 + nh * 64 + 4 * i4);
#pragma unroll
                for (int c = 0; c < 4; ++c) { hS[4 * i4 + c] = dec * hS[4 * i4 + c] + xdt * B4[c]; y += hS[4 * i4 + c] * C4[c]; } }
            RED[(nh * 16 + tt) * 256 + hl * 64 + p] = y;
        }
        __syncthreads();
#pragma unroll
        for (int r = 0; r < 2; ++r) { const int tt = 2 * wave + r; const size_t row = (size_t)b * SEQ + t0 + tt;
            float yv[4], ss = 0.f;
#pragma unroll
            for (int i = 0; i < 4; ++i) { const int c = lane + 64 * i; float y = RED[tt * 256 + c] + RED[(16 + tt) * 256 + c] + a.in[I_SSMD][g * 4 + i] * XS[tt * 256 + c];
                y *= bf2f(P[row * NPROJ + PC_Z + g * 256 + c]); yv[i] = y; ss += y * y; }
            const float rstd = rsqrtf(wave_sum(ss) * (1.0f / 256.0f) + EPS);
#pragma unroll
            for (int i = 0; i < 4; ++i) { const int c = lane + 64 * i; MIX[row * D + 512 + g * 256 + c] = (bf16)f2bf(yv[i] * rstd * a.in[I_SSMNW][g * 256 + c]); }
        }
        __syncthreads();
    }
}


typedef float f32x16 __attribute__((ext_vector_type(16)));
constexpr size_t WS_UHG = 480 * MiB, WS_SHG = 496 * MiB, WS_USSD = 512 * MiB, WS_SSSD = 544 * MiB, WS_DK = 560 * MiB, WS_DEC = 561 * MiB;
constexpr int LDA = 136, LDT = 72;

__device__ __forceinline__ int crow(int i, int hh) { return (i & 3) + 8 * (i >> 2) + 4 * hh; }
__device__ __forceinline__ void mma32(f32x16& acc, const LAS bf16* A, int lda, const LAS bf16* Bt, int ldb, int nsteps, int lane) {
    const LAS bf16* ap = A + (lane & 31) * lda + 8 * (lane >> 5);
    const LAS bf16* bp = Bt + (lane & 31) * ldb + 8 * (lane >> 5);
    for (int s = 0; s < nsteps; ++s) {
        const bf16x8 av = *(const LAS bf16x8*)(ap + 16 * s), bv = *(const LAS bf16x8*)(bp + 16 * s);
        acc = __builtin_amdgcn_mfma_f32_32x32x16_bf16(av, bv, acc, 0, 0, 0);
    }
}
__device__ __forceinline__ f32x16 zero16() { f32x16 z;
#pragma unroll
    for (int i = 0; i < 16; ++i) z[i] = 0.f; return z; }
__device__ __forceinline__ void st8(LAS bf16* p, float a, float b, float c, float d) { *(LAS unsigned long long*)p = (unsigned long long)pk2(a, b) | ((unsigned long long)pk2(c, d) << 32); }
__device__ __forceinline__ void st16x(LAS bf16* p, const float* v) {
    v4u a, b; a.x = pk2(v[0], v[1]); a.y = pk2(v[2], v[3]); a.z = pk2(v[4], v[5]); a.w = pk2(v[6], v[7]); b.x = pk2(v[8], v[9]); b.y = pk2(v[10], v[11]); b.z = pk2(v[12], v[13]); b.w = pk2(v[14], v[15]);
    *(LAS v4u*)p = a; *(LAS v4u*)(p + 8) = b; }

__device__ __forceinline__ float bfw(unsigned w, int hi) { return __uint_as_float(hi ? (w & 0xffff0000u) : (w << 16)); }
constexpr int HG_QS = 0, HG_KS = 17408, HG_KDT = 34816, HG_VT = 53248, HG_ST = 71680, HG_ATT = 106496, HG_QT = 115712, HG_EBM = 117760, HG_EBL = 118272;
constexpr int HG_VRAW = 118784;
struct HgWide { v4u q[2], k[2], v[2]; float lf[16]; };
template <bool FULL> __device__ __forceinline__ void hg_load(const Args& a, HgWide& r, int b, int h, int t0, int tid) {
    const bf16* P = (const bf16*)(a.ws + WS_P) + ((size_t)b * SEQ + t0) * NPROJ + h * 128;
#pragma unroll
    for (int i = 0; i < 2; ++i) { const int piece = tid + NTHR * i; const unsigned o = (unsigned)(piece >> 4) * NPROJ + 8u * (unsigned)(piece & 15);
        r.k[i] = *(const v4u*)(P + o + PC_K); r.v[i] = *(const v4u*)(P + o + PC_V); if (FULL) r.q[i] = *(const v4u*)(P + o + PC_Q); }
    const int k = tid & 127, tq = tid >> 7;
    const float* LF = (const float*)(a.ws + WS_LF) + ((size_t)b * SEQ + t0 + 16 * tq) * 512 + h * 128;
#pragma unroll
    for (int i = 0; i < 16; ++i) r.lf[i] = LF[(unsigned)i * 512 + (unsigned)k];
}
template <bool FULL> __device__ __forceinline__ float hg_stage(const HgWide& r, LAS unsigned char* lds, int tid) {
    LAS bf16* QS = (LAS bf16*)(lds + HG_QS); LAS bf16* KS = (LAS bf16*)(lds + HG_KS); LAS bf16* KDT = (LAS bf16*)(lds + HG_KDT); LAS bf16* VT = (LAS bf16*)(lds + HG_VT); LAS bf16* VR = (LAS bf16*)(lds + HG_VRAW);
    LAS float* QT = (LAS float*)(lds + HG_QT); LAS float* EBM = (LAS float*)(lds + HG_EBM); LAS float* EBL = (LAS float*)(lds + HG_EBL);
#pragma unroll
    for (int i = 0; i < 2; ++i) { const int piece = tid + NTHR * i; const int o = (piece >> 4) * LDA + 8 * (piece & 15);
        *(LAS v4u*)(KS + o) = r.k[i]; *(LAS v4u*)(VR + o) = r.v[i]; if (FULL) *(LAS v4u*)(QS + o) = r.q[i]; }
    const int k = tid & 127, tq = tid >> 7;
    float cum[16]; float run = 0.f;
#pragma unroll
    for (int i = 0; i < 16; ++i) { run += r.lf[i]; cum[i] = run; }
    QT[tq * 128 + k] = run;
    __syncthreads();
    const float q0 = QT[k], q1 = QT[128 + k], q2 = QT[256 + k], q3 = QT[384 + k];
    const float off = (tq > 0 ? q0 : 0.f) + (tq > 1 ? q1 : 0.f) + (tq > 2 ? q2 : 0.f), bmid = q0 + q1, blast = (q0 + q1) + (q2 + q3);
    float kd[16], vv[16];
#pragma unroll
    for (int i = 0; i < 16; ++i) { const float bt = off + cum[i]; const int e = (16 * tq + i) * LDA + k; const float kk = bf2f(KS[e]); vv[i] = bf2f(VR[e]); kd[i] = kk * __expf(blast - bt);
        if (FULL) { QS[e] = (bf16)f2bf(bf2f(QS[e]) * __expf(bt - bmid)); KS[e] = (bf16)f2bf(kk * __expf(bmid - bt)); } }
    st16x(KDT + k * LDT + 16 * tq, kd); st16x(VT + k * LDT + 16 * tq, vv);
    if (tq == 0) { EBL[k] = __expf(blast); if (FULL) EBM[k] = __expf(bmid); }
    __syncthreads();
    return blast;
}
__device__ __forceinline__ void hg_update(f32x16 (&S)[2], LAS unsigned char* lds, int wave, int lane) {
    const LAS bf16* KDT = (const LAS bf16*)(lds + HG_KDT); const LAS bf16* VT = (const LAS bf16*)(lds + HG_VT); const LAS float* EBL = (const LAS float*)(lds + HG_EBL);
    const int kt = wave >> 1, hh = lane >> 5;
#pragma unroll
    for (int g = 0; g < 4; ++g) { const f32x4 e = *(const LAS f32x4*)(EBL + 32 * kt + 8 * g + 4 * hh);
#pragma unroll
        for (int j = 0; j < 2; ++j) { S[j][4 * g + 0] *= e.x; S[j][4 * g + 1] *= e.y; S[j][4 * g + 2] *= e.z; S[j][4 * g + 3] *= e.w; } }
#pragma unroll
    for (int j = 0; j < 2; ++j) mma32(S[j], KDT + 32 * kt * LDT, LDT, VT + 32 * (2 * (wave & 1) + j) * LDT, LDT, 4, lane);
}
__device__ __forceinline__ void hg_passA(const Args& a, LAS unsigned char* lds, int u, int tid, int wave, int lane) {
    const int bh = u >> 5, seg = u & 31, b = bh >> 2, h = bh & 3, kt = wave >> 1, hh = lane >> 5, r = lane & 31;
    f32x16 S[2]; S[0] = zero16(); S[1] = zero16();
    float dsum = 0.f;
    HgWide cur; hg_load<false>(a, cur, b, h, seg * 256, tid);
#pragma unroll 1
    for (int c = 0; c < 4; ++c) {
        dsum += hg_stage<false>(cur, lds, tid);
        if (c < 3) hg_load<false>(a, cur, b, h, seg * 256 + 64 * (c + 1), tid);
        hg_update(S, lds, wave, lane);
        __syncthreads();
    }
    float* U = (float*)(a.ws + WS_UHG) + (size_t)u * 16384;
#pragma unroll
    for (int j = 0; j < 2; ++j)
#pragma unroll
        for (int i = 0; i < 16; ++i) U[(32 * kt + crow(i, hh)) * 128 + 32 * (2 * (wave & 1) + j) + r] = S[j][i];
    if (tid < 128) ((float*)(a.ws + WS_DK))[u * 128 + tid] = __expf(dsum);
}
__device__ __forceinline__ void hg_passC(const Args& a, LAS unsigned char* lds, int u, int tid, int wave, int lane) {
    const int bh = u >> 5, seg = u & 31, b = bh >> 2, h = bh & 3, kt = wave >> 1, hh = lane >> 5, r = lane & 31;
    LAS bf16* QS = (LAS bf16*)(lds + HG_QS); LAS bf16* KS = (LAS bf16*)(lds + HG_KS); LAS bf16* VT = (LAS bf16*)(lds + HG_VT);
    LAS bf16* ST = (LAS bf16*)(lds + HG_ST); LAS bf16* ATT = (LAS bf16*)(lds + HG_ATT); LAS float* EBM = (LAS float*)(lds + HG_EBM); LAS float* O = (LAS float*)(lds + HG_QS);
    const bf16* P = (const bf16*)(a.ws + WS_P); bf16* MIX = (bf16*)(a.ws + WS_MIX); const float* nw = a.in[I_HGNW];
    f32x16 S[2];
    { const float* SI = (const float*)(a.ws + WS_SHG) + (size_t)u * 16384;
#pragma unroll
      for (int j = 0; j < 2; ++j)
#pragma unroll
        for (int i = 0; i < 16; ++i) S[j][i] = SI[(32 * kt + crow(i, hh)) * 128 + 32 * (2 * (wave & 1) + j) + r]; }
    HgWide cur; hg_load<true>(a, cur, b, h, seg * 256, tid);
#pragma unroll 1
    for (int c = 0; c < 4; ++c) {
        const int t0 = seg * 256 + 64 * c;
        hg_stage<true>(cur, lds, tid);
        if (c < 3) hg_load<true>(a, cur, b, h, t0 + 64, tid);
#pragma unroll
        for (int g = 0; g < 4; ++g) { const int kb = 32 * kt + 8 * g + 4 * hh; const f32x4 e = *(const LAS f32x4*)(EBM + kb);
#pragma unroll
            for (int j = 0; j < 2; ++j) st8(ST + (32 * (2 * (wave & 1) + j) + r) * LDA + kb, S[j][4 * g] * e.x, S[j][4 * g + 1] * e.y, S[j][4 * g + 2] * e.z, S[j][4 * g + 3] * e.w); }
        if (wave < 3) { const int ti = (wave + 1) >> 1, si = wave >> 1;
            f32x16 at = zero16(); mma32(at, QS + 32 * ti * LDA, LDA, KS + 32 * si * LDA, LDA, 8, lane);
#pragma unroll
            for (int i = 0; i < 16; ++i) { const int t = 32 * ti + crow(i, hh), s = 32 * si + r; ATT[t * LDT + s] = (bf16)f2bf(s <= t ? at[i] : 0.f); } }
        __syncthreads();
        const int ti = wave >> 2, vj = wave & 3;
        f32x16 o = zero16();
        mma32(o, ATT + 32 * ti * LDT, LDT, VT + 32 * vj * LDT, LDT, 2 * (ti + 1), lane);
        mma32(o, QS + 32 * ti * LDA, LDA, ST + 32 * vj * LDA, LDA, 8, lane);
        hg_update(S, lds, wave, lane);
        __syncthreads();
#pragma unroll
        for (int i = 0; i < 16; ++i) O[(32 * ti + crow(i, hh)) * 132 + 32 * vj + r] = o[i];
        __syncthreads();
        { const int tt = tid >> 3, c16 = tid & 7; const size_t row = (size_t)b * SEQ + t0 + tt;
          float o[16]; float ss = 0.f;
#pragma unroll
          for (int q = 0; q < 4; ++q) { const f32x4 v = *(const LAS f32x4*)(O + tt * 132 + 16 * c16 + 4 * q); o[4 * q] = v.x; o[4 * q + 1] = v.y; o[4 * q + 2] = v.z; o[4 * q + 3] = v.w; ss += (v.x * v.x + v.y * v.y) + (v.z * v.z + v.w * v.w); }
          ss += __shfl_xor(ss, 1); ss += __shfl_xor(ss, 2); ss += __shfl_xor(ss, 4);
          const float rstd = rsqrtf(ss * (1.0f / 128.0f) + EPS);
          const bf16* gp = P + row * NPROJ + PC_G + h * 128 + 16 * c16; const v4u g0 = __builtin_nontemporal_load((const v4u*)gp), g1 = __builtin_nontemporal_load((const v4u*)(gp + 8)); const unsigned gw[8] = {g0.x, g0.y, g0.z, g0.w, g1.x, g1.y, g1.z, g1.w};
          unsigned ow[8];
#pragma unroll
          for (int j = 0; j < 8; ++j) ow[j] = pk2(o[2 * j] * rstd * nw[16 * c16 + 2 * j] * bfw(gw[j], 0), o[2 * j + 1] * rstd * nw[16 * c16 + 2 * j + 1] * bfw(gw[j], 1));
          bf16* mp = MIX + row * D + h * 128 + 16 * c16; *(v4u*)mp = (v4u){ow[0], ow[1], ow[2], ow[3]}; *(v4u*)(mp + 8) = (v4u){ow[4], ow[5], ow[6], ow[7]}; }
        __syncthreads();
    }
}

constexpr int SD_ACUM = 104448, SD_DTV = 106496, SD_SSQ = 108544, SD_CB = 109568;
__device__ __forceinline__ void ssd_scan_dt(const Args& a, LAS unsigned char* lds, size_t row0, int g, int wave, int lane) {
    LAS float* ACUM = (LAS float*)(lds + SD_ACUM); LAS float* DTV = (LAS float*)(lds + SD_DTV);
    if (wave < 4) { const float* DT = (const float*)(a.ws + WS_DT); const float A = -__expf(a.in[I_ALOG][g * 4 + wave]);
        const float d0 = DT[(row0 + 2 * lane) * 8 + g * 4 + wave], d1 = DT[(row0 + 2 * lane + 1) * 8 + g * 4 + wave];
        const float p0 = d0 * A, p1 = p0 + d1 * A; float incl = p1;
#pragma unroll
        for (int o = 1; o < 64; o <<= 1) { const float t = __shfl_up(incl, o); if (lane >= o) incl += t; }
        const float excl = incl - p1;
        ACUM[wave * 128 + 2 * lane] = excl + p0; ACUM[wave * 128 + 2 * lane + 1] = incl; DTV[wave * 128 + 2 * lane] = d0; DTV[wave * 128 + 2 * lane + 1] = d1; }
}
template <int NT> __device__ __forceinline__ void conv_run(const Args& a, int b, int tp0, int ch, float (&out)[NT]) {
    const bf16* Pb = (const bf16*)(a.ws + WS_P) + (size_t)b * SEQ * NPROJ + PC_X;
    const float w0 = a.in[I_CONVW][ch], w1 = a.in[I_CONVW][1024 + ch], w2 = a.in[I_CONVW][2048 + ch], w3 = a.in[I_CONVW][3072 + ch], cb = a.in[I_CONVB][ch];
    const unsigned o0 = (unsigned)tp0 * NPROJ + (unsigned)ch;
    float x0 = (tp0 >= 3) ? bf2f(Pb[o0 - 3u * NPROJ]) : 0.f, x1 = (tp0 >= 2) ? bf2f(Pb[o0 - 2u * NPROJ]) : 0.f, x2 = (tp0 >= 1) ? bf2f(Pb[o0 - 1u * NPROJ]) : 0.f;
#pragma unroll
    for (int i = 0; i < NT; ++i) { const float x3 = bf2f(Pb[o0 + (unsigned)i * NPROJ]); out[i] = silu_f(cb + w0 * x0 + w1 * x1 + w2 * x2 + w3 * x3); x0 = x1; x1 = x2; x2 = x3; }
}
template <bool NATURAL, bool NT = false> __device__ __forceinline__ void conv8x8(const Args& a, int b, int tp0, int ch0, LAS bf16* dst, const float* sc) {
    const bf16* Pb = (const bf16*)(a.ws + WS_P) + (size_t)b * SEQ * NPROJ + PC_X + ch0;
    const float* cw = a.in[I_CONVW] + ch0; const float* cbp = a.in[I_CONVB] + ch0;
    float w[4][8], bias[8];
#pragma unroll
    for (int q = 0; q < 4; ++q) { const f32x4 lo = *(const f32x4*)(cw + q * 1024), hi = *(const f32x4*)(cw + q * 1024 + 4);
        w[q][0] = lo.x; w[q][1] = lo.y; w[q][2] = lo.z; w[q][3] = lo.w; w[q][4] = hi.x; w[q][5] = hi.y; w[q][6] = hi.z; w[q][7] = hi.w; }
    { const f32x4 lo = *(const f32x4*)cbp, hi = *(const f32x4*)(cbp + 4); bias[0] = lo.x; bias[1] = lo.y; bias[2] = lo.z; bias[3] = lo.w; bias[4] = hi.x; bias[5] = hi.y; bias[6] = hi.z; bias[7] = hi.w; }
    v4u raw[11];
#pragma unroll
    for (int i = 0; i < 11; ++i) { const int tp = tp0 - 3 + i; const v4u* rp = (const v4u*)(Pb + (size_t)(unsigned)(tp < 0 ? 0 : tp) * NPROJ); raw[i] = (tp >= 0) ? (NT ? __builtin_nontemporal_load(rp) : *rp) : (v4u){0u, 0u, 0u, 0u}; }
    unsigned pkT[8][4];
#pragma unroll
    for (int tok = 0; tok < 8; ++tok) { float o[8];
#pragma unroll
        for (int c = 0; c < 8; ++c) { float v = bias[c];
#pragma unroll
            for (int q = 0; q < 4; ++q) v += w[q][c] * bfw(raw[tok + q][c >> 1], c & 1);
            o[c] = silu_f(v); }
        if (NATURAL) { v4u ov; ov.x = pk2(o[0], o[1]); ov.y = pk2(o[2], o[3]); ov.z = pk2(o[4], o[5]); ov.w = pk2(o[6], o[7]); *(LAS v4u*)(dst + tok * LDA) = ov; }
        else {
#pragma unroll
            for (int c = 0; c < 8; ++c) { const unsigned hb = f2bf(o[c] * sc[tok]); pkT[c][tok >> 1] = (tok & 1) ? (pkT[c][tok >> 1] | (hb << 16)) : hb; } } }
    if (!NATURAL) {
#pragma unroll
        for (int c = 0; c < 8; ++c) { v4u ov; ov.x = pkT[c][0]; ov.y = pkT[c][1]; ov.z = pkT[c][2]; ov.w = pkT[c][3]; *(LAS v4u*)(dst + c * LDA) = ov; } }
}
constexpr int SC_CM = 0, SC_BM = 34816, SC_XT = 69632, SC_SIN = 87040, SC_YS = 104448, SC_ACUM = 139264, SC_DTV = 141312;
__device__ __forceinline__ void ssd_scan_dt_at(const Args& a, LAS unsigned char* lds, int acum_off, int dtv_off, size_t row0, int g, int wave, int lane) {
    LAS float* ACUM = (LAS float*)(lds + acum_off); LAS float* DTV = (LAS float*)(lds + dtv_off);
    if (wave < 4) { const float* DT = (const float*)(a.ws + WS_DT); const float A = -__expf(a.in[I_ALOG][g * 4 + wave]);
        const float d0 = DT[(row0 + 2 * lane) * 8 + g * 4 + wave], d1 = DT[(row0 + 2 * lane + 1) * 8 + g * 4 + wave];
        const float p0 = d0 * A, p1 = p0 + d1 * A; float incl = p1;
#pragma unroll
        for (int o = 1; o < 64; o <<= 1) { const float t = __shfl_up(incl, o); if (lane >= o) incl += t; }
        const float excl = incl - p1;
        ACUM[wave * 128 + 2 * lane] = excl + p0; ACUM[wave * 128 + 2 * lane + 1] = incl; DTV[wave * 128 + 2 * lane] = d0; DTV[wave * 128 + 2 * lane + 1] = d1; }
}
__device__ __forceinline__ void ssd_passA(const Args& a, LAS unsigned char* lds, int u, int tid, int wave, int lane) {
    const int bg = u >> 6, c = u & 63, b = bg >> 1, g = bg & 1, t0 = c * 128; const size_t row0 = (size_t)b * SEQ + t0;
    LAS bf16* XDT = (LAS bf16*)lds; LAS bf16* BMT = (LAS bf16*)(lds + 69632); LAS float* ACUM = (LAS float*)(lds + SD_ACUM); LAS float* DTV = (LAS float*)(lds + SD_DTV);
    ssd_scan_dt(a, lds, row0, g, wave, lane);
    __syncthreads();
#pragma unroll 1
    for (int task = tid; task < 768; task += NTHR) {
        int task_o = task; asm volatile("" : "+v"(task_o));
        const int cg = task_o >> 4, tb = task_o & 15; float sc[8];
        if (cg < 32) { const int hd = cg >> 3; const float al = ACUM[hd * 128 + 127];
#pragma unroll
            for (int i = 0; i < 8; ++i) sc[i] = DTV[hd * 128 + 8 * tb + i] * __expf(al - ACUM[hd * 128 + 8 * tb + i]);
            conv8x8<false>(a, b, t0 + 8 * tb, g * 256 + 8 * cg, XDT + (8 * cg) * LDA + 8 * tb, sc); }
        else {
#pragma unroll
            for (int i = 0; i < 8; ++i) sc[i] = 1.0f;
            conv8x8<false>(a, b, t0 + 8 * tb, 512 + g * 128 + 8 * (cg - 32), BMT + (8 * (cg - 32)) * LDA + 8 * tb, sc); }
    }
    __syncthreads();
    const int hd = wave >> 1, pt = wave & 1, hh = lane >> 5, r = lane & 31;
    float* U = (float*)(a.ws + WS_USSD) + (size_t)u * 32768;
#pragma unroll
    for (int nt = 0; nt < 4; ++nt) { f32x16 acc = zero16(); mma32(acc, XDT + (hd * 64 + 32 * pt) * LDA, LDA, BMT + 32 * nt * LDA, LDA, 8, lane);
#pragma unroll
        for (int i = 0; i < 16; ++i) U[(hd * 64 + 32 * pt + crow(i, hh)) * 128 + 32 * nt + r] = acc[i]; }
    if (tid < 4) ((float*)(a.ws + WS_DEC))[u * 4 + tid] = __expf(ACUM[tid * 128 + 127]);
    __syncthreads();
}
__device__ __forceinline__ void ssd_passC(const Args& a, LAS unsigned char* lds, int u, int tid, int wave, int lane) {
    const int bg = u >> 6, c = u & 63, b = bg >> 1, g = bg & 1, t0 = c * 128; const size_t row0 = (size_t)b * SEQ + t0;
    LAS bf16* CM = (LAS bf16*)(lds + SC_CM); LAS bf16* BM = (LAS bf16*)(lds + SC_BM); LAS bf16* XT = (LAS bf16*)(lds + SC_XT); LAS bf16* SIN = (LAS bf16*)(lds + SC_SIN);
    LAS float* YS = (LAS float*)(lds + SC_YS); LAS float* ACUM = (LAS float*)(lds + SC_ACUM); LAS float* DTV = (LAS float*)(lds + SC_DTV);
    const bf16* P = (const bf16*)(a.ws + WS_P); bf16* MIX = (bf16*)(a.ws + WS_MIX);
    ssd_scan_dt_at(a, lds, SC_ACUM, SC_DTV, row0, g, wave, lane);
    { const int c8 = tid & 31, tb = tid >> 5;
      conv8x8<true>(a, b, t0 + 8 * tb, (c8 < 16) ? (512 + g * 128 + 8 * c8) : (768 + g * 128 + 8 * (c8 - 16)), ((c8 < 16) ? (BM + 8 * c8) : (CM + 8 * (c8 - 16))) + 8 * tb * LDA, nullptr); }
    __syncthreads();
    const int ti = wave >> 1, pj = wave & 1;
    const int et = tid >> 2, epq = tid & 3;
    float ssq = 0.f;
    const bf16* Pz = P + (row0 + et) * NPROJ + PC_Z + g * 256 + 16 * epq;
    bf16* Mo = MIX + (row0 + et) * D + 512 + g * 256 + 16 * epq;
    float ones[8];
#pragma unroll
    for (int i = 0; i < 8; ++i) ones[i] = 1.0f;
#pragma unroll 1
    for (int hd = 0; hd < 4; ++hd) {
        int tid_o = tid; asm volatile("" : "+v"(tid_o));
        const int lane = tid_o & 63, hh = lane >> 5, r = lane & 31;
        if (tid_o < 128) { const int c8 = tid_o & 7, tb = tid_o >> 3; conv8x8<false>(a, b, t0 + 8 * tb, g * 256 + hd * 64 + 8 * c8, XT + (8 * c8) * LDA + 8 * tb, ones); }
        { const int pr = tid_o >> 3, n0 = (tid_o & 7) * 16; const v4u* src = (const v4u*)((const bf16*)(a.ws + WS_SSSD) + (size_t)u * 32768) + (unsigned)((hd * 64 + pr) * 16 + (tid_o & 7) * 2);
          const v4u s0 = __builtin_nontemporal_load(src), s1 = __builtin_nontemporal_load(src + 1); *(LAS v4u*)(SIN + pr * LDA + n0) = s0; *(LAS v4u*)(SIN + pr * LDA + n0 + 8) = s1; }
        const v4u z0 = __builtin_nontemporal_load((const v4u*)(Pz + hd * 64)), z1 = __builtin_nontemporal_load((const v4u*)(Pz + hd * 64 + 8));
        __syncthreads();
        const float Dh = a.in[I_SSMD][g * 4 + hd];
        f32x16 yi = zero16(), yo = zero16();
        const int t = 32 * ti + r; const float at = ACUM[hd * 128 + t];
        for (int si = 0; si <= ti; ++si) {
            f32x16 cbT = zero16(); mma32(cbT, BM + 32 * si * LDA, LDA, CM + 32 * ti * LDA, LDA, 8, lane);
            float sv[16];
#pragma unroll
            for (int i = 0; i < 16; ++i) { const int s = 32 * si + crow(i, hh); float v = (s <= t) ? cbT[i] * __expf(at - ACUM[hd * 128 + s]) * DTV[hd * 128 + s] : 0.f; sv[i] = (s == t) ? v + Dh : v; }
#pragma unroll
            for (int st = 0; st < 2; ++st) {
                v4u av; av.x = pk2(sv[8 * st], sv[8 * st + 1]); av.y = pk2(sv[8 * st + 2], sv[8 * st + 3]); av.z = pk2(sv[8 * st + 4], sv[8 * st + 5]); av.w = pk2(sv[8 * st + 6], sv[8 * st + 7]);
                const LAS bf16* bp = XT + (32 * pj + r) * LDA + 32 * si + 16 * st + 4 * hh;
                const unsigned long long b0 = *(const LAS unsigned long long*)bp, b1 = *(const LAS unsigned long long*)(bp + 8);
                v4u bv; bv.x = (unsigned)b0; bv.y = (unsigned)(b0 >> 32); bv.z = (unsigned)b1; bv.w = (unsigned)(b1 >> 32);
                yi = __builtin_amdgcn_mfma_f32_32x32x16_bf16(__builtin_bit_cast(bf16x8, av), __builtin_bit_cast(bf16x8, bv), yi, 0, 0, 0);
            }
        }
        mma32(yo, CM + 32 * ti * LDA, LDA, SIN + 32 * pj * LDA, LDA, 8, lane);
#pragma unroll
        for (int i = 0; i < 16; ++i) { const int tt = 32 * ti + crow(i, hh); YS[tt * 68 + 32 * pj + r] = yi[i] + __expf(ACUM[hd * 128 + tt]) * yo[i]; }
        __syncthreads();
        { float y[16];
#pragma unroll
          for (int q = 0; q < 4; ++q) { const f32x4 v = *(const LAS f32x4*)(YS + et * 68 + 16 * epq + 4 * q); y[4 * q] = v.x; y[4 * q + 1] = v.y; y[4 * q + 2] = v.z; y[4 * q + 3] = v.w; }
          const unsigned zw[8] = {z0.x, z0.y, z0.z, z0.w, z1.x, z1.y, z1.z, z1.w};
#pragma unroll
          for (int j = 0; j < 16; ++j) { y[j] *= bfw(zw[j >> 1], j & 1); ssq += y[j] * y[j]; }
          v4u o0, o1; o0.x = pk2(y[0], y[1]); o0.y = pk2(y[2], y[3]); o0.z = pk2(y[4], y[5]); o0.w = pk2(y[6], y[7]); o1.x = pk2(y[8], y[9]); o1.y = pk2(y[10], y[11]); o1.z = pk2(y[12], y[13]); o1.w = pk2(y[14], y[15]);
          *(v4u*)(Mo + hd * 64) = o0; *(v4u*)(Mo + hd * 64 + 8) = o1; }
    }
    ssq += __shfl_xor(ssq, 1); ssq += __shfl_xor(ssq, 2);
    const float rstd = rsqrtf(ssq * (1.0f / 256.0f) + EPS);
    const float* nw = a.in[I_SSMNW] + g * 256 + 16 * epq;
#pragma unroll 1
    for (int hd = 0; hd < 4; ++hd) {
        const v4u i0 = *(const v4u*)(Mo + hd * 64), i1 = *(const v4u*)(Mo + hd * 64 + 8); const unsigned iw[8] = {i0.x, i0.y, i0.z, i0.w, i1.x, i1.y, i1.z, i1.w};
        float wv[16];
#pragma unroll
        for (int q = 0; q < 4; ++q) { const f32x4 v = *(const f32x4*)(nw + hd * 64 + 4 * q); wv[4 * q] = v.x; wv[4 * q + 1] = v.y; wv[4 * q + 2] = v.z; wv[4 * q + 3] = v.w; }
        unsigned ow[8];
#pragma unroll
        for (int j = 0; j < 8; ++j) ow[j] = pk2(bfw(iw[j], 0) * rstd * wv[2 * j], bfw(iw[j], 1) * rstd * wv[2 * j + 1]);
        *(v4u*)(Mo + hd * 64) = (v4u){ow[0], ow[1], ow[2], ow[3]}; *(v4u*)(Mo + hd * 64 + 8) = (v4u){ow[4], ow[5], ow[6], ow[7]};
    }
    __syncthreads();
}
__device__ __forceinline__ void mix_scan(const Args& a, int bid, int G, int tid) {
    typedef float f32x2 __attribute__((ext_vector_type(2)));
    for (int gt = bid * NTHR + tid; gt < 131072; gt += G * NTHR) {
        if (gt < 65536) { const int bh = gt >> 13, e2 = gt & 8191, k = e2 >> 6;
            const f32x2* U = (const f32x2*)(a.ws + WS_UHG) + (size_t)bh * 32 * 8192 + e2; f32x2* SI = (f32x2*)(a.ws + WS_SHG) + (size_t)bh * 32 * 8192 + e2; const float* DK = (const float*)(a.ws + WS_DK) + bh * 32 * 128 + k;
            f32x2 cur = {0.f, 0.f};
#pragma unroll 16
            for (int uu = 0; uu < 32; ++uu) { SI[(size_t)uu * 8192] = cur; cur = cur * DK[uu * 128] + __builtin_nontemporal_load(U + (size_t)uu * 8192); }
        } else { const int q = gt - 65536, bg = q >> 14, e2 = q & 16383, hd = e2 >> 12;
            const f32x2* U = (const f32x2*)(a.ws + WS_USSD) + (size_t)bg * 64 * 16384 + e2; unsigned* SI = (unsigned*)(a.ws + WS_SSSD) + (size_t)bg * 64 * 16384 + e2; const float* DEC = (const float*)(a.ws + WS_DEC) + bg * 64 * 4 + hd;
            f32x2 cur = {0.f, 0.f};
#pragma unroll 16
            for (int cc = 0; cc < 64; ++cc) { SI[(size_t)cc * 16384] = pk2(cur.x, cur.y); cur = cur * DEC[cc * 4] + __builtin_nontemporal_load(U + (size_t)cc * 16384); }
        }
    }
}

template <int HALF, int MASK> __device__ __forceinline__ void tr_step(float (&p)[32], int lane) {
    const bool up = (lane & MASK) != 0;
#pragma unroll
    for (int i = 0; i < HALF; ++i) { const float lo = p[i], hi = p[i + HALF]; const float send = up ? lo : hi, keep = up ? hi : lo; p[i] = keep + __shfl_xor(send, MASK); }
}
__device__ __forceinline__ void top4_store(float v, int lane, LAS int* SEL, LAS float* SELG, int ent) {
    float tv[4]; int ti[4];
#pragma unroll
    for (int k = 0; k < 4; ++k) { const float mx = wave_max(v); const unsigned long long bal = __ballot(v == mx); const int e = __builtin_ctzll(bal) >> 1;
        tv[k] = mx; ti[k] = e; v = ((lane >> 1) == e) ? -INFINITY : v; }
    const float e1 = __expf(tv[1] - tv[0]), e2 = __expf(tv[2] - tv[0]), e3 = __expf(tv[3] - tv[0]), inv = 1.0f / (1.0f + e1 + e2 + e3);
    if (lane < 4) { SEL[ent + lane] = (lane == 0) ? ti[0] : (lane == 1) ? ti[1] : (lane == 2) ? ti[2] : ti[3];
        SELG[ent + lane] = ((lane == 0) ? 1.0f : (lane == 1) ? e1 : (lane == 2) ? e2 : e3) * inv; }
}
__device__ __forceinline__ void p5_router(const Args& a, LAS unsigned char* lds, int bid, int G, int tid, int wave, int lane) {
    unsigned char* ws = a.ws;
    LAS float* RWT = (LAS float*)lds;
    LAS float* A2 = (LAS float*)(lds + AUX_OFF); LAS float* S2 = A2 + 1024;
    LAS int* SEL = (LAS int*)(S2 + 1024); LAS float* SELG = (LAS float*)(SEL + 256); LAS int* LSL = (LAS int*)(SELG + 256);
    const float* modf = (const float*)(ws + WS_MODF);
    { const f32x4* rw4 = (const f32x4*)a.in[I_RW];
#pragma unroll 4
      for (int it = 0; it < 16; ++it) { const int q = tid + NTHR * it, k = q >> 3, e0 = (q & 7) * 4; const f32x4 w = rw4[q];
          RWT[(e0 + 0) * 1024 + k] = w.x; RWT[(e0 + 1) * 1024 + k] = w.y; RWT[(e0 + 2) * 1024 + k] = w.z; RWT[(e0 + 3) * 1024 + k] = w.w; } }
    const bf16* x1 = (const bf16*)(ws + WS_X1); bf16* H = (bf16*)(ws + WS_H);
    int* tok_e = (int*)(ws + WS_TOK); int* tok_ls = tok_e + M * 4; float* tok_g = (float*)(tok_ls + M * 4);
    int* blkcnt = (int*)(ws + WS_BLKCNT);
    const float rbias = a.in[I_RB][lane >> 1];
    for (int c = bid; c < NCHUNK; c += G) {
        const int b = c >> 7;
        __syncthreads();
        load_mod_AS(A2, S2, a.in[I_N2W], modf, 1, nullptr, b, 3 * 1024, tid);
        __syncthreads();
        unsigned long long rwa[4], rwb[4];
        { const GAS unsigned long long* xa = (const GAS unsigned long long*)(x1 + (size_t)(c * 64 + wave * 8) * D) + lane;
#pragma unroll
          for (int j = 0; j < 4; ++j) { rwa[j] = xa[64 * j]; rwb[j] = xa[256 + 64 * j]; } }
#pragma unroll 1
        for (int r2 = 0; r2 < 4; ++r2) {
            const int m0 = c * 64 + wave * 8 + 2 * r2;
            f32x4 va[4], vb[4]; float sa = 0.f, sb = 0.f;
            {
#pragma unroll
              for (int j = 0; j < 4; ++j) { const unsigned long long wa = rwa[j], wb = rwb[j];
                  va[j] = (f32x4){bfw((unsigned)wa, 0), bfw((unsigned)wa, 1), bfw((unsigned)(wa >> 32), 0), bfw((unsigned)(wa >> 32), 1)};
                  vb[j] = (f32x4){bfw((unsigned)wb, 0), bfw((unsigned)wb, 1), bfw((unsigned)(wb >> 32), 0), bfw((unsigned)(wb >> 32), 1)}; }
              if (r2 < 3) { const GAS unsigned long long* xa = (const GAS unsigned long long*)(x1 + (size_t)(m0 + 2) * D) + lane;
#pragma unroll
                  for (int j = 0; j < 4; ++j) { rwa[j] = xa[64 * j]; rwb[j] = xa[256 + 64 * j]; } }
#pragma unroll
              for (int j = 0; j < 4; ++j) { sa += (va[j].x * va[j].x + va[j].y * va[j].y) + (va[j].z * va[j].z + va[j].w * va[j].w); sb += (vb[j].x * vb[j].x + vb[j].y * vb[j].y) + (vb[j].z * vb[j].z + vb[j].w * vb[j].w); } }
            const float ra = rsqrtf(wave_sum(sa) * (1.0f / D) + EPS), rb = rsqrtf(wave_sum(sb) * (1.0f / D) + EPS);
            GAS unsigned long long* oa = (GAS unsigned long long*)(H + (size_t)m0 * D) + lane; GAS unsigned long long* ob = oa + 256;
#pragma unroll
            for (int j = 0; j < 4; ++j) {
                const f32x4 av = *(const LAS f32x4*)(A2 + 256 * j + 4 * lane), sv = *(const LAS f32x4*)(S2 + 256 * j + 4 * lane);
                va[j] = va[j] * ra * av + sv; vb[j] = vb[j] * rb * av + sv;
#if MOE_FP8_G1
                ((GAS unsigned*)((unsigned char*)H + (size_t)m0 * D))[lane + 64 * j] = pk4_fp8(va[j].x * 8.f, va[j].y * 8.f, va[j].z * 8.f, va[j].w * 8.f);
                ((GAS unsigned*)((unsigned char*)H + (size_t)(m0 + 1) * D))[lane + 64 * j] = pk4_fp8(vb[j].x * 8.f, vb[j].y * 8.f, vb[j].z * 8.f, vb[j].w * 8.f);
#else
                oa[64 * j] = (unsigned long long)pk2(va[j].x, va[j].y) | ((unsigned long long)pk2(va[j].z, va[j].w) << 32);
                ob[64 * j] = (unsigned long long)pk2(vb[j].x, vb[j].y) | ((unsigned long long)pk2(vb[j].z, vb[j].w) << 32);
#endif
            }
            float pa[32], pb[32];
#pragma unroll
            for (int e = 0; e < 32; ++e) { float da = 0.f, db = 0.f;
#pragma unroll
                for (int j = 0; j < 4; ++j) { const f32x4 w = *(const LAS f32x4*)(RWT + e * 1024 + 256 * j + 4 * lane);
                    da += (va[j].x * w.x + va[j].y * w.y) + (va[j].z * w.z + va[j].w * w.w); db += (vb[j].x * w.x + vb[j].y * w.y) + (vb[j].z * w.z + vb[j].w * w.w); }
                pa[e] = da; pb[e] = db; }
            tr_step<16, 32>(pa, lane); tr_step<16, 32>(pb, lane); tr_step<8, 16>(pa, lane); tr_step<8, 16>(pb, lane); tr_step<4, 8>(pa, lane); tr_step<4, 8>(pb, lane);
            tr_step<2, 4>(pa, lane); tr_step<2, 4>(pb, lane); tr_step<1, 2>(pa, lane); tr_step<1, 2>(pb, lane);
            const float la = pa[0] + __shfl_xor(pa[0], 1) + rbias, lb = pb[0] + __shfl_xor(pb[0], 1) + rbias;
            top4_store(la, lane, SEL, SELG, (wave * 8 + 2 * r2) * 4);
            top4_store(lb, lane, SEL, SELG, (wave * 8 + 2 * r2 + 1) * 4);
        }
        __syncthreads();
        if (tid < 256 + 32) {
            const int mye = (tid < 256) ? SEL[tid] : (tid - 256), lim = (tid < 256) ? tid : 256; int cnt = 0;
#pragma unroll 4
            for (int j4 = 0; j4 < 64; ++j4) { const LAS int* sp = SEL + 4 * j4; const int s0 = sp[0], s1 = sp[1], s2 = sp[2], s3 = sp[3];
                cnt += (s0 == mye && 4 * j4 < lim) + (s1 == mye && 4 * j4 + 1 < lim) + (s2 == mye && 4 * j4 + 2 < lim) + (s3 == mye && 4 * j4 + 3 < lim); }
            if (tid < 256) LSL[tid] = cnt; else blkcnt[c * 32 + tid - 256] = cnt; }
        __syncthreads();
        if (tid < 256) { const size_t o = (size_t)c * 256 + tid; tok_e[o] = SEL[tid]; tok_ls[o] = LSL[tid]; tok_g[o] = SELG[tid]; }
    }
}

__device__ __forceinline__ void moe_tables(const Args& a, LAS unsigned char* lds, int c, int tid, int wave, int lane) {
    LAS int* TS = (LAS int*)(lds + MISC_OFF + 256); LAS int* RT2E = TS + 64; LAS int* BASE = (LAS int*)(lds + AUX_OFF); LAS int* PART = BASE + 64;
    const int* blkcnt = (const int*)(a.ws + WS_BLKCNT);
    { const int e = tid & 31, part = tid >> 5; int tot = 0, bs = 0;
#pragma unroll
      for (int i = 0; i < 16; ++i) { const int cc = part * 16 + i; const int v = blkcnt[cc * 32 + e]; tot += v; bs += (cc < c) ? v : 0; }
      PART[part * 32 + e] = tot; PART[512 + part * 32 + e] = bs; }
    __syncthreads();
    if (wave == 0) {
        int total = 0, base = 0;
        if (lane < 32) {
#pragma unroll
            for (int p = 0; p < 16; ++p) { total += PART[p * 32 + lane]; base += PART[512 + p * 32 + lane]; } }
        const int tiles = (lane < 32) ? ((total + 255) >> 8) : 0;
        int incl = tiles;
#pragma unroll
        for (int o = 1; o < 32; o <<= 1) { const int t = __shfl_up(incl, o); if (lane >= o) incl += t; }
        const int start = incl - tiles;
        if (lane < 32) { TS[lane] = start; BASE[lane] = start * 256 + base; for (int t = start; t < incl; ++t) RT2E[t] = lane; }
        if (lane == 31) TS[32] = incl;
    }
    __syncthreads();
}
__device__ __forceinline__ void p6_gather(const Args& a, LAS unsigned char* lds, int bid, int G, int tid, int wave, int lane) {
    unsigned char* ws = a.ws;
    LAS int* BASE = (LAS int*)(lds + AUX_OFF);
    const int* tok_e = (const int*)(ws + WS_TOK); const int* tok_ls = tok_e + M * 4; int* tok_pos = (int*)(ws + WS_TOK) + 3 * M * 4;
    const bf16* H = (const bf16*)(ws + WS_H); bf16* XG = (bf16*)(ws + WS_XG);
    if (bid >= NCHUNK) moe_tables(a, lds, NCHUNK, tid, wave, lane);
    for (int c = bid; c < NCHUNK; c += G) {
        __syncthreads();
        moe_tables(a, lds, c, tid, wave, lane);
        for (int i = wave; i < 256; i += NWAVES) {
            const size_t o = (size_t)c * 256 + i; const int e = tok_e[o]; const int pos = BASE[e] + tok_ls[o];
            if (lane == 0) tok_pos[o] = pos;
#if MOE_FP8_G1
            const GAS v4u* src = (const GAS v4u*)((const unsigned char*)H + (size_t)(c * 64 + (i >> 2)) * D); GAS v4u* dst = (GAS v4u*)((unsigned char*)XG + (size_t)pos * D);
            dst[lane] = src[lane];
#else
            const GAS v4u* src = (const GAS v4u*)(H + (size_t)(c * 64 + (i >> 2)) * D); GAS v4u* dst = (GAS v4u*)(XG + (size_t)pos * D);
            dst[lane] = src[lane]; dst[64 + lane] = src[64 + lane];
#endif
        }
    }
}

__device__ __forceinline__ void p9_final(const Args& a, int bid, int G, int wave, int lane) {
    unsigned char* ws = a.ws;
    const bf16* x1 = (const bf16*)(ws + WS_X1); const bf16* Y = (const bf16*)(ws + WS_XG);
    const float* tok_g = (const float*)(ws + WS_TOK) + 2 * M * 4; const int* tok_pos = (const int*)(ws + WS_TOK) + 3 * M * 4;
    const float* modf = (const float*)(ws + WS_MODF); const float* fnw = a.in[I_FNW]; float* out = a.out;
    const int gw = bid * NWAVES + wave, NGW = G * NWAVES;
    int pos_n[4]; float gk_n[4];
    if (gw < M) {
#pragma unroll
        for (int k = 0; k < 4; ++k) { pos_n[k] = tok_pos[(size_t)gw * 4 + k]; gk_n[k] = tok_g[(size_t)gw * 4 + k]; } }
#pragma unroll 1
    for (int m = gw; m < M; m += NGW) {
        const int b = m >> 13; const float* g2 = modf + b * 6144 + 5 * 1024;
        int posv[4]; float gkv[4];
#pragma unroll
        for (int k = 0; k < 4; ++k) { posv[k] = pos_n[k]; gkv[k] = gk_n[k]; }
        if (m + NGW < M) {
#pragma unroll
            for (int k = 0; k < 4; ++k) { pos_n[k] = tok_pos[(size_t)(m + NGW) * 4 + k]; gk_n[k] = tok_g[(size_t)(m + NGW) * 4 + k]; } }
        f32x4 mo[4];
#pragma unroll
        for (int j = 0; j < 4; ++j) mo[j] = (f32x4){0.f, 0.f, 0.f, 0.f};
#pragma unroll
        for (int k = 0; k < 4; ++k) { const int pos = posv[k];
#if Y_FP8
            const float gk = gkv[k] * 0.125f;
            const GAS unsigned* yr = (const GAS unsigned*)((const unsigned char*)Y + (size_t)pos * D) + lane;
#pragma unroll
            for (int j = 0; j < 4; ++j) { const int w = (int)__builtin_nontemporal_load((const unsigned*)yr + 64 * j); typedef float f32x2 __attribute__((ext_vector_type(2)));
                const f32x2 lo = __builtin_amdgcn_cvt_pk_f32_fp8(w, false), hi = __builtin_amdgcn_cvt_pk_f32_fp8(w, true);
                mo[j].x += gk * lo.x; mo[j].y += gk * lo.y; mo[j].z += gk * hi.x; mo[j].w += gk * hi.y; }
#else
            const float gk = gkv[k];
            const GAS unsigned long long* yr = (const GAS unsigned long long*)(Y + (size_t)pos * D) + lane;
#pragma unroll
            for (int j = 0; j < 4; ++j) { const unsigned long long w = yr[64 * j]; const unsigned lo = (unsigned)w, hi = (unsigned)(w >> 32);
                mo[j].x += gk * __uint_as_float(lo << 16); mo[j].y += gk * __uint_as_float(lo & 0xffff0000u); mo[j].z += gk * __uint_as_float(hi << 16); mo[j].w += gk * __uint_as_float(hi & 0xffff0000u); }
#endif
        }
        const GAS unsigned long long* xr = (const GAS unsigned long long*)(x1 + (size_t)m * D) + lane;
        f32x4 v[4]; float ss = 0.f;
#pragma unroll
        for (int j = 0; j < 4; ++j) { const f32x4 gv = *(const f32x4*)(g2 + 256 * j + 4 * lane); const unsigned long long xw = __builtin_nontemporal_load((const unsigned long long*)xr + 64 * j);
            v[j] = (f32x4){bfw((unsigned)xw, 0), bfw((unsigned)xw, 1), bfw((unsigned)(xw >> 32), 0), bfw((unsigned)(xw >> 32), 1)} + gv * mo[j]; ss += (v[j].x * v[j].x + v[j].y * v[j].y) + (v[j].z * v[j].z + v[j].w * v[j].w); }
        const float rstd = rsqrtf(wave_sum(ss) * (1.0f / D) + EPS);
        GAS f32x4* orow = (GAS f32x4*)(out + (size_t)m * D) + lane;
#pragma unroll
        for (int j = 0; j < 4; ++j) { const f32x4 wv = *(const f32x4*)(fnw + 256 * j + 4 * lane); __builtin_nontemporal_store(v[j] * rstd * wv, (f32x4*)(out + (size_t)m * D) + lane + 64 * j); }
    }
}

#ifndef REP_MASK
#define REP_MASK 0
#endif
#define NREP(k) (((REP_MASK) >> (k)) & 1 ? 2 : 1)
#define REPB(k, rr) do { if ((rr) + 1 < NREP(k) && multi) { if ((k) >= 9) { LANE_TID(); xcd_barrier(bar, tid == 0); } else xcd_barrier(bar, tid == 0); } } while (0)
#ifndef SKEW_TICKS
#define SKEW_TICKS 0
#endif
#define PHASE_SKEW() do { if (SKEW_TICKS > 0) { const unsigned long long t0_ = __builtin_amdgcn_s_memrealtime(), w_ = (unsigned long long)(bid & 3) * SKEW_TICKS; while (__builtin_amdgcn_s_memrealtime() - t0_ < w_) __builtin_amdgcn_s_sleep(2); } } while (0)
#ifndef HG_CHUNKED
#define HG_CHUNKED 1
#endif
#ifndef SSD_CHUNKED
#define SSD_CHUNKED 1
#endif
constexpr int NPHASE = 12;
__global__ void __launch_bounds__(NTHR, 2) mk_fwd(Args args) {
    extern __shared__ __attribute__((aligned(16))) unsigned char lds_raw[];
    LAS unsigned char* lds = (LAS unsigned char*)lds_raw;
    const int tid = threadIdx.x, lane = tid & 63, wave = __builtin_amdgcn_readfirstlane(tid >> 6); __builtin_assume(wave >= 0 && wave < 8);
#define LANE_TID() int lane; asm volatile("v_mbcnt_lo_u32_b32 %0, -1, 0\n\tv_mbcnt_hi_u32_b32 %0, -1, %0" : "=v"(lane)); __builtin_assume(lane >= 0 && lane < 64); const int tid = wave * 64 + lane; (void)tid
    const int G = gridDim.x, bid = blockIdx.x;
    unsigned char* ws = args.ws;
    gu32* ctl = (gu32*)(ws + WS_CTL);
    volatile LAS unsigned* MISC = (volatile LAS unsigned*)(lds + MISC_OFF);
    if (tid < 64) MISC[tid] = 0u;
    __syncthreads();
    const int lo = args.ph_lo, hi = args.ph_hi;
    const bool multi = (hi - lo) > 1;
    XcdBarrier bar; bar.bar = (unsigned*)(ctl + CW_BAR); bar.x = 0; bar.st = nullptr;
    if (multi) bar = xcd_barrier_post((unsigned*)(ctl + CW_BAR), MISC + 8, tid == 0);
#define IN(k) (lo <= (k) && (k) < hi)
#ifdef PROBE_A
#ifndef PROBE_BUSY
#define PROBE_BUSY 0
#endif
#define STAMP(k) do { int tid_s; if ((k) >= 9) { LANE_TID(); tid_s = tid; } else tid_s = tid; if (tid_s == 0) { const unsigned long long t_ = __builtin_amdgcn_s_memrealtime(); MISC[16 + 2 * (k)] = (unsigned)t_; MISC[17 + 2 * (k)] = (unsigned)(t_ >> 32); } } while (0)
#define ARRIVE(k) do { int tid_s; if ((k) >= 9) { LANE_TID(); tid_s = tid; } else tid_s = tid; if (tid_s == 0 && (k) == PROBE_A) { const unsigned long long t_ = __builtin_amdgcn_s_memrealtime(); const unsigned long long s_ = ((unsigned long long)MISC[17 + 2 * (k)] << 32) | MISC[16 + 2 * (k)]; \
    const unsigned busy = (unsigned)(t_ - s_); atomicMax((unsigned*)ctl + 3000, busy); atomicAdd((unsigned*)ctl + 3064, busy); } } while (0)
#else
#define STAMP(k) do { } while (0)
#define ARRIVE(k) do { } while (0)
#endif
#define SEAM(k) do { ARRIVE(k); if (IN(k) && IN((k) + 1)) { if ((k) >= 8) { LANE_TID(); xcd_barrier(bar, tid == 0); } else xcd_barrier(bar, tid == 0); } STAMP((k) + 1); } while (0)

    STAMP(0);
    if (IN(0)) { for (int rr_ = 0; rr_ < NREP(0); ++rr_) { p0_prologue(args, lds, bid, G, tid, wave, lane);  REPB(0, rr_); } } SEAM(0);
    if (IN(1)) { for (int rr_ = 0; rr_ < NREP(1); ++rr_) { p1_norm(args, lds, bid, G, tid, wave, lane);  REPB(1, rr_); } } SEAM(1);
    if (IN(2)) { for (int rr_ = 0; rr_ < NREP(2); ++rr_) {
        pg8::Gemm g{(const pg8::bf16_t*)(ws + WS_H), (const pg8::bf16_t*)(ws + WS_WIN), M, NPROJ, D}; pg8::StaticOrder S; S.init(M, NPROJ, G, bid);
        pg8::EpiIn E{(pg8::bf16_t*)(ws + WS_P), (float*)(ws + WS_LF), args.in[I_LBL]};
        pg8::gemm_phase<pg8::EpiIn, pg8::StaticOrder, true, true>(lds, g, S, E, wave);
        __syncthreads(); p0_bg_items(args, lds, bid, G, tid, wave, lane);
     REPB(2, rr_); } } SEAM(2);
    if (IN(3)) { for (int rr_ = 0; rr_ < NREP(3); ++rr_) {
        for (int u = bid; u < 256; u += G) {
            __syncthreads();
#if HG_CHUNKED
            hg_passA(args, lds, u, tid, wave, lane);
#endif
            __syncthreads();
#if SSD_CHUNKED
            ssd_passA(args, lds, u, tid, wave, lane);
#endif
        }
     REPB(3, rr_); } } SEAM(3);
    if (IN(4)) { for (int rr_ = 0; rr_ < NREP(4); ++rr_) { mix_scan(args, bid, G, tid);  REPB(4, rr_); } } SEAM(4);
    if (IN(5)) { for (int rr_ = 0; rr_ < NREP(5); ++rr_) {
        for (int u = bid; u < 256; u += G) {
            __syncthreads();
#if HG_CHUNKED
            hg_passC(args, lds, u, tid, wave, lane);
#else
            if (u < 8) hgrn_naive(args, lds, u, tid, wave, lane);
#endif
            __syncthreads();
#if SSD_CHUNKED
            ssd_passC(args, lds, u, tid, wave, lane);
#else
            if (u >= 8 && u < 12) ssd_naive(args, lds, u - 8, tid, wave, lane);
#endif
        }
     REPB(5, rr_); } } SEAM(5);
    if (IN(6)) { for (int rr_ = 0; rr_ < NREP(6); ++rr_) {
        pg8::Gemm g{(const pg8::bf16_t*)(ws + WS_MIX), (const pg8::bf16_t*)(ws + WS_WOUT), M, D, D}; pg8::StaticOrder S; S.init(M, D, G, bid);
        pg8::EpiOut E{args.in[I_X], (pg8::bf16_t*)(ws + WS_X1), (const float*)(ws + WS_MODF) + 2 * 1024};
        pg8::gemm_phase<pg8::EpiOut, pg8::StaticOrder, true, true>(lds, g, S, E, wave);
     REPB(6, rr_); } } SEAM(6);
    if (IN(7)) { for (int rr_ = 0; rr_ < NREP(7); ++rr_) { p5_router(args, lds, bid, G, tid, wave, lane);  REPB(7, rr_); } } SEAM(7);
    if (IN(8)) { for (int rr_ = 0; rr_ < NREP(8); ++rr_) { p6_gather(args, lds, bid, G, tid, wave, lane);  REPB(8, rr_); } } SEAM(8);
    if (IN(9) || IN(10)) {
        if (!IN(8)) { LANE_TID(); moe_tables(args, lds, NCHUNK, tid, wave, lane); }
        const PG8_LAS int* TS = (const PG8_LAS int*)(lds + MISC_OFF + 256);
        const int R = __builtin_amdgcn_readfirstlane(TS[32]);
        int kmoe1 = MOE_FP8_G1 ? D / 2 : D, kmoe2 = MOE_FP8_G2 ? D / 2 : D; asm volatile("" : "+s"(kmoe1), "+s"(kmoe2));
        if (IN(9)) { for (int rr_ = 0; rr_ < NREP(9); ++rr_) { LANE_TID();
            pg8::Gemm g{(const pg8::bf16_t*)(ws + WS_XG), (const pg8::bf16_t*)(ws + WS_W1), R * 256, 2048, kmoe1};
            PHASE_SKEW();
            pg8::MoeOrder S{TS + 64, 8, R * 8, G, bid};
            pg8::EpiW1<MOE_FP8_G1 != 0, MOE_FP8_G2 != 0> E{(void*)(ws + WS_ACT), args.in[I_B1]};
            pg8::gemm_phase<pg8::EpiW1<MOE_FP8_G1 != 0, MOE_FP8_G2 != 0>, pg8::MoeOrder, true, true, MOE_FP8_G1 != 0>(lds, g, S, E, wave);
         REPB(9, rr_); } }
        SEAM(9);
        if (IN(10)) { for (int rr_ = 0; rr_ < NREP(10); ++rr_) { LANE_TID();
            pg8::Gemm g{(const pg8::bf16_t*)(ws + WS_ACT), (const pg8::bf16_t*)(ws + WS_W2), R * 256, 1024, kmoe2};
            PHASE_SKEW();
            pg8::MoeOrder S{TS + 64, 4, R * 4, G, bid};
            pg8::EpiW2<Y_FP8 != 0> E{(void*)(ws + WS_XG), args.in[I_B2], MOE_FP8_G2 ? (1.0f / 512.0f) : 1.0f};
            pg8::gemm_phase<pg8::EpiW2<Y_FP8 != 0>, pg8::MoeOrder, true, true, MOE_FP8_G2 != 0>(lds, g, S, E, wave);
         REPB(10, rr_); } }
    }
    SEAM(10);
    if (IN(11)) { for (int rr_ = 0; rr_ < NREP(11); ++rr_) { LANE_TID(); p9_final(args, bid, G, wave, lane);  REPB(11, rr_); } }
#ifdef PROBE_A
    STAMP(12);
    int lpr_; asm volatile("v_mbcnt_lo_u32_b32 %0, -1, 0\n\tv_mbcnt_hi_u32_b32 %0, -1, %0" : "=v"(lpr_)); if (bid == 0 && wave == 0 && lpr_ == 0) {
        const unsigned long long mx = __hip_atomic_load((unsigned*)ctl + 3000, __ATOMIC_RELAXED, __HIP_MEMORY_SCOPE_AGENT);
        const unsigned long long sp = ((((unsigned long long)MISC[17 + 2 * (PROBE_A + 1)] << 32) | MISC[16 + 2 * (PROBE_A + 1)]) - (((unsigned long long)MISC[17 + 2 * PROBE_A] << 32) | MISC[16 + 2 * PROBE_A]));
        const unsigned long long wait = 64ull * (PROBE_BUSY ? mx : sp), t0 = __builtin_amdgcn_s_memrealtime();
        while (__builtin_amdgcn_s_memrealtime() - t0 < wait) __builtin_amdgcn_s_sleep(4);
    }
#endif
#undef IN
#undef SEAM
}

#ifndef MK_N_LAUNCHES
#define MK_N_LAUNCHES 1
#endif
extern "C" void kernel_launch(void* const* d_in, const int* in_sizes, int n_in, void* d_out, int out_size, void* d_ws, size_t ws_size, hipStream_t stream) {
    static int grid = 0;
    if (grid == 0) {
        if (n_in != 23 || out_size != M * D || ws_size < WS_END) { fprintf(stderr, "kernel_launch: unexpected shapes (n_in %d out %d ws %zu)\n", n_in, out_size, ws_size); grid = -1; return; }
        int dev = 0, cus = 0;
        if (hipGetDevice(&dev) != hipSuccess || hipDeviceGetAttribute(&cus, hipDeviceAttributeMultiprocessorCount, dev) != hipSuccess) { grid = -1; return; }
        if (hipFuncSetAttribute((const void*)mk_fwd, hipFuncAttributeMaxDynamicSharedMemorySize, LDS_BYTES) != hipSuccess) { fprintf(stderr, "kernel_launch: hipFuncSetAttribute failed\n"); grid = -1; return; }
        int per_cu = 0;
        if (hipOccupancyMaxActiveBlocksPerMultiprocessor(&per_cu, (const void*)mk_fwd, NTHR, LDS_BYTES) != hipSuccess || per_cu < 1) fprintf(stderr, "kernel_launch: occupancy query says %d\n", per_cu);
        (void)hipGetLastError();
        grid = cus;
    }
    if (grid < 0) return;
    (void)hipMemsetAsync((char*)d_ws + WS_CTL, 0, CTL_ZERO_BYTES, stream);
    Args a{};
    for (int i = 0; i < 23; ++i) a.in[i] = (const float*)d_in[i];
    a.out = (float*)d_out; a.ws = (unsigned char*)d_ws;
    if (MK_N_LAUNCHES == 1) { a.ph_lo = 0; a.ph_hi = NPHASE; hipLaunchKernelGGL(mk_fwd, dim3(grid), dim3(NTHR), LDS_BYTES, stream, a); }
    else for (int p = 0; p < NPHASE; ++p) { a.ph_lo = p; a.ph_hi = p + 1; hipLaunchKernelGGL(mk_fwd, dim3(grid), dim3(NTHR), LDS_BYTES, stream, a); }
}
```

```cpp
#include <hip/hip_runtime.h>
#include <cstdio>
#include <cstdint>
namespace pg8 {
#define PG8_LAS __attribute__((address_space(3)))
typedef unsigned short bf16_t;
typedef short bf16x8 __attribute__((ext_vector_type(8)));
typedef float f32x4 __attribute__((ext_vector_type(4)));
typedef unsigned u32x4 __attribute__((ext_vector_type(4)));
constexpr int BM = 256, BK = 64, HALF = 128, HTB = HALF * BK * 2  , STAGE_BYTES = 8 * HTB, NXCD = 8, WGM = 8;

__host__ __device__ __forceinline__ int lds_byte(int r, int c) { const int st = (r >> 4) * 2 + (c >> 5), rr = r & 15, cc = c & 31, ob = rr * 64 + cc * 2; return st * 1024 + (ob ^ (((ob >> 9) & 1) << 5)); }
__host__ __device__ __forceinline__ void stage_rc(int b, int& R, int& C) { const int st = b / 1024, sb = b % 1024, swz = sb ^ (((sb >> 9) & 1) << 5); R = (st >> 1) * 16 + swz / 64; C = (st & 1) * 32 + (swz % 64) / 2; }
__host__ __device__ __forceinline__ int perm32(int rho) { const int n = rho >> 4, i = rho & 15; return 8 * (i >> 2) + 4 * n + (i & 3); }

struct Unit { int pm, pn; };
struct Gemm { const bf16_t* A; const bf16_t* Bt; int M, N, K; };

struct StaticOrder {
    int nM, nN, nwg, G, c;
    __host__ __device__ void init(int M, int N, int G_, int c_) { nM = M / BM; nN = N / BM; nwg = nM * nN; G = G_; c = c_; }
    __host__ __device__ bool next(int i, Unit& u) const {
        const int L = i * G + c; if (L >= nwg) return false;
        int wgid = L; { const int q = nwg / NXCD, r = nwg % NXCD, xcd = wgid % NXCD, off = wgid / NXCD; wgid = (xcd < r ? xcd * (q + 1) : r * (q + 1) + (xcd - r) * q) + off; }
        const int nig = WGM * nN, gid = wgid / nig, fm = gid * WGM, gsz = (nM - fm) < WGM ? (nM - fm) : WGM;
        u.pm = fm + ((wgid % nig) % gsz); u.pn = (wgid % nig) / gsz; return true;
    }
    __device__ __forceinline__ void a_ready(const Unit&) const {}
    __device__ __forceinline__ void done(const Unit&) const {}
};

__device__ __forceinline__ unsigned cvt_pk_bf16(float lo, float hi) { unsigned r; asm volatile("v_cvt_pk_bf16_f32 %0, %1, %2" : "=v"(r) : "v"(lo), "v"(hi)); return r; }
typedef float f32x2 __attribute__((ext_vector_type(2)));
typedef int v8i32 __attribute__((ext_vector_type(8)));
__device__ __forceinline__ v8i32 cat8(bf16x8 lo, bf16x8 hi) { typedef short s16x16 __attribute__((ext_vector_type(16))); return __builtin_bit_cast(v8i32, __builtin_shufflevector(lo, hi, 0, 1, 2, 3, 4, 5, 6, 7, 8, 9, 10, 11, 12, 13, 14, 15)); }
template <class Epi, class Sched, bool ALIGN_EPI = false, bool SP2 = false, bool F8 = false>
__device__ __forceinline__ void gemm_phase(PG8_LAS unsigned char* lds, const Gemm g, const Sched& S, const Epi& E, int wid) {
    int lane; asm volatile("v_mbcnt_lo_u32_b32 %0, -1, 0\n\tv_mbcnt_hi_u32_b32 %0, -1, %0" : "=v"(lane)); __builtin_assume(lane >= 0 && lane < 64); __builtin_assume(wid >= 0 && wid < 8);
    const int tid = wid * 64 + lane, wr = wid >> 2, wc = wid & 3, fr = lane & 15, fq = lane >> 4;
    const int K = g.K, nt = K / BK;
    unsigned voffA[2], voffB[2];
#pragma unroll
    for (int i = 0; i < 2; ++i) { int R, C; stage_rc(tid * 16 + i * 8192, R, C); const int Rb = Epi::PERM ? ((R & ~31) + perm32(R & 31)) : R;
        voffA[i] = (unsigned)(R * K + C) * 2u; voffB[i] = (unsigned)(Rb * K + C) * 2u; }
    const unsigned kstep = (unsigned)(BK * 2);
    const unsigned hstep = (unsigned)HALF * (unsigned)K * 2u;
    const unsigned tstep = 2u * hstep;
    const unsigned ldsw = (unsigned)wid * 1024u;
    const int aoff = lds_byte(wr * 64 + fr, fq * 8), boff = lds_byte(wc * 32 + fr, fq * 8);
#define PG8_SA(b, h) (((b) * 2 + (h)) * HTB)
#define PG8_SB(b, h) ((4 + (b) * 2 + (h)) * HTB)
#define PG8_STAGE(bufoff, gbase, voff) do { _Pragma("unroll") for (int _i = 0; _i < 2; ++_i) \
        __builtin_amdgcn_global_load_lds((const unsigned*)((const char*)(gbase) + (voff)[_i]), (PG8_LAS unsigned*)(lds + (bufoff) + ldsw + _i * 8192), 16, 0, 0); } while (0)
#define PG8_LDA(dst, b, h) do { _Pragma("unroll") for (int m = 0; m < 4; ++m) _Pragma("unroll") for (int k = 0; k < 2; ++k) dst[m][k] = *(const PG8_LAS bf16x8*)(lds + PG8_SA(b, h) + aoff + m * 2048 + k * 1024); } while (0)
#define PG8_LDB(dst, b, h) do { _Pragma("unroll") for (int n = 0; n < 2; ++n) _Pragma("unroll") for (int k = 0; k < 2; ++k) dst[n][k] = *(const PG8_LAS bf16x8*)(lds + PG8_SB(b, h) + boff + n * 2048 + k * 1024); } while (0)
#define PG8_MMA(ai, bj, At, Bt) do { __builtin_amdgcn_s_setprio(1); _Pragma("unroll") for (int m = 0; m < 4; ++m) _Pragma("unroll") for (int n = 0; n < 2; ++n) { \
        if constexpr (F8) acc[ai][bj][m][n] = __builtin_amdgcn_mfma_scale_f32_16x16x128_f8f6f4(cat8(Bt[n][0], Bt[n][1]), cat8(At[m][0], At[m][1]), acc[ai][bj][m][n], 0, 0, 0, 0, 0, 0); \
        else { _Pragma("unroll") for (int k = 0; k < 2; ++k) acc[ai][bj][m][n] = __builtin_amdgcn_mfma_f32_16x16x32_bf16(Bt[n][k], At[m][k], acc[ai][bj][m][n], 0, 0, 0); } } __builtin_amdgcn_s_setprio(0); } while (0)
#define PG8_WAIT_V(n) asm volatile("s_waitcnt vmcnt(" #n ")" ::: "memory")
#define PG8_WAIT_L(n) asm volatile("s_waitcnt lgkmcnt(" #n ")" ::: "memory")
#define PG8_BAR __builtin_amdgcn_s_barrier()
#define PG8_SCHED __builtin_amdgcn_sched_barrier(0)
    Unit cur, nxt; int ui = 0;
    if (!S.next(0, cur)) return;
    f32x4 acc[2][2][4][2];
#pragma unroll
    for (int a = 0; a < 2; ++a)
#pragma unroll
        for (int b = 0; b < 2; ++b)
#pragma unroll
            for (int m = 0; m < 4; ++m)
#pragma unroll
                for (int n = 0; n < 2; ++n) acc[a][b][m][n] = (f32x4){0.f, 0.f, 0.f, 0.f};
    bf16x8 At[4][2], B0[2][2], B1[2][2];
    const char* cA = (const char*)g.A + (size_t)((unsigned)cur.pm * tstep); const char* cB = (const char*)g.Bt + (size_t)((unsigned)cur.pn * tstep);
    S.a_ready(cur);
    if constexpr (SP2) {
        PG8_STAGE(PG8_SB(0, 0), cB, voffB); PG8_STAGE(PG8_SB(0, 1), cB + hstep, voffB); PG8_STAGE(PG8_SA(0, 0), cA, voffA); PG8_STAGE(PG8_SA(0, 1), cA + hstep, voffA);
        if (wr == 1) PG8_BAR;
        PG8_WAIT_V(2); PG8_BAR;
        PG8_STAGE(PG8_SB(1, 0), cB + kstep, voffB); PG8_STAGE(PG8_SA(1, 0), cA + kstep, voffA); PG8_STAGE(PG8_SB(1, 1), cB + hstep + kstep, voffB);
        PG8_WAIT_V(6); PG8_BAR;
    } else {
        PG8_STAGE(PG8_SB(0, 0), cB, voffB); PG8_STAGE(PG8_SA(0, 0), cA, voffA); PG8_STAGE(PG8_SB(0, 1), cB + hstep, voffB); PG8_STAGE(PG8_SA(0, 1), cA + hstep, voffA);
        if (wr == 1) PG8_BAR;
        PG8_WAIT_V(4); PG8_BAR;
        PG8_STAGE(PG8_SB(1, 0), cB + kstep, voffB); PG8_STAGE(PG8_SA(1, 0), cA + kstep, voffA); PG8_STAGE(PG8_SB(1, 1), cB + hstep + kstep, voffB);
        PG8_WAIT_V(6); PG8_BAR;
    }
    for (;;) {
        const bool has_next = S.next(ui + 1, nxt);
        const char* nA = has_next ? (const char*)g.A + (size_t)((unsigned)nxt.pm * tstep) : cA; const char* nB = has_next ? (const char*)g.Bt + (size_t)((unsigned)nxt.pn * tstep) : cB;
        _Pragma("unroll 1") for (int t = 0; t < nt; t += 2) {
            const bool last = (t == nt - 2);
            const char* a1 = cA + (size_t)((unsigned)(t + 1) * kstep);
            const char* a2 = last ? nA : cA + (size_t)((unsigned)(t + 2) * kstep); const char* b2 = last ? nB : cB + (size_t)((unsigned)(t + 2) * kstep);
            const char* a3 = a2 + kstep; const char* b3 = b2 + kstep;
            const char* a1h = a1 + hstep; const char* a2h = a2 + hstep; const char* b2h = b2 + hstep; const char* b3h = b3 + hstep;
            asm volatile("" : "+s"(a1h), "+s"(a2), "+s"(a2h), "+s"(b2), "+s"(b2h), "+s"(a3), "+s"(b3), "+s"(b3h));
            if (last && has_next) S.a_ready(nxt);
            if constexpr (SP2) {
            PG8_LDB(B0, 0, 0); PG8_LDB(B1, 0, 1); PG8_SCHED; PG8_LDA(At, 0, 0); PG8_STAGE(PG8_SA(1, 1), a1h, voffA);
            PG8_WAIT_V(8); PG8_WAIT_L(0); PG8_BAR; PG8_MMA(0, 0, At, B0); PG8_MMA(0, 1, At, B1); PG8_BAR; PG8_SCHED;
            PG8_LDA(At, 0, 1); PG8_STAGE(PG8_SB(0, 0), b2, voffB); PG8_STAGE(PG8_SB(0, 1), b2h, voffB); PG8_STAGE(PG8_SA(0, 0), a2, voffA);
            PG8_WAIT_V(8); PG8_WAIT_L(0); PG8_BAR; PG8_MMA(1, 0, At, B0); PG8_MMA(1, 1, At, B1); PG8_BAR; PG8_SCHED;
            PG8_LDB(B0, 1, 0); PG8_LDB(B1, 1, 1); PG8_SCHED; PG8_LDA(At, 1, 0); PG8_STAGE(PG8_SA(0, 1), a2h, voffA);
            PG8_WAIT_V(8); PG8_WAIT_L(0); PG8_BAR; PG8_MMA(0, 0, At, B0); PG8_MMA(0, 1, At, B1); PG8_BAR; PG8_SCHED;
            PG8_LDA(At, 1, 1); PG8_STAGE(PG8_SB(1, 0), b3, voffB); PG8_STAGE(PG8_SB(1, 1), b3h, voffB); PG8_STAGE(PG8_SA(1, 0), a3, voffA);
            PG8_WAIT_V(8); PG8_WAIT_L(0); PG8_BAR; PG8_MMA(1, 0, At, B0); PG8_MMA(1, 1, At, B1); PG8_BAR; PG8_SCHED;
            } else {
            PG8_LDB(B0, 0, 0); PG8_SCHED; PG8_LDA(At, 0, 0); PG8_STAGE(PG8_SA(1, 1), a1h, voffA);
            PG8_WAIT_L(8); PG8_BAR; PG8_WAIT_L(0); PG8_MMA(0, 0, At, B0); PG8_BAR; PG8_SCHED;
            PG8_LDB(B1, 0, 1); PG8_STAGE(PG8_SB(0, 0), b2, voffB);
            PG8_BAR; PG8_WAIT_L(0); PG8_MMA(0, 1, At, B1); PG8_BAR;
            PG8_LDA(At, 0, 1); PG8_STAGE(PG8_SA(0, 0), a2, voffA);
            PG8_BAR; PG8_WAIT_L(0); PG8_MMA(1, 0, At, B0); PG8_BAR; PG8_SCHED;
            PG8_STAGE(PG8_SB(0, 1), b2h, voffB);
            PG8_WAIT_V(6); PG8_BAR; PG8_MMA(1, 1, At, B1); PG8_BAR;
            PG8_LDB(B0, 1, 0); PG8_SCHED; PG8_LDA(At, 1, 0); PG8_STAGE(PG8_SA(0, 1), a2h, voffA);
            PG8_WAIT_L(8); PG8_BAR; PG8_WAIT_L(0); PG8_MMA(0, 0, At, B0); PG8_BAR; PG8_SCHED;
            PG8_LDB(B1, 1, 1); PG8_STAGE(PG8_SB(1, 0), b3, voffB);
            PG8_BAR; PG8_WAIT_L(0); PG8_MMA(0, 1, At, B1); PG8_BAR;
            PG8_LDA(At, 1, 1); PG8_STAGE(PG8_SA(1, 0), a3, voffA);
            PG8_BAR; PG8_WAIT_L(0); PG8_MMA(1, 0, At, B0); PG8_BAR; PG8_SCHED;
            PG8_STAGE(PG8_SB(1, 1), b3h, voffB);
            PG8_WAIT_V(6); PG8_BAR; PG8_MMA(1, 1, At, B1); PG8_BAR;
            }
        }
#ifdef PROBE_G
        unsigned long long tk_ = 0; if (wid == 0) tk_ = __builtin_amdgcn_s_memrealtime();
#endif
        if constexpr (ALIGN_EPI) { if (wr == 0) PG8_BAR; }
        if constexpr (!Epi::AFTER_DRAIN) { int l2_; asm volatile("v_mbcnt_lo_u32_b32 %0, -1, 0\n\tv_mbcnt_hi_u32_b32 %0, -1, %0" : "=v"(l2_)); const int fr_o = l2_ & 15, fq_o = l2_ >> 4;
            Unit cu_ = cur; asm volatile("" : "+s"(cu_.pm), "+s"(cu_.pn));
            E(acc, cu_, wr, wc, fr_o, fq_o); S.done(cur); }
#ifdef PROBE_G
        if (wid == 0 && lane == 0 && *(volatile PG8_LAS unsigned*)(lds + 147456 + 4 * 61) != 0u) *(volatile PG8_LAS unsigned*)(lds + 147456 + 4 * 60) += (unsigned)(__builtin_amdgcn_s_memrealtime() - tk_);
#endif
        if (!has_next) break;
#pragma unroll
        for (int a = 0; a < 2; ++a)
#pragma unroll
            for (int b = 0; b < 2; ++b)
#pragma unroll
                for (int m = 0; m < 4; ++m)
#pragma unroll
                    for (int n = 0; n < 2; ++n) acc[a][b][m][n] = (f32x4){0.f, 0.f, 0.f, 0.f};
        cur = nxt; cA = nA; cB = nB; ++ui;
        if constexpr (ALIGN_EPI) { if (wr == 1) PG8_BAR; }
    }
    PG8_WAIT_V(0);
    if constexpr (!ALIGN_EPI) { if (wr == 0) PG8_BAR; }
    PG8_BAR;
    if constexpr (Epi::AFTER_DRAIN) { E.fused(acc, cur, wr, wc, fr, fq, lds, wid, lane); S.done(cur); }
#undef PG8_SA
#undef PG8_SB
#undef PG8_STAGE
#undef PG8_LDA
#undef PG8_LDB
#undef PG8_MMA
#undef PG8_WAIT_V
#undef PG8_WAIT_L
#undef PG8_BAR
#undef PG8_SCHED
}
}
#define GAS __attribute__((address_space(1)))
#define LAS __attribute__((address_space(3)))
typedef unsigned short bf16;
typedef unsigned v4u __attribute__((ext_vector_type(4)));
typedef float f32x4 __attribute__((ext_vector_type(4)));
typedef short bf16x8 __attribute__((ext_vector_type(8)));
typedef GAS unsigned gu32;
typedef GAS unsigned long long gu64;
#define RLX_AGENT __ATOMIC_RELAXED, __HIP_MEMORY_SCOPE_AGENT
#define LDS_WAIT() asm volatile("s_waitcnt lgkmcnt(0)" ::: "memory")
#define VM_WAIT() asm volatile("s_waitcnt vmcnt(0)" ::: "memory")
__device__ __forceinline__ unsigned long long rt() { return __builtin_amdgcn_s_memrealtime(); }
__device__ __forceinline__ unsigned f2bf(float f) { unsigned u = __builtin_bit_cast(unsigned, f); return (u + 0x7fffu + ((u >> 16) & 1u)) >> 16; }
__device__ __forceinline__ unsigned pk2(float lo, float hi) { return f2bf(lo) | (f2bf(hi) << 16); }
#define XB_TMO      128
#define XB_XCNT(j)  (256  + 64 * (j))
#define XB_XSUB(j)  (1280 + 64 * (j))
#define XB_XGEN(j)  (2304 + 64 * (j))
#define XB_TOP      3328
#define XB_TOPGEN   3392
#define XCD_BAR_WORDS 3456
#define XB_SPIN_CAP (1u << 18)

__device__ __forceinline__ unsigned xb_ld(unsigned* p)              { return __hip_atomic_load(p, __ATOMIC_RELAXED, __HIP_MEMORY_SCOPE_AGENT); }
__device__ __forceinline__ unsigned xb_add(unsigned* p, unsigned v) { return __hip_atomic_fetch_add(p, v, __ATOMIC_RELAXED, __HIP_MEMORY_SCOPE_AGENT); }
__device__ __forceinline__ unsigned xb_xcc_id() { return (unsigned)__builtin_amdgcn_s_getreg((3 << 11) | 20) & 0xFu; }
#define XB_SPIN(cond, bar) do { unsigned _sp = 0; while (cond) { __builtin_amdgcn_s_sleep(1); \
    if ((++_sp & 255u) == 0u) { if (xb_ld(&(bar)[XB_TMO])) break; if (_sp > XB_SPIN_CAP) { atomicAdd(&(bar)[XB_TMO], 1u); break; } } } } while (0)

struct XcdBarrier {
    unsigned* bar; unsigned x;
    volatile LAS unsigned* st;
};

__device__ __forceinline__ XcdBarrier xcd_barrier_post(unsigned* bar, volatile LAS unsigned* st, bool t0) {
    XcdBarrier b; b.bar = bar; b.x = xb_xcc_id(); b.st = st;
    if (t0) (void)xb_add(&bar[XB_XCNT(b.x)], 1u);
    return b;
}
__device__ __forceinline__ void xcd_barrier_complete(unsigned* bar, unsigned x, unsigned& nloc, unsigned& nx) {
    const unsigned G = gridDim.x * gridDim.y * gridDim.z;
    unsigned sum, cnt, mine, sp = 0u;
    for (;;) {
        sum = 0u; cnt = 0u; mine = 0u;
#pragma unroll
        for (unsigned j = 0; j < 16; ++j) { const unsigned c = xb_ld(&bar[XB_XCNT(j)]); sum += c; cnt += (c > 0u) ? 1u : 0u; mine = (j == x) ? c : mine; }
        if (sum == G) break;
        __builtin_amdgcn_s_sleep(1);
        if ((++sp & 255u) == 0u) { if (xb_ld(&bar[XB_TMO])) break; if (sp > XB_SPIN_CAP) { atomicAdd(&bar[XB_TMO], 1u); break; } }
    }
    nloc = mine > 0u ? mine : 1u; nx = cnt > 0u ? cnt : 1u;
}

__device__ __forceinline__ void xcd_barrier(const XcdBarrier& b, bool t0) {
    asm volatile("s_waitcnt vmcnt(0)" ::: "memory");
    __syncthreads();
    if (t0) {
        unsigned* bar = b.bar;
        __builtin_amdgcn_s_waitcnt(0);
        unsigned nloc = b.st[0], nx = b.st[1];
        if (nloc == 0u) { xcd_barrier_complete(bar, b.x, nloc, nx); b.st[0] = nloc; b.st[1] = nx; }
        const unsigned old = xb_add(&bar[XB_XSUB(b.x)], 1u);
        const unsigned gen = old / nloc;
        if (old + 1u == (gen + 1u) * nloc) {
            __builtin_amdgcn_fence(__ATOMIC_RELEASE, "agent");
            asm volatile("s_waitcnt vmcnt(0)" ::: "memory");
            const unsigned og = xb_add(&bar[XB_TOP], 1u);
            const unsigned tg = og / nx;
            if (og + 1u == (tg + 1u) * nx) xb_add(&bar[XB_TOPGEN], 1u);
            else XB_SPIN(xb_ld(&bar[XB_TOPGEN]) == tg, bar);
            __builtin_amdgcn_fence(__ATOMIC_ACQUIRE, "agent");
            xb_add(&bar[XB_XGEN(b.x)], 1u);
            asm volatile("s_waitcnt vmcnt(0)" ::: "memory");
        } else {
            XB_SPIN(xb_ld(&bar[XB_XGEN(b.x)]) == gen, bar);
            __builtin_amdgcn_fence(__ATOMIC_ACQUIRE, "agent");
            asm volatile("s_waitcnt vmcnt(0)" ::: "memory");
        }
    }
    __syncthreads();
}
#ifndef Y_FP8
#define Y_FP8 1
#endif
#ifndef MOE_FP8_G1
#define MOE_FP8_G1 1
#endif
#ifndef MOE_FP8_G2
#define MOE_FP8_G2 1
#endif

constexpr int NB = 2, SEQ = 8192, D = 1024, M = NB * SEQ;
constexpr int NPROJ = 3584, IN_COLS = 3592;
constexpr int NE = 32, TOPK = 4, DFF = 1024;
constexpr int NROWS_MAX = M * TOPK + NE * 256;
constexpr int MAXRT = NROWS_MAX / 256;
constexpr float EPS = 1e-6f;
constexpr int PC_Q = 0, PC_K = 512, PC_V = 1024, PC_G = 1536, PC_Z = 2048, PC_X = 2560;
constexpr int NCHUNK = M / 64;
constexpr int NWAVES = 8, NTHR = 512;

constexpr size_t MiB = 1u << 20;
constexpr size_t WS_CTL = 0, CTL_ZERO_BYTES = 32768;
constexpr size_t WS_MODP = 1 * MiB;
constexpr size_t WS_MODF = WS_MODP + 512 * 1024;
constexpr size_t WS_BLKCNT = WS_MODF + 256 * 1024;
constexpr size_t WS_DT = 2 * MiB;
constexpr size_t WS_TOK = 3 * MiB;
constexpr size_t WS_WIN = 4 * MiB, WS_WOUT = 11 * MiB, WS_W1 = 16 * MiB, WS_W2 = 144 * MiB;
constexpr size_t WS_H = 208 * MiB, WS_P = 240 * MiB, WS_LF = 352 * MiB, WS_MIX = 384 * MiB, WS_X1 = 416 * MiB;
constexpr size_t WS_XG = 480 * MiB, WS_ACT = 624 * MiB, WS_END = 768 * MiB;
constexpr int CW_TMO = 0, CW_BAR = 4096;

constexpr int RING_BYTES = 131072, AUX_OFF = RING_BYTES  , MISC_OFF = 147456, LDS_BYTES = 151552;

struct Args { const float* in[23]; float* out; unsigned char* ws; int ph_lo, ph_hi; };
enum { I_X = 0, I_C, I_ADAW, I_ADAB, I_N1W, I_WIN, I_LBL, I_HGNW, I_ALOG, I_DTB, I_SSMD, I_CONVW, I_CONVB, I_SSMNW, I_WOUT, I_N2W, I_RW, I_RB, I_W1, I_B1, I_W2, I_B2, I_FNW };

__device__ __forceinline__ float bf2f(bf16 v) { return __uint_as_float(((unsigned)v) << 16); }
__device__ __forceinline__ float wave_sum(float v) {
#pragma unroll
    for (int o = 1; o < 64; o <<= 1) v += __shfl_xor(v, o);
    return v;
}
__device__ __forceinline__ float wave_max(float v) {
#pragma unroll
    for (int o = 1; o < 64; o <<= 1) v = fmaxf(v, __shfl_xor(v, o));
    return v;
}
__device__ __forceinline__ float sigmoid_f(float x) { return __builtin_amdgcn_rcpf(1.0f + __expf(-x)); }
__device__ __forceinline__ float silu_f(float x) { return x * sigmoid_f(x); }

namespace pg8 {
struct EpiIn {
    static constexpr bool PERM = true, AFTER_DRAIN = false;
    bf16_t* P; float* LF; const float* lbl;
    __device__ __forceinline__ void operator()(const f32x4 (&acc)[2][2][4][2], const Unit& u, int wr, int wc, int fr, int fq) const {
        const int row0 = u.pm * BM + wr * 64 + fr, col0 = u.pn * BM + wc * 32 + 8 * fq;
        const int mode = (u.pn < 2) ? 1 : (u.pn < 4) ? 2 : (u.pn < 6) ? 0 : (u.pn < 10) ? 1 : 0;
        if (mode == 2) {
            float oml[2][8];
#pragma unroll
            for (int bj = 0; bj < 2; ++bj)
#pragma unroll
                for (int j = 0; j < 8; ++j) { const int cf = col0 + bj * HALF + j - 512; const float l0 = lbl[cf], l1 = lbl[512 + cf]; oml[bj][j] = 1.0f - 1.0f / (1.0f + __expf(l1 - l0)); }
#pragma unroll
            for (int ai = 0; ai < 2; ++ai)
#pragma unroll
                for (int m = 0; m < 4; ++m) { const size_t r = (size_t)(row0 + ai * HALF + m * 16);
#pragma unroll
                    for (int bj = 0; bj < 2; ++bj) { float kv[8], lf[8];
#pragma unroll
                        for (int j = 0; j < 8; ++j) { const float f = acc[ai][bj][m][j >> 2][j & 3]; const float k = oml[bj][j] * sigmoid_f(-f); kv[j] = k; lf[j] = __logf(1.0f - k); }
                        u32x4 w; w.x = cvt_pk_bf16(kv[0], kv[1]); w.y = cvt_pk_bf16(kv[2], kv[3]); w.z = cvt_pk_bf16(kv[4], kv[5]); w.w = cvt_pk_bf16(kv[6], kv[7]);
                        *(u32x4*)(P + r * NPROJ + col0 + bj * HALF) = w;
                        float* lp = LF + r * 512 + (col0 + bj * HALF - 512);
                        *(f32x4*)lp = (f32x4){lf[0], lf[1], lf[2], lf[3]}; *(f32x4*)(lp + 4) = (f32x4){lf[4], lf[5], lf[6], lf[7]}; } }
        } else {
#pragma unroll
            for (int ai = 0; ai < 2; ++ai)
#pragma unroll
                for (int m = 0; m < 4; ++m) { bf16_t* rowp = P + (size_t)(row0 + ai * HALF + m * 16) * NPROJ + col0;
#pragma unroll
                    for (int bj = 0; bj < 2; ++bj) { f32x4 v0 = acc[ai][bj][m][0], v1 = acc[ai][bj][m][1];
                        if (mode == 1) {
#pragma unroll
                            for (int j = 0; j < 4; ++j) { v0[j] = silu_f(v0[j]); v1[j] = silu_f(v1[j]); } }
                        u32x4 w; w.x = cvt_pk_bf16(v0[0], v0[1]); w.y = cvt_pk_bf16(v0[2], v0[3]); w.z = cvt_pk_bf16(v1[0], v1[1]); w.w = cvt_pk_bf16(v1[2], v1[3]);
                        *(u32x4*)(rowp + bj * HALF) = w; } }
        }
    }
};
struct EpiOut {
    static constexpr bool PERM = true, AFTER_DRAIN = false;
    const float* x; bf16_t* x1; const float* g1;
    __device__ __forceinline__ void operator()(const f32x4 (&acc)[2][2][4][2], const Unit& u, int wr, int wc, int fr, int fq) const {
        const int row0 = u.pm * BM + wr * 64 + fr, col0 = u.pn * BM + wc * 32 + 8 * fq;
        const float* gb = g1 + ((u.pm * BM) >> 13) * 6144 + col0;
        f32x4 gv[2][2];
#pragma unroll
        for (int bj = 0; bj < 2; ++bj)
#pragma unroll
            for (int n = 0; n < 2; ++n) gv[bj][n] = *(const f32x4*)(gb + bj * HALF + 4 * n);
#pragma unroll
        for (int ai = 0; ai < 2; ++ai)
#pragma unroll
            for (int m = 0; m < 4; ++m) { const size_t off = (size_t)(row0 + ai * HALF + m * 16) * D + col0;
#pragma unroll
                for (int bj = 0; bj < 2; ++bj) { const f32x4 x0 = *(const f32x4*)(x + off + bj * HALF), x1v = *(const f32x4*)(x + off + bj * HALF + 4);
                    const f32x4 v0 = x0 + gv[bj][0] * acc[ai][bj][m][0], v1 = x1v + gv[bj][1] * acc[ai][bj][m][1];
                    u32x4 w; w.x = cvt_pk_bf16(v0[0], v0[1]); w.y = cvt_pk_bf16(v0[2], v0[3]); w.z = cvt_pk_bf16(v1[0], v1[1]); w.w = cvt_pk_bf16(v1[2], v1[3]);
                    *(u32x4*)(x1 + off + bj * HALF) = w; } }
    }
};
__device__ __forceinline__ float sat8(float x) { return fminf(fmaxf(x, -448.0f), 448.0f); }
__device__ __forceinline__ unsigned pk4_fp8(float a, float b, float c, float d) { int w = 0; w = __builtin_amdgcn_cvt_pk_fp8_f32(sat8(a), sat8(b), w, false); w = __builtin_amdgcn_cvt_pk_fp8_f32(sat8(c), sat8(d), w, true); return (unsigned)w; }
template <bool F8IN, bool F8> struct EpiW1 {
    static constexpr bool PERM = true, AFTER_DRAIN = false;
    void* ACT; const float* b1;
    __device__ __forceinline__ void operator()(const f32x4 (&acc)[2][2][4][2], const Unit& u, int wr, int wc, int fr, int fq) const {
        const int e = u.pn >> 3, pn = u.pn & 7;
        const int row0 = u.pm * BM + wr * 64 + fr, cj = pn * 128 + wc * 32 + 8 * fq;
        const float* bg = b1 + e * 2048 + cj; const float sc = F8IN ? (1.0f / 1024.0f) : 1.0f;
#pragma unroll
        for (int ai = 0; ai < 2; ++ai)
#pragma unroll
            for (int m = 0; m < 4; ++m) {
                asm volatile("" ::: "memory");
                const f32x4 bg0 = *(const f32x4*)bg, bg1 = *(const f32x4*)(bg + 4), bl0 = *(const f32x4*)(bg + 1024), bl1 = *(const f32x4*)(bg + 1028);
                f32x4 g0 = acc[ai][0][m][0] * sc + bg0, g1 = acc[ai][0][m][1] * sc + bg1, l0 = acc[ai][1][m][0] * sc + bl0, l1 = acc[ai][1][m][1] * sc + bl1;
                float o[8];
                const float osc = F8 ? 4.0f : 1.0f;
#pragma unroll
                for (int j = 0; j < 4; ++j) {
                    float g = fminf(g0[j], 7.0f), l = __builtin_amdgcn_fmed3f(l0[j], -7.0f, 7.0f); o[j] = (g * osc) * __builtin_amdgcn_rcpf(1.0f + __builtin_amdgcn_exp2f(g * (-1.702f * 1.44269504f))) * (l + 1.0f);
                    g = fminf(g1[j], 7.0f); l = __builtin_amdgcn_fmed3f(l1[j], -7.0f, 7.0f); o[4 + j] = (g * osc) * __builtin_amdgcn_rcpf(1.0f + __builtin_amdgcn_exp2f(g * (-1.702f * 1.44269504f))) * (l + 1.0f); }
                const size_t off = (size_t)(row0 + ai * HALF + m * 16) * DFF + cj;
                if (F8) { typedef unsigned u32x2 __attribute__((ext_vector_type(2))); u32x2 w; int w0 = 0, w1 = 0;
                    w0 = __builtin_amdgcn_cvt_pk_fp8_f32(o[0], o[1], w0, false); w0 = __builtin_amdgcn_cvt_pk_fp8_f32(o[2], o[3], w0, true); w1 = __builtin_amdgcn_cvt_pk_fp8_f32(o[4], o[5], w1, false); w1 = __builtin_amdgcn_cvt_pk_fp8_f32(o[6], o[7], w1, true);
                    w.x = (unsigned)w0; w.y = (unsigned)w1; *(u32x2*)((unsigned char*)ACT + off) = w; }
                else { u32x4 w; w.x = cvt_pk_bf16(o[0], o[1]); w.y = cvt_pk_bf16(o[2], o[3]); w.z = cvt_pk_bf16(o[4], o[5]); w.w = cvt_pk_bf16(o[6], o[7]);
                    *(u32x4*)((bf16_t*)ACT + off) = w; } }
    }
};
template <bool Y8> struct EpiW2 {
    static constexpr bool PERM = true, AFTER_DRAIN = false;
    void* Y; const float* b2; float sc;
    __device__ __forceinline__ void operator()(const f32x4 (&acc)[2][2][4][2], const Unit& u, int wr, int wc, int fr, int fq) const {
        const int e = u.pn >> 2, pn = u.pn & 3;
        const int row0 = u.pm * BM + wr * 64 + fr, col0 = pn * BM + wc * 32 + 8 * fq;
        const float* bb = b2 + e * 1024 + col0;
        f32x4 bv[2][2];
#pragma unroll
        for (int bj = 0; bj < 2; ++bj) { bv[bj][0] = *(const f32x4*)(bb + bj * HALF); bv[bj][1] = *(const f32x4*)(bb + bj * HALF + 4); }
#pragma unroll
        for (int ai = 0; ai < 2; ++ai)
#pragma unroll
            for (int m = 0; m < 4; ++m) { const size_t off = (size_t)(row0 + ai * HALF + m * 16) * D + col0;
#pragma unroll
                for (int bj = 0; bj < 2; ++bj) { const f32x4 v0 = acc[ai][bj][m][0] * sc + bv[bj][0], v1 = acc[ai][bj][m][1] * sc + bv[bj][1];
                    if (Y8) { typedef unsigned u32x2 __attribute__((ext_vector_type(2))); u32x2 w; w.x = pk4_fp8(v0[0] * 8.f, v0[1] * 8.f, v0[2] * 8.f, v0[3] * 8.f); w.y = pk4_fp8(v1[0] * 8.f, v1[1] * 8.f, v1[2] * 8.f, v1[3] * 8.f);
                        *(u32x2*)((unsigned char*)Y + off + bj * HALF) = w; }
                    else { u32x4 w; w.x = cvt_pk_bf16(v0[0], v0[1]); w.y = cvt_pk_bf16(v0[2], v0[3]); w.z = cvt_pk_bf16(v1[0], v1[1]); w.w = cvt_pk_bf16(v1[2], v1[3]);
                        *(u32x4*)((bf16_t*)Y + off + bj * HALF) = w; } } }
    }
};
struct InProjOrder {
    int c;
    __device__ __forceinline__ bool next(int i, Unit& u) const { const int pn = (c >> 6) + 4 * i; if (pn >= NPROJ / BM) return false; u.pm = c & 63; u.pn = pn; return true; }
    __device__ __forceinline__ void a_ready(const Unit&) const {}
    __device__ __forceinline__ void done(const Unit&) const {}
};
struct MoeOrder {
    const PG8_LAS int* rt2e; int NT, nwg, G, c;
    __device__ __forceinline__ bool next(int i, Unit& u) const {
        const int L = i * G + c; if (L >= nwg) return false;
        int wgid = L; { const int q = nwg / NXCD, r = nwg % NXCD, xcd = wgid % NXCD, off = wgid / NXCD; wgid = (xcd < r ? xcd * (q + 1) : r * (q + 1) + (xcd - r) * q) + off; }
        const int rt = wgid / NT, pn = wgid % NT; const int e = __builtin_amdgcn_readfirstlane(rt2e[rt]);
        u.pm = rt; u.pn = e * NT + pn; return true;
    }
    __device__ __forceinline__ void a_ready(const Unit&) const {}
    __device__ __forceinline__ void done(const Unit&) const {}
};
}

using pg8::pk4_fp8;
__device__ __forceinline__ void transpose_item(const float* __restrict__ W, int ldw, int k0, int c0, bf16* WT, int drow0, LAS float* scr, int lane) {
#pragma unroll 8
    for (int i = 0; i < 32; ++i) { const int kk = 2 * i + (lane >> 5); scr[kk * 33 + (lane & 31)] = W[(size_t)(k0 + kk) * ldw + c0 + (lane & 31)]; }
    LDS_WAIT(); asm volatile("" ::: "memory");
    const int c = lane & 7;
#pragma unroll
    for (int j = 0; j < 4; ++j) { const int n = (lane >> 3) + 8 * j; const LAS float* s = scr + (8 * c) * 33 + n;
        v4u o; o.x = pk2(s[0 * 33], s[1 * 33]); o.y = pk2(s[2 * 33], s[3 * 33]); o.z = pk2(s[4 * 33], s[5 * 33]); o.w = pk2(s[6 * 33], s[7 * 33]);
        *(GAS v4u*)(WT + (size_t)(drow0 + n) * 1024 + k0 + 8 * c) = o; }
    LDS_WAIT(); asm volatile("" ::: "memory");
}
__device__ __forceinline__ void transpose_item8(const float* __restrict__ W, int ldw, int k0, int c0, unsigned char* WT, int drow0, float scale, LAS float* scr, int lane) {
#pragma unroll 8
    for (int i = 0; i < 32; ++i) { const int kk = 2 * i + (lane >> 5); scr[kk * 33 + (lane & 31)] = W[(size_t)(k0 + kk) * ldw + c0 + (lane & 31)]; }
    LDS_WAIT(); asm volatile("" ::: "memory");
    const int n = lane >> 1, hf = lane & 1; const LAS float* s = scr + (32 * hf) * 33 + n;
    v4u o0, o1;
    o0.x = pk4_fp8(s[0 * 33] * scale, s[1 * 33] * scale, s[2 * 33] * scale, s[3 * 33] * scale); o0.y = pk4_fp8(s[4 * 33] * scale, s[5 * 33] * scale, s[6 * 33] * scale, s[7 * 33] * scale);
    o0.z = pk4_fp8(s[8 * 33] * scale, s[9 * 33] * scale, s[10 * 33] * scale, s[11 * 33] * scale); o0.w = pk4_fp8(s[12 * 33] * scale, s[13 * 33] * scale, s[14 * 33] * scale, s[15 * 33] * scale);
    o1.x = pk4_fp8(s[16 * 33] * scale, s[17 * 33] * scale, s[18 * 33] * scale, s[19 * 33] * scale); o1.y = pk4_fp8(s[20 * 33] * scale, s[21 * 33] * scale, s[22 * 33] * scale, s[23 * 33] * scale);
    o1.z = pk4_fp8(s[24 * 33] * scale, s[25 * 33] * scale, s[26 * 33] * scale, s[27 * 33] * scale); o1.w = pk4_fp8(s[28 * 33] * scale, s[29 * 33] * scale, s[30 * 33] * scale, s[31 * 33] * scale);
    GAS v4u* dst = (GAS v4u*)(WT + (size_t)(drow0 + n) * 1024 + k0 + 32 * hf); dst[0] = o0; dst[1] = o1;
    LDS_WAIT(); asm volatile("" ::: "memory");
}
template <bool F8> __device__ __forceinline__ void p0_item(const float* __restrict__ W, int ldw, int k0, int c0, unsigned char* WT, int drow0, int rowb, float scale, LAS unsigned char* T, int tid, int wave, int lane) {
    constexpr int NB = F8 ? 2 : 1, TS = 516;
    const int l32 = lane & 31, hf = lane >> 5;
#pragma unroll 1
    for (int batch = 0; batch < NB; ++batch) {
        const int kb = batch * 256 + wave * 32;
        f32x4 v[4][4];
#pragma unroll
        for (int i = 0; i < 4; ++i)
#pragma unroll
            for (int j = 0; j < 4; ++j) v[i][j] = __builtin_nontemporal_load((const f32x4*)(W + (size_t)(k0 + kb + 4 * (2 * i + hf) + j) * ldw + c0 + 4 * l32));
#pragma unroll
        for (int i = 0; i < 4; ++i) { const int kk = kb + 4 * (2 * i + hf);
#pragma unroll
            for (int c = 0; c < 4; ++c) { LAS unsigned char* tp = T + (4 * l32 + c) * TS + (F8 ? kk : 2 * kk);
                if (F8) *(LAS unsigned*)tp = pk4_fp8(v[i][0][c] * scale, v[i][1][c] * scale, v[i][2][c] * scale, v[i][3][c] * scale);
                else { *(LAS unsigned*)tp = pk2(v[i][0][c], v[i][1][c]); *(LAS unsigned*)(tp + 4) = pk2(v[i][2][c], v[i][3][c]); } } }
    }
    __syncthreads();
#pragma unroll
    for (int i = 0; i < 8; ++i) { const int piece = tid + NTHR * i, n = piece >> 5, c = piece & 31; const LAS unsigned* tp = (const LAS unsigned*)(T + n * TS + 16 * c);
        v4u o; o.x = tp[0]; o.y = tp[1]; o.z = tp[2]; o.w = tp[3];
        *(GAS v4u*)(WT + (size_t)(drow0 + n) * rowb + (F8 ? k0 : 2 * k0) + 16 * c) = o; }
    __syncthreads();
}
constexpr int KB1 = MOE_FP8_G1 ? 2 : 4, KB2 = MOE_FP8_G2 ? 2 : 4, I_E1 = NE * 16 * KB1, I_E2 = NE * 8 * KB2, N_EXP_ITEMS = I_E1 + I_E2;
constexpr int N_BG_ITEMS = 0;
__device__ __forceinline__ void p0_expert_item(const Args& a, LAS unsigned char* lds, int it, int tid, int wave, int lane) {
    unsigned char* ws = a.ws;
    if (it < I_E1) { const int e = it / (16 * KB1), r2 = it % (16 * KB1), nb = r2 / KB1, kb = r2 % KB1, c0 = 128 * nb;
        const int drow = e * 2048 + ((c0 < 1024) ? (256 * (c0 >> 7)) : (256 * ((c0 - 1024) >> 7) + 128));
        p0_item<MOE_FP8_G1 != 0>(a.in[I_W1] + (size_t)e * 1024 * 2048, 2048, (MOE_FP8_G1 ? 512 : 256) * kb, c0, ws + WS_W1, drow, MOE_FP8_G1 ? 1024 : 2048, 128.0f, lds, tid, wave, lane); }
    else { const int r = it - I_E1, e = r / (8 * KB2), r2 = r % (8 * KB2), nb = r2 / KB2, kb = r2 % KB2;
        p0_item<MOE_FP8_G2 != 0>(a.in[I_W2] + (size_t)e * 1024 * 1024, 1024, (MOE_FP8_G2 ? 512 : 256) * kb, 128 * nb, ws + WS_W2, e * 1024 + 128 * nb, MOE_FP8_G2 ? 1024 : 2048, 128.0f, lds, tid, wave, lane); }
}
struct P0Src { const float* W; int ldw, k0, c0, drow; unsigned char* WT; };
__device__ __forceinline__ P0Src p0_expert_src(const Args& a, int it) {
    P0Src s;
    if (it < I_E1) { const int e = it / (16 * KB1), r2 = it % (16 * KB1), nb = r2 / KB1, kb = r2 % KB1, c0 = 128 * nb;
        s.W = a.in[I_W1] + (size_t)e * 1024 * 2048; s.ldw = 2048; s.k0 = 512 * kb; s.c0 = c0; s.drow = e * 2048 + ((c0 < 1024) ? (256 * (c0 >> 7)) : (256 * ((c0 - 1024) >> 7) + 128)); s.WT = a.ws + WS_W1; }
    else { const int r = it - I_E1, e = r / (8 * KB2), r2 = r % (8 * KB2), nb = r2 / KB2, kb = r2 % KB2;
        s.W = a.in[I_W2] + (size_t)e * 1024 * 1024; s.ldw = 1024; s.k0 = 512 * kb; s.c0 = 128 * nb; s.drow = e * 1024 + 128 * nb; s.WT = a.ws + WS_W2; }
    return s;
}
__device__ __forceinline__ void p0_load_batch(f32x4 (&v)[4][4], const P0Src& s, int batch, int wave, int lane) {
    const int l32 = lane & 31, hf = lane >> 5, kb = batch * 256 + wave * 32;
#pragma unroll
    for (int i = 0; i < 4; ++i)
#pragma unroll
        for (int j = 0; j < 4; ++j) v[i][j] = __builtin_nontemporal_load((const f32x4*)(s.W + (size_t)(s.k0 + kb + 4 * (2 * i + hf) + j) * s.ldw + s.c0 + 4 * l32));
}
__device__ __forceinline__ void p0_pack_batch8(const f32x4 (&v)[4][4], int batch, LAS unsigned char* T, int wave, int lane) {
    const int l32 = lane & 31, hf = lane >> 5, kb = batch * 256 + wave * 32;
#pragma unroll
    for (int i = 0; i < 4; ++i) { const int kk = kb + 4 * (2 * i + hf);
#pragma unroll
        for (int c = 0; c < 4; ++c) *(LAS unsigned*)(T + (4 * l32 + c) * 516 + kk) = pk4_fp8(v[i][0][c] * 128.0f, v[i][1][c] * 128.0f, v[i][2][c] * 128.0f, v[i][3][c] * 128.0f); }
}
__device__ __forceinline__ void p0_expert_items_pipelined(const Args& a, LAS unsigned char* T, int bid, int G, int n_items, int tid, int wave, int lane) {
    if (bid >= n_items) return;
    f32x4 vA[4][4], vB[4][4];
    P0Src cur = p0_expert_src(a, bid);
    p0_load_batch(vA, cur, 0, wave, lane);
#pragma unroll 1
    for (int it = bid; it < n_items; it += G) {
        p0_load_batch(vB, cur, 1, wave, lane);
        p0_pack_batch8(vA, 0, T, wave, lane);
        const int nx = it + G; const P0Src nxt = p0_expert_src(a, nx < n_items ? nx : it);
        if (nx < n_items) p0_load_batch(vA, nxt, 0, wave, lane);
        p0_pack_batch8(vB, 1, T, wave, lane);
        __syncthreads();
#pragma unroll
        for (int i = 0; i < 8; ++i) { const int piece = tid + NTHR * i, n = piece >> 5, c = piece & 31; const LAS unsigned* tp = (const LAS unsigned*)(T + n * 516 + 16 * c);
            v4u o; o.x = tp[0]; o.y = tp[1]; o.z = tp[2]; o.w = tp[3];
            *(GAS v4u*)(cur.WT + (size_t)(cur.drow + n) * 1024 + cur.k0 + 16 * c) = o; }
        __syncthreads();
        cur = nxt;
    }
}
__device__ __forceinline__ void p0_bg_items(const Args& a, LAS unsigned char* lds, int bid, int G, int tid, int wave, int lane) {
    if (G == 256 && bid >= 128) { for (int j = 0; j < N_BG_ITEMS / 128; ++j) p0_expert_item(a, lds, N_EXP_ITEMS - N_BG_ITEMS + (bid - 128) + 128 * j, tid, wave, lane); }
}
__device__ __forceinline__ void p0_prologue(const Args& a, LAS unsigned char* lds, int bid, int G, int tid, int wave, int lane) {
    unsigned char* ws = a.ws;
    { const int gw = (G - 1 - bid) * NWAVES + wave, NGW = G * NWAVES;
      for (int it = gw; it < 192; it += NGW) {
        const int nc = it % 24, kc = it / 24, n = nc * 256 + 4 * lane;
        const float* W = a.in[I_ADAW]; const float* c = a.in[I_C];
        f32x4 a0 = {0.f, 0.f, 0.f, 0.f}, a1 = {0.f, 0.f, 0.f, 0.f};
#pragma unroll 8
        for (int kk = 0; kk < 128; ++kk) { const int k = kc * 128 + kk; const f32x4 w = __builtin_nontemporal_load((const f32x4*)(W + (size_t)k * 6144 + n));
            const float c0 = silu_f(c[k]), c1 = silu_f(c[1024 + k]); a0 += c0 * w; a1 += c1 * w; }
        float* mp = (float*)(ws + WS_MODP);
        *(f32x4*)(mp + (size_t)(kc * 2 + 0) * 6144 + n) = a0; *(f32x4*)(mp + (size_t)(kc * 2 + 1) * 6144 + n) = a1;
      } }
    constexpr int I_IN = 28 * 4, I_OUT = 8 * 4;
    const int n_p0 = (G == 256) ? (N_EXP_ITEMS - N_BG_ITEMS) : N_EXP_ITEMS;
    if (MOE_FP8_G1 && MOE_FP8_G2) p0_expert_items_pipelined(a, lds, bid, G, n_p0, tid, wave, lane);
    else for (int it = bid; it < n_p0; it += G) p0_expert_item(a, lds, it, tid, wave, lane);
    for (int it = bid; it < I_IN + I_OUT; it += G) {
        if (it < I_IN) { const int nb = it >> 2, kb = it & 3; p0_item<false>(a.in[I_WIN], IN_COLS, 256 * kb, 128 * nb, ws + WS_WIN, 128 * nb, 2048, 1.0f, lds, tid, wave, lane); }
        else { const int r = it - I_IN, nb = r >> 2, kb = r & 3; p0_item<false>(a.in[I_WOUT], D, 256 * kb, 128 * nb, ws + WS_WOUT, 128 * nb, 2048, 1.0f, lds, tid, wave, lane); }
    }
}

__device__ __forceinline__ void load_mod_AS(LAS float* A, LAS float* S, const float* normw, const float* src, int nparts, const float* bias, int b, int shift_off, int tid) {
    for (int k = tid; k < 1024; k += NTHR) {
        float sh = bias ? bias[shift_off + k] : 0.f, sc = bias ? bias[shift_off + 1024 + k] : 0.f;
        for (int p = 0; p < nparts; ++p) { const float* q = src + (size_t)(p * 2 + b) * 6144 + shift_off; sh += q[k]; sc += q[1024 + k]; }
        A[k] = normw[k] * (1.0f + sc); S[k] = sh;
    }
}
__device__ __forceinline__ float softplus_f(float x) { return fmaxf(x, 0.f) + log1pf(__expf(-fabsf(x))); }

__device__ __forceinline__ void p1_norm(const Args& a, LAS unsigned char* lds, int bid, int G, int tid, int wave, int lane) {
    unsigned char* ws = a.ws;
    LAS float* A1 = (LAS float*)(lds); LAS float* S1 = A1 + 1024; LAS float* WDT = S1 + 1024;
    const float* modp = (const float*)(ws + WS_MODP);
    for (int idx = bid * NTHR + tid; idx < 2 * 6144; idx += G * NTHR) { const int b = idx / 6144, n = idx % 6144; float s = a.in[I_ADAB][n];
        for (int p = 0; p < 8; ++p) s += modp[(size_t)(p * 2 + b) * 6144 + n];
        ((float*)(ws + WS_MODF))[idx] = s; }
    for (int idx = tid; idx < 8192; idx += NTHR) { const int k = idx >> 3, jj = idx & 7; WDT[jj * 1024 + k] = a.in[I_WIN][(size_t)k * IN_COLS + NPROJ + jj]; }
    const float* x = a.in[I_X]; bf16* H = (bf16*)(ws + WS_H); float* DT = (float*)(ws + WS_DT);
    for (int c = bid; c < NCHUNK; c += G) {
        const int b = c >> 7;
        __syncthreads();
        load_mod_AS(A1, S1, a.in[I_N1W], modp, 8, a.in[I_ADAB], b, 0, tid);
        __syncthreads();
        f32x4 vn[4];
        { const GAS f32x4* xr = (const GAS f32x4*)(x + (size_t)(c * 64 + wave * 8) * D) + lane;
#pragma unroll
          for (int j = 0; j < 4; ++j) vn[j] = __builtin_nontemporal_load((const f32x4*)xr + 64 * j); }
#pragma unroll 1
        for (int r = 0; r < 8; ++r) {
            const int m = c * 64 + wave * 8 + r;
            f32x4 v[4]; float ss = 0.f;
#pragma unroll
            for (int j = 0; j < 4; ++j) { v[j] = vn[j]; ss += (v[j].x * v[j].x + v[j].y * v[j].y) + (v[j].z * v[j].z + v[j].w * v[j].w); }
            if (r < 7) { const GAS f32x4* xr = (const GAS f32x4*)(x + (size_t)(m + 1) * D) + lane;
#pragma unroll
                for (int j = 0; j < 4; ++j) vn[j] = __builtin_nontemporal_load((const f32x4*)xr + 64 * j); }
            const float rstd = rsqrtf(wave_sum(ss) * (1.0f / D) + EPS);
            float dacc[8];
#pragma unroll
            for (int jj = 0; jj < 8; ++jj) dacc[jj] = 0.f;
            GAS unsigned long long* o8 = (GAS unsigned long long*)(H + (size_t)m * D) + lane;
#pragma unroll
            for (int j = 0; j < 4; ++j) {
                const f32x4 av = *(const LAS f32x4*)(A1 + 256 * j + 4 * lane), sv = *(const LAS f32x4*)(S1 + 256 * j + 4 * lane);
                const f32x4 h = v[j] * rstd * av + sv;
                o8[64 * j] = (unsigned long long)pk2(h.x, h.y) | ((unsigned long long)pk2(h.z, h.w) << 32);
#pragma unroll
                for (int jj = 0; jj < 8; ++jj) { const f32x4 w = *(const LAS f32x4*)(WDT + jj * 1024 + 256 * j + 4 * lane); dacc[jj] += (h.x * w.x + h.y * w.y) + (h.z * w.z + h.w * w.w); }
            }
            { const bool u5 = (lane & 32) != 0, u4 = (lane & 16) != 0, u3 = (lane & 8) != 0; float p4[4], p2[2], p1;
#pragma unroll
              for (int i = 0; i < 4; ++i) { const float lo = dacc[i], hi = dacc[i + 4]; p4[i] = (u5 ? hi : lo) + __shfl_xor(u5 ? lo : hi, 32); }
#pragma unroll
              for (int i = 0; i < 2; ++i) { const float lo = p4[i], hi = p4[i + 2]; p2[i] = (u4 ? hi : lo) + __shfl_xor(u4 ? lo : hi, 16); }
              { const float lo = p2[0], hi = p2[1]; p1 = (u3 ? hi : lo) + __shfl_xor(u3 ? lo : hi, 8); }
              p1 += __shfl_xor(p1, 4); p1 += __shfl_xor(p1, 2); p1 += __shfl_xor(p1, 1);
              const int col = lane >> 3;
              if ((lane & 7) == 0) DT[(size_t)m * 8 + col] = softplus_f(p1 + a.in[I_DTB][col]); }
        }
    }
}

__device__ __forceinline__ void hgrn_naive(const Args& a, LAS unsigned char* lds, int bh, int tid, int wave, int lane) {
    unsigned char* ws = a.ws;
    const int b = bh >> 2, h = bh & 3, j = tid & 127, kq = tid >> 7;
    LAS float* FE = (LAS float*)lds; LAS float* KK = FE + 2048; LAS float* QQ = KK + 2048; LAS float* VV = QQ + 2048; LAS float* RED = VV + 2048;
    const bf16* P = (const bf16*)(ws + WS_P); const float* LF = (const float*)(ws + WS_LF); bf16* MIX = (bf16*)(ws + WS_MIX);
    const float* nw = a.in[I_HGNW];
    float S[32];
#pragma unroll
    for (int i = 0; i < 32; ++i) S[i] = 0.f;
    for (int t0 = 0; t0 < SEQ; t0 += 16) {
        for (int idx = tid; idx < 2048; idx += NTHR) { const int tt = idx >> 7, k = idx & 127; const size_t row = (size_t)b * SEQ + t0 + tt;
            FE[idx] = __expf(LF[row * 512 + h * 128 + k]); KK[idx] = bf2f(P[row * NPROJ + PC_K + h * 128 + k]);
            QQ[idx] = bf2f(P[row * NPROJ + PC_Q + h * 128 + k]); VV[idx] = bf2f(P[row * NPROJ + PC_V + h * 128 + k]); }
        __syncthreads();
#pragma unroll 1
        for (int tt = 0; tt < 16; ++tt) {
            const float vj = VV[tt * 128 + j]; float p = 0.f;
#pragma unroll
            for (int i4 = 0; i4 < 8; ++i4) {
                const f32x4 f4 = *(const LAS f32x4*)(FE + tt * 128 + 32 * kq + 4 * i4), k4 = *(const LAS f32x4*)(KK + tt * 128 + 32 * kq + 4 * i4), q4 = *(const LAS f32x4*)(QQ + tt * 128 + 32 * kq + 4 * i4);
#pragma unroll
                for (int c = 0; c < 4; ++c) { S[4 * i4 + c] = f4[c] * S[4 * i4 + c] + k4[c] * vj; p += S[4 * i4 + c] * q4[c]; }
            }
            RED[(kq * 16 + tt) * 128 + j] = p;
        }
        __syncthreads();
#pragma unroll
        for (int r = 0; r < 2; ++r) { const int tt = 2 * wave + r; const size_t row = (size_t)b * SEQ + t0 + tt;
            float o0 = 0.f, o1 = 0.f;
#pragma unroll
            for (int q = 0; q < 4; ++q) { o0 += RED[(q * 16 + tt) * 128 + lane]; o1 += RED[(q * 16 + tt) * 128 + 64 + lane]; }
            const float rstd = rsqrtf(wave_sum(o0 * o0 + o1 * o1) * (1.0f / 128.0f) + EPS);
            MIX[row * D + h * 128 + lane] = (bf16)f2bf(o0 * rstd * nw[lane] * bf2f(P[row * NPROJ + PC_G + h * 128 + lane]));
            MIX[row * D + h * 128 + 64 + lane] = (bf16)f2bf(o1 * rstd * nw[64 + lane] * bf2f(P[row * NPROJ + PC_G + h * 128 + 64 + lane])); }
    }
}
__device__ __forceinline__ void ssd_naive(const Args& a, LAS unsigned char* lds, int bg, int tid, int wave, int lane) {
    unsigned char* ws = a.ws;
    const int b = bg >> 1, g = bg & 1, p = tid & 63, hl = wave >> 1, nh = wave & 1;
    LAS float* XS = (LAS float*)lds; LAS float* BM = XS + 4096; LAS float* CM = BM + 2048; LAS float* DTL = CM + 2048; LAS float* DEC = DTL + 64; LAS float* RED = DEC + 64;
    const bf16* P = (const bf16*)(ws + WS_P); const float* DT = (const float*)(ws + WS_DT); bf16* MIX = (bf16*)(ws + WS_MIX);
    const float* cw = a.in[I_CONVW]; const float* cb = a.in[I_CONVB];
    float hS[64];
#pragma unroll
    for (int i = 0; i < 64; ++i) hS[i] = 0.f;
    for (int t0 = 0; t0 < SEQ; t0 += 16) {
        for (int idx = tid; idx < 16 * 512; idx += NTHR) { const int tt = idx >> 9, cc = idx & 511, t = t0 + tt;
            const int ch = (cc < 256) ? (g * 256 + cc) : (cc < 384) ? (512 + g * 128 + (cc - 256)) : (768 + g * 128 + (cc - 384));
            float v = cb[ch];
#pragma unroll
            for (int w = 0; w < 4; ++w) { const int ts = t - 3 + w; if (ts >= 0) v += bf2f(P[((size_t)b * SEQ + ts) * NPROJ + PC_X + ch]) * cw[w * 1024 + ch]; }
            v = silu_f(v);
            if (cc < 256) XS[tt * 256 + cc] = v; else if (cc < 384) BM[tt * 128 + cc - 256] = v; else CM[tt * 128 + cc - 384] = v; }
        if (tid < 64) { const int tt = tid >> 2, hh = tid & 3; const float dtv = DT[((size_t)b * SEQ + t0 + tt) * 8 + g * 4 + hh]; DTL[tid] = dtv; DEC[tid] = __expf(-dtv * __expf(a.in[I_ALOG][g * 4 + hh])); }
        __syncthreads();
#pragma unroll 1
        for (int tt = 0; tt < 16; ++tt) {
            const float dec = DEC[tt * 4 + hl], xdt = XS[tt * 256 + hl * 64 + p] * DTL[tt * 4 + hl]; float y = 0.f;
#pragma unroll
            for (int i4 = 0; i4 < 16; ++i4) { const f32x4 B4 = *(const LAS f32x4*)(BM + tt * 128 + nh * 64 + 4 * i4), C4 = *(const LAS f32x4*)(CM + tt * 128 + nh * 64 + 4 * i4);
#pragma unroll
                for (int c = 0; c < 4; ++c) { hS[4 * i4 + c] = dec * hS[4 * i4 + c] + xdt * B4[c]; y += hS[4 * i4 + c] * C4[c]; } }
            RED[(nh * 16 + tt) * 256 + hl * 64 + p] = y;
        }
        __syncthreads();
#pragma unroll
        for (int r = 0; r < 2; ++r) { const int tt = 2 * wave + r; const size_t row = (size_t)b * SEQ + t0 + tt;
            float yv[4], ss = 0.f;
#pragma unroll
            for (int i = 0; i < 4; ++i) { const int c = lane + 64 * i; float y = RED[tt * 256 + c] + RED[(16 + tt) * 256 + c] + a.in[I_SSMD][g * 4 + i] * XS[tt * 256 + c];
                y *= bf2f(P[row * NPROJ + PC_Z + g * 256 + c]); yv[i] = y; ss += y * y; }
            const float rstd = rsqrtf(wave_sum(ss) * (1.0f / 256.0f) + EPS);
#pragma unroll
            for (int i = 0; i < 4; ++i) { const int c = lane + 64 * i; MIX[row * D + 512 + g * 256 + c] = (bf16)f2bf(yv[i] * rstd * a.in[I_SSMNW][g * 256 + c]); }
        }
        __syncthreads();
    }
}


typedef float f32x16 __attribute__((ext_vector_type(16)));
constexpr size_t WS_UHG = 480 * MiB, WS_SHG = 496 * MiB, WS_USSD = 512 * MiB, WS_SSSD = 544 * MiB, WS_DK = 560 * MiB, WS_DEC = 561 * MiB;
constexpr int LDA = 136, LDT = 72;

__device__ __forceinline__ int crow(int i, int hh) { return (i & 3) + 8 * (i >> 2) + 4 * hh; }
__device__ __forceinline__ void mma32(f32x16& acc, const LAS bf16* A, int lda, const LAS bf16* Bt, int ldb, int nsteps, int lane) {
    const LAS bf16* ap = A + (lane & 31) * lda + 8 * (lane >> 5);
    const LAS bf16* bp = Bt + (lane & 31) * ldb + 8 * (lane >> 5);
    for (int s = 0; s < nsteps; ++s) {
        const bf16x8 av = *(const LAS bf16x8*)(ap + 16 * s), bv = *(const LAS bf16x8*)(bp + 16 * s);
        acc = __builtin_amdgcn_mfma_f32_32x32x16_bf16(av, bv, acc, 0, 0, 0);
    }
}
__device__ __forceinline__ f32x16 zero16() { f32x16 z;
#pragma unroll
    for (int i = 0; i < 16; ++i) z[i] = 0.f; return z; }
__device__ __forceinline__ void st8(LAS bf16* p, float a, float b, float c, float d) { *(LAS unsigned long long*)p = (unsigned long long)pk2(a, b) | ((unsigned long long)pk2(c, d) << 32); }
__device__ __forceinline__ void st16x(LAS bf16* p, const float* v) {
    v4u a, b; a.x = pk2(v[0], v[1]); a.y = pk2(v[2], v[3]); a.z = pk2(v[4], v[5]); a.w = pk2(v[6], v[7]); b.x = pk2(v[8], v[9]); b.y = pk2(v[10], v[11]); b.z = pk2(v[12], v[13]); b.w = pk2(v[14], v[15]);
    *(LAS v4u*)p = a; *(LAS v4u*)(p + 8) = b; }

__device__ __forceinline__ float bfw(unsigned w, int hi) { return __uint_as_float(hi ? (w & 0xffff0000u) : (w << 16)); }
constexpr int HG_QS = 0, HG_KS = 17408, HG_KDT = 34816, HG_VT = 53248, HG_ST = 71680, HG_ATT = 106496, HG_QT = 115712, HG_EBM = 117760, HG_EBL = 118272;
constexpr int HG_VRAW = 118784;
struct HgWide { v4u q[2], k[2], v[2]; float lf[16]; };
template <bool FULL> __device__ __forceinline__ void hg_load(const Args& a, HgWide& r, int b, int h, int t0, int tid) {
    const bf16* P = (const bf16*)(a.ws + WS_P) + ((size_t)b * SEQ + t0) * NPROJ + h * 128;
#pragma unroll
    for (int i = 0; i < 2; ++i) { const int piece = tid + NTHR * i; const unsigned o = (unsigned)(piece >> 4) * NPROJ + 8u * (unsigned)(piece & 15);
        r.k[i] = *(const v4u*)(P + o + PC_K); r.v[i] = *(const v4u*)(P + o + PC_V); if (FULL) r.q[i] = *(const v4u*)(P + o + PC_Q); }
    const int k = tid & 127, tq = tid >> 7;
    const float* LF = (const float*)(a.ws + WS_LF) + ((size_t)b * SEQ + t0 + 16 * tq) * 512 + h * 128;
#pragma unroll
    for (int i = 0; i < 16; ++i) r.lf[i] = LF[(unsigned)i * 512 + (unsigned)k];
}
template <bool FULL> __device__ __forceinline__ float hg_stage(const HgWide& r, LAS unsigned char* lds, int tid) {
    LAS bf16* QS = (LAS bf16*)(lds + HG_QS); LAS bf16* KS = (LAS bf16*)(lds + HG_KS); LAS bf16* KDT = (LAS bf16*)(lds + HG_KDT); LAS bf16* VT = (LAS bf16*)(lds + HG_VT); LAS bf16* VR = (LAS bf16*)(lds + HG_VRAW);
    LAS float* QT = (LAS float*)(lds + HG_QT); LAS float* EBM = (LAS float*)(lds + HG_EBM); LAS float* EBL = (LAS float*)(lds + HG_EBL);
#pragma unroll
    for (int i = 0; i < 2; ++i) { const int piece = tid + NTHR * i; const int o = (piece >> 4) * LDA + 8 * (piece & 15);
        *(LAS v4u*)(KS + o) = r.k[i]; *(LAS v4u*)(VR + o) = r.v[i]; if (FULL) *(LAS v4u*)(QS + o) = r.q[i]; }
    const int k = tid & 127, tq = tid >> 7;
    float cum[16]; float run = 0.f;
#pragma unroll
    for (int i = 0; i < 16; ++i) { run += r.lf[i]; cum[i] = run; }
    QT[tq * 128 + k] = run;
    __syncthreads();
    const float q0 = QT[k], q1 = QT[128 + k], q2 = QT[256 + k], q3 = QT[384 + k];
    const float off = (tq > 0 ? q0 : 0.f) + (tq > 1 ? q1 : 0.f) + (tq > 2 ? q2 : 0.f), bmid = q0 + q1, blast = (q0 + q1) + (q2 + q3);
    float kd[16], vv[16];
#pragma unroll
    for (int i = 0; i < 16; ++i) { const float bt = off + cum[i]; const int e = (16 * tq + i) * LDA + k; const float kk = bf2f(KS[e]); vv[i] = bf2f(VR[e]); kd[i] = kk * __expf(blast - bt);
        if (FULL) { QS[e] = (bf16)f2bf(bf2f(QS[e]) * __expf(bt - bmid)); KS[e] = (bf16)f2bf(kk * __expf(bmid - bt)); } }
    st16x(KDT + k * LDT + 16 * tq, kd); st16x(VT + k * LDT + 16 * tq, vv);
    if (tq == 0) { EBL[k] = __expf(blast); if (FULL) EBM[k] = __expf(bmid); }
    __syncthreads();
    return blast;
}
__device__ __forceinline__ void hg_update(f32x16 (&S)[2], LAS unsigned char* lds, int wave, int lane) {
    const LAS bf16* KDT = (const LAS bf16*)(lds + HG_KDT); const LAS bf16* VT = (const LAS bf16*)(lds + HG_VT); const LAS float* EBL = (const LAS float*)(lds + HG_EBL);
    const int kt = wave >> 1, hh = lane >> 5;
#pragma unroll
    for (int g = 0; g < 4; ++g) { const f32x4 e = *(const LAS f32x4*)(EBL + 32 * kt + 8 * g + 4 * hh);
#pragma unroll
        for (int j = 0; j < 2; ++j) { S[j][4 * g + 0] *= e.x; S[j][4 * g + 1] *= e.y; S[j][4 * g + 2] *= e.z; S[j][4 * g + 3] *= e.w; } }
#pragma unroll
    for (int j = 0; j < 2; ++j) mma32(S[j], KDT + 32 * kt * LDT, LDT, VT + 32 * (2 * (wave & 1) + j) * LDT, LDT, 4, lane);
}
__device__ __forceinline__ void hg_passA(const Args& a, LAS unsigned char* lds, int u, int tid, int wave, int lane) {
    const int bh = u >> 5, seg = u & 31, b = bh >> 2, h = bh & 3, kt = wave >> 1, hh = lane >> 5, r = lane & 31;
    f32x16 S[2]; S[0] = zero16(); S[1] = zero16();
    float dsum = 0.f;
    HgWide cur; hg_load<false>(a, cur, b, h, seg * 256, tid);
#pragma unroll 1
    for (int c = 0; c < 4; ++c) {
        dsum += hg_stage<false>(cur, lds, tid);
        if (c < 3) hg_load<false>(a, cur, b, h, seg * 256 + 64 * (c + 1), tid);
        hg_update(S, lds, wave, lane);
        __syncthreads();
    }
    float* U = (float*)(a.ws + WS_UHG) + (size_t)u * 16384;
#pragma unroll
    for (int j = 0; j < 2; ++j)
#pragma unroll
        for (int i = 0; i < 16; ++i) U[(32 * kt + crow(i, hh)) * 128 + 32 * (2 * (wave & 1) + j) + r] = S[j][i];
    if (tid < 128) ((float*)(a.ws + WS_DK))[u * 128 + tid] = __expf(dsum);
}
__device__ __forceinline__ void hg_passC(const Args& a, LAS unsigned char* lds, int u, int tid, int wave, int lane) {
    const int bh = u >> 5, seg = u & 31, b = bh >> 2, h = bh & 3, kt = wave >> 1, hh = lane >> 5, r = lane & 31;
    LAS bf16* QS = (LAS bf16*)(lds + HG_QS); LAS bf16* KS = (LAS bf16*)(lds + HG_KS); LAS bf16* VT = (LAS bf16*)(lds + HG_VT);
    LAS bf16* ST = (LAS bf16*)(lds + HG_ST); LAS bf16* ATT = (LAS bf16*)(lds + HG_ATT); LAS float* EBM = (LAS float*)(lds + HG_EBM); LAS float* O = (LAS float*)(lds + HG_QS);
    const bf16* P = (const bf16*)(a.ws + WS_P); bf16* MIX = (bf16*)(a.ws + WS_MIX); const float* nw = a.in[I_HGNW];
    f32x16 S[2];
    { const float* SI = (const float*)(a.ws + WS_SHG) + (size_t)u * 16384;
#pragma unroll
      for (int j = 0; j < 2; ++j)
#pragma unroll
        for (int i = 0; i < 16; ++i) S[j][i] = SI[(32 * kt + crow(i, hh)) * 128 + 32 * (2 * (wave & 1) + j) + r]; }
    HgWide cur; hg_load<true>(a, cur, b, h, seg * 256, tid);
#pragma unroll 1
    for (int c = 0; c < 4; ++c) {
        const int t0 = seg * 256 + 64 * c;
        hg_stage<true>(cur, lds, tid);
        if (c < 3) hg_load<true>(a, cur, b, h, t0 + 64, tid);
#pragma unroll
        for (int g = 0; g < 4; ++g) { const int kb = 32 * kt + 8 * g + 4 * hh; const f32x4 e = *(const LAS f32x4*)(EBM + kb);
#pragma unroll
            for (int j = 0; j < 2; ++j) st8(ST + (32 * (2 * (wave & 1) + j) + r) * LDA + kb, S[j][4 * g] * e.x, S[j][4 * g + 1] * e.y, S[j][4 * g + 2] * e.z, S[j][4 * g + 3] * e.w); }
        if (wave < 3) { const int ti = (wave + 1) >> 1, si = wave >> 1;
            f32x16 at = zero16(); mma32(at, QS + 32 * ti * LDA, LDA, KS + 32 * si * LDA, LDA, 8, lane);
#pragma unroll
            for (int i = 0; i < 16; ++i) { const int t = 32 * ti + crow(i, hh), s = 32 * si + r; ATT[t * LDT + s] = (bf16)f2bf(s <= t ? at[i] : 0.f); } }
        __syncthreads();
        const int ti = wave >> 2, vj = wave & 3;
        f32x16 o = zero16();
        mma32(o, ATT + 32 * ti * LDT, LDT, VT + 32 * vj * LDT, LDT, 2 * (ti + 1), lane);
        mma32(o, QS + 32 * ti * LDA, LDA, ST + 32 * vj * LDA, LDA, 8, lane);
        hg_update(S, lds, wave, lane);
        __syncthreads();
#pragma unroll
        for (int i = 0; i < 16; ++i) O[(32 * ti + crow(i, hh)) * 132 + 32 * vj + r] = o[i];
        __syncthreads();
        { const int tt = tid >> 3, c16 = tid & 7; const size_t row = (size_t)b * SEQ + t0 + tt;
          float o[16]; float ss = 0.f;
#pragma unroll
          for (int q = 0; q < 4; ++q) { const f32x4 v = *(const LAS f32x4*)(O + tt * 132 + 16 * c16 + 4 * q); o[4 * q] = v.x; o[4 * q + 1] = v.y; o[4 * q + 2] = v.z; o[4 * q + 3] = v.w; ss += (v.x * v.x + v.y * v.y) + (v.z * v.z + v.w * v.w); }
          ss += __shfl_xor(ss, 1); ss += __shfl_xor(ss, 2); ss += __shfl_xor(ss, 4);
          const float rstd = rsqrtf(ss * (1.0f / 128.0f) + EPS);
          const bf16* gp = P + row * NPROJ + PC_G + h * 128 + 16 * c16; const v4u g0 = __builtin_nontemporal_load((const v4u*)gp), g1 = __builtin_nontemporal_load((const v4u*)(gp + 8)); const unsigned gw[8] = {g0.x, g0.y, g0.z, g0.w, g1.x, g1.y, g1.z, g1.w};
          unsigned ow[8];
#pragma unroll
          for (int j = 0; j < 8; ++j) ow[j] = pk2(o[2 * j] * rstd * nw[16 * c16 + 2 * j] * bfw(gw[j], 0), o[2 * j + 1] * rstd * nw[16 * c16 + 2 * j + 1] * bfw(gw[j], 1));
          bf16* mp = MIX + row * D + h * 128 + 16 * c16; *(v4u*)mp = (v4u){ow[0], ow[1], ow[2], ow[3]}; *(v4u*)(mp + 8) = (v4u){ow[4], ow[5], ow[6], ow[7]}; }
        __syncthreads();
    }
}

constexpr int SD_ACUM = 104448, SD_DTV = 106496, SD_SSQ = 108544, SD_CB = 109568;
__device__ __forceinline__ void ssd_scan_dt(const Args& a, LAS unsigned char* lds, size_t row0, int g, int wave, int lane) {
    LAS float* ACUM = (LAS float*)(lds + SD_ACUM); LAS float* DTV = (LAS float*)(lds + SD_DTV);
    if (wave < 4) { const float* DT = (const float*)(a.ws + WS_DT); const float A = -__expf(a.in[I_ALOG][g * 4 + wave]);
        const float d0 = DT[(row0 + 2 * lane) * 8 + g * 4 + wave], d1 = DT[(row0 + 2 * lane + 1) * 8 + g * 4 + wave];
        const float p0 = d0 * A, p1 = p0 + d1 * A; float incl = p1;
#pragma unroll
        for (int o = 1; o < 64; o <<= 1) { const float t = __shfl_up(incl, o); if (lane >= o) incl += t; }
        const float excl = incl - p1;
        ACUM[wave * 128 + 2 * lane] = excl + p0; ACUM[wave * 128 + 2 * lane + 1] = incl; DTV[wave * 128 + 2 * lane] = d0; DTV[wave * 128 + 2 * lane + 1] = d1; }
}
template <int NT> __device__ __forceinline__ void conv_run(const Args& a, int b, int tp0, int ch, float (&out)[NT]) {
    const bf16* Pb = (const bf16*)(a.ws + WS_P) + (size_t)b * SEQ * NPROJ + PC_X;
    const float w0 = a.in[I_CONVW][ch], w1 = a.in[I_CONVW][1024 + ch], w2 = a.in[I_CONVW][2048 + ch], w3 = a.in[I_CONVW][3072 + ch], cb = a.in[I_CONVB][ch];
    const unsigned o0 = (unsigned)tp0 * NPROJ + (unsigned)ch;
    float x0 = (tp0 >= 3) ? bf2f(Pb[o0 - 3u * NPROJ]) : 0.f, x1 = (tp0 >= 2) ? bf2f(Pb[o0 - 2u * NPROJ]) : 0.f, x2 = (tp0 >= 1) ? bf2f(Pb[o0 - 1u * NPROJ]) : 0.f;
#pragma unroll
    for (int i = 0; i < NT; ++i) { const float x3 = bf2f(Pb[o0 + (unsigned)i * NPROJ]); out[i] = silu_f(cb + w0 * x0 + w1 * x1 + w2 * x2 + w3 * x3); x0 = x1; x1 = x2; x2 = x3; }
}
template <bool NATURAL, bool NT = false> __device__ __forceinline__ void conv8x8(const Args& a, int b, int tp0, int ch0, LAS bf16* dst, const float* sc) {
    const bf16* Pb = (const bf16*)(a.ws + WS_P) + (size_t)b * SEQ * NPROJ + PC_X + ch0;
    const float* cw = a.in[I_CONVW] + ch0; const float* cbp = a.in[I_CONVB] + ch0;
    float w[4][8], bias[8];
#pragma unroll
    for (int q = 0; q < 4; ++q) { const f32x4 lo = *(const f32x4*)(cw + q * 1024), hi = *(const f32x4*)(cw + q * 1024 + 4);
        w[q][0] = lo.x; w[q][1] = lo.y; w[q][2] = lo.z; w[q][3] = lo.w; w[q][4] = hi.x; w[q][5] = hi.y; w[q][6] = hi.z; w[q][7] = hi.w; }
    { const f32x4 lo = *(const f32x4*)cbp, hi = *(const f32x4*)(cbp + 4); bias[0] = lo.x; bias[1] = lo.y; bias[2] = lo.z; bias[3] = lo.w; bias[4] = hi.x; bias[5] = hi.y; bias[6] = hi.z; bias[7] = hi.w; }
    v4u raw[11];
#pragma unroll
    for (int i = 0; i < 11; ++i) { const int tp = tp0 - 3 + i; const v4u* rp = (const v4u*)(Pb + (size_t)(unsigned)(tp < 0 ? 0 : tp) * NPROJ); raw[i] = (tp >= 0) ? (NT ? __builtin_nontemporal_load(rp) : *rp) : (v4u){0u, 0u, 0u, 0u}; }
    unsigned pkT[8][4];
#pragma unroll
    for (int tok = 0; tok < 8; ++tok) { float o[8];
#pragma unroll
        for (int c = 0; c < 8; ++c) { float v = bias[c];
#pragma unroll
            for (int q = 0; q < 4; ++q) v += w[q][c] * bfw(raw[tok + q][c >> 1], c & 1);
            o[c] = silu_f(v); }
        if (NATURAL) { v4u ov; ov.x = pk2(o[0], o[1]); ov.y = pk2(o[2], o[3]); ov.z = pk2(o[4], o[5]); ov.w = pk2(o[6], o[7]); *(LAS v4u*)(dst + tok * LDA) = ov; }
        else {
#pragma unroll
            for (int c = 0; c < 8; ++c) { const unsigned hb = f2bf(o[c] * sc[tok]); pkT[c][tok >> 1] = (tok & 1) ? (pkT[c][tok >> 1] | (hb << 16)) : hb; } } }
    if (!NATURAL) {
#pragma unroll
        for (int c = 0; c < 8; ++c) { v4u ov; ov.x = pkT[c][0]; ov.y = pkT[c][1]; ov.z = pkT[c][2]; ov.w = pkT[c][3]; *(LAS v4u*)(dst + c * LDA) = ov; } }
}
constexpr int SC_CM = 0, SC_BM = 34816, SC_XT = 69632, SC_SIN = 87040, SC_YS = 104448, SC_ACUM = 139264, SC_DTV = 141312;
__device__ __forceinline__ void ssd_scan_dt_at(const Args& a, LAS unsigned char* lds, int acum_off, int dtv_off, size_t row0, int g, int wave, int lane) {
    LAS float* ACUM = (LAS float*)(lds + acum_off); LAS float* DTV = (LAS float*)(lds + dtv_off);
    if (wave < 4) { const float* DT = (const float*)(a.ws + WS_DT); const float A = -__expf(a.in[I_ALOG][g * 4 + wave]);
        const float d0 = DT[(row0 + 2 * lane) * 8 + g * 4 + wave], d1 = DT[(row0 + 2 * lane + 1) * 8 + g * 4 + wave];
        const float p0 = d0 * A, p1 = p0 + d1 * A; float incl = p1;
#pragma unroll
        for (int o = 1; o < 64; o <<= 1) { const float t = __shfl_up(incl, o); if (lane >= o) incl += t; }
        const float excl = incl - p1;
        ACUM[wave * 128 + 2 * lane] = excl + p0; ACUM[wave * 128 + 2 * lane + 1] = incl; DTV[wave * 128 + 2 * lane] = d0; DTV[wave * 128 + 2 * lane + 1] = d1; }
}
__device__ __forceinline__ void ssd_passA(const Args& a, LAS unsigned char* lds, int u, int tid, int wave, int lane) {
    const int bg = u >> 6, c = u & 63, b = bg >> 1, g = bg & 1, t0 = c * 128; const size_t row0 = (size_t)b * SEQ + t0;
    LAS bf16* XDT = (LAS bf16*)lds; LAS bf16* BMT = (LAS bf16*)(lds + 69632); LAS float* ACUM = (LAS float*)(lds + SD_ACUM); LAS float* DTV = (LAS float*)(lds + SD_DTV);
    ssd_scan_dt(a, lds, row0, g, wave, lane);
    __syncthreads();
#pragma unroll 1
    for (int task = tid; task < 768; task += NTHR) {
        int task_o = task; asm volatile("" : "+v"(task_o));
        const int cg = task_o >> 4, tb = task_o & 15; float sc[8];
        if (cg < 32) { const int hd = cg >> 3; const float al = ACUM[hd * 128 + 127];
#pragma unroll
            for (int i = 0; i < 8; ++i) sc[i] = DTV[hd * 128 + 8 * tb + i] * __expf(al - ACUM[hd * 128 + 8 * tb + i]);
            conv8x8<false>(a, b, t0 + 8 * tb, g * 256 + 8 * cg, XDT + (8 * cg) * LDA + 8 * tb, sc); }
        else {
#pragma unroll
            for (int i = 0; i < 8; ++i) sc[i] = 1.0f;
            conv8x8<false>(a, b, t0 + 8 * tb, 512 + g * 128 + 8 * (cg - 32), BMT + (8 * (cg - 32)) * LDA + 8 * tb, sc); }
    }
    __syncthreads();
    const int hd = wave >> 1, pt = wave & 1, hh = lane >> 5, r = lane & 31;
    float* U = (float*)(a.ws + WS_USSD) + (size_t)u * 32768;
#pragma unroll
    for (int nt = 0; nt < 4; ++nt) { f32x16 acc = zero16(); mma32(acc, XDT + (hd * 64 + 32 * pt) * LDA, LDA, BMT + 32 * nt * LDA, LDA, 8, lane);
#pragma unroll
        for (int i = 0; i < 16; ++i) U[(hd * 64 + 32 * pt + crow(i, hh)) * 128 + 32 * nt + r] = acc[i]; }
    if (tid < 4) ((float*)(a.ws + WS_DEC))[u * 4 + tid] = __expf(ACUM[tid * 128 + 127]);
    __syncthreads();
}
__device__ __forceinline__ void ssd_passC(const Args& a, LAS unsigned char* lds, int u, int tid, int wave, int lane) {
    const int bg = u >> 6, c = u & 63, b = bg >> 1, g = bg & 1, t0 = c * 128; const size_t row0 = (size_t)b * SEQ + t0;
    LAS bf16* CM = (LAS bf16*)(lds + SC_CM); LAS bf16* BM = (LAS bf16*)(lds + SC_BM); LAS bf16* XT = (LAS bf16*)(lds + SC_XT); LAS bf16* SIN = (LAS bf16*)(lds + SC_SIN);
    LAS float* YS = (LAS float*)(lds + SC_YS); LAS float* ACUM = (LAS float*)(lds + SC_ACUM); LAS float* DTV = (LAS float*)(lds + SC_DTV);
    const bf16* P = (const bf16*)(a.ws + WS_P); bf16* MIX = (bf16*)(a.ws + WS_MIX);
    ssd_scan_dt_at(a, lds, SC_ACUM, SC_DTV, row0, g, wave, lane);
    { const int c8 = tid & 31, tb = tid >> 5;
      conv8x8<true>(a, b, t0 + 8 * tb, (c8 < 16) ? (512 + g * 128 + 8 * c8) : (768 + g * 128 + 8 * (c8 - 16)), ((c8 < 16) ? (BM + 8 * c8) : (CM + 8 * (c8 - 16))) + 8 * tb * LDA, nullptr); }
    __syncthreads();
    const int ti = wave >> 1, pj = wave & 1;
    const int et = tid >> 2, epq = tid & 3;
    float ssq = 0.f;
    const bf16* Pz = P + (row0 + et) * NPROJ + PC_Z + g * 256 + 16 * epq;
    bf16* Mo = MIX + (row0 + et) * D + 512 + g * 256 + 16 * epq;
    float ones[8];
#pragma unroll
    for (int i = 0; i < 8; ++i) ones[i] = 1.0f;
#pragma unroll 1
    for (int hd = 0; hd < 4; ++hd) {
        int tid_o = tid; asm volatile("" : "+v"(tid_o));
        const int lane = tid_o & 63, hh = lane >> 5, r = lane & 31;
        if (tid_o < 128) { const int c8 = tid_o & 7, tb = tid_o >> 3; conv8x8<false>(a, b, t0 + 8 * tb, g * 256 + hd * 64 + 8 * c8, XT + (8 * c8) * LDA + 8 * tb, ones); }
        { const int pr = tid_o >> 3, n0 = (tid_o & 7) * 16; const v4u* src = (const v4u*)((const bf16*)(a.ws + WS_SSSD) + (size_t)u * 32768) + (unsigned)((hd * 64 + pr) * 16 + (tid_o & 7) * 2);
          const v4u s0 = __builtin_nontemporal_load(src), s1 = __builtin_nontemporal_load(src + 1); *(LAS v4u*)(SIN + pr * LDA + n0) = s0; *(LAS v4u*)(SIN + pr * LDA + n0 + 8) = s1; }
        const v4u z0 = __builtin_nontemporal_load((const v4u*)(Pz + hd * 64)), z1 = __builtin_nontemporal_load((const v4u*)(Pz + hd * 64 + 8));
        __syncthreads();
        const float Dh = a.in[I_SSMD][g * 4 + hd];
        f32x16 yi = zero16(), yo = zero16();
        const int t = 32 * ti + r; const float at = ACUM[hd * 128 + t];
        for (int si = 0; si <= ti; ++si) {
            f32x16 cbT = zero16(); mma32(cbT, BM + 32 * si * LDA, LDA, CM + 32 * ti * LDA, LDA, 8, lane);
            float sv[16];
#pragma unroll
            for (int i = 0; i < 16; ++i) { const int s = 32 * si + crow(i, hh); float v = (s <= t) ? cbT[i] * __expf(at - ACUM[hd * 128 + s]) * DTV[hd * 128 + s] : 0.f; sv[i] = (s == t) ? v + Dh : v; }
#pragma unroll
            for (int st = 0; st < 2; ++st) {
                v4u av; av.x = pk2(sv[8 * st], sv[8 * st + 1]); av.y = pk2(sv[8 * st + 2], sv[8 * st + 3]); av.z = pk2(sv[8 * st + 4], sv[8 * st + 5]); av.w = pk2(sv[8 * st + 6], sv[8 * st + 7]);
                const LAS bf16* bp = XT + (32 * pj + r) * LDA + 32 * si + 16 * st + 4 * hh;
                const unsigned long long b0 = *(const LAS unsigned long long*)bp, b1 = *(const LAS unsigned long long*)(bp + 8);
                v4u bv; bv.x = (unsigned)b0; bv.y = (unsigned)(b0 >> 32); bv.z = (unsigned)b1; bv.w = (unsigned)(b1 >> 32);
                yi = __builtin_amdgcn_mfma_f32_32x32x16_bf16(__builtin_bit_cast(bf16x8, av), __builtin_bit_cast(bf16x8, bv), yi, 0, 0, 0);
            }
        }
        mma32(yo, CM + 32 * ti * LDA, LDA, SIN + 32 * pj * LDA, LDA, 8, lane);
#pragma unroll
        for (int i = 0; i < 16; ++i) { const int tt = 32 * ti + crow(i, hh); YS[tt * 68 + 32 * pj + r] = yi[i] + __expf(ACUM[hd * 128 + tt]) * yo[i]; }
        __syncthreads();
        { float y[16];
#pragma unroll
          for (int q = 0; q < 4; ++q) { const f32x4 v = *(const LAS f32x4*)(YS + et * 68 + 16 * epq + 4 * q); y[4 * q] = v.x; y[4 * q + 1] = v.y; y[4 * q + 2] = v.z; y[4 * q + 3] = v.w; }
          const unsigned zw[8] = {z0.x, z0.y, z0.z, z0.w, z1.x, z1.y, z1.z, z1.w};
#pragma unroll
          for (int j = 0; j < 16; ++j) { y[j] *= bfw(zw[j >> 1], j & 1); ssq += y[j] * y[j]; }
          v4u o0, o1; o0.x = pk2(y[0], y[1]); o0.y = pk2(y[2], y[3]); o0.z = pk2(y[4], y[5]); o0.w = pk2(y[6], y[7]); o1.x = pk2(y[8], y[9]); o1.y = pk2(y[10], y[11]); o1.z = pk2(y[12], y[13]); o1.w = pk2(y[14], y[15]);
          *(v4u*)(Mo + hd * 64) = o0; *(v4u*)(Mo + hd * 64 + 8) = o1; }
    }
    ssq += __shfl_xor(ssq, 1); ssq += __shfl_xor(ssq, 2);
    const float rstd = rsqrtf(ssq * (1.0f / 256.0f) + EPS);
    const float* nw = a.in[I_SSMNW] + g * 256 + 16 * epq;
#pragma unroll 1
    for (int hd = 0; hd < 4; ++hd) {
        const v4u i0 = *(const v4u*)(Mo + hd * 64), i1 = *(const v4u*)(Mo + hd * 64 + 8); const unsigned iw[8] = {i0.x, i0.y, i0.z, i0.w, i1.x, i1.y, i1.z, i1.w};
        float wv[16];
#pragma unroll
        for (int q = 0; q < 4; ++q) { const f32x4 v = *(const f32x4*)(nw + hd * 64 + 4 * q); wv[4 * q] = v.x; wv[4 * q + 1] = v.y; wv[4 * q + 2] = v.z; wv[4 * q + 3] = v.w; }
        unsigned ow[8];
#pragma unroll
        for (int j = 0; j < 8; ++j) ow[j] = pk2(bfw(iw[j], 0) * rstd * wv[2 * j], bfw(iw[j], 1) * rstd * wv[2 * j + 1]);
        *(v4u*)(Mo + hd * 64) = (v4u){ow[0], ow[1], ow[2], ow[3]}; *(v4u*)(Mo + hd * 64 + 8) = (v4u){ow[4], ow[5], ow[6], ow[7]};
    }
    __syncthreads();
}
__device__ __forceinline__ void mix_scan(const Args& a, int bid, int G, int tid) {
    typedef float f32x2 __attribute__((ext_vector_type(2)));
    for (int gt = bid * NTHR + tid; gt < 131072; gt += G * NTHR) {
        if (gt < 65536) { const int bh = gt >> 13, e2 = gt & 8191, k = e2 >> 6;
            const f32x2* U = (const f32x2*)(a.ws + WS_UHG) + (size_t)bh * 32 * 8192 + e2; f32x2* SI = (f32x2*)(a.ws + WS_SHG) + (size_t)bh * 32 * 8192 + e2; const float* DK = (const float*)(a.ws + WS_DK) + bh * 32 * 128 + k;
            f32x2 cur = {0.f, 0.f};
#pragma unroll 16
            for (int uu = 0; uu < 32; ++uu) { SI[(size_t)uu * 8192] = cur; cur = cur * DK[uu * 128] + __builtin_nontemporal_load(U + (size_t)uu * 8192); }
        } else { const int q = gt - 65536, bg = q >> 14, e2 = q & 16383, hd = e2 >> 12;
            const f32x2* U = (const f32x2*)(a.ws + WS_USSD) + (size_t)bg * 64 * 16384 + e2; unsigned* SI = (unsigned*)(a.ws + WS_SSSD) + (size_t)bg * 64 * 16384 + e2; const float* DEC = (const float*)(a.ws + WS_DEC) + bg * 64 * 4 + hd;
            f32x2 cur = {0.f, 0.f};
#pragma unroll 16
            for (int cc = 0; cc < 64; ++cc) { SI[(size_t)cc * 16384] = pk2(cur.x, cur.y); cur = cur * DEC[cc * 4] + __builtin_nontemporal_load(U + (size_t)cc * 16384); }
        }
    }
}

template <int HALF, int MASK> __device__ __forceinline__ void tr_step(float (&p)[32], int lane) {
    const bool up = (lane & MASK) != 0;
#pragma unroll
    for (int i = 0; i < HALF; ++i) { const float lo = p[i], hi = p[i + HALF]; const float send = up ? lo : hi, keep = up ? hi : lo; p[i] = keep + __shfl_xor(send, MASK); }
}
__device__ __forceinline__ void top4_store(float v, int lane, LAS int* SEL, LAS float* SELG, int ent) {
    float tv[4]; int ti[4];
#pragma unroll
    for (int k = 0; k < 4; ++k) { const float mx = wave_max(v); const unsigned long long bal = __ballot(v == mx); const int e = __builtin_ctzll(bal) >> 1;
        tv[k] = mx; ti[k] = e; v = ((lane >> 1) == e) ? -INFINITY : v; }
    const float e1 = __expf(tv[1] - tv[0]), e2 = __expf(tv[2] - tv[0]), e3 = __expf(tv[3] - tv[0]), inv = 1.0f / (1.0f + e1 + e2 + e3);
    if (lane < 4) { SEL[ent + lane] = (lane == 0) ? ti[0] : (lane == 1) ? ti[1] : (lane == 2) ? ti[2] : ti[3];
        SELG[ent + lane] = ((lane == 0) ? 1.0f : (lane == 1) ? e1 : (lane == 2) ? e2 : e3) * inv; }
}
constexpr int RT_WB = 0, RT_HB = 66048, RT_PITCH = 1032;
__device__ __forceinline__ void p5_router(const Args& a, LAS unsigned char* lds, int bid, int G, int tid, int wave, int lane) {
    unsigned char* ws = a.ws;
    LAS bf16* WB = (LAS bf16*)(lds + RT_WB); LAS bf16* HB = (LAS bf16*)(lds + RT_HB); LAS float* PART = (LAS float*)(lds + RT_HB);
    LAS float* A2 = (LAS float*)(lds + AUX_OFF + 1024); LAS float* S2 = A2 + 1024;
    LAS float* SELG = (LAS float*)(S2 + 1024); LAS float* LOGIT = SELG + 256;
    LAS int* SEL = (LAS int*)(lds + MISC_OFF + 2048); LAS int* LSL = SEL + 256;
    const float* modf = (const float*)(ws + WS_MODF);
    { const f32x4* rw4 = (const f32x4*)a.in[I_RW];
#pragma unroll 4
      for (int it = 0; it < 16; ++it) { const int q = tid + NTHR * it, k = q >> 3, e0 = (q & 7) * 4; const f32x4 w = rw4[q];
          WB[(e0 + 0) * RT_PITCH + k] = (bf16)f2bf(w.x); WB[(e0 + 1) * RT_PITCH + k] = (bf16)f2bf(w.y); WB[(e0 + 2) * RT_PITCH + k] = (bf16)f2bf(w.z); WB[(e0 + 3) * RT_PITCH + k] = (bf16)f2bf(w.w); } }
    const bf16* x1 = (const bf16*)(ws + WS_X1); bf16* H = (bf16*)(ws + WS_H);
    int* tok_e = (int*)(ws + WS_TOK); int* tok_ls = tok_e + M * 4; float* tok_g = (float*)(tok_ls + M * 4);
    int* blkcnt = (int*)(ws + WS_BLKCNT);
    for (int c = bid; c < NCHUNK; c += G) {
        const int b = c >> 7;
        __syncthreads();
        load_mod_AS(A2, S2, a.in[I_N2W], modf, 1, nullptr, b, 3 * 1024, tid);
        __syncthreads();
        unsigned long long hb[8][4];
        unsigned long long rwa[4];
        { const GAS unsigned long long* xa = (const GAS unsigned long long*)(x1 + (size_t)(c * 64 + wave * 8) * D) + lane;
#pragma unroll
          for (int j = 0; j < 4; ++j) rwa[j] = xa[64 * j]; }
#pragma unroll
        for (int r = 0; r < 8; ++r) {
            const int m0 = c * 64 + wave * 8 + r;
            f32x4 va[4]; float sa = 0.f;
#pragma unroll
            for (int j = 0; j < 4; ++j) { const unsigned long long wa = rwa[j];
                va[j] = (f32x4){bfw((unsigned)wa, 0), bfw((unsigned)wa, 1), bfw((unsigned)(wa >> 32), 0), bfw((unsigned)(wa >> 32), 1)};
                sa += (va[j].x * va[j].x + va[j].y * va[j].y) + (va[j].z * va[j].z + va[j].w * va[j].w); }
            if (r < 7) { const GAS unsigned long long* xa = (const GAS unsigned long long*)(x1 + (size_t)(m0 + 1) * D) + lane;
#pragma unroll
                for (int j = 0; j < 4; ++j) rwa[j] = xa[64 * j]; }
            const float ra = rsqrtf(wave_sum(sa) * (1.0f / D) + EPS);
#pragma unroll
            for (int j = 0; j < 4; ++j) {
                const f32x4 av = *(const LAS f32x4*)(A2 + 256 * j + 4 * lane), sv = *(const LAS f32x4*)(S2 + 256 * j + 4 * lane);
                const f32x4 h = va[j] * ra * av + sv;
#if MOE_FP8_G1
                ((GAS unsigned*)((unsigned char*)H + (size_t)m0 * D))[lane + 64 * j] = pk4_fp8(h.x * 8.f, h.y * 8.f, h.z * 8.f, h.w * 8.f);
#else
                ((GAS unsigned long long*)(H + (size_t)m0 * D))[lane + 64 * j] = (unsigned long long)pk2(h.x, h.y) | ((unsigned long long)pk2(h.z, h.w) << 32);
#endif
                hb[r][j] = (unsigned long long)pk2(h.x, h.y) | ((unsigned long long)pk2(h.z, h.w) << 32);
            }
        }
#pragma unroll
        for (int pass = 0; pass < 2; ++pass) {
            if ((wave >> 2) == pass) {
#pragma unroll
                for (int r = 0; r < 8; ++r)
#pragma unroll
                    for (int j = 0; j < 4; ++j) *(LAS unsigned long long*)(HB + ((wave & 3) * 8 + r) * RT_PITCH + 256 * j + 4 * lane) = hb[r][j]; }
            __syncthreads();
            f32x16 acc = zero16(); mma32(acc, HB + 128 * wave, RT_PITCH, WB + 128 * wave, RT_PITCH, 8, lane);
            __syncthreads();
#pragma unroll
            for (int i = 0; i < 16; ++i) PART[wave * 1024 + crow(i, lane >> 5) * 32 + (lane & 31)] = acc[i];
            __syncthreads();
#pragma unroll
            for (int q = 0; q < 2; ++q) { const int el = tid + NTHR * q; float sacc = 0.f;
#pragma unroll
                for (int w = 0; w < 8; ++w) sacc += PART[w * 1024 + el];
                LOGIT[(el >> 5) * 33 + (el & 31)] = sacc + a.in[I_RB][el & 31]; }
            __syncthreads();
            if (tid < 32) {
                float v[32];
#pragma unroll
                for (int e = 0; e < 32; ++e) v[e] = LOGIT[tid * 33 + e];
                float tv[4]; int ti[4];
#pragma unroll
                for (int k = 0; k < 4; ++k) { float best = v[0]; int bi = 0;
#pragma unroll
                    for (int e = 1; e < 32; ++e) { const bool gt = v[e] > best; best = gt ? v[e] : best; bi = gt ? e : bi; }
                    tv[k] = best; ti[k] = bi;
#pragma unroll
                    for (int e = 0; e < 32; ++e) v[e] = (e == bi) ? -INFINITY : v[e]; }
                const float e1 = __expf(tv[1] - tv[0]), e2 = __expf(tv[2] - tv[0]), e3 = __expf(tv[3] - tv[0]), inv = 1.0f / (1.0f + e1 + e2 + e3);
                const int ent = (32 * pass + tid) * 4;
                SEL[ent] = ti[0]; SEL[ent + 1] = ti[1]; SEL[ent + 2] = ti[2]; SEL[ent + 3] = ti[3];
                SELG[ent] = inv; SELG[ent + 1] = e1 * inv; SELG[ent + 2] = e2 * inv; SELG[ent + 3] = e3 * inv; }
        }
        __syncthreads();
        if (tid < 256 + 32) {
            const int mye = (tid < 256) ? SEL[tid] : (tid - 256), lim = (tid < 256) ? tid : 256; int cnt = 0;
#pragma unroll 4
            for (int j4 = 0; j4 < 64; ++j4) { const LAS int* sp = SEL + 4 * j4; const int s0 = sp[0], s1 = sp[1], s2 = sp[2], s3 = sp[3];
                cnt += (s0 == mye && 4 * j4 < lim) + (s1 == mye && 4 * j4 + 1 < lim) + (s2 == mye && 4 * j4 + 2 < lim) + (s3 == mye && 4 * j4 + 3 < lim); }
            if (tid < 256) LSL[tid] = cnt; else blkcnt[c * 32 + tid - 256] = cnt; }
        __syncthreads();
        if (tid < 256) { const size_t o = (size_t)c * 256 + tid; tok_e[o] = SEL[tid]; tok_ls[o] = LSL[tid]; tok_g[o] = SELG[tid]; }
    }
}

__device__ __forceinline__ void moe_tables(const Args& a, LAS unsigned char* lds, int c, int tid, int wave, int lane) {
    LAS int* TS = (LAS int*)(lds + MISC_OFF + 256); LAS int* RT2E = TS + 64; LAS int* BASE = (LAS int*)(lds + AUX_OFF); LAS int* PART = BASE + 64;
    const int* blkcnt = (const int*)(a.ws + WS_BLKCNT);
    { const int e = tid & 31, part = tid >> 5; int tot = 0, bs = 0;
#pragma unroll
      for (int i = 0; i < 16; ++i) { const int cc = part * 16 + i; const int v = blkcnt[cc * 32 + e]; tot += v; bs += (cc < c) ? v : 0; }
      PART[part * 32 + e] = tot; PART[512 + part * 32 + e] = bs; }
    __syncthreads();
    if (wave == 0) {
        int total = 0, base = 0;
        if (lane < 32) {
#pragma unroll
            for (int p = 0; p < 16; ++p) { total += PART[p * 32 + lane]; base += PART[512 + p * 32 + lane]; } }
        const int tiles = (lane < 32) ? ((total + 255) >> 8) : 0;
        int incl = tiles;
#pragma unroll
        for (int o = 1; o < 32; o <<= 1) { const int t = __shfl_up(incl, o); if (lane >= o) incl += t; }
        const int start = incl - tiles;
        if (lane < 32) { TS[lane] = start; BASE[lane] = start * 256 + base; for (int t = start; t < incl; ++t) RT2E[t] = lane; }
        if (lane == 31) TS[32] = incl;
    }
    __syncthreads();
}
__device__ __forceinline__ void p6_gather(const Args& a, LAS unsigned char* lds, int bid, int G, int tid, int wave, int lane) {
    unsigned char* ws = a.ws;
    LAS int* BASE = (LAS int*)(lds + AUX_OFF);
    const int* tok_e = (const int*)(ws + WS_TOK); const int* tok_ls = tok_e + M * 4; int* tok_pos = (int*)(ws + WS_TOK) + 3 * M * 4;
    const bf16* H = (const bf16*)(ws + WS_H); bf16* XG = (bf16*)(ws + WS_XG);
    if (bid >= NCHUNK) moe_tables(a, lds, NCHUNK, tid, wave, lane);
    for (int c = bid; c < NCHUNK; c += G) {
        __syncthreads();
        moe_tables(a, lds, c, tid, wave, lane);
        for (int i = wave; i < 256; i += NWAVES) {
            const size_t o = (size_t)c * 256 + i; const int e = tok_e[o]; const int pos = BASE[e] + tok_ls[o];
            if (lane == 0) tok_pos[o] = pos;
#if MOE_FP8_G1
            const GAS v4u* src = (const GAS v4u*)((const unsigned char*)H + (size_t)(c * 64 + (i >> 2)) * D); GAS v4u* dst = (GAS v4u*)((unsigned char*)XG + (size_t)pos * D);
            dst[lane] = src[lane];
#else
            const GAS v4u* src = (const GAS v4u*)(H + (size_t)(c * 64 + (i >> 2)) * D); GAS v4u* dst = (GAS v4u*)(XG + (size_t)pos * D);
            dst[lane] = src[lane]; dst[64 + lane] = src[64 + lane];
#endif
        }
    }
}

__device__ __forceinline__ void p9_final(const Args& a, int bid, int G, int wave, int lane) {
    unsigned char* ws = a.ws;
    const bf16* x1 = (const bf16*)(ws + WS_X1); const bf16* Y = (const bf16*)(ws + WS_XG);
    const float* tok_g = (const float*)(ws + WS_TOK) + 2 * M * 4; const int* tok_pos = (const int*)(ws + WS_TOK) + 3 * M * 4;
    const float* modf = (const float*)(ws + WS_MODF); const float* fnw = a.in[I_FNW]; float* out = a.out;
    const int gw = bid * NWAVES + wave, NGW = G * NWAVES;
    int pos_n[4]; float gk_n[4];
    if (gw < M) {
#pragma unroll
        for (int k = 0; k < 4; ++k) { pos_n[k] = tok_pos[(size_t)gw * 4 + k]; gk_n[k] = tok_g[(size_t)gw * 4 + k]; } }
#pragma unroll 1
    for (int m = gw; m < M; m += NGW) {
        const int b = m >> 13; const float* g2 = modf + b * 6144 + 5 * 1024;
        int posv[4]; float gkv[4];
#pragma unroll
        for (int k = 0; k < 4; ++k) { posv[k] = pos_n[k]; gkv[k] = gk_n[k]; }
        if (m + NGW < M) {
#pragma unroll
            for (int k = 0; k < 4; ++k) { pos_n[k] = tok_pos[(size_t)(m + NGW) * 4 + k]; gk_n[k] = tok_g[(size_t)(m + NGW) * 4 + k]; } }
        f32x4 mo[4];
#pragma unroll
        for (int j = 0; j < 4; ++j) mo[j] = (f32x4){0.f, 0.f, 0.f, 0.f};
#pragma unroll
        for (int k = 0; k < 4; ++k) { const int pos = posv[k];
#if Y_FP8
            const float gk = gkv[k] * 0.125f;
            const GAS unsigned* yr = (const GAS unsigned*)((const unsigned char*)Y + (size_t)pos * D) + lane;
#pragma unroll
            for (int j = 0; j < 4; ++j) { const int w = (int)__builtin_nontemporal_load((const unsigned*)yr + 64 * j); typedef float f32x2 __attribute__((ext_vector_type(2)));
                const f32x2 lo = __builtin_amdgcn_cvt_pk_f32_fp8(w, false), hi = __builtin_amdgcn_cvt_pk_f32_fp8(w, true);
                mo[j].x += gk * lo.x; mo[j].y += gk * lo.y; mo[j].z += gk * hi.x; mo[j].w += gk * hi.y; }
#else
            const float gk = gkv[k];
            const GAS unsigned long long* yr = (const GAS unsigned long long*)(Y + (size_t)pos * D) + lane;
#pragma unroll
            for (int j = 0; j < 4; ++j) { const unsigned long long w = yr[64 * j]; const unsigned lo = (unsigned)w, hi = (unsigned)(w >> 32);
                mo[j].x += gk * __uint_as_float(lo << 16); mo[j].y += gk * __uint_as_float(lo & 0xffff0000u); mo[j].z += gk * __uint_as_float(hi << 16); mo[j].w += gk * __uint_as_float(hi & 0xffff0000u); }
#endif
        }
        const GAS unsigned long long* xr = (const GAS unsigned long long*)(x1 + (size_t)m * D) + lane;
        f32x4 v[4]; float ss = 0.f;
#pragma unroll
        for (int j = 0; j < 4; ++j) { const f32x4 gv = *(const f32x4*)(g2 + 256 * j + 4 * lane); const unsigned long long xw = __builtin_nontemporal_load((const unsigned long long*)xr + 64 * j);
            v[j] = (f32x4){bfw((unsigned)xw, 0), bfw((unsigned)xw, 1), bfw((unsigned)(xw >> 32), 0), bfw((unsigned)(xw >> 32), 1)} + gv * mo[j]; ss += (v[j].x * v[j].x + v[j].y * v[j].y) + (v[j].z * v[j].z + v[j].w * v[j].w); }
        const float rstd = rsqrtf(wave_sum(ss) * (1.0f / D) + EPS);
        GAS f32x4* orow = (GAS f32x4*)(out + (size_t)m * D) + lane;
#pragma unroll
        for (int j = 0; j < 4; ++j) { const f32x4 wv = *(const f32x4*)(fnw + 256 * j + 4 * lane); __builtin_nontemporal_store(v[j] * rstd * wv, (f32x4*)(out + (size_t)m * D) + lane + 64 * j); }
    }
}

#ifndef REP_MASK
#define REP_MASK 0
#endif
#define NREP(k) (((REP_MASK) >> (k)) & 1 ? 2 : 1)
#define REPB(k, rr) do { if ((rr) + 1 < NREP(k) && multi) { if ((k) >= 9) { LANE_TID(); xcd_barrier(bar, tid == 0); } else xcd_barrier(bar, tid == 0); } } while (0)
#ifndef SKEW_TICKS
#define SKEW_TICKS 0
#endif
#define PHASE_SKEW() do { if (SKEW_TICKS > 0) { const unsigned long long t0_ = __builtin_amdgcn_s_memrealtime(), w_ = (unsigned long long)(bid & 3) * SKEW_TICKS; while (__builtin_amdgcn_s_memrealtime() - t0_ < w_) __builtin_amdgcn_s_sleep(2); } } while (0)
#ifndef HG_CHUNKED
#define HG_CHUNKED 1
#endif
#ifndef SSD_CHUNKED
#define SSD_CHUNKED 1
#endif
constexpr int NPHASE = 12;
__global__ void __launch_bounds__(NTHR, 2) mk_fwd(Args args) {
    extern __shared__ __attribute__((aligned(16))) unsigned char lds_raw[];
    LAS unsigned char* lds = (LAS unsigned char*)lds_raw;
    const int tid = threadIdx.x, lane = tid & 63, wave = __builtin_amdgcn_readfirstlane(tid >> 6); __builtin_assume(wave >= 0 && wave < 8);
#define LANE_TID() int lane; asm volatile("v_mbcnt_lo_u32_b32 %0, -1, 0\n\tv_mbcnt_hi_u32_b32 %0, -1, %0" : "=v"(lane)); __builtin_assume(lane >= 0 && lane < 64); const int tid = wave * 64 + lane; (void)tid
    const int G = gridDim.x, bid = blockIdx.x;
    unsigned char* ws = args.ws;
    gu32* ctl = (gu32*)(ws + WS_CTL);
    volatile LAS unsigned* MISC = (volatile LAS unsigned*)(lds + MISC_OFF);
    if (tid < 64) MISC[tid] = 0u;
    __syncthreads();
    const int lo = args.ph_lo, hi = args.ph_hi;
    const bool multi = (hi - lo) > 1;
    XcdBarrier bar; bar.bar = (unsigned*)(ctl + CW_BAR); bar.x = 0; bar.st = nullptr;
    if (multi) bar = xcd_barrier_post((unsigned*)(ctl + CW_BAR), MISC + 8, tid == 0);
#define IN(k) (lo <= (k) && (k) < hi)
#ifdef PROBE_A
#ifndef PROBE_BUSY
#define PROBE_BUSY 0
#endif
#define STAMP(k) do { int tid_s; if ((k) >= 9) { LANE_TID(); tid_s = tid; } else tid_s = tid; if (tid_s == 0) { const unsigned long long t_ = __builtin_amdgcn_s_memrealtime(); MISC[16 + 2 * (k)] = (unsigned)t_; MISC[17 + 2 * (k)] = (unsigned)(t_ >> 32); } } while (0)
#define ARRIVE(k) do { int tid_s; if ((k) >= 9) { LANE_TID(); tid_s = tid; } else tid_s = tid; if (tid_s == 0 && (k) == PROBE_A) { const unsigned long long t_ = __builtin_amdgcn_s_memrealtime(); const unsigned long long s_ = ((unsigned long long)MISC[17 + 2 * (k)] << 32) | MISC[16 + 2 * (k)]; \
    const unsigned busy = (unsigned)(t_ - s_); atomicMax((unsigned*)ctl + 3000, busy); atomicAdd((unsigned*)ctl + 3064, busy); } } while (0)
#else
#define STAMP(k) do { } while (0)
#define ARRIVE(k) do { } while (0)
#endif
#define SEAM(k) do { ARRIVE(k); if (IN(k) && IN((k) + 1)) { if ((k) >= 8) { LANE_TID(); xcd_barrier(bar, tid == 0); } else xcd_barrier(bar, tid == 0); } STAMP((k) + 1); } while (0)

    STAMP(0);
    if (IN(0)) { for (int rr_ = 0; rr_ < NREP(0); ++rr_) { p0_prologue(args, lds, bid, G, tid, wave, lane);  REPB(0, rr_); } } SEAM(0);
    if (IN(1)) { for (int rr_ = 0; rr_ < NREP(1); ++rr_) { p1_norm(args, lds, bid, G, tid, wave, lane);  REPB(1, rr_); } } SEAM(1);
    if (IN(2)) { for (int rr_ = 0; rr_ < NREP(2); ++rr_) {
        pg8::Gemm g{(const pg8::bf16_t*)(ws + WS_H), (const pg8::bf16_t*)(ws + WS_WIN), M, NPROJ, D}; pg8::StaticOrder S; S.init(M, NPROJ, G, bid);
        pg8::EpiIn E{(pg8::bf16_t*)(ws + WS_P), (float*)(ws + WS_LF), args.in[I_LBL]};
#ifdef PROBE_G
        if (threadIdx.x == 0) MISC[61] = (PROBE_G == 2) ? 1u : 0u; __syncthreads();
#endif
        pg8::gemm_phase<pg8::EpiIn, pg8::StaticOrder, true, true>(lds, g, S, E, wave);
        __syncthreads(); p0_bg_items(args, lds, bid, G, tid, wave, lane);
     REPB(2, rr_); } } SEAM(2);
    if (IN(3)) { for (int rr_ = 0; rr_ < NREP(3); ++rr_) {
        for (int u = bid; u < 256; u += G) {
            __syncthreads();
#if HG_CHUNKED
            hg_passA(args, lds, u, tid, wave, lane);
            STAMP(14);
#endif
            __syncthreads();
#if SSD_CHUNKED
            ssd_passA(args, lds, u, tid, wave, lane);
#endif
        }
     REPB(3, rr_); } } SEAM(3);
    if (IN(4)) { for (int rr_ = 0; rr_ < NREP(4); ++rr_) { mix_scan(args, bid, G, tid);  REPB(4, rr_); } } SEAM(4);
    if (IN(5)) { for (int rr_ = 0; rr_ < NREP(5); ++rr_) {
        for (int u = bid; u < 256; u += G) {
            __syncthreads();
#if HG_CHUNKED
            hg_passC(args, lds, u, tid, wave, lane);
            STAMP(13);
#else
            if (u < 8) hgrn_naive(args, lds, u, tid, wave, lane);
#endif
            __syncthreads();
#if SSD_CHUNKED
            ssd_passC(args, lds, u, tid, wave, lane);
#else
            if (u >= 8 && u < 12) ssd_naive(args, lds, u - 8, tid, wave, lane);
#endif
        }
     REPB(5, rr_); } } SEAM(5);
    if (IN(6)) { for (int rr_ = 0; rr_ < NREP(6); ++rr_) {
        pg8::Gemm g{(const pg8::bf16_t*)(ws + WS_MIX), (const pg8::bf16_t*)(ws + WS_WOUT), M, D, D}; pg8::StaticOrder S; S.init(M, D, G, bid);
        pg8::EpiOut E{args.in[I_X], (pg8::bf16_t*)(ws + WS_X1), (const float*)(ws + WS_MODF) + 2 * 1024};
#ifdef PROBE_G
        if (threadIdx.x == 0) MISC[61] = (PROBE_G == 6) ? 1u : 0u; __syncthreads();
#endif
        pg8::gemm_phase<pg8::EpiOut, pg8::StaticOrder, true, true>(lds, g, S, E, wave);
     REPB(6, rr_); } } SEAM(6);
    if (IN(7)) { for (int rr_ = 0; rr_ < NREP(7); ++rr_) { p5_router(args, lds, bid, G, tid, wave, lane);  REPB(7, rr_); } } SEAM(7);
    if (IN(8)) { for (int rr_ = 0; rr_ < NREP(8); ++rr_) { p6_gather(args, lds, bid, G, tid, wave, lane);  REPB(8, rr_); } } SEAM(8);
    if (IN(9) || IN(10)) {
        if (!IN(8)) { LANE_TID(); moe_tables(args, lds, NCHUNK, tid, wave, lane); }
        const PG8_LAS int* TS = (const PG8_LAS int*)(lds + MISC_OFF + 256);
        const int R = __builtin_amdgcn_readfirstlane(TS[32]);
        int kmoe1 = MOE_FP8_G1 ? D / 2 : D, kmoe2 = MOE_FP8_G2 ? D / 2 : D; asm volatile("" : "+s"(kmoe1), "+s"(kmoe2));
        if (IN(9)) { for (int rr_ = 0; rr_ < NREP(9); ++rr_) { LANE_TID();
            pg8::Gemm g{(const pg8::bf16_t*)(ws + WS_XG), (const pg8::bf16_t*)(ws + WS_W1), R * 256, 2048, kmoe1};
            PHASE_SKEW();
            pg8::MoeOrder S{TS + 64, 8, R * 8, G, bid};
            pg8::EpiW1<MOE_FP8_G1 != 0, MOE_FP8_G2 != 0> E{(void*)(ws + WS_ACT), args.in[I_B1]};
#ifdef PROBE_G
        if (threadIdx.x == 0) MISC[61] = (PROBE_G == 9) ? 1u : 0u; __syncthreads();
#endif
            pg8::gemm_phase<pg8::EpiW1<MOE_FP8_G1 != 0, MOE_FP8_G2 != 0>, pg8::MoeOrder, true, true, MOE_FP8_G1 != 0>(lds, g, S, E, wave);
         REPB(9, rr_); } }
        SEAM(9);
        if (IN(10)) { for (int rr_ = 0; rr_ < NREP(10); ++rr_) { LANE_TID();
            pg8::Gemm g{(const pg8::bf16_t*)(ws + WS_ACT), (const pg8::bf16_t*)(ws + WS_W2), R * 256, 1024, kmoe2};
            PHASE_SKEW();
            pg8::MoeOrder S{TS + 64, 4, R * 4, G, bid};
            pg8::EpiW2<Y_FP8 != 0> E{(void*)(ws + WS_XG), args.in[I_B2], MOE_FP8_G2 ? (1.0f / 512.0f) : 1.0f};
#ifdef PROBE_G
        if (threadIdx.x == 0) MISC[61] = (PROBE_G == 10) ? 1u : 0u; __syncthreads();
#endif
            pg8::gemm_phase<pg8::EpiW2<Y_FP8 != 0>, pg8::MoeOrder, true, true, MOE_FP8_G2 != 0>(lds, g, S, E, wave);
         REPB(10, rr_); } }
    }
    SEAM(10);
    if (IN(11)) { for (int rr_ = 0; rr_ < NREP(11); ++rr_) { LANE_TID(); p9_final(args, bid, G, wave, lane);  REPB(11, rr_); } }
#ifdef PROBE_A
    STAMP(12);
    int lpr_; asm volatile("v_mbcnt_lo_u32_b32 %0, -1, 0\n\tv_mbcnt_hi_u32_b32 %0, -1, %0" : "=v"(lpr_)); if (bid == 0 && wave == 0 && lpr_ == 0) {
        const unsigned long long mx = __hip_atomic_load((unsigned*)ctl + 3000, __ATOMIC_RELAXED, __HIP_MEMORY_SCOPE_AGENT);
        const unsigned long long sp = ((((unsigned long long)MISC[17 + 2 * (PROBE_A + 1)] << 32) | MISC[16 + 2 * (PROBE_A + 1)]) - (((unsigned long long)MISC[17 + 2 * PROBE_A] << 32) | MISC[16 + 2 * PROBE_A]));
#ifndef PROBE_B
#define PROBE_B (PROBE_A + 1)
#endif
        const unsigned long long sp2 = ((((unsigned long long)MISC[17 + 2 * (PROBE_B)] << 32) | MISC[16 + 2 * (PROBE_B)]) - (((unsigned long long)MISC[17 + 2 * PROBE_A] << 32) | MISC[16 + 2 * PROBE_A]));
#ifdef PROBE_G
        const unsigned long long wait = 64ull * (unsigned long long)MISC[60], t0 = __builtin_amdgcn_s_memrealtime();
#else
        (void)sp; const unsigned long long wait = 64ull * (PROBE_BUSY ? mx : sp2), t0 = __builtin_amdgcn_s_memrealtime();
#endif
        while (__builtin_amdgcn_s_memrealtime() - t0 < wait) __builtin_amdgcn_s_sleep(4);
    }
#endif
#undef IN
#undef SEAM
}

#ifndef MK_N_LAUNCHES
#define MK_N_LAUNCHES 1
#endif
extern "C" void kernel_launch(void* const* d_in, const int* in_sizes, int n_in, void* d_out, int out_size, void* d_ws, size_t ws_size, hipStream_t stream) {
    static int grid = 0;
    if (grid == 0) {
        if (n_in != 23 || out_size != M * D || ws_size < WS_END) { fprintf(stderr, "kernel_launch: unexpected shapes (n_in %d out %d ws %zu)\n", n_in, out_size, ws_size); grid = -1; return; }
        int dev = 0, cus = 0;
        if (hipGetDevice(&dev) != hipSuccess || hipDeviceGetAttribute(&cus, hipDeviceAttributeMultiprocessorCount, dev) != hipSuccess) { grid = -1; return; }
        if (hipFuncSetAttribute((const void*)mk_fwd, hipFuncAttributeMaxDynamicSharedMemorySize, LDS_BYTES) != hipSuccess) { fprintf(stderr, "kernel_launch: hipFuncSetAttribute failed\n"); grid = -1; return; }
        int per_cu = 0;
        if (hipOccupancyMaxActiveBlocksPerMultiprocessor(&per_cu, (const void*)mk_fwd, NTHR, LDS_BYTES) != hipSuccess || per_cu < 1) fprintf(stderr, "kernel_launch: occupancy query says %d\n", per_cu);
        (void)hipGetLastError();
        grid = cus;
    }
    if (grid < 0) return;
    (void)hipMemsetAsync((char*)d_ws + WS_CTL, 0, CTL_ZERO_BYTES, stream);
    Args a{};
    for (int i = 0; i < 23; ++i) a.in[i] = (const float*)d_in[i];
    a.out = (float*)d_out; a.ws = (unsigned char*)d_ws;
    if (MK_N_LAUNCHES == 1) { a.ph_lo = 0; a.ph_hi = NPHASE; hipLaunchKernelGGL(mk_fwd, dim3(grid), dim3(NTHR), LDS_BYTES, stream, a); }
    else for (int p = 0; p < NPHASE; ++p) { a.ph_lo = p; a.ph_hi = p + 1; hipLaunchKernelGGL(mk_fwd, dim3(grid), dim3(NTHR), LDS_BYTES, stream, a); }
}
```

```cpp
#include <hip/hip_runtime.h>
#include <cstdio>
#include <cstdint>
namespace pg8 {
#define PG8_LAS __attribute__((address_space(3)))
typedef unsigned short bf16_t;
typedef short bf16x8 __attribute__((ext_vector_type(8)));
typedef float f32x4 __attribute__((ext_vector_type(4)));
typedef unsigned u32x4 __attribute__((ext_vector_type(4)));
constexpr int BM = 256, BK = 64, HALF = 128, HTB = HALF * BK * 2  , STAGE_BYTES = 8 * HTB, NXCD = 8, WGM = 8;

__host__ __device__ __forceinline__ int lds_byte(int r, int c) { const int st = (r >> 4) * 2 + (c >> 5), rr = r & 15, cc = c & 31, ob = rr * 64 + cc * 2; return st * 1024 + (ob ^ (((ob >> 9) & 1) << 5)); }
__host__ __device__ __forceinline__ void stage_rc(int b, int& R, int& C) { const int st = b / 1024, sb = b % 1024, swz = sb ^ (((sb >> 9) & 1) << 5); R = (st >> 1) * 16 + swz / 64; C = (st & 1) * 32 + (swz % 64) / 2; }
__host__ __device__ __forceinline__ int perm32(int rho) { const int n = rho >> 4, i = rho & 15; return 8 * (i >> 2) + 4 * n + (i & 3); }

struct Unit { int pm, pn; };
struct Gemm { const bf16_t* A; const bf16_t* Bt; int M, N, K; };

struct StaticOrder {
    int nM, nN, nwg, G, c;
    __host__ __device__ void init(int M, int N, int G_, int c_) { nM = M / BM; nN = N / BM; nwg = nM * nN; G = G_; c = c_; }
    __host__ __device__ bool next(int i, Unit& u) const {
        const int L = i * G + c; if (L >= nwg) return false;
        int wgid = L; { const int q = nwg / NXCD, r = nwg % NXCD, xcd = wgid % NXCD, off = wgid / NXCD; wgid = (xcd < r ? xcd * (q + 1) : r * (q + 1) + (xcd - r) * q) + off; }
        const int nig = WGM * nN, gid = wgid / nig, fm = gid * WGM, gsz = (nM - fm) < WGM ? (nM - fm) : WGM;
        u.pm = fm + ((wgid % nig) % gsz); u.pn = (wgid % nig) / gsz; return true;
    }
    __device__ __forceinline__ void a_ready(const Unit&) const {}
    __device__ __forceinline__ void done(const Unit&) const {}
};

__device__ __forceinline__ unsigned cvt_pk_bf16(float lo, float hi) { unsigned r; asm volatile("v_cvt_pk_bf16_f32 %0, %1, %2" : "=v"(r) : "v"(lo), "v"(hi)); return r; }
typedef float f32x2 __attribute__((ext_vector_type(2)));
typedef int v8i32 __attribute__((ext_vector_type(8)));
__device__ __forceinline__ v8i32 cat8(bf16x8 lo, bf16x8 hi) { typedef short s16x16 __attribute__((ext_vector_type(16))); return __builtin_bit_cast(v8i32, __builtin_shufflevector(lo, hi, 0, 1, 2, 3, 4, 5, 6, 7, 8, 9, 10, 11, 12, 13, 14, 15)); }
template <class Epi, class Sched, bool ALIGN_EPI = false, bool SP2 = false, bool F8 = false>
__device__ __forceinline__ void gemm_phase(PG8_LAS unsigned char* lds, const Gemm g, const Sched& S, const Epi& E, int wid) {
    int lane; asm volatile("v_mbcnt_lo_u32_b32 %0, -1, 0\n\tv_mbcnt_hi_u32_b32 %0, -1, %0" : "=v"(lane)); __builtin_assume(lane >= 0 && lane < 64); __builtin_assume(wid >= 0 && wid < 8);
    const int tid = wid * 64 + lane, wr = wid >> 2, wc = wid & 3, fr = lane & 15, fq = lane >> 4;
    const int K = g.K, nt = K / BK;
    unsigned voffA[2], voffB[2];
#pragma unroll
    for (int i = 0; i < 2; ++i) { int R, C; stage_rc(tid * 16 + i * 8192, R, C); const int Rb = Epi::PERM ? ((R & ~31) + perm32(R & 31)) : R;
        voffA[i] = (unsigned)(R * K + C) * 2u; voffB[i] = (unsigned)(Rb * K + C) * 2u; }
    const unsigned kstep = (unsigned)(BK * 2);
    const unsigned hstep = (unsigned)HALF * (unsigned)K * 2u;
    const unsigned tstep = 2u * hstep;
    const unsigned ldsw = (unsigned)wid * 1024u;
    const int aoff = lds_byte(wr * 64 + fr, fq * 8), boff = lds_byte(wc * 32 + fr, fq * 8);
#define PG8_SA(b, h) (((b) * 2 + (h)) * HTB)
#define PG8_SB(b, h) ((4 + (b) * 2 + (h)) * HTB)
#define PG8_STAGE(bufoff, gbase, voff) do { _Pragma("unroll") for (int _i = 0; _i < 2; ++_i) \
        __builtin_amdgcn_global_load_lds((const unsigned*)((const char*)(gbase) + (voff)[_i]), (PG8_LAS unsigned*)(lds + (bufoff) + ldsw + _i * 8192), 16, 0, 0); } while (0)
#define PG8_LDA(dst, b, h) do { _Pragma("unroll") for (int m = 0; m < 4; ++m) _Pragma("unroll") for (int k = 0; k < 2; ++k) dst[m][k] = *(const PG8_LAS bf16x8*)(lds + PG8_SA(b, h) + aoff + m * 2048 + k * 1024); } while (0)
#define PG8_LDB(dst, b, h) do { _Pragma("unroll") for (int n = 0; n < 2; ++n) _Pragma("unroll") for (int k = 0; k < 2; ++k) dst[n][k] = *(const PG8_LAS bf16x8*)(lds + PG8_SB(b, h) + boff + n * 2048 + k * 1024); } while (0)
#define PG8_MMA(ai, bj, At, Bt) do { __builtin_amdgcn_s_setprio(1); _Pragma("unroll") for (int m = 0; m < 4; ++m) _Pragma("unroll") for (int n = 0; n < 2; ++n) { \
        if constexpr (F8) acc[ai][bj][m][n] = __builtin_amdgcn_mfma_scale_f32_16x16x128_f8f6f4(cat8(Bt[n][0], Bt[n][1]), cat8(At[m][0], At[m][1]), acc[ai][bj][m][n], 0, 0, 0, 0, 0, 0); \
        else { _Pragma("unroll") for (int k = 0; k < 2; ++k) acc[ai][bj][m][n] = __builtin_amdgcn_mfma_f32_16x16x32_bf16(Bt[n][k], At[m][k], acc[ai][bj][m][n], 0, 0, 0); } } __builtin_amdgcn_s_setprio(0); } while (0)
#define PG8_WAIT_V(n) asm volatile("s_waitcnt vmcnt(" #n ")" ::: "memory")
#define PG8_WAIT_L(n) asm volatile("s_waitcnt lgkmcnt(" #n ")" ::: "memory")
#define PG8_BAR __builtin_amdgcn_s_barrier()
#define PG8_SCHED __builtin_amdgcn_sched_barrier(0)
    Unit cur, nxt; int ui = 0;
    if (!S.next(0, cur)) return;
    f32x4 acc[2][2][4][2];
#pragma unroll
    for (int a = 0; a < 2; ++a)
#pragma unroll
        for (int b = 0; b < 2; ++b)
#pragma unroll
            for (int m = 0; m < 4; ++m)
#pragma unroll
                for (int n = 0; n < 2; ++n) acc[a][b][m][n] = (f32x4){0.f, 0.f, 0.f, 0.f};
    bf16x8 At[4][2], B0[2][2], B1[2][2];
    const char* cA = (const char*)g.A + (size_t)((unsigned)cur.pm * tstep); const char* cB = (const char*)g.Bt + (size_t)((unsigned)cur.pn * tstep);
    S.a_ready(cur);
    if constexpr (SP2) {
        PG8_STAGE(PG8_SB(0, 0), cB, voffB); PG8_STAGE(PG8_SB(0, 1), cB + hstep, voffB); PG8_STAGE(PG8_SA(0, 0), cA, voffA); PG8_STAGE(PG8_SA(0, 1), cA + hstep, voffA);
        if (wr == 1) PG8_BAR;
        PG8_WAIT_V(2); PG8_BAR;
        PG8_STAGE(PG8_SB(1, 0), cB + kstep, voffB); PG8_STAGE(PG8_SA(1, 0), cA + kstep, voffA); PG8_STAGE(PG8_SB(1, 1), cB + hstep + kstep, voffB);
        PG8_WAIT_V(6); PG8_BAR;
    } else {
        PG8_STAGE(PG8_SB(0, 0), cB, voffB); PG8_STAGE(PG8_SA(0, 0), cA, voffA); PG8_STAGE(PG8_SB(0, 1), cB + hstep, voffB); PG8_STAGE(PG8_SA(0, 1), cA + hstep, voffA);
        if (wr == 1) PG8_BAR;
        PG8_WAIT_V(4); PG8_BAR;
        PG8_STAGE(PG8_SB(1, 0), cB + kstep, voffB); PG8_STAGE(PG8_SA(1, 0), cA + kstep, voffA); PG8_STAGE(PG8_SB(1, 1), cB + hstep + kstep, voffB);
        PG8_WAIT_V(6); PG8_BAR;
    }
    for (;;) {
        const bool has_next = S.next(ui + 1, nxt);
        const char* nA = has_next ? (const char*)g.A + (size_t)((unsigned)nxt.pm * tstep) : cA; const char* nB = has_next ? (const char*)g.Bt + (size_t)((unsigned)nxt.pn * tstep) : cB;
        _Pragma("unroll 1") for (int t = 0; t < nt; t += 2) {
            const bool last = (t == nt - 2);
            const char* a1 = cA + (size_t)((unsigned)(t + 1) * kstep);
            const char* a2 = last ? nA : cA + (size_t)((unsigned)(t + 2) * kstep); const char* b2 = last ? nB : cB + (size_t)((unsigned)(t + 2) * kstep);
            const char* a3 = a2 + kstep; const char* b3 = b2 + kstep;
            const char* a1h = a1 + hstep; const char* a2h = a2 + hstep; const char* b2h = b2 + hstep; const char* b3h = b3 + hstep;
            asm volatile("" : "+s"(a1h), "+s"(a2), "+s"(a2h), "+s"(b2), "+s"(b2h), "+s"(a3), "+s"(b3), "+s"(b3h));
            if (last && has_next) S.a_ready(nxt);
            if constexpr (SP2) {
            PG8_LDB(B0, 0, 0); PG8_LDB(B1, 0, 1); PG8_SCHED; PG8_LDA(At, 0, 0); PG8_STAGE(PG8_SA(1, 1), a1h, voffA);
            PG8_WAIT_V(8); PG8_WAIT_L(0); PG8_BAR; PG8_MMA(0, 0, At, B0); PG8_MMA(0, 1, At, B1); PG8_BAR; PG8_SCHED;
            PG8_LDA(At, 0, 1); PG8_STAGE(PG8_SB(0, 0), b2, voffB); PG8_STAGE(PG8_SB(0, 1), b2h, voffB); PG8_STAGE(PG8_SA(0, 0), a2, voffA);
            PG8_WAIT_V(8); PG8_WAIT_L(0); PG8_BAR; PG8_MMA(1, 0, At, B0); PG8_MMA(1, 1, At, B1); PG8_BAR; PG8_SCHED;
            PG8_LDB(B0, 1, 0); PG8_LDB(B1, 1, 1); PG8_SCHED; PG8_LDA(At, 1, 0); PG8_STAGE(PG8_SA(0, 1), a2h, voffA);
            PG8_WAIT_V(8); PG8_WAIT_L(0); PG8_BAR; PG8_MMA(0, 0, At, B0); PG8_MMA(0, 1, At, B1); PG8_BAR; PG8_SCHED;
            PG8_LDA(At, 1, 1); PG8_STAGE(PG8_SB(1, 0), b3, voffB); PG8_STAGE(PG8_SB(1, 1), b3h, voffB); PG8_STAGE(PG8_SA(1, 0), a3, voffA);
            PG8_WAIT_V(8); PG8_WAIT_L(0); PG8_BAR; PG8_MMA(1, 0, At, B0); PG8_MMA(1, 1, At, B1); PG8_BAR; PG8_SCHED;
            } else {
            PG8_LDB(B0, 0, 0); PG8_SCHED; PG8_LDA(At, 0, 0); PG8_STAGE(PG8_SA(1, 1), a1h, voffA);
            PG8_WAIT_L(8); PG8_BAR; PG8_WAIT_L(0); PG8_MMA(0, 0, At, B0); PG8_BAR; PG8_SCHED;
            PG8_LDB(B1, 0, 1); PG8_STAGE(PG8_SB(0, 0), b2, voffB);
            PG8_BAR; PG8_WAIT_L(0); PG8_MMA(0, 1, At, B1); PG8_BAR;
            PG8_LDA(At, 0, 1); PG8_STAGE(PG8_SA(0, 0), a2, voffA);
            PG8_BAR; PG8_WAIT_L(0); PG8_MMA(1, 0, At, B0); PG8_BAR; PG8_SCHED;
            PG8_STAGE(PG8_SB(0, 1), b2h, voffB);
            PG8_WAIT_V(6); PG8_BAR; PG8_MMA(1, 1, At, B1); PG8_BAR;
            PG8_LDB(B0, 1, 0); PG8_SCHED; PG8_LDA(At, 1, 0); PG8_STAGE(PG8_SA(0, 1), a2h, voffA);
            PG8_WAIT_L(8); PG8_BAR; PG8_WAIT_L(0); PG8_MMA(0, 0, At, B0); PG8_BAR; PG8_SCHED;
            PG8_LDB(B1, 1, 1); PG8_STAGE(PG8_SB(1, 0), b3, voffB);
            PG8_BAR; PG8_WAIT_L(0); PG8_MMA(0, 1, At, B1); PG8_BAR;
            PG8_LDA(At, 1, 1); PG8_STAGE(PG8_SA(1, 0), a3, voffA);
            PG8_BAR; PG8_WAIT_L(0); PG8_MMA(1, 0, At, B0); PG8_BAR; PG8_SCHED;
            PG8_STAGE(PG8_SB(1, 1), b3h, voffB);
            PG8_WAIT_V(6); PG8_BAR; PG8_MMA(1, 1, At, B1); PG8_BAR;
            }
        }
#ifdef PROBE_G
        unsigned long long tk_ = 0; if (wid == 0) tk_ = __builtin_amdgcn_s_memrealtime();
#endif
        if constexpr (ALIGN_EPI) { if (wr == 0) PG8_BAR; }
        if constexpr (!Epi::AFTER_DRAIN) { int l2_; asm volatile("v_mbcnt_lo_u32_b32 %0, -1, 0\n\tv_mbcnt_hi_u32_b32 %0, -1, %0" : "=v"(l2_)); const int fr_o = l2_ & 15, fq_o = l2_ >> 4;
            Unit cu_ = cur; asm volatile("" : "+s"(cu_.pm), "+s"(cu_.pn));
            E(acc, cu_, wr, wc, fr_o, fq_o); S.done(cur); }
#ifdef PROBE_G
        if (wid == 0 && lane == 0 && *(volatile PG8_LAS unsigned*)(lds + 147456 + 4 * 61) != 0u) *(volatile PG8_LAS unsigned*)(lds + 147456 + 4 * 60) += (unsigned)(__builtin_amdgcn_s_memrealtime() - tk_);
#endif
        if (!has_next) break;
#pragma unroll
        for (int a = 0; a < 2; ++a)
#pragma unroll
            for (int b = 0; b < 2; ++b)
#pragma unroll
                for (int m = 0; m < 4; ++m)
#pragma unroll
                    for (int n = 0; n < 2; ++n) acc[a][b][m][n] = (f32x4){0.f, 0.f, 0.f, 0.f};
        cur = nxt; cA = nA; cB = nB; ++ui;
        if constexpr (ALIGN_EPI) { if (wr == 1) PG8_BAR; }
    }
    PG8_WAIT_V(0);
    if constexpr (!ALIGN_EPI) { if (wr == 0) PG8_BAR; }
    PG8_BAR;
    if constexpr (Epi::AFTER_DRAIN) { E.fused(acc, cur, wr, wc, fr, fq, lds, wid, lane); S.done(cur); }
#undef PG8_SA
#undef PG8_SB
#undef PG8_STAGE
#undef PG8_LDA
#undef PG8_LDB
#undef PG8_MMA
#undef PG8_WAIT_V
#undef PG8_WAIT_L
#undef PG8_BAR
#undef PG8_SCHED
}
}
#define GAS __attribute__((address_space(1)))
#define LAS __attribute__((address_space(3)))
typedef unsigned short bf16;
typedef unsigned v4u __attribute__((ext_vector_type(4)));
typedef float f32x4 __attribute__((ext_vector_type(4)));
typedef short bf16x8 __attribute__((ext_vector_type(8)));
typedef GAS unsigned gu32;
typedef GAS unsigned long long gu64;
#define RLX_AGENT __ATOMIC_RELAXED, __HIP_MEMORY_SCOPE_AGENT
#define LDS_WAIT() asm volatile("s_waitcnt lgkmcnt(0)" ::: "memory")
#define VM_WAIT() asm volatile("s_waitcnt vmcnt(0)" ::: "memory")
__device__ __forceinline__ unsigned long long rt() { return __builtin_amdgcn_s_memrealtime(); }
__device__ __forceinline__ unsigned f2bf(float f) { unsigned u = __builtin_bit_cast(unsigned, f); return (u + 0x7fffu + ((u >> 16) & 1u)) >> 16; }
__device__ __forceinline__ unsigned pk2(float lo, float hi) { return f2bf(lo) | (f2bf(hi) << 16); }
#define XB_TMO      128
#define XB_XCNT(j)  (256  + 64 * (j))
#define XB_XSUB(j)  (1280 + 64 * (j))
#define XB_XGEN(j)  (2304 + 64 * (j))
#define XB_TOP      3328
#define XB_TOPGEN   3392
#define XCD_BAR_WORDS 3456
#define XB_SPIN_CAP (1u << 18)

__device__ __forceinline__ unsigned xb_ld(unsigned* p)              { return __hip_atomic_load(p, __ATOMIC_RELAXED, __HIP_MEMORY_SCOPE_AGENT); }
__device__ __forceinline__ unsigned xb_add(unsigned* p, unsigned v) { return __hip_atomic_fetch_add(p, v, __ATOMIC_RELAXED, __HIP_MEMORY_SCOPE_AGENT); }
__device__ __forceinline__ unsigned xb_xcc_id() { return (unsigned)__builtin_amdgcn_s_getreg((3 << 11) | 20) & 0xFu; }
#define XB_SPIN(cond, bar) do { unsigned _sp = 0; while (cond) { __builtin_amdgcn_s_sleep(1); \
    if ((++_sp & 255u) == 0u) { if (xb_ld(&(bar)[XB_TMO])) break; if (_sp > XB_SPIN_CAP) { atomicAdd(&(bar)[XB_TMO], 1u); break; } } } } while (0)

struct XcdBarrier {
    unsigned* bar; unsigned x;
    volatile LAS unsigned* st;
};

__device__ __forceinline__ XcdBarrier xcd_barrier_post(unsigned* bar, volatile LAS unsigned* st, bool t0) {
    XcdBarrier b; b.bar = bar; b.x = xb_xcc_id(); b.st = st;
    if (t0) (void)xb_add(&bar[XB_XCNT(b.x)], 1u);
    return b;
}
__device__ __forceinline__ void xcd_barrier_complete(unsigned* bar, unsigned x, unsigned& nloc, unsigned& nx) {
    const unsigned G = gridDim.x * gridDim.y * gridDim.z;
    unsigned sum, cnt, mine, sp = 0u;
    for (;;) {
        sum = 0u; cnt = 0u; mine = 0u;
#pragma unroll
        for (unsigned j = 0; j < 16; ++j) { const unsigned c = xb_ld(&bar[XB_XCNT(j)]); sum += c; cnt += (c > 0u) ? 1u : 0u; mine = (j == x) ? c : mine; }
        if (sum == G) break;
        __builtin_amdgcn_s_sleep(1);
        if ((++sp & 255u) == 0u) { if (xb_ld(&bar[XB_TMO])) break; if (sp > XB_SPIN_CAP) { atomicAdd(&bar[XB_TMO], 1u); break; } }
    }
    nloc = mine > 0u ? mine : 1u; nx = cnt > 0u ? cnt : 1u;
}

__device__ __forceinline__ void xcd_barrier(const XcdBarrier& b, bool t0) {
    asm volatile("s_waitcnt vmcnt(0)" ::: "memory");
    __syncthreads();
    if (t0) {
        unsigned* bar = b.bar;
        __builtin_amdgcn_s_waitcnt(0);
        unsigned nloc = b.st[0], nx = b.st[1];
        if (nloc == 0u) { xcd_barrier_complete(bar, b.x, nloc, nx); b.st[0] = nloc; b.st[1] = nx; }
        const unsigned old = xb_add(&bar[XB_XSUB(b.x)], 1u);
        const unsigned gen = old / nloc;
        if (old + 1u == (gen + 1u) * nloc) {
            __builtin_amdgcn_fence(__ATOMIC_RELEASE, "agent");
            asm volatile("s_waitcnt vmcnt(0)" ::: "memory");
            const unsigned og = xb_add(&bar[XB_TOP], 1u);
            const unsigned tg = og / nx;
            if (og + 1u == (tg + 1u) * nx) xb_add(&bar[XB_TOPGEN], 1u);
            else XB_SPIN(xb_ld(&bar[XB_TOPGEN]) == tg, bar);
            __builtin_amdgcn_fence(__ATOMIC_ACQUIRE, "agent");
            xb_add(&bar[XB_XGEN(b.x)], 1u);
            asm volatile("s_waitcnt vmcnt(0)" ::: "memory");
        } else {
            XB_SPIN(xb_ld(&bar[XB_XGEN(b.x)]) == gen, bar);
            __builtin_amdgcn_fence(__ATOMIC_ACQUIRE, "agent");
            asm volatile("s_waitcnt vmcnt(0)" ::: "memory");
        }
    }
    __syncthreads();
}
#ifndef Y_FP8
#define Y_FP8 1
#endif
#ifndef MOE_FP8_G1
#define MOE_FP8_G1 1
#endif
#ifndef MOE_FP8_G2
#define MOE_FP8_G2 1
#endif

constexpr int NB = 2, SEQ = 8192, D = 1024, M = NB * SEQ;
constexpr int NPROJ = 3584, IN_COLS = 3592;
constexpr int NE = 32, TOPK = 4, DFF = 1024;
constexpr int NROWS_MAX = M * TOPK + NE * 256;
constexpr int MAXRT = NROWS_MAX / 256;
constexpr float EPS = 1e-6f;
constexpr int PC_Q = 0, PC_K = 512, PC_V = 1024, PC_G = 1536, PC_Z = 2048, PC_X = 2560;
constexpr int NCHUNK = M / 64;
constexpr int NWAVES = 8, NTHR = 512;

constexpr size_t MiB = 1u << 20;
constexpr size_t WS_CTL = 0, CTL_ZERO_BYTES = 32768;
constexpr size_t WS_MODP = 1 * MiB;
constexpr size_t WS_MODF = WS_MODP + 512 * 1024;
constexpr size_t WS_BLKCNT = WS_MODF + 256 * 1024;
constexpr size_t WS_DT = 2 * MiB;
constexpr size_t WS_TOK = 3 * MiB;
constexpr size_t WS_WIN = 4 * MiB, WS_WOUT = 11 * MiB, WS_W1 = 16 * MiB, WS_W2 = 144 * MiB;
constexpr size_t WS_H = 208 * MiB, WS_P = 240 * MiB, WS_LF = 352 * MiB, WS_MIX = 384 * MiB, WS_X1 = 416 * MiB;
constexpr size_t WS_XG = 480 * MiB, WS_ACT = 624 * MiB, WS_END = 768 * MiB;
constexpr int CW_TMO = 0, CW_BAR = 4096;

constexpr int RING_BYTES = 131072, AUX_OFF = RING_BYTES  , MISC_OFF = 147456, LDS_BYTES = 151552;

struct Args { const float* in[23]; float* out; unsigned char* ws; int ph_lo, ph_hi; };
enum { I_X = 0, I_C, I_ADAW, I_ADAB, I_N1W, I_WIN, I_LBL, I_HGNW, I_ALOG, I_DTB, I_SSMD, I_CONVW, I_CONVB, I_SSMNW, I_WOUT, I_N2W, I_RW, I_RB, I_W1, I_B1, I_W2, I_B2, I_FNW };

__device__ __forceinline__ float bf2f(bf16 v) { return __uint_as_float(((unsigned)v) << 16); }
__device__ __forceinline__ float wave_sum(float v) {
#pragma unroll
    for (int o = 1; o < 64; o <<= 1) v += __shfl_xor(v, o);
    return v;
}
__device__ __forceinline__ float wave_max(float v) {
#pragma unroll
    for (int o = 1; o < 64; o <<= 1) v = fmaxf(v, __shfl_xor(v, o));
    return v;
}
__device__ __forceinline__ float sigmoid_f(float x) { return __builtin_amdgcn_rcpf(1.0f + __expf(-x)); }
__device__ __forceinline__ float silu_f(float x) { return x * sigmoid_f(x); }

namespace pg8 {
struct EpiIn {
    static constexpr bool PERM = true, AFTER_DRAIN = false;
    bf16_t* P; float* LF; const float* lbl;
    __device__ __forceinline__ void operator()(const f32x4 (&acc)[2][2][4][2], const Unit& u, int wr, int wc, int fr, int fq) const {
        const int row0 = u.pm * BM + wr * 64 + fr, col0 = u.pn * BM + wc * 32 + 8 * fq;
        const int mode = (u.pn < 2) ? 1 : (u.pn < 4) ? 2 : (u.pn < 6) ? 0 : (u.pn < 10) ? 1 : 0;
        if (mode == 2) {
            float oml[2][8];
#pragma unroll
            for (int bj = 0; bj < 2; ++bj)
#pragma unroll
                for (int j = 0; j < 8; ++j) { const int cf = col0 + bj * HALF + j - 512; const float l0 = lbl[cf], l1 = lbl[512 + cf]; oml[bj][j] = 1.0f - 1.0f / (1.0f + __expf(l1 - l0)); }
#pragma unroll
            for (int ai = 0; ai < 2; ++ai)
#pragma unroll
                for (int m = 0; m < 4; ++m) { const size_t r = (size_t)(row0 + ai * HALF + m * 16);
#pragma unroll
                    for (int bj = 0; bj < 2; ++bj) { float kv[8], lf[8];
#pragma unroll
                        for (int j = 0; j < 8; ++j) { const float f = acc[ai][bj][m][j >> 2][j & 3]; const float k = oml[bj][j] * sigmoid_f(-f); kv[j] = k; lf[j] = __logf(1.0f - k); }
                        u32x4 w; w.x = cvt_pk_bf16(kv[0], kv[1]); w.y = cvt_pk_bf16(kv[2], kv[3]); w.z = cvt_pk_bf16(kv[4], kv[5]); w.w = cvt_pk_bf16(kv[6], kv[7]);
                        *(u32x4*)(P + r * NPROJ + col0 + bj * HALF) = w;
                        float* lp = LF + r * 512 + (col0 + bj * HALF - 512);
                        *(f32x4*)lp = (f32x4){lf[0], lf[1], lf[2], lf[3]}; *(f32x4*)(lp + 4) = (f32x4){lf[4], lf[5], lf[6], lf[7]}; } }
        } else {
#pragma unroll
            for (int ai = 0; ai < 2; ++ai)
#pragma unroll
                for (int m = 0; m < 4; ++m) { bf16_t* rowp = P + (size_t)(row0 + ai * HALF + m * 16) * NPROJ + col0;
#pragma unroll
                    for (int bj = 0; bj < 2; ++bj) { f32x4 v0 = acc[ai][bj][m][0], v1 = acc[ai][bj][m][1];
                        if (mode == 1) {
#pragma unroll
                            for (int j = 0; j < 4; ++j) { v0[j] = silu_f(v0[j]); v1[j] = silu_f(v1[j]); } }
                        u32x4 w; w.x = cvt_pk_bf16(v0[0], v0[1]); w.y = cvt_pk_bf16(v0[2], v0[3]); w.z = cvt_pk_bf16(v1[0], v1[1]); w.w = cvt_pk_bf16(v1[2], v1[3]);
                        *(u32x4*)(rowp + bj * HALF) = w; } }
        }
    }
};
struct EpiOut {
    static constexpr bool PERM = true, AFTER_DRAIN = false;
    const float* x; bf16_t* x1; const float* g1;
    __device__ __forceinline__ void operator()(const f32x4 (&acc)[2][2][4][2], const Unit& u, int wr, int wc, int fr, int fq) const {
        const int row0 = u.pm * BM + wr * 64 + fr, col0 = u.pn * BM + wc * 32 + 8 * fq;
        const float* gb = g1 + ((u.pm * BM) >> 13) * 6144 + col0;
        f32x4 gv[2][2];
#pragma unroll
        for (int bj = 0; bj < 2; ++bj)
#pragma unroll
            for (int n = 0; n < 2; ++n) gv[bj][n] = *(const f32x4*)(gb + bj * HALF + 4 * n);
#pragma unroll
        for (int ai = 0; ai < 2; ++ai)
#pragma unroll
            for (int m = 0; m < 4; ++m) { const size_t off = (size_t)(row0 + ai * HALF + m * 16) * D + col0;
#pragma unroll
                for (int bj = 0; bj < 2; ++bj) { const f32x4 x0 = *(const f32x4*)(x + off + bj * HALF), x1v = *(const f32x4*)(x + off + bj * HALF + 4);
                    const f32x4 v0 = x0 + gv[bj][0] * acc[ai][bj][m][0], v1 = x1v + gv[bj][1] * acc[ai][bj][m][1];
                    u32x4 w; w.x = cvt_pk_bf16(v0[0], v0[1]); w.y = cvt_pk_bf16(v0[2], v0[3]); w.z = cvt_pk_bf16(v1[0], v1[1]); w.w = cvt_pk_bf16(v1[2], v1[3]);
                    *(u32x4*)(x1 + off + bj * HALF) = w; } }
    }
};
__device__ __forceinline__ float sat8(float x) { return fminf(fmaxf(x, -448.0f), 448.0f); }
__device__ __forceinline__ unsigned pk4_fp8(float a, float b, float c, float d) { int w = 0; w = __builtin_amdgcn_cvt_pk_fp8_f32(sat8(a), sat8(b), w, false); w = __builtin_amdgcn_cvt_pk_fp8_f32(sat8(c), sat8(d), w, true); return (unsigned)w; }
template <bool F8IN, bool F8> struct EpiW1 {
    static constexpr bool PERM = true, AFTER_DRAIN = false;
    void* ACT; const float* b1;
    __device__ __forceinline__ void operator()(const f32x4 (&acc)[2][2][4][2], const Unit& u, int wr, int wc, int fr, int fq) const {
        const int e = u.pn >> 3, pn = u.pn & 7;
        const int row0 = u.pm * BM + wr * 64 + fr, cj = pn * 128 + wc * 32 + 8 * fq;
        const float* bg = b1 + e * 2048 + cj; const float sc = F8IN ? (1.0f / 1024.0f) : 1.0f;
#pragma unroll
        for (int ai = 0; ai < 2; ++ai)
#pragma unroll
            for (int m = 0; m < 4; ++m) {
                asm volatile("" ::: "memory");
                const f32x4 bg0 = *(const f32x4*)bg, bg1 = *(const f32x4*)(bg + 4), bl0 = *(const f32x4*)(bg + 1024), bl1 = *(const f32x4*)(bg + 1028);
                f32x4 g0 = acc[ai][0][m][0] * sc + bg0, g1 = acc[ai][0][m][1] * sc + bg1, l0 = acc[ai][1][m][0] * sc + bl0, l1 = acc[ai][1][m][1] * sc + bl1;
                float o[8];
                const float osc = F8 ? 4.0f : 1.0f;
#pragma unroll
                for (int j = 0; j < 4; ++j) {
                    float g = fminf(g0[j], 7.0f), l = __builtin_amdgcn_fmed3f(l0[j], -7.0f, 7.0f); o[j] = (g * osc) * __builtin_amdgcn_rcpf(1.0f + __builtin_amdgcn_exp2f(g * (-1.702f * 1.44269504f))) * (l + 1.0f);
                    g = fminf(g1[j], 7.0f); l = __builtin_amdgcn_fmed3f(l1[j], -7.0f, 7.0f); o[4 + j] = (g * osc) * __builtin_amdgcn_rcpf(1.0f + __builtin_amdgcn_exp2f(g * (-1.702f * 1.44269504f))) * (l + 1.0f); }
                const size_t off = (size_t)(row0 + ai * HALF + m * 16) * DFF + cj;
                if (F8) { typedef unsigned u32x2 __attribute__((ext_vector_type(2))); u32x2 w; int w0 = 0, w1 = 0;
                    w0 = __builtin_amdgcn_cvt_pk_fp8_f32(o[0], o[1], w0, false); w0 = __builtin_amdgcn_cvt_pk_fp8_f32(o[2], o[3], w0, true); w1 = __builtin_amdgcn_cvt_pk_fp8_f32(o[4], o[5], w1, false); w1 = __builtin_amdgcn_cvt_pk_fp8_f32(o[6], o[7], w1, true);
                    w.x = (unsigned)w0; w.y = (unsigned)w1; *(u32x2*)((unsigned char*)ACT + off) = w; }
                else { u32x4 w; w.x = cvt_pk_bf16(o[0], o[1]); w.y = cvt_pk_bf16(o[2], o[3]); w.z = cvt_pk_bf16(o[4], o[5]); w.w = cvt_pk_bf16(o[6], o[7]);
                    *(u32x4*)((bf16_t*)ACT + off) = w; } }
    }
};
template <bool Y8> struct EpiW2 {
    static constexpr bool PERM = true, AFTER_DRAIN = false;
    void* Y; const float* b2; float sc;
    __device__ __forceinline__ void operator()(const f32x4 (&acc)[2][2][4][2], const Unit& u, int wr, int wc, int fr, int fq) const {
        const int e = u.pn >> 2, pn = u.pn & 3;
        const int row0 = u.pm * BM + wr * 64 + fr, col0 = pn * BM + wc * 32 + 8 * fq;
        const float* bb = b2 + e * 1024 + col0;
        f32x4 bv[2][2];
#pragma unroll
        for (int bj = 0; bj < 2; ++bj) { bv[bj][0] = *(const f32x4*)(bb + bj * HALF); bv[bj][1] = *(const f32x4*)(bb + bj * HALF + 4); }
#pragma unroll
        for (int ai = 0; ai < 2; ++ai)
#pragma unroll
            for (int m = 0; m < 4; ++m) { const size_t off = (size_t)(row0 + ai * HALF + m * 16) * D + col0;
#pragma unroll
                for (int bj = 0; bj < 2; ++bj) { const f32x4 v0 = acc[ai][bj][m][0] * sc + bv[bj][0], v1 = acc[ai][bj][m][1] * sc + bv[bj][1];
                    if (Y8) { typedef unsigned u32x2 __attribute__((ext_vector_type(2))); u32x2 w; w.x = pk4_fp8(v0[0] * 8.f, v0[1] * 8.f, v0[2] * 8.f, v0[3] * 8.f); w.y = pk4_fp8(v1[0] * 8.f, v1[1] * 8.f, v1[2] * 8.f, v1[3] * 8.f);
                        *(u32x2*)((unsigned char*)Y + off + bj * HALF) = w; }
                    else { u32x4 w; w.x = cvt_pk_bf16(v0[0], v0[1]); w.y = cvt_pk_bf16(v0[2], v0[3]); w.z = cvt_pk_bf16(v1[0], v1[1]); w.w = cvt_pk_bf16(v1[2], v1[3]);
                        *(u32x4*)((bf16_t*)Y + off + bj * HALF) = w; } } }
    }
};
struct InProjOrder {
    int c;
    __device__ __forceinline__ bool next(int i, Unit& u) const { const int pn = (c >> 6) + 4 * i; if (pn >= NPROJ / BM) return false; u.pm = c & 63; u.pn = pn; return true; }
    __device__ __forceinline__ void a_ready(const Unit&) const {}
    __device__ __forceinline__ void done(const Unit&) const {}
};
struct MoeOrder {
    const PG8_LAS int* rt2e; int NT, nwg, G, c;
    __device__ __forceinline__ bool next(int i, Unit& u) const {
        const int L = i * G + c; if (L >= nwg) return false;
        int wgid = L; { const int q = nwg / NXCD, r = nwg % NXCD, xcd = wgid % NXCD, off = wgid / NXCD; wgid = (xcd < r ? xcd * (q + 1) : r * (q + 1) + (xcd - r) * q) + off; }
        const int rt = wgid / NT, pn = wgid % NT; const int e = __builtin_amdgcn_readfirstlane(rt2e[rt]);
        u.pm = rt; u.pn = e * NT + pn; return true;
    }
    __device__ __forceinline__ void a_ready(const Unit&) const {}
    __device__ __forceinline__ void done(const Unit&) const {}
};
}

using pg8::pk4_fp8;
__device__ __forceinline__ void transpose_item(const float* __restrict__ W, int ldw, int k0, int c0, bf16* WT, int drow0, LAS float* scr, int lane) {
#pragma unroll 8
    for (int i = 0; i < 32; ++i) { const int kk = 2 * i + (lane >> 5); scr[kk * 33 + (lane & 31)] = W[(size_t)(k0 + kk) * ldw + c0 + (lane & 31)]; }
    LDS_WAIT(); asm volatile("" ::: "memory");
    const int c = lane & 7;
#pragma unroll
    for (int j = 0; j < 4; ++j) { const int n = (lane >> 3) + 8 * j; const LAS float* s = scr + (8 * c) * 33 + n;
        v4u o; o.x = pk2(s[0 * 33], s[1 * 33]); o.y = pk2(s[2 * 33], s[3 * 33]); o.z = pk2(s[4 * 33], s[5 * 33]); o.w = pk2(s[6 * 33], s[7 * 33]);
        *(GAS v4u*)(WT + (size_t)(drow0 + n) * 1024 + k0 + 8 * c) = o; }
    LDS_WAIT(); asm volatile("" ::: "memory");
}
__device__ __forceinline__ void transpose_item8(const float* __restrict__ W, int ldw, int k0, int c0, unsigned char* WT, int drow0, float scale, LAS float* scr, int lane) {
#pragma unroll 8
    for (int i = 0; i < 32; ++i) { const int kk = 2 * i + (lane >> 5); scr[kk * 33 + (lane & 31)] = W[(size_t)(k0 + kk) * ldw + c0 + (lane & 31)]; }
    LDS_WAIT(); asm volatile("" ::: "memory");
    const int n = lane >> 1, hf = lane & 1; const LAS float* s = scr + (32 * hf) * 33 + n;
    v4u o0, o1;
    o0.x = pk4_fp8(s[0 * 33] * scale, s[1 * 33] * scale, s[2 * 33] * scale, s[3 * 33] * scale); o0.y = pk4_fp8(s[4 * 33] * scale, s[5 * 33] * scale, s[6 * 33] * scale, s[7 * 33] * scale);
    o0.z = pk4_fp8(s[8 * 33] * scale, s[9 * 33] * scale, s[10 * 33] * scale, s[11 * 33] * scale); o0.w = pk4_fp8(s[12 * 33] * scale, s[13 * 33] * scale, s[14 * 33] * scale, s[15 * 33] * scale);
    o1.x = pk4_fp8(s[16 * 33] * scale, s[17 * 33] * scale, s[18 * 33] * scale, s[19 * 33] * scale); o1.y = pk4_fp8(s[20 * 33] * scale, s[21 * 33] * scale, s[22 * 33] * scale, s[23 * 33] * scale);
    o1.z = pk4_fp8(s[24 * 33] * scale, s[25 * 33] * scale, s[26 * 33] * scale, s[27 * 33] * scale); o1.w = pk4_fp8(s[28 * 33] * scale, s[29 * 33] * scale, s[30 * 33] * scale, s[31 * 33] * scale);
    GAS v4u* dst = (GAS v4u*)(WT + (size_t)(drow0 + n) * 1024 + k0 + 32 * hf); dst[0] = o0; dst[1] = o1;
    LDS_WAIT(); asm volatile("" ::: "memory");
}
template <bool F8> __device__ __forceinline__ void p0_item(const float* __restrict__ W, int ldw, int k0, int c0, unsigned char* WT, int drow0, int rowb, float scale, LAS unsigned char* T, int tid, int wave, int lane) {
    constexpr int NB = F8 ? 2 : 1, TS = 516;
    const int l32 = lane & 31, hf = lane >> 5;
#pragma unroll 1
    for (int batch = 0; batch < NB; ++batch) {
        const int kb = batch * 256 + wave * 32;
        f32x4 v[4][4];
#pragma unroll
        for (int i = 0; i < 4; ++i)
#pragma unroll
            for (int j = 0; j < 4; ++j) v[i][j] = __builtin_nontemporal_load((const f32x4*)(W + (size_t)(k0 + kb + 4 * (2 * i + hf) + j) * ldw + c0 + 4 * l32));
#pragma unroll
        for (int i = 0; i < 4; ++i) { const int kk = kb + 4 * (2 * i + hf);
#pragma unroll
            for (int c = 0; c < 4; ++c) { LAS unsigned char* tp = T + (4 * l32 + c) * TS + (F8 ? kk : 2 * kk);
                if (F8) *(LAS unsigned*)tp = pk4_fp8(v[i][0][c] * scale, v[i][1][c] * scale, v[i][2][c] * scale, v[i][3][c] * scale);
                else { *(LAS unsigned*)tp = pk2(v[i][0][c], v[i][1][c]); *(LAS unsigned*)(tp + 4) = pk2(v[i][2][c], v[i][3][c]); } } }
    }
    __syncthreads();
#pragma unroll
    for (int i = 0; i < 8; ++i) { const int piece = tid + NTHR * i, n = piece >> 5, c = piece & 31; const LAS unsigned* tp = (const LAS unsigned*)(T + n * TS + 16 * c);
        v4u o; o.x = tp[0]; o.y = tp[1]; o.z = tp[2]; o.w = tp[3];
        *(GAS v4u*)(WT + (size_t)(drow0 + n) * rowb + (F8 ? k0 : 2 * k0) + 16 * c) = o; }
    __syncthreads();
}
constexpr int KB1 = MOE_FP8_G1 ? 2 : 4, KB2 = MOE_FP8_G2 ? 2 : 4, I_E1 = NE * 16 * KB1, I_E2 = NE * 8 * KB2, N_EXP_ITEMS = I_E1 + I_E2;
constexpr int N_BG_ITEMS = 0;
__device__ __forceinline__ void p0_expert_item(const Args& a, LAS unsigned char* lds, int it, int tid, int wave, int lane) {
    unsigned char* ws = a.ws;
    if (it < I_E1) { const int e = it / (16 * KB1), r2 = it % (16 * KB1), nb = r2 / KB1, kb = r2 % KB1, c0 = 128 * nb;
        const int drow = e * 2048 + ((c0 < 1024) ? (256 * (c0 >> 7)) : (256 * ((c0 - 1024) >> 7) + 128));
        p0_item<MOE_FP8_G1 != 0>(a.in[I_W1] + (size_t)e * 1024 * 2048, 2048, (MOE_FP8_G1 ? 512 : 256) * kb, c0, ws + WS_W1, drow, MOE_FP8_G1 ? 1024 : 2048, 128.0f, lds, tid, wave, lane); }
    else { const int r = it - I_E1, e = r / (8 * KB2), r2 = r % (8 * KB2), nb = r2 / KB2, kb = r2 % KB2;
        p0_item<MOE_FP8_G2 != 0>(a.in[I_W2] + (size_t)e * 1024 * 1024, 1024, (MOE_FP8_G2 ? 512 : 256) * kb, 128 * nb, ws + WS_W2, e * 1024 + 128 * nb, MOE_FP8_G2 ? 1024 : 2048, 128.0f, lds, tid, wave, lane); }
}
struct P0Src { const float* W; int ldw, k0, c0, drow; unsigned char* WT; };
__device__ __forceinline__ P0Src p0_expert_src(const Args& a, int it) {
    P0Src s;
    if (it < I_E1) { const int e = it / (16 * KB1), r2 = it % (16 * KB1), nb = r2 / KB1, kb = r2 % KB1, c0 = 128 * nb;
        s.W = a.in[I_W1] + (size_t)e * 1024 * 2048; s.ldw = 2048; s.k0 = 512 * kb; s.c0 = c0; s.drow = e * 2048 + ((c0 < 1024) ? (256 * (c0 >> 7)) : (256 * ((c0 - 1024) >> 7) + 128)); s.WT = a.ws + WS_W1; }
    else { const int r = it - I_E1, e = r / (8 * KB2), r2 = r % (8 * KB2), nb = r2 / KB2, kb = r2 % KB2;
        s.W = a.in[I_W2] + (size_t)e * 1024 * 1024; s.ldw = 1024; s.k0 = 512 * kb; s.c0 = 128 * nb; s.drow = e * 1024 + 128 * nb; s.WT = a.ws + WS_W2; }
    return s;
}
__device__ __forceinline__ void p0_load_batch(f32x4 (&v)[4][4], const P0Src& s, int batch, int wave, int lane) {
    const int l32 = lane & 31, hf = lane >> 5, kb = batch * 256 + wave * 32;
#pragma unroll
    for (int i = 0; i < 4; ++i)
#pragma unroll
        for (int j = 0; j < 4; ++j) v[i][j] = __builtin_nontemporal_load((const f32x4*)(s.W + (size_t)(s.k0 + kb + 4 * (2 * i + hf) + j) * s.ldw + s.c0 + 4 * l32));
}
__device__ __forceinline__ void p0_pack_batch8(const f32x4 (&v)[4][4], int batch, LAS unsigned char* T, int wave, int lane) {
    const int l32 = lane & 31, hf = lane >> 5, kb = batch * 256 + wave * 32;
#pragma unroll
    for (int i = 0; i < 4; ++i) { const int kk = kb + 4 * (2 * i + hf);
#pragma unroll
        for (int c = 0; c < 4; ++c) *(LAS unsigned*)(T + (4 * l32 + c) * 516 + kk) = pk4_fp8(v[i][0][c] * 128.0f, v[i][1][c] * 128.0f, v[i][2][c] * 128.0f, v[i][3][c] * 128.0f); }
}
__device__ __forceinline__ void p0_expert_items_pipelined(const Args& a, LAS unsigned char* T, int bid, int G, int n_items, int tid, int wave, int lane) {
    if (bid >= n_items) return;
    f32x4 vA[4][4], vB[4][4];
    P0Src cur = p0_expert_src(a, bid);
    p0_load_batch(vA, cur, 0, wave, lane);
#pragma unroll 1
    for (int it = bid; it < n_items; it += G) {
        p0_load_batch(vB, cur, 1, wave, lane);
        p0_pack_batch8(vA, 0, T, wave, lane);
        const int nx = it + G; const P0Src nxt = p0_expert_src(a, nx < n_items ? nx : it);
        if (nx < n_items) p0_load_batch(vA, nxt, 0, wave, lane);
        p0_pack_batch8(vB, 1, T, wave, lane);
        __syncthreads();
#pragma unroll
        for (int i = 0; i < 8; ++i) { const int piece = tid + NTHR * i, n = piece >> 5, c = piece & 31; const LAS unsigned* tp = (const LAS unsigned*)(T + n * 516 + 16 * c);
            v4u o; o.x = tp[0]; o.y = tp[1]; o.z = tp[2]; o.w = tp[3];
            *(GAS v4u*)(cur.WT + (size_t)(cur.drow + n) * 1024 + cur.k0 + 16 * c) = o; }
        __syncthreads();
        cur = nxt;
    }
}
__device__ __forceinline__ void p0_bg_items(const Args& a, LAS unsigned char* lds, int bid, int G, int tid, int wave, int lane) {
    if (G == 256 && bid >= 128) { for (int j = 0; j < N_BG_ITEMS / 128; ++j) p0_expert_item(a, lds, N_EXP_ITEMS - N_BG_ITEMS + (bid - 128) + 128 * j, tid, wave, lane); }
}
__device__ __forceinline__ void p0_prologue(const Args& a, LAS unsigned char* lds, int bid, int G, int tid, int wave, int lane) {
    unsigned char* ws = a.ws;
    { const int gw = (G - 1 - bid) * NWAVES + wave, NGW = G * NWAVES;
      for (int it = gw; it < 192; it += NGW) {
        const int nc = it % 24, kc = it / 24, n = nc * 256 + 4 * lane;
        const float* W = a.in[I_ADAW]; const float* c = a.in[I_C];
        f32x4 a0 = {0.f, 0.f, 0.f, 0.f}, a1 = {0.f, 0.f, 0.f, 0.f};
#pragma unroll 8
        for (int kk = 0; kk < 128; ++kk) { const int k = kc * 128 + kk; const f32x4 w = __builtin_nontemporal_load((const f32x4*)(W + (size_t)k * 6144 + n));
            const float c0 = silu_f(c[k]), c1 = silu_f(c[1024 + k]); a0 += c0 * w; a1 += c1 * w; }
        float* mp = (float*)(ws + WS_MODP);
        *(f32x4*)(mp + (size_t)(kc * 2 + 0) * 6144 + n) = a0; *(f32x4*)(mp + (size_t)(kc * 2 + 1) * 6144 + n) = a1;
      } }
    constexpr int I_IN = 28 * 4, I_OUT = 8 * 4;
    const int n_p0 = (G == 256) ? (N_EXP_ITEMS - N_BG_ITEMS) : N_EXP_ITEMS;
    if (MOE_FP8_G1 && MOE_FP8_G2) p0_expert_items_pipelined(a, lds, bid, G, n_p0, tid, wave, lane);
    else for (int it = bid; it < n_p0; it += G) p0_expert_item(a, lds, it, tid, wave, lane);
    for (int it = bid; it < I_IN + I_OUT; it += G) {
        if (it < I_IN) { const int nb = it >> 2, kb = it & 3; p0_item<false>(a.in[I_WIN], IN_COLS, 256 * kb, 128 * nb, ws + WS_WIN, 128 * nb, 2048, 1.0f, lds, tid, wave, lane); }
        else { const int r = it - I_IN, nb = r >> 2, kb = r & 3; p0_item<false>(a.in[I_WOUT], D, 256 * kb, 128 * nb, ws + WS_WOUT, 128 * nb, 2048, 1.0f, lds, tid, wave, lane); }
    }
}

__device__ __forceinline__ void load_mod_AS(LAS float* A, LAS float* S, const float* normw, const float* src, int nparts, const float* bias, int b, int shift_off, int tid) {
    for (int k = tid; k < 1024; k += NTHR) {
        float sh = bias ? bias[shift_off + k] : 0.f, sc = bias ? bias[shift_off + 1024 + k] : 0.f;
        for (int p = 0; p < nparts; ++p) { const float* q = src + (size_t)(p * 2 + b) * 6144 + shift_off; sh += q[k]; sc += q[1024 + k]; }
        A[k] = normw[k] * (1.0f + sc); S[k] = sh;
    }
}
__device__ __forceinline__ float softplus_f(float x) { return fmaxf(x, 0.f) + log1pf(__expf(-fabsf(x))); }

__device__ __forceinline__ void p1_norm(const Args& a, LAS unsigned char* lds, int bid, int G, int tid, int wave, int lane) {
    unsigned char* ws = a.ws;
    LAS float* A1 = (LAS float*)(lds); LAS float* S1 = A1 + 1024; LAS float* WDT = S1 + 1024;
    const float* modp = (const float*)(ws + WS_MODP);
    for (int idx = bid * NTHR + tid; idx < 2 * 6144; idx += G * NTHR) { const int b = idx / 6144, n = idx % 6144; float s = a.in[I_ADAB][n];
        for (int p = 0; p < 8; ++p) s += modp[(size_t)(p * 2 + b) * 6144 + n];
        ((float*)(ws + WS_MODF))[idx] = s; }
    for (int idx = tid; idx < 8192; idx += NTHR) { const int k = idx >> 3, jj = idx & 7; WDT[jj * 1024 + k] = a.in[I_WIN][(size_t)k * IN_COLS + NPROJ + jj]; }
    const float* x = a.in[I_X]; bf16* H = (bf16*)(ws + WS_H); float* DT = (float*)(ws + WS_DT);
    for (int c = bid; c < NCHUNK; c += G) {
        const int b = c >> 7;
        __syncthreads();
        load_mod_AS(A1, S1, a.in[I_N1W], modp, 8, a.in[I_ADAB], b, 0, tid);
        __syncthreads();
        f32x4 vn[4];
        { const GAS f32x4* xr = (const GAS f32x4*)(x + (size_t)(c * 64 + wave * 8) * D) + lane;
#pragma unroll
          for (int j = 0; j < 4; ++j) vn[j] = __builtin_nontemporal_load((const f32x4*)xr + 64 * j); }
#pragma unroll 1
        for (int r = 0; r < 8; ++r) {
            const int m = c * 64 + wave * 8 + r;
            f32x4 v[4]; float ss = 0.f;
#pragma unroll
            for (int j = 0; j < 4; ++j) { v[j] = vn[j]; ss += (v[j].x * v[j].x + v[j].y * v[j].y) + (v[j].z * v[j].z + v[j].w * v[j].w); }
            if (r < 7) { const GAS f32x4* xr = (const GAS f32x4*)(x + (size_t)(m + 1) * D) + lane;
#pragma unroll
                for (int j = 0; j < 4; ++j) vn[j] = __builtin_nontemporal_load((const f32x4*)xr + 64 * j); }
            const float rstd = rsqrtf(wave_sum(ss) * (1.0f / D) + EPS);
            float dacc[8];
#pragma unroll
            for (int jj = 0; jj < 8; ++jj) dacc[jj] = 0.f;
            GAS unsigned long long* o8 = (GAS unsigned long long*)(H + (size_t)m * D) + lane;
#pragma unroll
            for (int j = 0; j < 4; ++j) {
                const f32x4 av = *(const LAS f32x4*)(A1 + 256 * j + 4 * lane), sv = *(const LAS f32x4*)(S1 + 256 * j + 4 * lane);
                const f32x4 h = v[j] * rstd * av + sv;
                o8[64 * j] = (unsigned long long)pk2(h.x, h.y) | ((unsigned long long)pk2(h.z, h.w) << 32);
#pragma unroll
                for (int jj = 0; jj < 8; ++jj) { const f32x4 w = *(const LAS f32x4*)(WDT + jj * 1024 + 256 * j + 4 * lane); dacc[jj] += (h.x * w.x + h.y * w.y) + (h.z * w.z + h.w * w.w); }
            }
            { const bool u5 = (lane & 32) != 0, u4 = (lane & 16) != 0, u3 = (lane & 8) != 0; float p4[4], p2[2], p1;
#pragma unroll
              for (int i = 0; i < 4; ++i) { const float lo = dacc[i], hi = dacc[i + 4]; p4[i] = (u5 ? hi : lo) + __shfl_xor(u5 ? lo : hi, 32); }
#pragma unroll
              for (int i = 0; i < 2; ++i) { const float lo = p4[i], hi = p4[i + 2]; p2[i] = (u4 ? hi : lo) + __shfl_xor(u4 ? lo : hi, 16); }
              { const float lo = p2[0], hi = p2[1]; p1 = (u3 ? hi : lo) + __shfl_xor(u3 ? lo : hi, 8); }
              p1 += __shfl_xor(p1, 4); p1 += __shfl_xor(p1, 2); p1 += __shfl_xor(p1, 1);
              const int col = lane >> 3;
              if ((lane & 7) == 0) DT[(size_t)m * 8 + col] = softplus_f(p1 + a.in[I_DTB][col]); }
        }
    }
}

__device__ __forceinline__ void hgrn_naive(const Args& a, LAS unsigned char* lds, int bh, int tid, int wave, int lane) {
    unsigned char* ws = a.ws;
    const int b = bh >> 2, h = bh & 3, j = tid & 127, kq = tid >> 7;
    LAS float* FE = (LAS float*)lds; LAS float* KK = FE + 2048; LAS float* QQ = KK + 2048; LAS float* VV = QQ + 2048; LAS float* RED = VV + 2048;
    const bf16* P = (const bf16*)(ws + WS_P); const float* LF = (const float*)(ws + WS_LF); bf16* MIX = (bf16*)(ws + WS_MIX);
    const float* nw = a.in[I_HGNW];
    float S[32];
#pragma unroll
    for (int i = 0; i < 32; ++i) S[i] = 0.f;
    for (int t0 = 0; t0 < SEQ; t0 += 16) {
        for (int idx = tid; idx < 2048; idx += NTHR) { const int tt = idx >> 7, k = idx & 127; const size_t row = (size_t)b * SEQ + t0 + tt;
            FE[idx] = __expf(LF[row * 512 + h * 128 + k]); KK[idx] = bf2f(P[row * NPROJ + PC_K + h * 128 + k]);
            QQ[idx] = bf2f(P[row * NPROJ + PC_Q + h * 128 + k]); VV[idx] = bf2f(P[row * NPROJ + PC_V + h * 128 + k]); }
        __syncthreads();
#pragma unroll 1
        for (int tt = 0; tt < 16; ++tt) {
            const float vj = VV[tt * 128 + j]; float p = 0.f;
#pragma unroll
            for (int i4 = 0; i4 < 8; ++i4) {
                const f32x4 f4 = *(const LAS f32x4*)(FE + tt * 128 + 32 * kq + 4 * i4), k4 = *(const LAS f32x4*)(KK + tt * 128 + 32 * kq + 4 * i4), q4 = *(const LAS f32x4*)(QQ + tt * 128 + 32 * kq + 4 * i4);
#pragma unroll
                for (int c = 0; c < 4; ++c) { S[4 * i4 + c] = f4[c] * S[4 * i4 + c] + k4[c] * vj; p += S[4 * i4 + c] * q4[c]; }
            }
            RED[(kq * 16 + tt) * 128 + j] = p;
        }
        __syncthreads();
#pragma unroll
        for (int r = 0; r < 2; ++r) { const int tt = 2 * wave + r; const size_t row = (size_t)b * SEQ + t0 + tt;
            float o0 = 0.f, o1 = 0.f;
#pragma unroll
            for (int q = 0; q < 4; ++q) { o0 += RED[(q * 16 + tt) * 128 + lane]; o1 += RED[(q * 16 + tt) * 128 + 64 + lane]; }
            const float rstd = rsqrtf(wave_sum(o0 * o0 + o1 * o1) * (1.0f / 128.0f) + EPS);
            MIX[row * D + h * 128 + lane] = (bf16)f2bf(o0 * rstd * nw[lane] * bf2f(P[row * NPROJ + PC_G + h * 128 + lane]));
            MIX[row * D + h * 128 + 64 + lane] = (bf16)f2bf(o1 * rstd * nw[64 + lane] * bf2f(P[row * NPROJ + PC_G + h * 128 + 64 + lane])); }
    }
}
__device__ __forceinline__ void ssd_naive(const Args& a, LAS unsigned char* lds, int bg, int tid, int wave, int lane) {
    unsigned char* ws = a.ws;
    const int b = bg >> 1, g = bg & 1, p = tid & 63, hl = wave >> 1, nh = wave & 1;
    LAS float* XS = (LAS float*)lds; LAS float* BM = XS + 4096; LAS float* CM = BM + 2048; LAS float* DTL = CM + 2048; LAS float* DEC = DTL + 64; LAS float* RED = DEC + 64;
    const bf16* P = (const bf16*)(ws + WS_P); const float* DT = (const float*)(ws + WS_DT); bf16* MIX = (bf16*)(ws + WS_MIX);
    const float* cw = a.in[I_CONVW]; const float* cb = a.in[I_CONVB];
    float hS[64];
#pragma unroll
    for (int i = 0; i < 64; ++i) hS[i] = 0.f;
    for (int t0 = 0; t0 < SEQ; t0 += 16) {
        for (int idx = tid; idx < 16 * 512; idx += NTHR) { const int tt = idx >> 9, cc = idx & 511, t = t0 + tt;
            const int ch = (cc < 256) ? (g * 256 + cc) : (cc < 384) ? (512 + g * 128 + (cc - 256)) : (768 + g * 128 + (cc - 384));
            float v = cb[ch];
#pragma unroll
            for (int w = 0; w < 4; ++w) { const int ts = t - 3 + w; if (ts >= 0) v += bf2f(P[((size_t)b * SEQ + ts) * NPROJ + PC_X + ch]) * cw[w * 1024 + ch]; }
            v = silu_f(v);
            if (cc < 256) XS[tt * 256 + cc] = v; else if (cc < 384) BM[tt * 128 + cc - 256] = v; else CM[tt * 128 + cc - 384] = v; }
        if (tid < 64) { const int tt = tid >> 2, hh = tid & 3; const float dtv = DT[((size_t)b * SEQ + t0 + tt) * 8 + g * 4 + hh]; DTL[tid] = dtv; DEC[tid] = __expf(-dtv * __expf(a.in[I_ALOG][g * 4 + hh])); }
        __syncthreads();
#pragma unroll 1
        for (int tt = 0; tt < 16; ++tt) {
            const float dec = DEC[tt * 4 + hl], xdt = XS[tt * 256 + hl * 64 + p] * DTL[tt * 4 + hl]; float y = 0.f;
#pragma unroll
            for (int i4 = 0; i4 < 16; ++i4) { const f32x4 B4 = *(const LAS f32x4*)(BM + tt * 128 + nh * 64 + 4 * i4), C4 = *(const LAS f32x4*)(CM + tt * 128 + nh * 64 + 4 * i4);
#pragma unroll
                for (int c = 0; c < 4; ++c) { hS[4 * i4 + c] = dec * hS[4 * i4 + c] + xdt * B4[c]; y += hS[4 * i4 + c] * C4[c]; } }
            RED[(nh * 16 + tt) * 256 + hl * 64 + p] = y;
        }
        __syncthreads();
#pragma unroll
        for (int r = 0; r < 2; ++r) { const int tt = 2 * wave + r; const size_t row = (size_t)b * SEQ + t0 + tt;
            float yv[4], ss = 0.f;
#pragma unroll
            for (int i = 0; i < 4; ++i) { const int c = lane + 64 * i; float y = RED[tt * 256 + c] + RED[(16 + tt) * 256 + c] + a.in[I_SSMD][g * 4 + i] * XS[tt * 256 + c];
                y *= bf2f(P[row * NPROJ + PC_Z + g * 256 + c]); yv[i] = y; ss += y * y; }
            const float rstd = rsqrtf(wave_sum(ss) * (1.0f / 256.0f) + EPS);
#pragma unroll
            for (int i = 0; i < 4; ++i) { const int c = lane + 64 * i; MIX[row * D + 512 + g * 256 + c] = (bf16)f2bf(yv[i] * rstd * a.in[I_SSMNW][g * 256 + c]); }
        }
        __syncthreads();
    }
}


typedef float f32x16 __attribute__((ext_vector_type(16)));
constexpr size_t WS_UHG = 480 * MiB, WS_SHG = 496 * MiB, WS_USSD = 512 * MiB, WS_SSSD = 544 * MiB, WS_DK = 560 * MiB, WS_DEC = 561 * MiB;
constexpr int LDA = 136, LDT = 72;

__device__ __forceinline__ int crow(int i, int hh) { return (i & 3) + 8 * (i >> 2) + 4 * hh; }
__device__ __forceinline__ void mma32(f32x16& acc, const LAS bf16* A, int lda, const LAS bf16* Bt, int ldb, int nsteps, int lane) {
    const LAS bf16* ap = A + (lane & 31) * lda + 8 * (lane >> 5);
    const LAS bf16* bp = Bt + (lane & 31) * ldb + 8 * (lane >> 5);
    for (int s = 0; s < nsteps; ++s) {
        const bf16x8 av = *(const LAS bf16x8*)(ap + 16 * s), bv = *(const LAS bf16x8*)(bp + 16 * s);
        acc = __builtin_amdgcn_mfma_f32_32x32x16_bf16(av, bv, acc, 0, 0, 0);
    }
}
__device__ __forceinline__ f32x16 zero16() { f32x16 z;
#pragma unroll
    for (int i = 0; i < 16; ++i) z[i] = 0.f; return z; }
__device__ __forceinline__ void st8(LAS bf16* p, float a, float b, float c, float d) { *(LAS unsigned long long*)p = (unsigned long long)pk2(a, b) | ((unsigned long long)pk2(c, d) << 32); }
__device__ __forceinline__ void st16x(LAS bf16* p, const float* v) {
    v4u a, b; a.x = pk2(v[0], v[1]); a.y = pk2(v[2], v[3]); a.z = pk2(v[4], v[5]); a.w = pk2(v[6], v[7]); b.x = pk2(v[8], v[9]); b.y = pk2(v[10], v[11]); b.z = pk2(v[12], v[13]); b.w = pk2(v[14], v[15]);
    *(LAS v4u*)p = a; *(LAS v4u*)(p + 8) = b; }

__device__ __forceinline__ float bfw(unsigned w, int hi) { return __uint_as_float(hi ? (w & 0xffff0000u) : (w << 16)); }
constexpr int HG_QS = 0, HG_KS = 17408, HG_KDT = 34816, HG_VT = 53248, HG_ST = 71680, HG_ATT = 106496, HG_QT = 115712, HG_EBM = 117760, HG_EBL = 118272;
constexpr int HG_VRAW = 118784;
struct HgWide { v4u q[2], k[2], v[2]; float lf[16]; };
template <bool FULL> __device__ __forceinline__ void hg_load(const Args& a, HgWide& r, int b, int h, int t0, int tid) {
    const bf16* P = (const bf16*)(a.ws + WS_P) + ((size_t)b * SEQ + t0) * NPROJ + h * 128;
#pragma unroll
    for (int i = 0; i < 2; ++i) { const int piece = tid + NTHR * i; const unsigned o = (unsigned)(piece >> 4) * NPROJ + 8u * (unsigned)(piece & 15);
        r.k[i] = *(const v4u*)(P + o + PC_K); r.v[i] = *(const v4u*)(P + o + PC_V); if (FULL) r.q[i] = *(const v4u*)(P + o + PC_Q); }
    const int k = tid & 127, tq = tid >> 7;
    const float* LF = (const float*)(a.ws + WS_LF) + ((size_t)b * SEQ + t0 + 16 * tq) * 512 + h * 128;
#pragma unroll
    for (int i = 0; i < 16; ++i) r.lf[i] = LF[(unsigned)i * 512 + (unsigned)k];
}
template <bool FULL> __device__ __forceinline__ float hg_stage(const HgWide& r, LAS unsigned char* lds, int tid) {
    LAS bf16* QS = (LAS bf16*)(lds + HG_QS); LAS bf16* KS = (LAS bf16*)(lds + HG_KS); LAS bf16* KDT = (LAS bf16*)(lds + HG_KDT); LAS bf16* VT = (LAS bf16*)(lds + HG_VT); LAS bf16* VR = (LAS bf16*)(lds + HG_VRAW);
    LAS float* QT = (LAS float*)(lds + HG_QT); LAS float* EBM = (LAS float*)(lds + HG_EBM); LAS float* EBL = (LAS float*)(lds + HG_EBL);
#pragma unroll
    for (int i = 0; i < 2; ++i) { const int piece = tid + NTHR * i; const int o = (piece >> 4) * LDA + 8 * (piece & 15);
        *(LAS v4u*)(KS + o) = r.k[i]; *(LAS v4u*)(VR + o) = r.v[i]; if (FULL) *(LAS v4u*)(QS + o) = r.q[i]; }
    const int k = tid & 127, tq = tid >> 7;
    float cum[16]; float run = 0.f;
#pragma unroll
    for (int i = 0; i < 16; ++i) { run += r.lf[i]; cum[i] = run; }
    QT[tq * 128 + k] = run;
    __syncthreads();
    const float q0 = QT[k], q1 = QT[128 + k], q2 = QT[256 + k], q3 = QT[384 + k];
    const float off = (tq > 0 ? q0 : 0.f) + (tq > 1 ? q1 : 0.f) + (tq > 2 ? q2 : 0.f), bmid = q0 + q1, blast = (q0 + q1) + (q2 + q3);
    float kd[16], vv[16];
#pragma unroll
    for (int i = 0; i < 16; ++i) { const float bt = off + cum[i]; const int e = (16 * tq + i) * LDA + k; const float kk = bf2f(KS[e]); vv[i] = bf2f(VR[e]); kd[i] = kk * __expf(blast - bt);
        if (FULL) { QS[e] = (bf16)f2bf(bf2f(QS[e]) * __expf(bt - bmid)); KS[e] = (bf16)f2bf(kk * __expf(bmid - bt)); } }
    st16x(KDT + k * LDT + 16 * tq, kd); st16x(VT + k * LDT + 16 * tq, vv);
    if (tq == 0) { EBL[k] = __expf(blast); if (FULL) EBM[k] = __expf(bmid); }
    __syncthreads();
    return blast;
}
__device__ __forceinline__ void hg_update(f32x16 (&S)[2], LAS unsigned char* lds, int wave, int lane) {
    const LAS bf16* KDT = (const LAS bf16*)(lds + HG_KDT); const LAS bf16* VT = (const LAS bf16*)(lds + HG_VT); const LAS float* EBL = (const LAS float*)(lds + HG_EBL);
    const int kt = wave >> 1, hh = lane >> 5;
#pragma unroll
    for (int g = 0; g < 4; ++g) { const f32x4 e = *(const LAS f32x4*)(EBL + 32 * kt + 8 * g + 4 * hh);
#pragma unroll
        for (int j = 0; j < 2; ++j) { S[j][4 * g + 0] *= e.x; S[j][4 * g + 1] *= e.y; S[j][4 * g + 2] *= e.z; S[j][4 * g + 3] *= e.w; } }
#pragma unroll
    for (int j = 0; j < 2; ++j) mma32(S[j], KDT + 32 * kt * LDT, LDT, VT + 32 * (2 * (wave & 1) + j) * LDT, LDT, 4, lane);
}
__device__ __forceinline__ void hg_passA(const Args& a, LAS unsigned char* lds, int u, int tid, int wave, int lane) {
    const int bh = u >> 5, seg = u & 31, b = bh >> 2, h = bh & 3, kt = wave >> 1, hh = lane >> 5, r = lane & 31;
    f32x16 S[2]; S[0] = zero16(); S[1] = zero16();
    float dsum = 0.f;
    HgWide cur; hg_load<false>(a, cur, b, h, seg * 256, tid);
#pragma unroll 1
    for (int c = 0; c < 4; ++c) {
        dsum += hg_stage<false>(cur, lds, tid);
        if (c < 3) hg_load<false>(a, cur, b, h, seg * 256 + 64 * (c + 1), tid);
        hg_update(S, lds, wave, lane);
        __syncthreads();
    }
    float* U = (float*)(a.ws + WS_UHG) + (size_t)u * 16384;
#pragma unroll
    for (int j = 0; j < 2; ++j)
#pragma unroll
        for (int i = 0; i < 16; ++i) U[(32 * kt + crow(i, hh)) * 128 + 32 * (2 * (wave & 1) + j) + r] = S[j][i];
    if (tid < 128) ((float*)(a.ws + WS_DK))[u * 128 + tid] = __expf(dsum);
}
__device__ __forceinline__ void hg_passC(const Args& a, LAS unsigned char* lds, int u, int tid, int wave, int lane) {
    const int bh = u >> 5, seg = u & 31, b = bh >> 2, h = bh & 3, kt = wave >> 1, hh = lane >> 5, r = lane & 31;
    LAS bf16* QS = (LAS bf16*)(lds + HG_QS); LAS bf16* KS = (LAS bf16*)(lds + HG_KS); LAS bf16* VT = (LAS bf16*)(lds + HG_VT);
    LAS bf16* ST = (LAS bf16*)(lds + HG_ST); LAS bf16* ATT = (LAS bf16*)(lds + HG_ATT); LAS float* EBM = (LAS float*)(lds + HG_EBM); LAS float* O = (LAS float*)(lds + HG_QS);
    const bf16* P = (const bf16*)(a.ws + WS_P); bf16* MIX = (bf16*)(a.ws + WS_MIX); const float* nw = a.in[I_HGNW];
    f32x16 S[2];
    { const float* SI = (const float*)(a.ws + WS_SHG) + (size_t)u * 16384;
#pragma unroll
      for (int j = 0; j < 2; ++j)
#pragma unroll
        for (int i = 0; i < 16; ++i) S[j][i] = SI[(32 * kt + crow(i, hh)) * 128 + 32 * (2 * (wave & 1) + j) + r]; }
    HgWide cur; hg_load<true>(a, cur, b, h, seg * 256, tid);
#pragma unroll 1
    for (int c = 0; c < 4; ++c) {
        const int t0 = seg * 256 + 64 * c;
        hg_stage<true>(cur, lds, tid);
        if (c < 3) hg_load<true>(a, cur, b, h, t0 + 64, tid);
#pragma unroll
        for (int g = 0; g < 4; ++g) { const int kb = 32 * kt + 8 * g + 4 * hh; const f32x4 e = *(const LAS f32x4*)(EBM + kb);
#pragma unroll
            for (int j = 0; j < 2; ++j) st8(ST + (32 * (2 * (wave & 1) + j) + r) * LDA + kb, S[j][4 * g] * e.x, S[j][4 * g + 1] * e.y, S[j][4 * g + 2] * e.z, S[j][4 * g + 3] * e.w); }
        if (wave < 3) { const int ti = (wave + 1) >> 1, si = wave >> 1;
            f32x16 at = zero16(); mma32(at, QS + 32 * ti * LDA, LDA, KS + 32 * si * LDA, LDA, 8, lane);
#pragma unroll
            for (int i = 0; i < 16; ++i) { const int t = 32 * ti + crow(i, hh), s = 32 * si + r; ATT[t * LDT + s] = (bf16)f2bf(s <= t ? at[i] : 0.f); } }
        __syncthreads();
        const int ti = wave >> 2, vj = wave & 3;
        f32x16 o = zero16();
        mma32(o, ATT + 32 * ti * LDT, LDT, VT + 32 * vj * LDT, LDT, 2 * (ti + 1), lane);
        mma32(o, QS + 32 * ti * LDA, LDA, ST + 32 * vj * LDA, LDA, 8, lane);
        hg_update(S, lds, wave, lane);
        __syncthreads();
#pragma unroll
        for (int i = 0; i < 16; ++i) O[(32 * ti + crow(i, hh)) * 132 + 32 * vj + r] = o[i];
        __syncthreads();
        { const int tt = tid >> 3, c16 = tid & 7; const size_t row = (size_t)b * SEQ + t0 + tt;
          float o[16]; float ss = 0.f;
#pragma unroll
          for (int q = 0; q < 4; ++q) { const f32x4 v = *(const LAS f32x4*)(O + tt * 132 + 16 * c16 + 4 * q); o[4 * q] = v.x; o[4 * q + 1] = v.y; o[4 * q + 2] = v.z; o[4 * q + 3] = v.w; ss += (v.x * v.x + v.y * v.y) + (v.z * v.z + v.w * v.w); }
          ss += __shfl_xor(ss, 1); ss += __shfl_xor(ss, 2); ss += __shfl_xor(ss, 4);
          const float rstd = rsqrtf(ss * (1.0f / 128.0f) + EPS);
          const bf16* gp = P + row * NPROJ + PC_G + h * 128 + 16 * c16; const v4u g0 = __builtin_nontemporal_load((const v4u*)gp), g1 = __builtin_nontemporal_load((const v4u*)(gp + 8)); const unsigned gw[8] = {g0.x, g0.y, g0.z, g0.w, g1.x, g1.y, g1.z, g1.w};
          unsigned ow[8];
#pragma unroll
          for (int j = 0; j < 8; ++j) ow[j] = pk2(o[2 * j] * rstd * nw[16 * c16 + 2 * j] * bfw(gw[j], 0), o[2 * j + 1] * rstd * nw[16 * c16 + 2 * j + 1] * bfw(gw[j], 1));
          bf16* mp = MIX + row * D + h * 128 + 16 * c16; *(v4u*)mp = (v4u){ow[0], ow[1], ow[2], ow[3]}; *(v4u*)(mp + 8) = (v4u){ow[4], ow[5], ow[6], ow[7]}; }
        __syncthreads();
    }
}

constexpr int SD_ACUM = 104448, SD_DTV = 106496, SD_SSQ = 108544, SD_CB = 109568;
__device__ __forceinline__ void ssd_scan_dt(const Args& a, LAS unsigned char* lds, size_t row0, int g, int wave, int lane) {
    LAS float* ACUM = (LAS float*)(lds + SD_ACUM); LAS float* DTV = (LAS float*)(lds + SD_DTV);
    if (wave < 4) { const float* DT = (const float*)(a.ws + WS_DT); const float A = -__expf(a.in[I_ALOG][g * 4 + wave]);
        const float d0 = DT[(row0 + 2 * lane) * 8 + g * 4 + wave], d1 = DT[(row0 + 2 * lane + 1) * 8 + g * 4 + wave];
        const float p0 = d0 * A, p1 = p0 + d1 * A; float incl = p1;
#pragma unroll
        for (int o = 1; o < 64; o <<= 1) { const float t = __shfl_up(incl, o); if (lane >= o) incl += t; }
        const float excl = incl - p1;
        ACUM[wave * 128 + 2 * lane] = excl + p0; ACUM[wave * 128 + 2 * lane + 1] = incl; DTV[wave * 128 + 2 * lane] = d0; DTV[wave * 128 + 2 * lane + 1] = d1; }
}
template <int NT> __device__ __forceinline__ void conv_run(const Args& a, int b, int tp0, int ch, float (&out)[NT]) {
    const bf16* Pb = (const bf16*)(a.ws + WS_P) + (size_t)b * SEQ * NPROJ + PC_X;
    const float w0 = a.in[I_CONVW][ch], w1 = a.in[I_CONVW][1024 + ch], w2 = a.in[I_CONVW][2048 + ch], w3 = a.in[I_CONVW][3072 + ch], cb = a.in[I_CONVB][ch];
    const unsigned o0 = (unsigned)tp0 * NPROJ + (unsigned)ch;
    float x0 = (tp0 >= 3) ? bf2f(Pb[o0 - 3u * NPROJ]) : 0.f, x1 = (tp0 >= 2) ? bf2f(Pb[o0 - 2u * NPROJ]) : 0.f, x2 = (tp0 >= 1) ? bf2f(Pb[o0 - 1u * NPROJ]) : 0.f;
#pragma unroll
    for (int i = 0; i < NT; ++i) { const float x3 = bf2f(Pb[o0 + (unsigned)i * NPROJ]); out[i] = silu_f(cb + w0 * x0 + w1 * x1 + w2 * x2 + w3 * x3); x0 = x1; x1 = x2; x2 = x3; }
}
template <bool NATURAL, bool NT = false, int NTOK = 8> __device__ __forceinline__ void conv8x8(const Args& a, int b, int tp0, int ch0, LAS bf16* dst, const float* sc) {
    const bf16* Pb = (const bf16*)(a.ws + WS_P) + (size_t)b * SEQ * NPROJ + PC_X + ch0;
    const float* cw = a.in[I_CONVW] + ch0; const float* cbp = a.in[I_CONVB] + ch0;
    float w[4][8], bias[8];
#pragma unroll
    for (int q = 0; q < 4; ++q) { const f32x4 lo = *(const f32x4*)(cw + q * 1024), hi = *(const f32x4*)(cw + q * 1024 + 4);
        w[q][0] = lo.x; w[q][1] = lo.y; w[q][2] = lo.z; w[q][3] = lo.w; w[q][4] = hi.x; w[q][5] = hi.y; w[q][6] = hi.z; w[q][7] = hi.w; }
    { const f32x4 lo = *(const f32x4*)cbp, hi = *(const f32x4*)(cbp + 4); bias[0] = lo.x; bias[1] = lo.y; bias[2] = lo.z; bias[3] = lo.w; bias[4] = hi.x; bias[5] = hi.y; bias[6] = hi.z; bias[7] = hi.w; }
    v4u raw[NTOK + 3];
#pragma unroll
    for (int i = 0; i < NTOK + 3; ++i) { const int tp = tp0 - 3 + i; const v4u* rp = (const v4u*)(Pb + (size_t)(unsigned)(tp < 0 ? 0 : tp) * NPROJ); raw[i] = (tp >= 0) ? (NT ? __builtin_nontemporal_load(rp) : *rp) : (v4u){0u, 0u, 0u, 0u}; }
    unsigned pkT[8][NTOK / 2];
#pragma unroll
    for (int tok = 0; tok < NTOK; ++tok) { float o[8];
#pragma unroll
        for (int c = 0; c < 8; ++c) { float v = bias[c];
#pragma unroll
            for (int q = 0; q < 4; ++q) v += w[q][c] * bfw(raw[tok + q][c >> 1], c & 1);
            o[c] = silu_f(v); }
        if (NATURAL) { v4u ov; ov.x = pk2(o[0], o[1]); ov.y = pk2(o[2], o[3]); ov.z = pk2(o[4], o[5]); ov.w = pk2(o[6], o[7]); *(LAS v4u*)(dst + tok * LDA) = ov; }
        else {
#pragma unroll
            for (int c = 0; c < 8; ++c) { const unsigned hb = f2bf(o[c] * sc[tok]); pkT[c][tok >> 1] = (tok & 1) ? (pkT[c][tok >> 1] | (hb << 16)) : hb; } } }
    if (!NATURAL) {
#pragma unroll
        for (int c = 0; c < 8; ++c) {
            if (NTOK == 8) { v4u ov; ov.x = pkT[c][0]; ov.y = pkT[c][1]; ov.z = pkT[c][NTOK == 8 ? 2 : 0]; ov.w = pkT[c][NTOK == 8 ? 3 : 0]; *(LAS v4u*)(dst + c * LDA) = ov; }
            else *(LAS unsigned long long*)(dst + c * LDA) = (unsigned long long)pkT[c][0] | ((unsigned long long)pkT[c][1] << 32); } }
}
constexpr int SC_CM = 0, SC_BM = 34816, SC_XT = 69632, SC_SIN = 87040, SC_YS = 104448, SC_ACUM = 139264, SC_DTV = 141312;
__device__ __forceinline__ void ssd_scan_dt_at(const Args& a, LAS unsigned char* lds, int acum_off, int dtv_off, size_t row0, int g, int wave, int lane) {
    LAS float* ACUM = (LAS float*)(lds + acum_off); LAS float* DTV = (LAS float*)(lds + dtv_off);
    if (wave < 4) { const float* DT = (const float*)(a.ws + WS_DT); const float A = -__expf(a.in[I_ALOG][g * 4 + wave]);
        const float d0 = DT[(row0 + 2 * lane) * 8 + g * 4 + wave], d1 = DT[(row0 + 2 * lane + 1) * 8 + g * 4 + wave];
        const float p0 = d0 * A, p1 = p0 + d1 * A; float incl = p1;
#pragma unroll
        for (int o = 1; o < 64; o <<= 1) { const float t = __shfl_up(incl, o); if (lane >= o) incl += t; }
        const float excl = incl - p1;
        ACUM[wave * 128 + 2 * lane] = excl + p0; ACUM[wave * 128 + 2 * lane + 1] = incl; DTV[wave * 128 + 2 * lane] = d0; DTV[wave * 128 + 2 * lane + 1] = d1; }
}
__device__ __forceinline__ void ssd_passA(const Args& a, LAS unsigned char* lds, int u, int tid, int wave, int lane) {
    const int bg = u >> 6, c = u & 63, b = bg >> 1, g = bg & 1, t0 = c * 128; const size_t row0 = (size_t)b * SEQ + t0;
    LAS bf16* XDT = (LAS bf16*)lds; LAS bf16* BMT = (LAS bf16*)(lds + 69632); LAS float* ACUM = (LAS float*)(lds + SD_ACUM); LAS float* DTV = (LAS float*)(lds + SD_DTV);
    ssd_scan_dt(a, lds, row0, g, wave, lane);
    __syncthreads();
#pragma unroll 1
    for (int task = tid; task < 768; task += NTHR) {
        int task_o = task; asm volatile("" : "+v"(task_o));
        const int cg = task_o >> 4, tb = task_o & 15; float sc[8];
        if (cg < 32) { const int hd = cg >> 3; const float al = ACUM[hd * 128 + 127];
#pragma unroll
            for (int i = 0; i < 8; ++i) sc[i] = DTV[hd * 128 + 8 * tb + i] * __expf(al - ACUM[hd * 128 + 8 * tb + i]);
            conv8x8<false>(a, b, t0 + 8 * tb, g * 256 + 8 * cg, XDT + (8 * cg) * LDA + 8 * tb, sc); }
        else {
#pragma unroll
            for (int i = 0; i < 8; ++i) sc[i] = 1.0f;
            conv8x8<false>(a, b, t0 + 8 * tb, 512 + g * 128 + 8 * (cg - 32), BMT + (8 * (cg - 32)) * LDA + 8 * tb, sc); }
    }
    __syncthreads();
    const int hd = wave >> 1, pt = wave & 1, hh = lane >> 5, r = lane & 31;
    float* U = (float*)(a.ws + WS_USSD) + (size_t)u * 32768;
#pragma unroll
    for (int nt = 0; nt < 4; ++nt) { f32x16 acc = zero16(); mma32(acc, XDT + (hd * 64 + 32 * pt) * LDA, LDA, BMT + 32 * nt * LDA, LDA, 8, lane);
#pragma unroll
        for (int i = 0; i < 16; ++i) U[(hd * 64 + 32 * pt + crow(i, hh)) * 128 + 32 * nt + r] = acc[i]; }
    if (tid < 4) ((float*)(a.ws + WS_DEC))[u * 4 + tid] = __expf(ACUM[tid * 128 + 127]);
    __syncthreads();
}
constexpr int S2_CM = 0, S2_CBT = 34816, S2_BUF = 55296, S2_BUFSZ = 34816, S2_BM = S2_BUF + S2_BUFSZ, S2_YS = 124928, S2_ACUM = 143360, S2_DTV = 145408;
__device__ __forceinline__ void ssd_stage_head(const Args& a, LAS unsigned char* lds, int u, int b, int g, int t0, int hd, int buf, int tid256, const float* ones) {
    LAS bf16* XT = (LAS bf16*)(lds + S2_BUF + buf * S2_BUFSZ); LAS bf16* SIN = XT + 64 * LDA;
    const int c8 = tid256 & 7, tb = tid256 >> 3;
    conv8x8<false, false, 4>(a, b, t0 + 4 * tb, g * 256 + hd * 64 + 8 * c8, XT + (8 * c8) * LDA + 4 * tb, ones);
    const v4u* src = (const v4u*)((const bf16*)(a.ws + WS_SSSD) + (size_t)u * 32768) + (unsigned)(hd * 64 * 16);
#pragma unroll
    for (int j = 0; j < 4; ++j) { const int piece = tid256 + 256 * j, pr = piece >> 4, c = piece & 15; *(LAS v4u*)(SIN + pr * LDA + 8 * c) = __builtin_nontemporal_load(src + piece); }
}
__device__ __forceinline__ void ssd_passC(const Args& a, LAS unsigned char* lds, int u, int tid, int wave, int lane) {
    const int bg = u >> 6, c = u & 63, b = bg >> 1, g = bg & 1, t0 = c * 128; const size_t row0 = (size_t)b * SEQ + t0;
    LAS bf16* CM = (LAS bf16*)(lds + S2_CM); LAS bf16* BM = (LAS bf16*)(lds + S2_BM); LAS unsigned char* CBT = lds + S2_CBT;
    LAS bf16* YS = (LAS bf16*)(lds + S2_YS); LAS float* ACUM = (LAS float*)(lds + S2_ACUM); LAS float* DTV = (LAS float*)(lds + S2_DTV);
    const bf16* P = (const bf16*)(a.ws + WS_P); bf16* MIX = (bf16*)(a.ws + WS_MIX);
    float ones[4];
#pragma unroll
    for (int i = 0; i < 4; ++i) ones[i] = 1.0f;
    ssd_scan_dt_at(a, lds, S2_ACUM, S2_DTV, row0, g, wave, lane);
    { const int c8 = tid & 31, tb = tid >> 5;
      conv8x8<true>(a, b, t0 + 8 * tb, (c8 < 16) ? (512 + g * 128 + 8 * c8) : (768 + g * 128 + 8 * (c8 - 16)), ((c8 < 16) ? (BM + 8 * c8) : (CM + 8 * (c8 - 16))) + 8 * tb * LDA, nullptr); }
    __syncthreads();
    for (int idx = wave; idx < 10; idx += NWAVES) { const int ti = (idx >= 6) ? 3 : (idx >= 3) ? 2 : (idx >= 1) ? 1 : 0, si = idx - ti * (ti + 1) / 2;
        f32x16 cbT = zero16(); mma32(cbT, BM + 32 * si * LDA, LDA, CM + 32 * ti * LDA, LDA, 8, lane);
        v4u o0, o1; o0.x = pk2(cbT[0], cbT[1]); o0.y = pk2(cbT[2], cbT[3]); o0.z = pk2(cbT[4], cbT[5]); o0.w = pk2(cbT[6], cbT[7]); o1.x = pk2(cbT[8], cbT[9]); o1.y = pk2(cbT[10], cbT[11]); o1.z = pk2(cbT[12], cbT[13]); o1.w = pk2(cbT[14], cbT[15]);
        *(LAS v4u*)(CBT + idx * 2048 + lane * 32) = o0; *(LAS v4u*)(CBT + idx * 2048 + lane * 32 + 16) = o1; }
    if (tid < 256) ssd_stage_head(a, lds, u, b, g, t0, 0, 0, tid, ones);
    __syncthreads();
    const int ti = wave >> 1, pj = wave & 1;
    const int et = tid >> 2, epq = tid & 3;
    float ssq = 0.f;
    const bf16* Pz = P + (row0 + et) * NPROJ + PC_Z + g * 256 + 16 * epq;
    bf16* Mo = MIX + (row0 + et) * D + 512 + g * 256 + 16 * epq;
#pragma unroll 1
    for (int hd = 0; hd < 4; ++hd) {
        int tid_o = tid; asm volatile("" : "+v"(tid_o));
        const int lane = tid_o & 63, hh = lane >> 5, r = lane & 31;
        const LAS bf16* XT = (const LAS bf16*)(lds + S2_BUF + (hd & 1) * S2_BUFSZ); const LAS bf16* SIN = XT + 64 * LDA;
        const v4u z0 = __builtin_nontemporal_load((const v4u*)(Pz + hd * 64)), z1 = __builtin_nontemporal_load((const v4u*)(Pz + hd * 64 + 8));
        const float Dh = a.in[I_SSMD][g * 4 + hd];
        f32x16 yi = zero16(), yo = zero16();
        const int t = 32 * ti + r; const float at = ACUM[hd * 128 + t];
        for (int si = 0; si <= ti; ++si) {
            const LAS unsigned char* cp = CBT + (ti * (ti + 1) / 2 + si) * 2048 + lane * 32; const v4u c0 = *(const LAS v4u*)cp, c1 = *(const LAS v4u*)(cp + 16);
            const unsigned cw[8] = {c0.x, c0.y, c0.z, c0.w, c1.x, c1.y, c1.z, c1.w};
            float sv[16];
#pragma unroll
            for (int i = 0; i < 16; ++i) { const int s = 32 * si + crow(i, hh); float v = (s <= t) ? bfw(cw[i >> 1], i & 1) * __expf(at - ACUM[hd * 128 + s]) * DTV[hd * 128 + s] : 0.f; sv[i] = (s == t) ? v + Dh : v; }
#pragma unroll
            for (int st = 0; st < 2; ++st) {
                v4u av; av.x = pk2(sv[8 * st], sv[8 * st + 1]); av.y = pk2(sv[8 * st + 2], sv[8 * st + 3]); av.z = pk2(sv[8 * st + 4], sv[8 * st + 5]); av.w = pk2(sv[8 * st + 6], sv[8 * st + 7]);
                const LAS bf16* bp = XT + (32 * pj + r) * LDA + 32 * si + 16 * st + 4 * hh;
                const unsigned long long b0 = *(const LAS unsigned long long*)bp, b1 = *(const LAS unsigned long long*)(bp + 8);
                v4u bv; bv.x = (unsigned)b0; bv.y = (unsigned)(b0 >> 32); bv.z = (unsigned)b1; bv.w = (unsigned)(b1 >> 32);
                yi = __builtin_amdgcn_mfma_f32_32x32x16_bf16(__builtin_bit_cast(bf16x8, av), __builtin_bit_cast(bf16x8, bv), yi, 0, 0, 0);
            }
        }
        mma32(yo, CM + 32 * ti * LDA, LDA, SIN + 32 * pj * LDA, LDA, 8, lane);
#pragma unroll
        for (int i = 0; i < 16; ++i) { const int tt = 32 * ti + crow(i, hh); YS[tt * 72 + 32 * pj + r] = (bf16)f2bf(yi[i] + __expf(ACUM[hd * 128 + tt]) * yo[i]); }
        if (tid_o < 256 && hd < 3) ssd_stage_head(a, lds, u, b, g, t0, hd + 1, (hd + 1) & 1, tid_o, ones);
        __syncthreads();
        { const LAS v4u* yp = (const LAS v4u*)(YS + et * 72 + 16 * epq); const v4u y0 = yp[0], y1 = yp[1];
          const unsigned yw[8] = {y0.x, y0.y, y0.z, y0.w, y1.x, y1.y, y1.z, y1.w}, zw[8] = {z0.x, z0.y, z0.z, z0.w, z1.x, z1.y, z1.z, z1.w};
          float y[16];
#pragma unroll
          for (int j = 0; j < 16; ++j) { y[j] = bfw(yw[j >> 1], j & 1) * bfw(zw[j >> 1], j & 1); ssq += y[j] * y[j]; }
          v4u o0, o1; o0.x = pk2(y[0], y[1]); o0.y = pk2(y[2], y[3]); o0.z = pk2(y[4], y[5]); o0.w = pk2(y[6], y[7]); o1.x = pk2(y[8], y[9]); o1.y = pk2(y[10], y[11]); o1.z = pk2(y[12], y[13]); o1.w = pk2(y[14], y[15]);
          *(v4u*)(Mo + hd * 64) = o0; *(v4u*)(Mo + hd * 64 + 8) = o1; }
        __syncthreads();
    }
    ssq += __shfl_xor(ssq, 1); ssq += __shfl_xor(ssq, 2);
    const float rstd = rsqrtf(ssq * (1.0f / 256.0f) + EPS);
    const float* nw = a.in[I_SSMNW] + g * 256 + 16 * epq;
#pragma unroll 1
    for (int hd = 0; hd < 4; ++hd) {
        const v4u i0 = *(const v4u*)(Mo + hd * 64), i1 = *(const v4u*)(Mo + hd * 64 + 8); const unsigned iw[8] = {i0.x, i0.y, i0.z, i0.w, i1.x, i1.y, i1.z, i1.w};
        float wv[16];
#pragma unroll
        for (int q = 0; q < 4; ++q) { const f32x4 v = *(const f32x4*)(nw + hd * 64 + 4 * q); wv[4 * q] = v.x; wv[4 * q + 1] = v.y; wv[4 * q + 2] = v.z; wv[4 * q + 3] = v.w; }
        unsigned ow[8];
#pragma unroll
        for (int j = 0; j < 8; ++j) ow[j] = pk2(bfw(iw[j], 0) * rstd * wv[2 * j], bfw(iw[j], 1) * rstd * wv[2 * j + 1]);
        *(v4u*)(Mo + hd * 64) = (v4u){ow[0], ow[1], ow[2], ow[3]}; *(v4u*)(Mo + hd * 64 + 8) = (v4u){ow[4], ow[5], ow[6], ow[7]};
    }
    __syncthreads();
}
__device__ __forceinline__ void mix_scan(const Args& a, int bid, int G, int tid) {
    typedef float f32x2 __attribute__((ext_vector_type(2)));
    for (int gt = bid * NTHR + tid; gt < 131072; gt += G * NTHR) {
        if (gt < 65536) { const int bh = gt >> 13, e2 = gt & 8191, k = e2 >> 6;
            const f32x2* U = (const f32x2*)(a.ws + WS_UHG) + (size_t)bh * 32 * 8192 + e2; f32x2* SI = (f32x2*)(a.ws + WS_SHG) + (size_t)bh * 32 * 8192 + e2; const float* DK = (const float*)(a.ws + WS_DK) + bh * 32 * 128 + k;
            f32x2 cur = {0.f, 0.f};
#pragma unroll 16
            for (int uu = 0; uu < 32; ++uu) { SI[(size_t)uu * 8192] = cur; cur = cur * DK[uu * 128] + __builtin_nontemporal_load(U + (size_t)uu * 8192); }
        } else { const int q = gt - 65536, bg = q >> 14, e2 = q & 16383, hd = e2 >> 12;
            const f32x2* U = (const f32x2*)(a.ws + WS_USSD) + (size_t)bg * 64 * 16384 + e2; unsigned* SI = (unsigned*)(a.ws + WS_SSSD) + (size_t)bg * 64 * 16384 + e2; const float* DEC = (const float*)(a.ws + WS_DEC) + bg * 64 * 4 + hd;
            f32x2 cur = {0.f, 0.f};
#pragma unroll 16
            for (int cc = 0; cc < 64; ++cc) { SI[(size_t)cc * 16384] = pk2(cur.x, cur.y); cur = cur * DEC[cc * 4] + __builtin_nontemporal_load(U + (size_t)cc * 16384); }
        }
    }
}

template <int HALF, int MASK> __device__ __forceinline__ void tr_step(float (&p)[32], int lane) {
    const bool up = (lane & MASK) != 0;
#pragma unroll
    for (int i = 0; i < HALF; ++i) { const float lo = p[i], hi = p[i + HALF]; const float send = up ? lo : hi, keep = up ? hi : lo; p[i] = keep + __shfl_xor(send, MASK); }
}
__device__ __forceinline__ void top4_store(float v, int lane, LAS int* SEL, LAS float* SELG, int ent) {
    float tv[4]; int ti[4];
#pragma unroll
    for (int k = 0; k < 4; ++k) { const float mx = wave_max(v); const unsigned long long bal = __ballot(v == mx); const int e = __builtin_ctzll(bal) >> 1;
        tv[k] = mx; ti[k] = e; v = ((lane >> 1) == e) ? -INFINITY : v; }
    const float e1 = __expf(tv[1] - tv[0]), e2 = __expf(tv[2] - tv[0]), e3 = __expf(tv[3] - tv[0]), inv = 1.0f / (1.0f + e1 + e2 + e3);
    if (lane < 4) { SEL[ent + lane] = (lane == 0) ? ti[0] : (lane == 1) ? ti[1] : (lane == 2) ? ti[2] : ti[3];
        SELG[ent + lane] = ((lane == 0) ? 1.0f : (lane == 1) ? e1 : (lane == 2) ? e2 : e3) * inv; }
}
constexpr int RT_WB = 0, RT_HB = 66048, RT_PITCH = 1032;
__device__ __forceinline__ void p5_router(const Args& a, LAS unsigned char* lds, int bid, int G, int tid, int wave, int lane) {
    unsigned char* ws = a.ws;
    LAS bf16* WB = (LAS bf16*)(lds + RT_WB); LAS bf16* HB = (LAS bf16*)(lds + RT_HB); LAS float* PART = (LAS float*)(lds + RT_HB);
    LAS float* A2 = (LAS float*)(lds + AUX_OFF + 1024); LAS float* S2 = A2 + 1024;
    LAS float* SELG = (LAS float*)(S2 + 1024); LAS float* LOGIT = SELG + 256;
    LAS int* SEL = (LAS int*)(lds + MISC_OFF + 2048); LAS int* LSL = SEL + 256;
    const float* modf = (const float*)(ws + WS_MODF);
    { const f32x4* rw4 = (const f32x4*)a.in[I_RW];
#pragma unroll 4
      for (int it = 0; it < 16; ++it) { const int q = tid + NTHR * it, k = q >> 3, e0 = (q & 7) * 4; const f32x4 w = rw4[q];
          WB[(e0 + 0) * RT_PITCH + k] = (bf16)f2bf(w.x); WB[(e0 + 1) * RT_PITCH + k] = (bf16)f2bf(w.y); WB[(e0 + 2) * RT_PITCH + k] = (bf16)f2bf(w.z); WB[(e0 + 3) * RT_PITCH + k] = (bf16)f2bf(w.w); } }
    const bf16* x1 = (const bf16*)(ws + WS_X1); bf16* H = (bf16*)(ws + WS_H);
    int* tok_e = (int*)(ws + WS_TOK); int* tok_ls = tok_e + M * 4; float* tok_g = (float*)(tok_ls + M * 4);
    int* blkcnt = (int*)(ws + WS_BLKCNT);
    for (int c = bid; c < NCHUNK; c += G) {
        const int b = c >> 7;
        __syncthreads();
        load_mod_AS(A2, S2, a.in[I_N2W], modf, 1, nullptr, b, 3 * 1024, tid);
        __syncthreads();
        unsigned long long hb[8][4];
        unsigned long long rwa[4];
        { const GAS unsigned long long* xa = (const GAS unsigned long long*)(x1 + (size_t)(c * 64 + wave * 8) * D) + lane;
#pragma unroll
          for (int j = 0; j < 4; ++j) rwa[j] = xa[64 * j]; }
#pragma unroll
        for (int r = 0; r < 8; ++r) {
            const int m0 = c * 64 + wave * 8 + r;
            f32x4 va[4]; float sa = 0.f;
#pragma unroll
            for (int j = 0; j < 4; ++j) { const unsigned long long wa = rwa[j];
                va[j] = (f32x4){bfw((unsigned)wa, 0), bfw((unsigned)wa, 1), bfw((unsigned)(wa >> 32), 0), bfw((unsigned)(wa >> 32), 1)};
                sa += (va[j].x * va[j].x + va[j].y * va[j].y) + (va[j].z * va[j].z + va[j].w * va[j].w); }
            if (r < 7) { const GAS unsigned long long* xa = (const GAS unsigned long long*)(x1 + (size_t)(m0 + 1) * D) + lane;
#pragma unroll
                for (int j = 0; j < 4; ++j) rwa[j] = xa[64 * j]; }
            const float ra = rsqrtf(wave_sum(sa) * (1.0f / D) + EPS);
#pragma unroll
            for (int j = 0; j < 4; ++j) {
                const f32x4 av = *(const LAS f32x4*)(A2 + 256 * j + 4 * lane), sv = *(const LAS f32x4*)(S2 + 256 * j + 4 * lane);
                const f32x4 h = va[j] * ra * av + sv;
#if MOE_FP8_G1
                ((GAS unsigned*)((unsigned char*)H + (size_t)m0 * D))[lane + 64 * j] = pk4_fp8(h.x * 8.f, h.y * 8.f, h.z * 8.f, h.w * 8.f);
#else
                ((GAS unsigned long long*)(H + (size_t)m0 * D))[lane + 64 * j] = (unsigned long long)pk2(h.x, h.y) | ((unsigned long long)pk2(h.z, h.w) << 32);
#endif
                hb[r][j] = (unsigned long long)pk2(h.x, h.y) | ((unsigned long long)pk2(h.z, h.w) << 32);
            }
        }
#pragma unroll
        for (int pass = 0; pass < 2; ++pass) {
            if ((wave >> 2) == pass) {
#pragma unroll
                for (int r = 0; r < 8; ++r)
#pragma unroll
                    for (int j = 0; j < 4; ++j) *(LAS unsigned long long*)(HB + ((wave & 3) * 8 + r) * RT_PITCH + 256 * j + 4 * lane) = hb[r][j]; }
            __syncthreads();
            f32x16 acc = zero16(); mma32(acc, HB + 128 * wave, RT_PITCH, WB + 128 * wave, RT_PITCH, 8, lane);
            __syncthreads();
#pragma unroll
            for (int i = 0; i < 16; ++i) PART[wave * 1024 + crow(i, lane >> 5) * 32 + (lane & 31)] = acc[i];
            __syncthreads();
#pragma unroll
            for (int q = 0; q < 2; ++q) { const int el = tid + NTHR * q; float sacc = 0.f;
#pragma unroll
                for (int w = 0; w < 8; ++w) sacc += PART[w * 1024 + el];
                LOGIT[(el >> 5) * 33 + (el & 31)] = sacc + a.in[I_RB][el & 31]; }
            __syncthreads();
            if (tid < 32) {
                float v[32];
#pragma unroll
                for (int e = 0; e < 32; ++e) v[e] = LOGIT[tid * 33 + e];
                float tv[4]; int ti[4];
#pragma unroll
                for (int k = 0; k < 4; ++k) { float best = v[0]; int bi = 0;
#pragma unroll
                    for (int e = 1; e < 32; ++e) { const bool gt = v[e] > best; best = gt ? v[e] : best; bi = gt ? e : bi; }
                    tv[k] = best; ti[k] = bi;
#pragma unroll
                    for (int e = 0; e < 32; ++e) v[e] = (e == bi) ? -INFINITY : v[e]; }
                const float e1 = __expf(tv[1] - tv[0]), e2 = __expf(tv[2] - tv[0]), e3 = __expf(tv[3] - tv[0]), inv = 1.0f / (1.0f + e1 + e2 + e3);
                const int ent = (32 * pass + tid) * 4;
                SEL[ent] = ti[0]; SEL[ent + 1] = ti[1]; SEL[ent + 2] = ti[2]; SEL[ent + 3] = ti[3];
                SELG[ent] = inv; SELG[ent + 1] = e1 * inv; SELG[ent + 2] = e2 * inv; SELG[ent + 3] = e3 * inv; }
        }
        __syncthreads();
        if (tid < 256 + 32) {
            const int mye = (tid < 256) ? SEL[tid] : (tid - 256), lim = (tid < 256) ? tid : 256; int cnt = 0;
#pragma unroll 4
            for (int j4 = 0; j4 < 64; ++j4) { const LAS int* sp = SEL + 4 * j4; const int s0 = sp[0], s1 = sp[1], s2 = sp[2], s3 = sp[3];
                cnt += (s0 == mye && 4 * j4 < lim) + (s1 == mye && 4 * j4 + 1 < lim) + (s2 == mye && 4 * j4 + 2 < lim) + (s3 == mye && 4 * j4 + 3 < lim); }
            if (tid < 256) LSL[tid] = cnt; else blkcnt[c * 32 + tid - 256] = cnt; }
        __syncthreads();
        if (tid < 256) { const size_t o = (size_t)c * 256 + tid; tok_e[o] = SEL[tid]; tok_ls[o] = LSL[tid]; tok_g[o] = SELG[tid]; }
    }
}

__device__ __forceinline__ void moe_tables(const Args& a, LAS unsigned char* lds, int c, int tid, int wave, int lane) {
    LAS int* TS = (LAS int*)(lds + MISC_OFF + 256); LAS int* RT2E = TS + 64; LAS int* BASE = (LAS int*)(lds + AUX_OFF); LAS int* PART = BASE + 64;
    const int* blkcnt = (const int*)(a.ws + WS_BLKCNT);
    { const int e = tid & 31, part = tid >> 5; int tot = 0, bs = 0;
#pragma unroll
      for (int i = 0; i < 16; ++i) { const int cc = part * 16 + i; const int v = blkcnt[cc * 32 + e]; tot += v; bs += (cc < c) ? v : 0; }
      PART[part * 32 + e] = tot; PART[512 + part * 32 + e] = bs; }
    __syncthreads();
    if (wave == 0) {
        int total = 0, base = 0;
        if (lane < 32) {
#pragma unroll
            for (int p = 0; p < 16; ++p) { total += PART[p * 32 + lane]; base += PART[512 + p * 32 + lane]; } }
        const int tiles = (lane < 32) ? ((total + 255) >> 8) : 0;
        int incl = tiles;
#pragma unroll
        for (int o = 1; o < 32; o <<= 1) { const int t = __shfl_up(incl, o); if (lane >= o) incl += t; }
        const int start = incl - tiles;
        if (lane < 32) { TS[lane] = start; BASE[lane] = start * 256 + base; for (int t = start; t < incl; ++t) RT2E[t] = lane; }
        if (lane == 31) TS[32] = incl;
    }
    __syncthreads();
}
__device__ __forceinline__ void p6_gather(const Args& a, LAS unsigned char* lds, int bid, int G, int tid, int wave, int lane) {
    unsigned char* ws = a.ws;
    LAS int* BASE = (LAS int*)(lds + AUX_OFF);
    const int* tok_e = (const int*)(ws + WS_TOK); const int* tok_ls = tok_e + M * 4; int* tok_pos = (int*)(ws + WS_TOK) + 3 * M * 4;
    const bf16* H = (const bf16*)(ws + WS_H); bf16* XG = (bf16*)(ws + WS_XG);
    if (bid >= NCHUNK) moe_tables(a, lds, NCHUNK, tid, wave, lane);
    for (int c = bid; c < NCHUNK; c += G) {
        __syncthreads();
        moe_tables(a, lds, c, tid, wave, lane);
        for (int i = wave; i < 256; i += NWAVES) {
            const size_t o = (size_t)c * 256 + i; const int e = tok_e[o]; const int pos = BASE[e] + tok_ls[o];
            if (lane == 0) tok_pos[o] = pos;
#if MOE_FP8_G1
            const GAS v4u* src = (const GAS v4u*)((const unsigned char*)H + (size_t)(c * 64 + (i >> 2)) * D); GAS v4u* dst = (GAS v4u*)((unsigned char*)XG + (size_t)pos * D);
            dst[lane] = src[lane];
#else
            const GAS v4u* src = (const GAS v4u*)(H + (size_t)(c * 64 + (i >> 2)) * D); GAS v4u* dst = (GAS v4u*)(XG + (size_t)pos * D);
            dst[lane] = src[lane]; dst[64 + lane] = src[64 + lane];
#endif
        }
    }
}

__device__ __forceinline__ void p9_final(const Args& a, int bid, int G, int wave, int lane) {
    unsigned char* ws = a.ws;
    const bf16* x1 = (const bf16*)(ws + WS_X1); const bf16* Y = (const bf16*)(ws + WS_XG);
    const float* tok_g = (const float*)(ws + WS_TOK) + 2 * M * 4; const int* tok_pos = (const int*)(ws + WS_TOK) + 3 * M * 4;
    const float* modf = (const float*)(ws + WS_MODF); const float* fnw = a.in[I_FNW]; float* out = a.out;
    const int gw = bid * NWAVES + wave, NGW = G * NWAVES;
    int pos_n[4]; float gk_n[4];
    if (gw < M) {
#pragma unroll
        for (int k = 0; k < 4; ++k) { pos_n[k] = tok_pos[(size_t)gw * 4 + k]; gk_n[k] = tok_g[(size_t)gw * 4 + k]; } }
#pragma unroll 1
    for (int m = gw; m < M; m += NGW) {
        const int b = m >> 13; const float* g2 = modf + b * 6144 + 5 * 1024;
        int posv[4]; float gkv[4];
#pragma unroll
        for (int k = 0; k < 4; ++k) { posv[k] = pos_n[k]; gkv[k] = gk_n[k]; }
        if (m + NGW < M) {
#pragma unroll
            for (int k = 0; k < 4; ++k) { pos_n[k] = tok_pos[(size_t)(m + NGW) * 4 + k]; gk_n[k] = tok_g[(size_t)(m + NGW) * 4 + k]; } }
        f32x4 mo[4];
#pragma unroll
        for (int j = 0; j < 4; ++j) mo[j] = (f32x4){0.f, 0.f, 0.f, 0.f};
#pragma unroll
        for (int k = 0; k < 4; ++k) { const int pos = posv[k];
#if Y_FP8
            const float gk = gkv[k] * 0.125f;
            const GAS unsigned* yr = (const GAS unsigned*)((const unsigned char*)Y + (size_t)pos * D) + lane;
#pragma unroll
            for (int j = 0; j < 4; ++j) { const int w = (int)__builtin_nontemporal_load((const unsigned*)yr + 64 * j); typedef float f32x2 __attribute__((ext_vector_type(2)));
                const f32x2 lo = __builtin_amdgcn_cvt_pk_f32_fp8(w, false), hi = __builtin_amdgcn_cvt_pk_f32_fp8(w, true);
                mo[j].x += gk * lo.x; mo[j].y += gk * lo.y; mo[j].z += gk * hi.x; mo[j].w += gk * hi.y; }
#else
            const float gk = gkv[k];
            const GAS unsigned long long* yr = (const GAS unsigned long long*)(Y + (size_t)pos * D) + lane;
#pragma unroll
            for (int j = 0; j < 4; ++j) { const unsigned long long w = yr[64 * j]; const unsigned lo = (unsigned)w, hi = (unsigned)(w >> 32);
                mo[j].x += gk * __uint_as_float(lo << 16); mo[j].y += gk * __uint_as_float(lo & 0xffff0000u); mo[j].z += gk * __uint_as_float(hi << 16); mo[j].w += gk * __uint_as_float(hi & 0xffff0000u); }
#endif
        }
        const GAS unsigned long long* xr = (const GAS unsigned long long*)(x1 + (size_t)m * D) + lane;
        f32x4 v[4]; float ss = 0.f;
#pragma unroll
        for (int j = 0; j < 4; ++j) { const f32x4 gv = *(const f32x4*)(g2 + 256 * j + 4 * lane); const unsigned long long xw = __builtin_nontemporal_load((const unsigned long long*)xr + 64 * j);
            v[j] = (f32x4){bfw((unsigned)xw, 0), bfw((unsigned)xw, 1), bfw((unsigned)(xw >> 32), 0), bfw((unsigned)(xw >> 32), 1)} + gv * mo[j]; ss += (v[j].x * v[j].x + v[j].y * v[j].y) + (v[j].z * v[j].z + v[j].w * v[j].w); }
        const float rstd = rsqrtf(wave_sum(ss) * (1.0f / D) + EPS);
        GAS f32x4* orow = (GAS f32x4*)(out + (size_t)m * D) + lane;
#pragma unroll
        for (int j = 0; j < 4; ++j) { const f32x4 wv = *(const f32x4*)(fnw + 256 * j + 4 * lane); __builtin_nontemporal_store(v[j] * rstd * wv, (f32x4*)(out + (size_t)m * D) + lane + 64 * j); }
    }
}

#ifndef REP_MASK
#define REP_MASK 0
#endif
#define NREP(k) (((REP_MASK) >> (k)) & 1 ? 2 : 1)
#define REPB(k, rr) do { if ((rr) + 1 < NREP(k) && multi) { if ((k) >= 9) { LANE_TID(); xcd_barrier(bar, tid == 0); } else xcd_barrier(bar, tid == 0); } } while (0)
#ifndef SKEW_TICKS
#define SKEW_TICKS 0
#endif
#define PHASE_SKEW() do { if (SKEW_TICKS > 0) { const unsigned long long t0_ = __builtin_amdgcn_s_memrealtime(), w_ = (unsigned long long)(bid & 3) * SKEW_TICKS; while (__builtin_amdgcn_s_memrealtime() - t0_ < w_) __builtin_amdgcn_s_sleep(2); } } while (0)
#ifndef HG_CHUNKED
#define HG_CHUNKED 1
#endif
#ifndef SSD_CHUNKED
#define SSD_CHUNKED 1
#endif
constexpr int NPHASE = 12;
__global__ void __launch_bounds__(NTHR, 2) mk_fwd(Args args) {
    extern __shared__ __attribute__((aligned(16))) unsigned char lds_raw[];
    LAS unsigned char* lds = (LAS unsigned char*)lds_raw;
    const int tid = threadIdx.x, lane = tid & 63, wave = __builtin_amdgcn_readfirstlane(tid >> 6); __builtin_assume(wave >= 0 && wave < 8);
#define LANE_TID() int lane; asm volatile("v_mbcnt_lo_u32_b32 %0, -1, 0\n\tv_mbcnt_hi_u32_b32 %0, -1, %0" : "=v"(lane)); __builtin_assume(lane >= 0 && lane < 64); const int tid = wave * 64 + lane; (void)tid
    const int G = gridDim.x, bid = blockIdx.x;
    unsigned char* ws = args.ws;
    gu32* ctl = (gu32*)(ws + WS_CTL);
    volatile LAS unsigned* MISC = (volatile LAS unsigned*)(lds + MISC_OFF);
    if (tid < 64) MISC[tid] = 0u;
    __syncthreads();
    const int lo = args.ph_lo, hi = args.ph_hi;
    const bool multi = (hi - lo) > 1;
    XcdBarrier bar; bar.bar = (unsigned*)(ctl + CW_BAR); bar.x = 0; bar.st = nullptr;
    if (multi) bar = xcd_barrier_post((unsigned*)(ctl + CW_BAR), MISC + 8, tid == 0);
#define IN(k) (lo <= (k) && (k) < hi)
#ifdef PROBE_A
#ifndef PROBE_BUSY
#define PROBE_BUSY 0
#endif
#define STAMP(k) do { int tid_s; if ((k) >= 9) { LANE_TID(); tid_s = tid; } else tid_s = tid; if (tid_s == 0) { const unsigned long long t_ = __builtin_amdgcn_s_memrealtime(); MISC[16 + 2 * (k)] = (unsigned)t_; MISC[17 + 2 * (k)] = (unsigned)(t_ >> 32); } } while (0)
#define ARRIVE(k) do { int tid_s; if ((k) >= 9) { LANE_TID(); tid_s = tid; } else tid_s = tid; if (tid_s == 0 && (k) == PROBE_A) { const unsigned long long t_ = __builtin_amdgcn_s_memrealtime(); const unsigned long long s_ = ((unsigned long long)MISC[17 + 2 * (k)] << 32) | MISC[16 + 2 * (k)]; \
    const unsigned busy = (unsigned)(t_ - s_); atomicMax((unsigned*)ctl + 3000, busy); atomicAdd((unsigned*)ctl + 3064, busy); } } while (0)
#else
#define STAMP(k) do { } while (0)
#define ARRIVE(k) do { } while (0)
#endif
#define SEAM(k) do { ARRIVE(k); if (IN(k) && IN((k) + 1)) { if ((k) >= 8) { LANE_TID(); xcd_barrier(bar, tid == 0); } else xcd_barrier(bar, tid == 0); } STAMP((k) + 1); } while (0)

    STAMP(0);
    if (IN(0)) { for (int rr_ = 0; rr_ < NREP(0); ++rr_) { p0_prologue(args, lds, bid, G, tid, wave, lane);  REPB(0, rr_); } } SEAM(0);
    if (IN(1)) { for (int rr_ = 0; rr_ < NREP(1); ++rr_) { p1_norm(args, lds, bid, G, tid, wave, lane);  REPB(1, rr_); } } SEAM(1);
    if (IN(2)) { for (int rr_ = 0; rr_ < NREP(2); ++rr_) {
        pg8::Gemm g{(const pg8::bf16_t*)(ws + WS_H), (const pg8::bf16_t*)(ws + WS_WIN), M, NPROJ, D}; pg8::StaticOrder S; S.init(M, NPROJ, G, bid);
        pg8::EpiIn E{(pg8::bf16_t*)(ws + WS_P), (float*)(ws + WS_LF), args.in[I_LBL]};
#ifdef PROBE_G
        if (threadIdx.x == 0) MISC[61] = (PROBE_G == 2) ? 1u : 0u; __syncthreads();
#endif
        pg8::gemm_phase<pg8::EpiIn, pg8::StaticOrder, true, true>(lds, g, S, E, wave);
        __syncthreads(); p0_bg_items(args, lds, bid, G, tid, wave, lane);
     REPB(2, rr_); } } SEAM(2);
    if (IN(3)) { for (int rr_ = 0; rr_ < NREP(3); ++rr_) {
        for (int u = bid; u < 256; u += G) {
            __syncthreads();
#if HG_CHUNKED
            hg_passA(args, lds, u, tid, wave, lane);
            STAMP(14);
#endif
            __syncthreads();
#if SSD_CHUNKED
            ssd_passA(args, lds, u, tid, wave, lane);
#endif
        }
     REPB(3, rr_); } } SEAM(3);
    if (IN(4)) { for (int rr_ = 0; rr_ < NREP(4); ++rr_) { mix_scan(args, bid, G, tid);  REPB(4, rr_); } } SEAM(4);
    if (IN(5)) { for (int rr_ = 0; rr_ < NREP(5); ++rr_) {
        for (int u = bid; u < 256; u += G) {
            __syncthreads();
#if HG_CHUNKED
            hg_passC(args, lds, u, tid, wave, lane);
            STAMP(13);
#else
            if (u < 8) hgrn_naive(args, lds, u, tid, wave, lane);
#endif
            __syncthreads();
#if SSD_CHUNKED
            ssd_passC(args, lds, u, tid, wave, lane);
#else
            if (u >= 8 && u < 12) ssd_naive(args, lds, u - 8, tid, wave, lane);
#endif
        }
     REPB(5, rr_); } } SEAM(5);
    if (IN(6)) { for (int rr_ = 0; rr_ < NREP(6); ++rr_) {
        pg8::Gemm g{(const pg8::bf16_t*)(ws + WS_MIX), (const pg8::bf16_t*)(ws + WS_WOUT), M, D, D}; pg8::StaticOrder S; S.init(M, D, G, bid);
        pg8::EpiOut E{args.in[I_X], (pg8::bf16_t*)(ws + WS_X1), (const float*)(ws + WS_MODF) + 2 * 1024};
#ifdef PROBE_G
        if (threadIdx.x == 0) MISC[61] = (PROBE_G == 6) ? 1u : 0u; __syncthreads();
#endif
        pg8::gemm_phase<pg8::EpiOut, pg8::StaticOrder, true, true>(lds, g, S, E, wave);
     REPB(6, rr_); } } SEAM(6);
    if (IN(7)) { for (int rr_ = 0; rr_ < NREP(7); ++rr_) { p5_router(args, lds, bid, G, tid, wave, lane);  REPB(7, rr_); } } SEAM(7);
    if (IN(8)) { for (int rr_ = 0; rr_ < NREP(8); ++rr_) { p6_gather(args, lds, bid, G, tid, wave, lane);  REPB(8, rr_); } } SEAM(8);
    if (IN(9) || IN(10)) {
        if (!IN(8)) { LANE_TID(); moe_tables(args, lds, NCHUNK, tid, wave, lane); }
        const PG8_LAS int* TS = (const PG8_LAS int*)(lds + MISC_OFF + 256);
        const int R = __builtin_amdgcn_readfirstlane(TS[32]);
        int kmoe1 = MOE_FP8_G1 ? D / 2 : D, kmoe2 = MOE_FP8_G2 ? D / 2 : D; asm volatile("" : "+s"(kmoe1), "+s"(kmoe2));
        if (IN(9)) { for (int rr_ = 0; rr_ < NREP(9); ++rr_) { LANE_TID();
            pg8::Gemm g{(const pg8::bf16_t*)(ws + WS_XG), (const pg8::bf16_t*)(ws + WS_W1), R * 256, 2048, kmoe1};
            PHASE_SKEW();
            pg8::MoeOrder S{TS + 64, 8, R * 8, G, bid};
            pg8::EpiW1<MOE_FP8_G1 != 0, MOE_FP8_G2 != 0> E{(void*)(ws + WS_ACT), args.in[I_B1]};
#ifdef PROBE_G
        if (threadIdx.x == 0) MISC[61] = (PROBE_G == 9) ? 1u : 0u; __syncthreads();
#endif
            pg8::gemm_phase<pg8::EpiW1<MOE_FP8_G1 != 0, MOE_FP8_G2 != 0>, pg8::MoeOrder, true, true, MOE_FP8_G1 != 0>(lds, g, S, E, wave);
         REPB(9, rr_); } }
        SEAM(9);
        if (IN(10)) { for (int rr_ = 0; rr_ < NREP(10); ++rr_) { LANE_TID();
            pg8::Gemm g{(const pg8::bf16_t*)(ws + WS_ACT), (const pg8::bf16_t*)(ws + WS_W2), R * 256, 1024, kmoe2};
            PHASE_SKEW();
            pg8::MoeOrder S{TS + 64, 4, R * 4, G, bid};
            pg8::EpiW2<Y_FP8 != 0> E{(void*)(ws + WS_XG), args.in[I_B2], MOE_FP8_G2 ? (1.0f / 512.0f) : 1.0f};
#ifdef PROBE_G
        if (threadIdx.x == 0) MISC[61] = (PROBE_G == 10) ? 1u : 0u; __syncthreads();
#endif
            pg8::gemm_phase<pg8::EpiW2<Y_FP8 != 0>, pg8::MoeOrder, true, true, MOE_FP8_G2 != 0>(lds, g, S, E, wave);
         REPB(10, rr_); } }
    }
    SEAM(10);
    if (IN(11)) { for (int rr_ = 0; rr_ < NREP(11); ++rr_) { LANE_TID(); p9_final(args, bid, G, wave, lane);  REPB(11, rr_); } }
#ifdef PROBE_A
    STAMP(12);
    int lpr_; asm volatile("v_mbcnt_lo_u32_b32 %0, -1, 0\n\tv_mbcnt_hi_u32_b32 %0, -1, %0" : "=v"(lpr_)); if (bid == 0 && wave == 0 && lpr_ == 0) {
        const unsigned long long mx = __hip_atomic_load((unsigned*)ctl + 3000, __ATOMIC_RELAXED, __HIP_MEMORY_SCOPE_AGENT);
        const unsigned long long sp = ((((unsigned long long)MISC[17 + 2 * (PROBE_A + 1)] << 32) | MISC[16 + 2 * (PROBE_A + 1)]) - (((unsigned long long)MISC[17 + 2 * PROBE_A] << 32) | MISC[16 + 2 * PROBE_A]));
#ifndef PROBE_B
#define PROBE_B (PROBE_A + 1)
#endif
        const unsigned long long sp2 = ((((unsigned long long)MISC[17 + 2 * (PROBE_B)] << 32) | MISC[16 + 2 * (PROBE_B)]) - (((unsigned long long)MISC[17 + 2 * PROBE_A] << 32) | MISC[16 + 2 * PROBE_A]));
#ifdef PROBE_G
        const unsigned long long wait = 64ull * (unsigned long long)MISC[60], t0 = __builtin_amdgcn_s_memrealtime();
#else
        (void)sp; const unsigned long long wait = 64ull * (PROBE_BUSY ? mx : sp2), t0 = __builtin_amdgcn_s_memrealtime();
#endif
        while (__builtin_amdgcn_s_memrealtime() - t0 < wait) __builtin_amdgcn_s_sleep(4);
    }
#endif
#undef IN
#undef SEAM
}

#ifndef MK_N_LAUNCHES
#define MK_N_LAUNCHES 1
#endif
extern "C" void kernel_launch(void* const* d_in, const int* in_sizes, int n_in, void* d_out, int out_size, void* d_ws, size_t ws_size, hipStream_t stream) {
    static int grid = 0;
    if (grid == 0) {
        if (n_in != 23 || out_size != M * D || ws_size < WS_END) { fprintf(stderr, "kernel_launch: unexpected shapes (n_in %d out %d ws %zu)\n", n_in, out_size, ws_size); grid = -1; return; }
        int dev = 0, cus = 0;
        if (hipGetDevice(&dev) != hipSuccess || hipDeviceGetAttribute(&cus, hipDeviceAttributeMultiprocessorCount, dev) != hipSuccess) { grid = -1; return; }
        if (hipFuncSetAttribute((const void*)mk_fwd, hipFuncAttributeMaxDynamicSharedMemorySize, LDS_BYTES) != hipSuccess) { fprintf(stderr, "kernel_launch: hipFuncSetAttribute failed\n"); grid = -1; return; }
        int per_cu = 0;
        if (hipOccupancyMaxActiveBlocksPerMultiprocessor(&per_cu, (const void*)mk_fwd, NTHR, LDS_BYTES) != hipSuccess || per_cu < 1) fprintf(stderr, "kernel_launch: occupancy query says %d\n", per_cu);
        (void)hipGetLastError();
        grid = cus;
    }
    if (grid < 0) return;
    (void)hipMemsetAsync((char*)d_ws + WS_CTL, 0, CTL_ZERO_BYTES, stream);
    Args a{};
    for (int i = 0; i < 23; ++i) a.in[i] = (const float*)d_in[i];
    a.out = (float*)d_out; a.ws = (unsigned char*)d_ws;
    if (MK_N_LAUNCHES == 1) { a.ph_lo = 0; a.ph_hi = NPHASE; hipLaunchKernelGGL(mk_fwd, dim3(grid), dim3(NTHR), LDS_BYTES, stream, a); }
    else for (int p = 0; p < NPHASE; ++p) { a.ph_lo = p; a.ph_hi = p + 1; hipLaunchKernelGGL(mk_fwd, dim3(grid), dim3(NTHR), LDS_BYTES, stream, a); }
}
```

```cpp
#include <hip/hip_runtime.h>
#include <cstdio>
#include <cstdint>
namespace pg8 {
#define PG8_LAS __attribute__((address_space(3)))
typedef unsigned short bf16_t;
typedef short bf16x8 __attribute__((ext_vector_type(8)));
typedef float f32x4 __attribute__((ext_vector_type(4)));
typedef unsigned u32x4 __attribute__((ext_vector_type(4)));
constexpr int BM = 256, BK = 64, HALF = 128, HTB = HALF * BK * 2  , STAGE_BYTES = 8 * HTB, NXCD = 8, WGM = 8;

__host__ __device__ __forceinline__ int lds_byte(int r, int c) { const int st = (r >> 4) * 2 + (c >> 5), rr = r & 15, cc = c & 31, ob = rr * 64 + cc * 2; return st * 1024 + (ob ^ (((ob >> 9) & 1) << 5)); }
__host__ __device__ __forceinline__ void stage_rc(int b, int& R, int& C) { const int st = b / 1024, sb = b % 1024, swz = sb ^ (((sb >> 9) & 1) << 5); R = (st >> 1) * 16 + swz / 64; C = (st & 1) * 32 + (swz % 64) / 2; }
__host__ __device__ __forceinline__ int perm32(int rho) { const int n = rho >> 4, i = rho & 15; return 8 * (i >> 2) + 4 * n + (i & 3); }

struct Unit { int pm, pn; };
struct Gemm { const bf16_t* A; const bf16_t* Bt; int M, N, K; };

struct StaticOrder {
    int nM, nN, nwg, G, c;
    __host__ __device__ void init(int M, int N, int G_, int c_) { nM = M / BM; nN = N / BM; nwg = nM * nN; G = G_; c = c_; }
    __host__ __device__ bool next(int i, Unit& u) const {
        const int L = i * G + c; if (L >= nwg) return false;
        int wgid = L; { const int q = nwg / NXCD, r = nwg % NXCD, xcd = wgid % NXCD, off = wgid / NXCD; wgid = (xcd < r ? xcd * (q + 1) : r * (q + 1) + (xcd - r) * q) + off; }
        const int nig = WGM * nN, gid = wgid / nig, fm = gid * WGM, gsz = (nM - fm) < WGM ? (nM - fm) : WGM;
        u.pm = fm + ((wgid % nig) % gsz); u.pn = (wgid % nig) / gsz; return true;
    }
    __device__ __forceinline__ void a_ready(const Unit&) const {}
    __device__ __forceinline__ void done(const Unit&) const {}
};

__device__ __forceinline__ unsigned cvt_pk_bf16(float lo, float hi) { unsigned r; asm volatile("v_cvt_pk_bf16_f32 %0, %1, %2" : "=v"(r) : "v"(lo), "v"(hi)); return r; }
typedef float f32x2 __attribute__((ext_vector_type(2)));
typedef int v8i32 __attribute__((ext_vector_type(8)));
__device__ __forceinline__ v8i32 cat8(bf16x8 lo, bf16x8 hi) { typedef short s16x16 __attribute__((ext_vector_type(16))); return __builtin_bit_cast(v8i32, __builtin_shufflevector(lo, hi, 0, 1, 2, 3, 4, 5, 6, 7, 8, 9, 10, 11, 12, 13, 14, 15)); }
template <class Epi, class Sched, bool ALIGN_EPI = false, bool SP2 = false, bool F8 = false>
__device__ __forceinline__ void gemm_phase(PG8_LAS unsigned char* lds, const Gemm g, const Sched& S, const Epi& E, int wid) {
    int lane; asm volatile("v_mbcnt_lo_u32_b32 %0, -1, 0\n\tv_mbcnt_hi_u32_b32 %0, -1, %0" : "=v"(lane)); __builtin_assume(lane >= 0 && lane < 64); __builtin_assume(wid >= 0 && wid < 8);
    const int tid = wid * 64 + lane, wr = wid >> 2, wc = wid & 3, fr = lane & 15, fq = lane >> 4;
    const int K = g.K, nt = K / BK;
    unsigned voffA[2], voffB[2];
#pragma unroll
    for (int i = 0; i < 2; ++i) { int R, C; stage_rc(tid * 16 + i * 8192, R, C); const int Rb = Epi::PERM ? ((R & ~31) + perm32(R & 31)) : R;
        voffA[i] = (unsigned)(R * K + C) * 2u; voffB[i] = (unsigned)(Rb * K + C) * 2u; }
    const unsigned kstep = (unsigned)(BK * 2);
    const unsigned hstep = (unsigned)HALF * (unsigned)K * 2u;
    const unsigned tstep = 2u * hstep;
    const unsigned ldsw = (unsigned)wid * 1024u;
    const int aoff = lds_byte(wr * 64 + fr, fq * 8), boff = lds_byte(wc * 32 + fr, fq * 8);
#define PG8_SA(b, h) (((b) * 2 + (h)) * HTB)
#define PG8_SB(b, h) ((4 + (b) * 2 + (h)) * HTB)
#define PG8_STAGE(bufoff, gbase, voff) do { _Pragma("unroll") for (int _i = 0; _i < 2; ++_i) \
        __builtin_amdgcn_global_load_lds((const unsigned*)((const char*)(gbase) + (voff)[_i]), (PG8_LAS unsigned*)(lds + (bufoff) + ldsw + _i * 8192), 16, 0, 0); } while (0)
#define PG8_LDA(dst, b, h) do { _Pragma("unroll") for (int m = 0; m < 4; ++m) _Pragma("unroll") for (int k = 0; k < 2; ++k) dst[m][k] = *(const PG8_LAS bf16x8*)(lds + PG8_SA(b, h) + aoff + m * 2048 + k * 1024); } while (0)
#define PG8_LDB(dst, b, h) do { _Pragma("unroll") for (int n = 0; n < 2; ++n) _Pragma("unroll") for (int k = 0; k < 2; ++k) dst[n][k] = *(const PG8_LAS bf16x8*)(lds + PG8_SB(b, h) + boff + n * 2048 + k * 1024); } while (0)
#define PG8_MMA(ai, bj, At, Bt) do { __builtin_amdgcn_s_setprio(1); _Pragma("unroll") for (int m = 0; m < 4; ++m) _Pragma("unroll") for (int n = 0; n < 2; ++n) { \
        if constexpr (F8) acc[ai][bj][m][n] = __builtin_amdgcn_mfma_scale_f32_16x16x128_f8f6f4(cat8(Bt[n][0], Bt[n][1]), cat8(At[m][0], At[m][1]), acc[ai][bj][m][n], 0, 0, 0, 0, 0, 0); \
        else { _Pragma("unroll") for (int k = 0; k < 2; ++k) acc[ai][bj][m][n] = __builtin_amdgcn_mfma_f32_16x16x32_bf16(Bt[n][k], At[m][k], acc[ai][bj][m][n], 0, 0, 0); } } __builtin_amdgcn_s_setprio(0); } while (0)
#define PG8_WAIT_V(n) asm volatile("s_waitcnt vmcnt(" #n ")" ::: "memory")
#define PG8_WAIT_L(n) asm volatile("s_waitcnt lgkmcnt(" #n ")" ::: "memory")
#define PG8_BAR __builtin_amdgcn_s_barrier()
#define PG8_SCHED __builtin_amdgcn_sched_barrier(0)
    Unit cur, nxt; int ui = 0;
    if (!S.next(0, cur)) return;
    f32x4 acc[2][2][4][2];
#pragma unroll
    for (int a = 0; a < 2; ++a)
#pragma unroll
        for (int b = 0; b < 2; ++b)
#pragma unroll
            for (int m = 0; m < 4; ++m)
#pragma unroll
                for (int n = 0; n < 2; ++n) acc[a][b][m][n] = (f32x4){0.f, 0.f, 0.f, 0.f};
    bf16x8 At[4][2], B0[2][2], B1[2][2];
    const char* cA = (const char*)g.A + (size_t)((unsigned)cur.pm * tstep); const char* cB = (const char*)g.Bt + (size_t)((unsigned)cur.pn * tstep);
    S.a_ready(cur);
    if constexpr (SP2) {
        PG8_STAGE(PG8_SB(0, 0), cB, voffB); PG8_STAGE(PG8_SB(0, 1), cB + hstep, voffB); PG8_STAGE(PG8_SA(0, 0), cA, voffA); PG8_STAGE(PG8_SA(0, 1), cA + hstep, voffA);
        if (wr == 1) PG8_BAR;
        PG8_WAIT_V(2); PG8_BAR;
        PG8_STAGE(PG8_SB(1, 0), cB + kstep, voffB); PG8_STAGE(PG8_SA(1, 0), cA + kstep, voffA); PG8_STAGE(PG8_SB(1, 1), cB + hstep + kstep, voffB);
        PG8_WAIT_V(6); PG8_BAR;
    } else {
        PG8_STAGE(PG8_SB(0, 0), cB, voffB); PG8_STAGE(PG8_SA(0, 0), cA, voffA); PG8_STAGE(PG8_SB(0, 1), cB + hstep, voffB); PG8_STAGE(PG8_SA(0, 1), cA + hstep, voffA);
        if (wr == 1) PG8_BAR;
        PG8_WAIT_V(4); PG8_BAR;
        PG8_STAGE(PG8_SB(1, 0), cB + kstep, voffB); PG8_STAGE(PG8_SA(1, 0), cA + kstep, voffA); PG8_STAGE(PG8_SB(1, 1), cB + hstep + kstep, voffB);
        PG8_WAIT_V(6); PG8_BAR;
    }
    for (;;) {
        const bool has_next = S.next(ui + 1, nxt);
        const char* nA = has_next ? (const char*)g.A + (size_t)((unsigned)nxt.pm * tstep) : cA; const char* nB = has_next ? (const char*)g.Bt + (size_t)((unsigned)nxt.pn * tstep) : cB;
        _Pragma("unroll 1") for (int t = 0; t < nt; t += 2) {
            const bool last = (t == nt - 2);
            const char* a1 = cA + (size_t)((unsigned)(t + 1) * kstep);
            const char* a2 = last ? nA : cA + (size_t)((unsigned)(t + 2) * kstep); const char* b2 = last ? nB : cB + (size_t)((unsigned)(t + 2) * kstep);
            const char* a3 = a2 + kstep; const char* b3 = b2 + kstep;
            const char* a1h = a1 + hstep; const char* a2h = a2 + hstep; const char* b2h = b2 + hstep; const char* b3h = b3 + hstep;
            asm volatile("" : "+s"(a1h), "+s"(a2), "+s"(a2h), "+s"(b2), "+s"(b2h), "+s"(a3), "+s"(b3), "+s"(b3h));
            if (last && has_next) S.a_ready(nxt);
            if constexpr (SP2) {
            PG8_LDB(B0, 0, 0); PG8_LDB(B1, 0, 1); PG8_SCHED; PG8_LDA(At, 0, 0); PG8_STAGE(PG8_SA(1, 1), a1h, voffA);
            PG8_WAIT_V(8); PG8_WAIT_L(0); PG8_BAR; PG8_MMA(0, 0, At, B0); PG8_MMA(0, 1, At, B1); PG8_BAR; PG8_SCHED;
            PG8_LDA(At, 0, 1); PG8_STAGE(PG8_SB(0, 0), b2, voffB); PG8_STAGE(PG8_SB(0, 1), b2h, voffB); PG8_STAGE(PG8_SA(0, 0), a2, voffA);
            PG8_WAIT_V(8); PG8_WAIT_L(0); PG8_BAR; PG8_MMA(1, 0, At, B0); PG8_MMA(1, 1, At, B1); PG8_BAR; PG8_SCHED;
            PG8_LDB(B0, 1, 0); PG8_LDB(B1, 1, 1); PG8_SCHED; PG8_LDA(At, 1, 0); PG8_STAGE(PG8_SA(0, 1), a2h, voffA);
            PG8_WAIT_V(8); PG8_WAIT_L(0); PG8_BAR; PG8_MMA(0, 0, At, B0); PG8_MMA(0, 1, At, B1); PG8_BAR; PG8_SCHED;
            PG8_LDA(At, 1, 1); PG8_STAGE(PG8_SB(1, 0), b3, voffB); PG8_STAGE(PG8_SB(1, 1), b3h, voffB); PG8_STAGE(PG8_SA(1, 0), a3, voffA);
            PG8_WAIT_V(8); PG8_WAIT_L(0); PG8_BAR; PG8_MMA(1, 0, At, B0); PG8_MMA(1, 1, At, B1); PG8_BAR; PG8_SCHED;
            } else {
            PG8_LDB(B0, 0, 0); PG8_SCHED; PG8_LDA(At, 0, 0); PG8_STAGE(PG8_SA(1, 1), a1h, voffA);
            PG8_WAIT_L(8); PG8_BAR; PG8_WAIT_L(0); PG8_MMA(0, 0, At, B0); PG8_BAR; PG8_SCHED;
            PG8_LDB(B1, 0, 1); PG8_STAGE(PG8_SB(0, 0), b2, voffB);
            PG8_BAR; PG8_WAIT_L(0); PG8_MMA(0, 1, At, B1); PG8_BAR;
            PG8_LDA(At, 0, 1); PG8_STAGE(PG8_SA(0, 0), a2, voffA);
            PG8_BAR; PG8_WAIT_L(0); PG8_MMA(1, 0, At, B0); PG8_BAR; PG8_SCHED;
            PG8_STAGE(PG8_SB(0, 1), b2h, voffB);
            PG8_WAIT_V(6); PG8_BAR; PG8_MMA(1, 1, At, B1); PG8_BAR;
            PG8_LDB(B0, 1, 0); PG8_SCHED; PG8_LDA(At, 1, 0); PG8_STAGE(PG8_SA(0, 1), a2h, voffA);
            PG8_WAIT_L(8); PG8_BAR; PG8_WAIT_L(0); PG8_MMA(0, 0, At, B0); PG8_BAR; PG8_SCHED;
            PG8_LDB(B1, 1, 1); PG8_STAGE(PG8_SB(1, 0), b3, voffB);
            PG8_BAR; PG8_WAIT_L(0); PG8_MMA(0, 1, At, B1); PG8_BAR;
            PG8_LDA(At, 1, 1); PG8_STAGE(PG8_SA(1, 0), a3, voffA);
            PG8_BAR; PG8_WAIT_L(0); PG8_MMA(1, 0, At, B0); PG8_BAR; PG8_SCHED;
            PG8_STAGE(PG8_SB(1, 1), b3h, voffB);
            PG8_WAIT_V(6); PG8_BAR; PG8_MMA(1, 1, At, B1); PG8_BAR;
            }
        }
#ifdef PROBE_G
        unsigned long long tk_ = 0; if (wid == 0) tk_ = __builtin_amdgcn_s_memrealtime();
#endif
        if constexpr (ALIGN_EPI) { if (wr == 0) PG8_BAR; }
        if constexpr (!Epi::AFTER_DRAIN) { int l2_; asm volatile("v_mbcnt_lo_u32_b32 %0, -1, 0\n\tv_mbcnt_hi_u32_b32 %0, -1, %0" : "=v"(l2_)); const int fr_o = l2_ & 15, fq_o = l2_ >> 4;
            Unit cu_ = cur; asm volatile("" : "+s"(cu_.pm), "+s"(cu_.pn));
            E(acc, cu_, wr, wc, fr_o, fq_o); S.done(cur); }
#ifdef PROBE_G
        if (wid == 0 && lane == 0 && *(volatile PG8_LAS unsigned*)(lds + 147456 + 4 * 61) != 0u) *(volatile PG8_LAS unsigned*)(lds + 147456 + 4 * 60) += (unsigned)(__builtin_amdgcn_s_memrealtime() - tk_);
#endif
        if (!has_next) break;
#pragma unroll
        for (int a = 0; a < 2; ++a)
#pragma unroll
            for (int b = 0; b < 2; ++b)
#pragma unroll
                for (int m = 0; m < 4; ++m)
#pragma unroll
                    for (int n = 0; n < 2; ++n) acc[a][b][m][n] = (f32x4){0.f, 0.f, 0.f, 0.f};
        cur = nxt; cA = nA; cB = nB; ++ui;
        if constexpr (ALIGN_EPI) { if (wr == 1) PG8_BAR; }
    }
    PG8_WAIT_V(0);
    if constexpr (!ALIGN_EPI) { if (wr == 0) PG8_BAR; }
    PG8_BAR;
    if constexpr (Epi::AFTER_DRAIN) { E.fused(acc, cur, wr, wc, fr, fq, lds, wid, lane); S.done(cur); }
#undef PG8_SA
#undef PG8_SB
#undef PG8_STAGE
#undef PG8_LDA
#undef PG8_LDB
#undef PG8_MMA
#undef PG8_WAIT_V
#undef PG8_WAIT_L
#undef PG8_BAR
#undef PG8_SCHED
}
}
#define GAS __attribute__((address_space(1)))
#define LAS __attribute__((address_space(3)))
typedef unsigned short bf16;
typedef unsigned v4u __attribute__((ext_vector_type(4)));
typedef float f32x4 __attribute__((ext_vector_type(4)));
typedef short bf16x8 __attribute__((ext_vector_type(8)));
typedef GAS unsigned gu32;
typedef GAS unsigned long long gu64;
#define RLX_AGENT __ATOMIC_RELAXED, __HIP_MEMORY_SCOPE_AGENT
#define LDS_WAIT() asm volatile("s_waitcnt lgkmcnt(0)" ::: "memory")
#define VM_WAIT() asm volatile("s_waitcnt vmcnt(0)" ::: "memory")
__device__ __forceinline__ unsigned long long rt() { return __builtin_amdgcn_s_memrealtime(); }
__device__ __forceinline__ unsigned f2bf(float f) { unsigned u = __builtin_bit_cast(unsigned, f); return (u + 0x7fffu + ((u >> 16) & 1u)) >> 16; }
__device__ __forceinline__ unsigned pk2(float lo, float hi) { return f2bf(lo) | (f2bf(hi) << 16); }
#define XB_TMO      128
#define XB_XCNT(j)  (256  + 64 * (j))
#define XB_XSUB(j)  (1280 + 64 * (j))
#define XB_XGEN(j)  (2304 + 64 * (j))
#define XB_TOP      3328
#define XB_TOPGEN   3392
#define XCD_BAR_WORDS 3456
#define XB_SPIN_CAP (1u << 18)

__device__ __forceinline__ unsigned xb_ld(unsigned* p)              { return __hip_atomic_load(p, __ATOMIC_RELAXED, __HIP_MEMORY_SCOPE_AGENT); }
__device__ __forceinline__ unsigned xb_add(unsigned* p, unsigned v) { return __hip_atomic_fetch_add(p, v, __ATOMIC_RELAXED, __HIP_MEMORY_SCOPE_AGENT); }
__device__ __forceinline__ unsigned xb_xcc_id() { return (unsigned)__builtin_amdgcn_s_getreg((3 << 11) | 20) & 0xFu; }
#define XB_SPIN(cond, bar) do { unsigned _sp = 0; while (cond) { __builtin_amdgcn_s_sleep(1); \
    if ((++_sp & 255u) == 0u) { if (xb_ld(&(bar)[XB_TMO])) break; if (_sp > XB_SPIN_CAP) { atomicAdd(&(bar)[XB_TMO], 1u); break; } } } } while (0)

struct XcdBarrier {
    unsigned* bar; unsigned x;
    volatile LAS unsigned* st;
};

__device__ __forceinline__ XcdBarrier xcd_barrier_post(unsigned* bar, volatile LAS unsigned* st, bool t0) {
    XcdBarrier b; b.bar = bar; b.x = xb_xcc_id(); b.st = st;
    if (t0) (void)xb_add(&bar[XB_XCNT(b.x)], 1u);
    return b;
}
__device__ __forceinline__ void xcd_barrier_complete(unsigned* bar, unsigned x, unsigned& nloc, unsigned& nx) {
    const unsigned G = gridDim.x * gridDim.y * gridDim.z;
    unsigned sum, cnt, mine, sp = 0u;
    for (;;) {
        sum = 0u; cnt = 0u; mine = 0u;
#pragma unroll
        for (unsigned j = 0; j < 16; ++j) { const unsigned c = xb_ld(&bar[XB_XCNT(j)]); sum += c; cnt += (c > 0u) ? 1u : 0u; mine = (j == x) ? c : mine; }
        if (sum == G) break;
        __builtin_amdgcn_s_sleep(1);
        if ((++sp & 255u) == 0u) { if (xb_ld(&bar[XB_TMO])) break; if (sp > XB_SPIN_CAP) { atomicAdd(&bar[XB_TMO], 1u); break; } }
    }
    nloc = mine > 0u ? mine : 1u; nx = cnt > 0u ? cnt : 1u;
}

__device__ __forceinline__ void xcd_barrier(const XcdBarrier& b, bool t0) {
    asm volatile("s_waitcnt vmcnt(0)" ::: "memory");
    __syncthreads();
    if (t0) {
        unsigned* bar = b.bar;
        __builtin_amdgcn_s_waitcnt(0);
        unsigned nloc = b.st[0], nx = b.st[1];
        if (nloc == 0u) { xcd_barrier_complete(bar, b.x, nloc, nx); b.st[0] = nloc; b.st[1] = nx; }
        const unsigned old = xb_add(&bar[XB_XSUB(b.x)], 1u);
        const unsigned gen = old / nloc;
        if (old + 1u == (gen + 1u) * nloc) {
            __builtin_amdgcn_fence(__ATOMIC_RELEASE, "agent");
            asm volatile("s_waitcnt vmcnt(0)" ::: "memory");
            const unsigned og = xb_add(&bar[XB_TOP], 1u);
            const unsigned tg = og / nx;
            if (og + 1u == (tg + 1u) * nx) xb_add(&bar[XB_TOPGEN], 1u);
            else XB_SPIN(xb_ld(&bar[XB_TOPGEN]) == tg, bar);
            __builtin_amdgcn_fence(__ATOMIC_ACQUIRE, "agent");
            xb_add(&bar[XB_XGEN(b.x)], 1u);
            asm volatile("s_waitcnt vmcnt(0)" ::: "memory");
        } else {
            XB_SPIN(xb_ld(&bar[XB_XGEN(b.x)]) == gen, bar);
            __builtin_amdgcn_fence(__ATOMIC_ACQUIRE, "agent");
            asm volatile("s_waitcnt vmcnt(0)" ::: "memory");
        }
    }
    __syncthreads();
}
#ifndef Y_FP8
#define Y_FP8 1
#endif
#ifndef MOE_FP8_G1
#define MOE_FP8_G1 1
#endif
#ifndef MOE_FP8_G2
#define MOE_FP8_G2 1
#endif

constexpr int NB = 2, SEQ = 8192, D = 1024, M = NB * SEQ;
constexpr int NPROJ = 3584, IN_COLS = 3592;
constexpr int NE = 32, TOPK = 4, DFF = 1024;
constexpr int NROWS_MAX = M * TOPK + NE * 256;
constexpr int MAXRT = NROWS_MAX / 256;
constexpr float EPS = 1e-6f;
constexpr int PC_Q = 0, PC_K = 512, PC_V = 1024, PC_G = 1536, PC_Z = 2048, PC_X = 2560;
constexpr int NCHUNK = M / 64;
constexpr int NWAVES = 8, NTHR = 512;

constexpr size_t MiB = 1u << 20;
constexpr size_t WS_CTL = 0, CTL_ZERO_BYTES = 32768;
constexpr size_t WS_MODP = 1 * MiB;
constexpr size_t WS_MODF = WS_MODP + 512 * 1024;
constexpr size_t WS_BLKCNT = WS_MODF + 256 * 1024;
constexpr size_t WS_DT = 2 * MiB;
constexpr size_t WS_TOK = 3 * MiB;
constexpr size_t WS_WIN = 4 * MiB, WS_WOUT = 11 * MiB, WS_W1 = 16 * MiB, WS_W2 = 144 * MiB;
constexpr size_t WS_H = 208 * MiB, WS_P = 240 * MiB, WS_LF = 352 * MiB, WS_MIX = 384 * MiB, WS_X1 = 416 * MiB;
constexpr size_t WS_XG = 480 * MiB, WS_ACT = 624 * MiB, WS_END = 768 * MiB;
constexpr int CW_TMO = 0, CW_BAR = 4096;

constexpr int RING_BYTES = 131072, AUX_OFF = RING_BYTES  , MISC_OFF = 147456, LDS_BYTES = 151552;

struct Args { const float* in[23]; float* out; unsigned char* ws; int ph_lo, ph_hi; };
enum { I_X = 0, I_C, I_ADAW, I_ADAB, I_N1W, I_WIN, I_LBL, I_HGNW, I_ALOG, I_DTB, I_SSMD, I_CONVW, I_CONVB, I_SSMNW, I_WOUT, I_N2W, I_RW, I_RB, I_W1, I_B1, I_W2, I_B2, I_FNW };

__device__ __forceinline__ float bf2f(bf16 v) { return __uint_as_float(((unsigned)v) << 16); }
__device__ __forceinline__ float wave_sum(float v) {
#pragma unroll
    for (int o = 1; o < 64; o <<= 1) v += __shfl_xor(v, o);
    return v;
}
__device__ __forceinline__ float wave_max(float v) {
#pragma unroll
    for (int o = 1; o < 64; o <<= 1) v = fmaxf(v, __shfl_xor(v, o));
    return v;
}
__device__ __forceinline__ float sigmoid_f(float x) { return __builtin_amdgcn_rcpf(1.0f + __expf(-x)); }
__device__ __forceinline__ float silu_f(float x) { return x * sigmoid_f(x); }

namespace pg8 {
struct EpiIn {
    static constexpr bool PERM = true, AFTER_DRAIN = false;
    bf16_t* P; float* LF; const float* lbl;
    __device__ __forceinline__ void operator()(const f32x4 (&acc)[2][2][4][2], const Unit& u, int wr, int wc, int fr, int fq) const {
        const int row0 = u.pm * BM + wr * 64 + fr, col0 = u.pn * BM + wc * 32 + 8 * fq;
        const int mode = (u.pn < 2) ? 1 : (u.pn < 4) ? 2 : (u.pn < 6) ? 0 : (u.pn < 10) ? 1 : 0;
        if (mode == 2) {
            float oml[2][8];
#pragma unroll
            for (int bj = 0; bj < 2; ++bj)
#pragma unroll
                for (int j = 0; j < 8; ++j) { const int cf = col0 + bj * HALF + j - 512; const float l0 = lbl[cf], l1 = lbl[512 + cf]; oml[bj][j] = 1.0f - 1.0f / (1.0f + __expf(l1 - l0)); }
#pragma unroll
            for (int ai = 0; ai < 2; ++ai)
#pragma unroll
                for (int m = 0; m < 4; ++m) { const size_t r = (size_t)(row0 + ai * HALF + m * 16);
#pragma unroll
                    for (int bj = 0; bj < 2; ++bj) { float kv[8], lf[8];
#pragma unroll
                        for (int j = 0; j < 8; ++j) { const float f = acc[ai][bj][m][j >> 2][j & 3]; const float k = oml[bj][j] * sigmoid_f(-f); kv[j] = k; lf[j] = __logf(1.0f - k); }
                        u32x4 w; w.x = cvt_pk_bf16(kv[0], kv[1]); w.y = cvt_pk_bf16(kv[2], kv[3]); w.z = cvt_pk_bf16(kv[4], kv[5]); w.w = cvt_pk_bf16(kv[6], kv[7]);
                        *(u32x4*)(P + r * NPROJ + col0 + bj * HALF) = w;
                        float* lp = LF + r * 512 + (col0 + bj * HALF - 512);
                        *(f32x4*)lp = (f32x4){lf[0], lf[1], lf[2], lf[3]}; *(f32x4*)(lp + 4) = (f32x4){lf[4], lf[5], lf[6], lf[7]}; } }
        } else {
#pragma unroll
            for (int ai = 0; ai < 2; ++ai)
#pragma unroll
                for (int m = 0; m < 4; ++m) { bf16_t* rowp = P + (size_t)(row0 + ai * HALF + m * 16) * NPROJ + col0;
#pragma unroll
                    for (int bj = 0; bj < 2; ++bj) { f32x4 v0 = acc[ai][bj][m][0], v1 = acc[ai][bj][m][1];
                        if (mode == 1) {
#pragma unroll
                            for (int j = 0; j < 4; ++j) { v0[j] = silu_f(v0[j]); v1[j] = silu_f(v1[j]); } }
                        u32x4 w; w.x = cvt_pk_bf16(v0[0], v0[1]); w.y = cvt_pk_bf16(v0[2], v0[3]); w.z = cvt_pk_bf16(v1[0], v1[1]); w.w = cvt_pk_bf16(v1[2], v1[3]);
                        *(u32x4*)(rowp + bj * HALF) = w; } }
        }
    }
};
struct EpiOut {
    static constexpr bool PERM = true, AFTER_DRAIN = false;
    const float* x; bf16_t* x1; const float* g1;
    __device__ __forceinline__ void operator()(const f32x4 (&acc)[2][2][4][2], const Unit& u, int wr, int wc, int fr, int fq) const {
        const int row0 = u.pm * BM + wr * 64 + fr, col0 = u.pn * BM + wc * 32 + 8 * fq;
        const float* gb = g1 + ((u.pm * BM) >> 13) * 6144 + col0;
        f32x4 gv[2][2];
#pragma unroll
        for (int bj = 0; bj < 2; ++bj)
#pragma unroll
            for (int n = 0; n < 2; ++n) gv[bj][n] = *(const f32x4*)(gb + bj * HALF + 4 * n);
#pragma unroll
        for (int ai = 0; ai < 2; ++ai)
#pragma unroll
            for (int m = 0; m < 4; ++m) { const size_t off = (size_t)(row0 + ai * HALF + m * 16) * D + col0;
#pragma unroll
                for (int bj = 0; bj < 2; ++bj) { const f32x4 x0 = *(const f32x4*)(x + off + bj * HALF), x1v = *(const f32x4*)(x + off + bj * HALF + 4);
                    const f32x4 v0 = x0 + gv[bj][0] * acc[ai][bj][m][0], v1 = x1v + gv[bj][1] * acc[ai][bj][m][1];
                    u32x4 w; w.x = cvt_pk_bf16(v0[0], v0[1]); w.y = cvt_pk_bf16(v0[2], v0[3]); w.z = cvt_pk_bf16(v1[0], v1[1]); w.w = cvt_pk_bf16(v1[2], v1[3]);
                    *(u32x4*)(x1 + off + bj * HALF) = w; } }
    }
};
__device__ __forceinline__ float sat8(float x) { return fminf(fmaxf(x, -448.0f), 448.0f); }
__device__ __forceinline__ unsigned pk4_fp8(float a, float b, float c, float d) { int w = 0; w = __builtin_amdgcn_cvt_pk_fp8_f32(sat8(a), sat8(b), w, false); w = __builtin_amdgcn_cvt_pk_fp8_f32(sat8(c), sat8(d), w, true); return (unsigned)w; }
template <bool F8IN, bool F8> struct EpiW1 {
    static constexpr bool PERM = true, AFTER_DRAIN = false;
    void* ACT; const float* b1;
    __device__ __forceinline__ void operator()(const f32x4 (&acc)[2][2][4][2], const Unit& u, int wr, int wc, int fr, int fq) const {
        const int e = u.pn >> 3, pn = u.pn & 7;
        const int row0 = u.pm * BM + wr * 64 + fr, cj = pn * 128 + wc * 32 + 8 * fq;
        const float* bg = b1 + e * 2048 + cj; const float sc = F8IN ? (1.0f / 1024.0f) : 1.0f;
#pragma unroll
        for (int ai = 0; ai < 2; ++ai)
#pragma unroll
            for (int m = 0; m < 4; ++m) {
                asm volatile("" ::: "memory");
                const f32x4 bg0 = *(const f32x4*)bg, bg1 = *(const f32x4*)(bg + 4), bl0 = *(const f32x4*)(bg + 1024), bl1 = *(const f32x4*)(bg + 1028);
                f32x4 g0 = acc[ai][0][m][0] * sc + bg0, g1 = acc[ai][0][m][1] * sc + bg1, l0 = acc[ai][1][m][0] * sc + bl0, l1 = acc[ai][1][m][1] * sc + bl1;
                float o[8];
                const float osc = F8 ? 4.0f : 1.0f;
#pragma unroll
                for (int j = 0; j < 4; ++j) {
                    float g = fminf(g0[j], 7.0f), l = __builtin_amdgcn_fmed3f(l0[j], -7.0f, 7.0f); o[j] = (g * osc) * __builtin_amdgcn_rcpf(1.0f + __builtin_amdgcn_exp2f(g * (-1.702f * 1.44269504f))) * (l + 1.0f);
                    g = fminf(g1[j], 7.0f); l = __builtin_amdgcn_fmed3f(l1[j], -7.0f, 7.0f); o[4 + j] = (g * osc) * __builtin_amdgcn_rcpf(1.0f + __builtin_amdgcn_exp2f(g * (-1.702f * 1.44269504f))) * (l + 1.0f); }
                const size_t off = (size_t)(row0 + ai * HALF + m * 16) * DFF + cj;
                if (F8) { typedef unsigned u32x2 __attribute__((ext_vector_type(2))); u32x2 w; int w0 = 0, w1 = 0;
                    w0 = __builtin_amdgcn_cvt_pk_fp8_f32(o[0], o[1], w0, false); w0 = __builtin_amdgcn_cvt_pk_fp8_f32(o[2], o[3], w0, true); w1 = __builtin_amdgcn_cvt_pk_fp8_f32(o[4], o[5], w1, false); w1 = __builtin_amdgcn_cvt_pk_fp8_f32(o[6], o[7], w1, true);
                    w.x = (unsigned)w0; w.y = (unsigned)w1; *(u32x2*)((unsigned char*)ACT + off) = w; }
                else { u32x4 w; w.x = cvt_pk_bf16(o[0], o[1]); w.y = cvt_pk_bf16(o[2], o[3]); w.z = cvt_pk_bf16(o[4], o[5]); w.w = cvt_pk_bf16(o[6], o[7]);
                    *(u32x4*)((bf16_t*)ACT + off) = w; } }
    }
};
template <bool Y8> struct EpiW2 {
    static constexpr bool PERM = true, AFTER_DRAIN = false;
    void* Y; const float* b2; float sc;
    __device__ __forceinline__ void operator()(const f32x4 (&acc)[2][2][4][2], const Unit& u, int wr, int wc, int fr, int fq) const {
        const int e = u.pn >> 2, pn = u.pn & 3;
        const int row0 = u.pm * BM + wr * 64 + fr, col0 = pn * BM + wc * 32 + 8 * fq;
        const float* bb = b2 + e * 1024 + col0;
        f32x4 bv[2][2];
#pragma unroll
        for (int bj = 0; bj < 2; ++bj) { bv[bj][0] = *(const f32x4*)(bb + bj * HALF); bv[bj][1] = *(const f32x4*)(bb + bj * HALF + 4); }
#pragma unroll
        for (int ai = 0; ai < 2; ++ai)
#pragma unroll
            for (int m = 0; m < 4; ++m) { const size_t off = (size_t)(row0 + ai * HALF + m * 16) * D + col0;
#pragma unroll
                for (int bj = 0; bj < 2; ++bj) { const f32x4 v0 = acc[ai][bj][m][0] * sc + bv[bj][0], v1 = acc[ai][bj][m][1] * sc + bv[bj][1];
                    if (Y8) { typedef unsigned u32x2 __attribute__((ext_vector_type(2))); u32x2 w; w.x = pk4_fp8(v0[0] * 8.f, v0[1] * 8.f, v0[2] * 8.f, v0[3] * 8.f); w.y = pk4_fp8(v1[0] * 8.f, v1[1] * 8.f, v1[2] * 8.f, v1[3] * 8.f);
                        *(u32x2*)((unsigned char*)Y + off + bj * HALF) = w; }
                    else { u32x4 w; w.x = cvt_pk_bf16(v0[0], v0[1]); w.y = cvt_pk_bf16(v0[2], v0[3]); w.z = cvt_pk_bf16(v1[0], v1[1]); w.w = cvt_pk_bf16(v1[2], v1[3]);
                        *(u32x4*)((bf16_t*)Y + off + bj * HALF) = w; } } }
    }
};
struct InProjOrder {
    int c;
    __device__ __forceinline__ bool next(int i, Unit& u) const { const int pn = (c >> 6) + 4 * i; if (pn >= NPROJ / BM) return false; u.pm = c & 63; u.pn = pn; return true; }
    __device__ __forceinline__ void a_ready(const Unit&) const {}
    __device__ __forceinline__ void done(const Unit&) const {}
};
struct MoeOrder {
    const PG8_LAS int* rt2e; int NT, nwg, G, c;
    __device__ __forceinline__ bool next(int i, Unit& u) const {
        const int L = i * G + c; if (L >= nwg) return false;
        int wgid = L; { const int q = nwg / NXCD, r = nwg % NXCD, xcd = wgid % NXCD, off = wgid / NXCD; wgid = (xcd < r ? xcd * (q + 1) : r * (q + 1) + (xcd - r) * q) + off; }
        const int rt = wgid / NT, pn = wgid % NT; const int e = __builtin_amdgcn_readfirstlane(rt2e[rt]);
        u.pm = rt; u.pn = e * NT + pn; return true;
    }
    __device__ __forceinline__ void a_ready(const Unit&) const {}
    __device__ __forceinline__ void done(const Unit&) const {}
};
}

using pg8::pk4_fp8;
__device__ __forceinline__ void transpose_item(const float* __restrict__ W, int ldw, int k0, int c0, bf16* WT, int drow0, LAS float* scr, int lane) {
#pragma unroll 8
    for (int i = 0; i < 32; ++i) { const int kk = 2 * i + (lane >> 5); scr[kk * 33 + (lane & 31)] = W[(size_t)(k0 + kk) * ldw + c0 + (lane & 31)]; }
    LDS_WAIT(); asm volatile("" ::: "memory");
    const int c = lane & 7;
#pragma unroll
    for (int j = 0; j < 4; ++j) { const int n = (lane >> 3) + 8 * j; const LAS float* s = scr + (8 * c) * 33 + n;
        v4u o; o.x = pk2(s[0 * 33], s[1 * 33]); o.y = pk2(s[2 * 33], s[3 * 33]); o.z = pk2(s[4 * 33], s[5 * 33]); o.w = pk2(s[6 * 33], s[7 * 33]);
        *(GAS v4u*)(WT + (size_t)(drow0 + n) * 1024 + k0 + 8 * c) = o; }
    LDS_WAIT(); asm volatile("" ::: "memory");
}
__device__ __forceinline__ void transpose_item8(const float* __restrict__ W, int ldw, int k0, int c0, unsigned char* WT, int drow0, float scale, LAS float* scr, int lane) {
#pragma unroll 8
    for (int i = 0; i < 32; ++i) { const int kk = 2 * i + (lane >> 5); scr[kk * 33 + (lane & 31)] = W[(size_t)(k0 + kk) * ldw + c0 + (lane & 31)]; }
    LDS_WAIT(); asm volatile("" ::: "memory");
    const int n = lane >> 1, hf = lane & 1; const LAS float* s = scr + (32 * hf) * 33 + n;
    v4u o0, o1;
    o0.x = pk4_fp8(s[0 * 33] * scale, s[1 * 33] * scale, s[2 * 33] * scale, s[3 * 33] * scale); o0.y = pk4_fp8(s[4 * 33] * scale, s[5 * 33] * scale, s[6 * 33] * scale, s[7 * 33] * scale);
    o0.z = pk4_fp8(s[8 * 33] * scale, s[9 * 33] * scale, s[10 * 33] * scale, s[11 * 33] * scale); o0.w = pk4_fp8(s[12 * 33] * scale, s[13 * 33] * scale, s[14 * 33] * scale, s[15 * 33] * scale);
    o1.x = pk4_fp8(s[16 * 33] * scale, s[17 * 33] * scale, s[18 * 33] * scale, s[19 * 33] * scale); o1.y = pk4_fp8(s[20 * 33] * scale, s[21 * 33] * scale, s[22 * 33] * scale, s[23 * 33] * scale);
    o1.z = pk4_fp8(s[24 * 33] * scale, s[25 * 33] * scale, s[26 * 33] * scale, s[27 * 33] * scale); o1.w = pk4_fp8(s[28 * 33] * scale, s[29 * 33] * scale, s[30 * 33] * scale, s[31 * 33] * scale);
    GAS v4u* dst = (GAS v4u*)(WT + (size_t)(drow0 + n) * 1024 + k0 + 32 * hf); dst[0] = o0; dst[1] = o1;
    LDS_WAIT(); asm volatile("" ::: "memory");
}
template <bool F8> __device__ __forceinline__ void p0_item(const float* __restrict__ W, int ldw, int k0, int c0, unsigned char* WT, int drow0, int rowb, float scale, LAS unsigned char* T, int tid, int wave, int lane) {
    constexpr int NB = F8 ? 2 : 1, TS = 516;
    const int l32 = lane & 31, hf = lane >> 5;
#pragma unroll 1
    for (int batch = 0; batch < NB; ++batch) {
        const int kb = batch * 256 + wave * 32;
        f32x4 v[4][4];
#pragma unroll
        for (int i = 0; i < 4; ++i)
#pragma unroll
            for (int j = 0; j < 4; ++j) v[i][j] = __builtin_nontemporal_load((const f32x4*)(W + (size_t)(k0 + kb + 4 * (2 * i + hf) + j) * ldw + c0 + 4 * l32));
#pragma unroll
        for (int i = 0; i < 4; ++i) { const int kk = kb + 4 * (2 * i + hf);
#pragma unroll
            for (int c = 0; c < 4; ++c) { LAS unsigned char* tp = T + (4 * l32 + c) * TS + (F8 ? kk : 2 * kk);
                if (F8) *(LAS unsigned*)tp = pk4_fp8(v[i][0][c] * scale, v[i][1][c] * scale, v[i][2][c] * scale, v[i][3][c] * scale);
                else { *(LAS unsigned*)tp = pk2(v[i][0][c], v[i][1][c]); *(LAS unsigned*)(tp + 4) = pk2(v[i][2][c], v[i][3][c]); } } }
    }
    __syncthreads();
#pragma unroll
    for (int i = 0; i < 8; ++i) { const int piece = tid + NTHR * i, n = piece >> 5, c = piece & 31; const LAS unsigned* tp = (const LAS unsigned*)(T + n * TS + 16 * c);
        v4u o; o.x = tp[0]; o.y = tp[1]; o.z = tp[2]; o.w = tp[3];
        *(GAS v4u*)(WT + (size_t)(drow0 + n) * rowb + (F8 ? k0 : 2 * k0) + 16 * c) = o; }
    __syncthreads();
}
constexpr int KB1 = MOE_FP8_G1 ? 2 : 4, KB2 = MOE_FP8_G2 ? 2 : 4, I_E1 = NE * 16 * KB1, I_E2 = NE * 8 * KB2, N_EXP_ITEMS = I_E1 + I_E2;
constexpr int N_BG_ITEMS = 0;
__device__ __forceinline__ void p0_expert_item(const Args& a, LAS unsigned char* lds, int it, int tid, int wave, int lane) {
    unsigned char* ws = a.ws;
    if (it < I_E1) { const int e = it / (16 * KB1), r2 = it % (16 * KB1), nb = r2 / KB1, kb = r2 % KB1, c0 = 128 * nb;
        const int drow = e * 2048 + ((c0 < 1024) ? (256 * (c0 >> 7)) : (256 * ((c0 - 1024) >> 7) + 128));
        p0_item<MOE_FP8_G1 != 0>(a.in[I_W1] + (size_t)e * 1024 * 2048, 2048, (MOE_FP8_G1 ? 512 : 256) * kb, c0, ws + WS_W1, drow, MOE_FP8_G1 ? 1024 : 2048, 128.0f, lds, tid, wave, lane); }
    else { const int r = it - I_E1, e = r / (8 * KB2), r2 = r % (8 * KB2), nb = r2 / KB2, kb = r2 % KB2;
        p0_item<MOE_FP8_G2 != 0>(a.in[I_W2] + (size_t)e * 1024 * 1024, 1024, (MOE_FP8_G2 ? 512 : 256) * kb, 128 * nb, ws + WS_W2, e * 1024 + 128 * nb, MOE_FP8_G2 ? 1024 : 2048, 128.0f, lds, tid, wave, lane); }
}
struct P0Src { const float* W; int ldw, k0, c0, drow; unsigned char* WT; };
__device__ __forceinline__ P0Src p0_expert_src(const Args& a, int it) {
    P0Src s;
    if (it < I_E1) { const int e = it / (16 * KB1), r2 = it % (16 * KB1), nb = r2 / KB1, kb = r2 % KB1, c0 = 128 * nb;
        s.W = a.in[I_W1] + (size_t)e * 1024 * 2048; s.ldw = 2048; s.k0 = 512 * kb; s.c0 = c0; s.drow = e * 2048 + ((c0 < 1024) ? (256 * (c0 >> 7)) : (256 * ((c0 - 1024) >> 7) + 128)); s.WT = a.ws + WS_W1; }
    else { const int r = it - I_E1, e = r / (8 * KB2), r2 = r % (8 * KB2), nb = r2 / KB2, kb = r2 % KB2;
        s.W = a.in[I_W2] + (size_t)e * 1024 * 1024; s.ldw = 1024; s.k0 = 512 * kb; s.c0 = 128 * nb; s.drow = e * 1024 + 128 * nb; s.WT = a.ws + WS_W2; }
    return s;
}
__device__ __forceinline__ void p0_load_batch(f32x4 (&v)[4][4], const P0Src& s, int batch, int wave, int lane) {
    const int l32 = lane & 31, hf = lane >> 5, kb = batch * 256 + wave * 32;
#pragma unroll
    for (int i = 0; i < 4; ++i)
#pragma unroll
        for (int j = 0; j < 4; ++j) v[i][j] = __builtin_nontemporal_load((const f32x4*)(s.W + (size_t)(s.k0 + kb + 4 * (2 * i + hf) + j) * s.ldw + s.c0 + 4 * l32));
}
__device__ __forceinline__ void p0_pack_batch8(const f32x4 (&v)[4][4], int batch, LAS unsigned char* T, int wave, int lane) {
    const int l32 = lane & 31, hf = lane >> 5, kb = batch * 256 + wave * 32;
#pragma unroll
    for (int i = 0; i < 4; ++i) { const int kk = kb + 4 * (2 * i + hf);
#pragma unroll
        for (int c = 0; c < 4; ++c) *(LAS unsigned*)(T + (4 * l32 + c) * 516 + kk) = pk4_fp8(v[i][0][c] * 128.0f, v[i][1][c] * 128.0f, v[i][2][c] * 128.0f, v[i][3][c] * 128.0f); }
}
__device__ __forceinline__ void p0_expert_items_pipelined(const Args& a, LAS unsigned char* T, int bid, int G, int n_items, int tid, int wave, int lane) {
    if (bid >= n_items) return;
    f32x4 vA[4][4], vB[4][4];
    P0Src cur = p0_expert_src(a, bid);
    p0_load_batch(vA, cur, 0, wave, lane);
#pragma unroll 1
    for (int it = bid; it < n_items; it += G) {
        p0_load_batch(vB, cur, 1, wave, lane);
        p0_pack_batch8(vA, 0, T, wave, lane);
        const int nx = it + G; const P0Src nxt = p0_expert_src(a, nx < n_items ? nx : it);
        if (nx < n_items) p0_load_batch(vA, nxt, 0, wave, lane);
        p0_pack_batch8(vB, 1, T, wave, lane);
        __syncthreads();
#pragma unroll
        for (int i = 0; i < 8; ++i) { const int piece = tid + NTHR * i, n = piece >> 5, c = piece & 31; const LAS unsigned* tp = (const LAS unsigned*)(T + n * 516 + 16 * c);
            v4u o; o.x = tp[0]; o.y = tp[1]; o.z = tp[2]; o.w = tp[3];
            *(GAS v4u*)(cur.WT + (size_t)(cur.drow + n) * 1024 + cur.k0 + 16 * c) = o; }
        __syncthreads();
        cur = nxt;
    }
}
__device__ __forceinline__ void p0_bg_items(const Args& a, LAS unsigned char* lds, int bid, int G, int tid, int wave, int lane) {
    if (G == 256 && bid >= 128) { for (int j = 0; j < N_BG_ITEMS / 128; ++j) p0_expert_item(a, lds, N_EXP_ITEMS - N_BG_ITEMS + (bid - 128) + 128 * j, tid, wave, lane); }
}
__device__ __forceinline__ void p0_prologue(const Args& a, LAS unsigned char* lds, int bid, int G, int tid, int wave, int lane) {
    unsigned char* ws = a.ws;
    { const int gw = (G - 1 - bid) * NWAVES + wave, NGW = G * NWAVES;
      for (int it = gw; it < 192; it += NGW) {
        const int nc = it % 24, kc = it / 24, n = nc * 256 + 4 * lane;
        const float* W = a.in[I_ADAW]; const float* c = a.in[I_C];
        f32x4 a0 = {0.f, 0.f, 0.f, 0.f}, a1 = {0.f, 0.f, 0.f, 0.f};
#pragma unroll 8
        for (int kk = 0; kk < 128; ++kk) { const int k = kc * 128 + kk; const f32x4 w = __builtin_nontemporal_load((const f32x4*)(W + (size_t)k * 6144 + n));
            const float c0 = silu_f(c[k]), c1 = silu_f(c[1024 + k]); a0 += c0 * w; a1 += c1 * w; }
        float* mp = (float*)(ws + WS_MODP);
        *(f32x4*)(mp + (size_t)(kc * 2 + 0) * 6144 + n) = a0; *(f32x4*)(mp + (size_t)(kc * 2 + 1) * 6144 + n) = a1;
      } }
    constexpr int I_IN = 28 * 4, I_OUT = 8 * 4;
    const int n_p0 = (G == 256) ? (N_EXP_ITEMS - N_BG_ITEMS) : N_EXP_ITEMS;
    if (MOE_FP8_G1 && MOE_FP8_G2) p0_expert_items_pipelined(a, lds, bid, G, n_p0, tid, wave, lane);
    else for (int it = bid; it < n_p0; it += G) p0_expert_item(a, lds, it, tid, wave, lane);
    for (int it = bid; it < I_IN + I_OUT; it += G) {
        if (it < I_IN) { const int nb = it >> 2, kb = it & 3; p0_item<false>(a.in[I_WIN], IN_COLS, 256 * kb, 128 * nb, ws + WS_WIN, 128 * nb, 2048, 1.0f, lds, tid, wave, lane); }
        else { const int r = it - I_IN, nb = r >> 2, kb = r & 3; p0_item<false>(a.in[I_WOUT], D, 256 * kb, 128 * nb, ws + WS_WOUT, 128 * nb, 2048, 1.0f, lds, tid, wave, lane); }
    }
}

__device__ __forceinline__ void load_mod_AS(LAS float* A, LAS float* S, const float* normw, const float* src, int nparts, const float* bias, int b, int shift_off, int tid) {
    for (int k = tid; k < 1024; k += NTHR) {
        float sh = bias ? bias[shift_off + k] : 0.f, sc = bias ? bias[shift_off + 1024 + k] : 0.f;
        for (int p = 0; p < nparts; ++p) { const float* q = src + (size_t)(p * 2 + b) * 6144 + shift_off; sh += q[k]; sc += q[1024 + k]; }
        A[k] = normw[k] * (1.0f + sc); S[k] = sh;
    }
}
__device__ __forceinline__ float softplus_f(float x) { return fmaxf(x, 0.f) + log1pf(__expf(-fabsf(x))); }

__device__ __forceinline__ void p1_norm(const Args& a, LAS unsigned char* lds, int bid, int G, int tid, int wave, int lane) {
    unsigned char* ws = a.ws;
    LAS float* A1 = (LAS float*)(lds); LAS float* S1 = A1 + 1024; LAS float* WDT = S1 + 1024;
    const float* modp = (const float*)(ws + WS_MODP);
    for (int idx = bid * NTHR + tid; idx < 2 * 6144; idx += G * NTHR) { const int b = idx / 6144, n = idx % 6144; float s = a.in[I_ADAB][n];
        for (int p = 0; p < 8; ++p) s += modp[(size_t)(p * 2 + b) * 6144 + n];
        ((float*)(ws + WS_MODF))[idx] = s; }
    for (int idx = tid; idx < 8192; idx += NTHR) { const int k = idx >> 3, jj = idx & 7; WDT[jj * 1024 + k] = a.in[I_WIN][(size_t)k * IN_COLS + NPROJ + jj]; }
    const float* x = a.in[I_X]; bf16* H = (bf16*)(ws + WS_H); float* DT = (float*)(ws + WS_DT);
    for (int c = bid; c < NCHUNK; c += G) {
        const int b = c >> 7;
        __syncthreads();
        load_mod_AS(A1, S1, a.in[I_N1W], modp, 8, a.in[I_ADAB], b, 0, tid);
        __syncthreads();
        f32x4 vn[4];
        { const GAS f32x4* xr = (const GAS f32x4*)(x + (size_t)(c * 64 + wave * 8) * D) + lane;
#pragma unroll
          for (int j = 0; j < 4; ++j) vn[j] = __builtin_nontemporal_load((const f32x4*)xr + 64 * j); }
#pragma unroll 1
        for (int r = 0; r < 8; ++r) {
            const int m = c * 64 + wave * 8 + r;
            f32x4 v[4]; float ss = 0.f;
#pragma unroll
            for (int j = 0; j < 4; ++j) { v[j] = vn[j]; ss += (v[j].x * v[j].x + v[j].y * v[j].y) + (v[j].z * v[j].z + v[j].w * v[j].w); }
            if (r < 7) { const GAS f32x4* xr = (const GAS f32x4*)(x + (size_t)(m + 1) * D) + lane;
#pragma unroll
                for (int j = 0; j < 4; ++j) vn[j] = __builtin_nontemporal_load((const f32x4*)xr + 64 * j); }
            const float rstd = rsqrtf(wave_sum(ss) * (1.0f / D) + EPS);
            float dacc[8];
#pragma unroll
            for (int jj = 0; jj < 8; ++jj) dacc[jj] = 0.f;
            GAS unsigned long long* o8 = (GAS unsigned long long*)(H + (size_t)m * D) + lane;
#pragma unroll
            for (int j = 0; j < 4; ++j) {
                const f32x4 av = *(const LAS f32x4*)(A1 + 256 * j + 4 * lane), sv = *(const LAS f32x4*)(S1 + 256 * j + 4 * lane);
                const f32x4 h = v[j] * rstd * av + sv;
                o8[64 * j] = (unsigned long long)pk2(h.x, h.y) | ((unsigned long long)pk2(h.z, h.w) << 32);
#pragma unroll
                for (int jj = 0; jj < 8; ++jj) { const f32x4 w = *(const LAS f32x4*)(WDT + jj * 1024 + 256 * j + 4 * lane); dacc[jj] += (h.x * w.x + h.y * w.y) + (h.z * w.z + h.w * w.w); }
            }
            { const bool u5 = (lane & 32) != 0, u4 = (lane & 16) != 0, u3 = (lane & 8) != 0; float p4[4], p2[2], p1;
#pragma unroll
              for (int i = 0; i < 4; ++i) { const float lo = dacc[i], hi = dacc[i + 4]; p4[i] = (u5 ? hi : lo) + __shfl_xor(u5 ? lo : hi, 32); }
#pragma unroll
              for (int i = 0; i < 2; ++i) { const float lo = p4[i], hi = p4[i + 2]; p2[i] = (u4 ? hi : lo) + __shfl_xor(u4 ? lo : hi, 16); }
              { const float lo = p2[0], hi = p2[1]; p1 = (u3 ? hi : lo) + __shfl_xor(u3 ? lo : hi, 8); }
              p1 += __shfl_xor(p1, 4); p1 += __shfl_xor(p1, 2); p1 += __shfl_xor(p1, 1);
              const int col = lane >> 3;
              if ((lane & 7) == 0) DT[(size_t)m * 8 + col] = softplus_f(p1 + a.in[I_DTB][col]); }
        }
    }
}

__device__ __forceinline__ void hgrn_naive(const Args& a, LAS unsigned char* lds, int bh, int tid, int wave, int lane) {
    unsigned char* ws = a.ws;
    const int b = bh >> 2, h = bh & 3, j = tid & 127, kq = tid >> 7;
    LAS float* FE = (LAS float*)lds; LAS float* KK = FE + 2048; LAS float* QQ = KK + 2048; LAS float* VV = QQ + 2048; LAS float* RED = VV + 2048;
    const bf16* P = (const bf16*)(ws + WS_P); const float* LF = (const float*)(ws + WS_LF); bf16* MIX = (bf16*)(ws + WS_MIX);
    const float* nw = a.in[I_HGNW];
    float S[32];
#pragma unroll
    for (int i = 0; i < 32; ++i) S[i] = 0.f;
    for (int t0 = 0; t0 < SEQ; t0 += 16) {
        for (int idx = tid; idx < 2048; idx += NTHR) { const int tt = idx >> 7, k = idx & 127; const size_t row = (size_t)b * SEQ + t0 + tt;
            FE[idx] = __expf(LF[row * 512 + h * 128 + k]); KK[idx] = bf2f(P[row * NPROJ + PC_K + h * 128 + k]);
            QQ[idx] = bf2f(P[row * NPROJ + PC_Q + h * 128 + k]); VV[idx] = bf2f(P[row * NPROJ + PC_V + h * 128 + k]); }
        __syncthreads();
#pragma unroll 1
        for (int tt = 0; tt < 16; ++tt) {
            const float vj = VV[tt * 128 + j]; float p = 0.f;
#pragma unroll
            for (int i4 = 0; i4 < 8; ++i4) {
                const f32x4 f4 = *(const LAS f32x4*)(FE + tt * 128 + 32 * kq + 4 * i4), k4 = *(const LAS f32x4*)(KK + tt * 128 + 32 * kq + 4 * i4), q4 = *(const LAS f32x4*)(QQ + tt * 128 + 32 * kq + 4 * i4);
#pragma unroll
                for (int c = 0; c < 4; ++c) { S[4 * i4 + c] = f4[c] * S[4 * i4 + c] + k4[c] * vj; p += S[4 * i4 + c] * q4[c]; }
            }
            RED[(kq * 16 + tt) * 128 + j] = p;
        }
        __syncthreads();
#pragma unroll
        for (int r = 0; r < 2; ++r) { const int tt = 2 * wave + r; const size_t row = (size_t)b * SEQ + t0 + tt;
            float o0 = 0.f, o1 = 0.f;
#pragma unroll
            for (int q = 0; q < 4; ++q) { o0 += RED[(q * 16 + tt) * 128 + lane]; o1 += RED[(q * 16 + tt) * 128 + 64 + lane]; }
            const float rstd = rsqrtf(wave_sum(o0 * o0 + o1 * o1) * (1.0f / 128.0f) + EPS);
            MIX[row * D + h * 128 + lane] = (bf16)f2bf(o0 * rstd * nw[lane] * bf2f(P[row * NPROJ + PC_G + h * 128 + lane]));
            MIX[row * D + h * 128 + 64 + lane] = (bf16)f2bf(o1 * rstd * nw[64 + lane] * bf2f(P[row * NPROJ + PC_G + h * 128 + 64 + lane])); }
    }
}
__device__ __forceinline__ void ssd_naive(const Args& a, LAS unsigned char* lds, int bg, int tid, int wave, int lane) {
    unsigned char* ws = a.ws;
    const int b = bg >> 1, g = bg & 1, p = tid & 63, hl = wave >> 1, nh = wave & 1;
    LAS float* XS = (LAS float*)lds; LAS float* BM = XS + 4096; LAS float* CM = BM + 2048; LAS float* DTL = CM + 2048; LAS float* DEC = DTL + 64; LAS float* RED = DEC + 64;
    const bf16* P = (const bf16*)(ws + WS_P); const float* DT = (const float*)(ws + WS_DT); bf16* MIX = (bf16*)(ws + WS_MIX);
    const float* cw = a.in[I_CONVW]; const float* cb = a.in[I_CONVB];
    float hS[64];
#pragma unroll
    for (int i = 0; i < 64; ++i) hS[i] = 0.f;
    for (int t0 = 0; t0 < SEQ; t0 += 16) {
        for (int idx = tid; idx < 16 * 512; idx += NTHR) { const int tt = idx >> 9, cc = idx & 511, t = t0 + tt;
            const int ch = (cc < 256) ? (g * 256 + cc) : (cc < 384) ? (512 + g * 128 + (cc - 256)) : (768 + g * 128 + (cc - 384));
            float v = cb[ch];
#pragma unroll
            for (int w = 0; w < 4; ++w) { const int ts = t - 3 + w; if (ts >= 0) v += bf2f(P[((size_t)b * SEQ + ts) * NPROJ + PC_X + ch]) * cw[w * 1024 + ch]; }
            v = silu_f(v);
            if (cc < 256) XS[tt * 256 + cc] = v; else if (cc < 384) BM[tt * 128 + cc - 256] = v; else CM[tt * 128 + cc - 384] = v; }
        if (tid < 64) { const int tt = tid >> 2, hh = tid & 3; const float dtv = DT[((size_t)b * SEQ + t0 + tt) * 8 + g * 4 + hh]; DTL[tid] = dtv; DEC[tid] = __expf(-dtv * __expf(a.in[I_ALOG][g * 4 + hh])); }
        __syncthreads();
#pragma unroll 1
        for (int tt = 0; tt < 16; ++tt) {
            const float dec = DEC[tt * 4 + hl], xdt = XS[tt * 256 + hl * 64 + p] * DTL[tt * 4 + hl]; float y = 0.f;
#pragma unroll
            for (int i4 = 0; i4 < 16; ++i4) { const f32x4 B4 = *(const LAS f32x4*)(BM + tt * 128 + nh * 64 + 4 * i4), C4 = *(const LAS f32x4*)(CM + tt * 128 + nh * 64 + 4 * i4);
#pragma unroll
                for (int c = 0; c < 4; ++c) { hS[4 * i4 + c] = dec * hS[4 * i4 + c] + xdt * B4[c]; y += hS[4 * i4 + c] * C4[c]; } }
            RED[(nh * 16 + tt) * 256 + hl * 64 + p] = y;
        }
        __syncthreads();
#pragma unroll
        for (int r = 0; r < 2; ++r) { const int tt = 2 * wave + r; const size_t row = (size_t)b * SEQ + t0 + tt;
            float yv[4], ss = 0.f;
#pragma unroll
            for (int i = 0; i < 4; ++i) { const int c = lane + 64 * i; float y = RED[tt * 256 + c] + RED[(16 + tt) * 256 + c] + a.in[I_SSMD][g * 4 + i] * XS[tt * 256 + c];
                y *= bf2f(P[row * NPROJ + PC_Z + g * 256 + c]); yv[i] = y; ss += y * y; }
            const float rstd = rsqrtf(wave_sum(ss) * (1.0f / 256.0f) + EPS);
#pragma unroll
            for (int i = 0; i < 4; ++i) { const int c = lane + 64 * i; MIX[row * D + 512 + g * 256 + c] = (bf16)f2bf(yv[i] * rstd * a.in[I_SSMNW][g * 256 + c]); }
        }
        __syncthreads();
    }
}


typedef float f32x16 __attribute__((ext_vector_type(16)));
constexpr size_t WS_UHG = 480 * MiB, WS_SHG = 496 * MiB, WS_USSD = 512 * MiB, WS_SSSD = 544 * MiB, WS_DK = 560 * MiB, WS_DEC = 561 * MiB;
constexpr int LDA = 136, LDT = 72;

__device__ __forceinline__ int crow(int i, int hh) { return (i & 3) + 8 * (i >> 2) + 4 * hh; }
__device__ __forceinline__ void mma32(f32x16& acc, const LAS bf16* A, int lda, const LAS bf16* Bt, int ldb, int nsteps, int lane) {
    const LAS bf16* ap = A + (lane & 31) * lda + 8 * (lane >> 5);
    const LAS bf16* bp = Bt + (lane & 31) * ldb + 8 * (lane >> 5);
    for (int s = 0; s < nsteps; ++s) {
        const bf16x8 av = *(const LAS bf16x8*)(ap + 16 * s), bv = *(const LAS bf16x8*)(bp + 16 * s);
        acc = __builtin_amdgcn_mfma_f32_32x32x16_bf16(av, bv, acc, 0, 0, 0);
    }
}
__device__ __forceinline__ f32x16 zero16() { f32x16 z;
#pragma unroll
    for (int i = 0; i < 16; ++i) z[i] = 0.f; return z; }
__device__ __forceinline__ void st8(LAS bf16* p, float a, float b, float c, float d) { *(LAS unsigned long long*)p = (unsigned long long)pk2(a, b) | ((unsigned long long)pk2(c, d) << 32); }
__device__ __forceinline__ void st16x(LAS bf16* p, const float* v) {
    v4u a, b; a.x = pk2(v[0], v[1]); a.y = pk2(v[2], v[3]); a.z = pk2(v[4], v[5]); a.w = pk2(v[6], v[7]); b.x = pk2(v[8], v[9]); b.y = pk2(v[10], v[11]); b.z = pk2(v[12], v[13]); b.w = pk2(v[14], v[15]);
    *(LAS v4u*)p = a; *(LAS v4u*)(p + 8) = b; }

__device__ __forceinline__ float bfw(unsigned w, int hi) { return __uint_as_float(hi ? (w & 0xffff0000u) : (w << 16)); }
constexpr int HG_QS = 0, HG_KS = 17408, HG_KDT = 34816, HG_VT = 53248, HG_ST = 71680, HG_ATT = 106496, HG_QT = 115712, HG_EBM = 117760, HG_EBL = 118272;
constexpr int HG_VRAW = 118784;
struct HgWide { v4u q[2], k[2], v[2]; float lf[16]; };
template <bool FULL> __device__ __forceinline__ void hg_load(const Args& a, HgWide& r, int b, int h, int t0, int tid) {
    const bf16* P = (const bf16*)(a.ws + WS_P) + ((size_t)b * SEQ + t0) * NPROJ + h * 128;
#pragma unroll
    for (int i = 0; i < 2; ++i) { const int piece = tid + NTHR * i; const unsigned o = (unsigned)(piece >> 4) * NPROJ + 8u * (unsigned)(piece & 15);
        r.k[i] = *(const v4u*)(P + o + PC_K); r.v[i] = *(const v4u*)(P + o + PC_V); if (FULL) r.q[i] = *(const v4u*)(P + o + PC_Q); }
    const int k = tid & 127, tq = tid >> 7;
    const float* LF = (const float*)(a.ws + WS_LF) + ((size_t)b * SEQ + t0 + 16 * tq) * 512 + h * 128;
#pragma unroll
    for (int i = 0; i < 16; ++i) r.lf[i] = LF[(unsigned)i * 512 + (unsigned)k];
}
template <bool FULL> __device__ __forceinline__ float hg_stage(const HgWide& r, LAS unsigned char* lds, int tid) {
    LAS bf16* QS = (LAS bf16*)(lds + HG_QS); LAS bf16* KS = (LAS bf16*)(lds + HG_KS); LAS bf16* KDT = (LAS bf16*)(lds + HG_KDT); LAS bf16* VT = (LAS bf16*)(lds + HG_VT); LAS bf16* VR = (LAS bf16*)(lds + HG_VRAW);
    LAS float* QT = (LAS float*)(lds + HG_QT); LAS float* EBM = (LAS float*)(lds + HG_EBM); LAS float* EBL = (LAS float*)(lds + HG_EBL);
#pragma unroll
    for (int i = 0; i < 2; ++i) { const int piece = tid + NTHR * i; const int o = (piece >> 4) * LDA + 8 * (piece & 15);
        *(LAS v4u*)(KS + o) = r.k[i]; *(LAS v4u*)(VR + o) = r.v[i]; if (FULL) *(LAS v4u*)(QS + o) = r.q[i]; }
    const int k = tid & 127, tq = tid >> 7;
    float cum[16]; float run = 0.f;
#pragma unroll
    for (int i = 0; i < 16; ++i) { run += r.lf[i]; cum[i] = run; }
    QT[tq * 128 + k] = run;
    __syncthreads();
    const float q0 = QT[k], q1 = QT[128 + k], q2 = QT[256 + k], q3 = QT[384 + k];
    const float off = (tq > 0 ? q0 : 0.f) + (tq > 1 ? q1 : 0.f) + (tq > 2 ? q2 : 0.f), bmid = q0 + q1, blast = (q0 + q1) + (q2 + q3);
    float kd[16], vv[16];
#pragma unroll
    for (int i = 0; i < 16; ++i) { const float bt = off + cum[i]; const int e = (16 * tq + i) * LDA + k; const float kk = bf2f(KS[e]); vv[i] = bf2f(VR[e]); kd[i] = kk * __expf(blast - bt);
        if (FULL) { QS[e] = (bf16)f2bf(bf2f(QS[e]) * __expf(bt - bmid)); KS[e] = (bf16)f2bf(kk * __expf(bmid - bt)); } }
    st16x(KDT + k * LDT + 16 * tq, kd); st16x(VT + k * LDT + 16 * tq, vv);
    if (tq == 0) { EBL[k] = __expf(blast); if (FULL) EBM[k] = __expf(bmid); }
    __syncthreads();
    return blast;
}
__device__ __forceinline__ void hg_update(f32x16 (&S)[2], LAS unsigned char* lds, int wave, int lane) {
    const LAS bf16* KDT = (const LAS bf16*)(lds + HG_KDT); const LAS bf16* VT = (const LAS bf16*)(lds + HG_VT); const LAS float* EBL = (const LAS float*)(lds + HG_EBL);
    const int kt = wave >> 1, hh = lane >> 5;
#pragma unroll
    for (int g = 0; g < 4; ++g) { const f32x4 e = *(const LAS f32x4*)(EBL + 32 * kt + 8 * g + 4 * hh);
#pragma unroll
        for (int j = 0; j < 2; ++j) { S[j][4 * g + 0] *= e.x; S[j][4 * g + 1] *= e.y; S[j][4 * g + 2] *= e.z; S[j][4 * g + 3] *= e.w; } }
#pragma unroll
    for (int j = 0; j < 2; ++j) mma32(S[j], KDT + 32 * kt * LDT, LDT, VT + 32 * (2 * (wave & 1) + j) * LDT, LDT, 4, lane);
}
__device__ __forceinline__ void hg_passA(const Args& a, LAS unsigned char* lds, int u, int tid, int wave, int lane) {
    const int bh = u >> 5, seg = u & 31, b = bh >> 2, h = bh & 3, kt = wave >> 1, hh = lane >> 5, r = lane & 31;
    f32x16 S[2]; S[0] = zero16(); S[1] = zero16();
    float dsum = 0.f;
    HgWide cur; hg_load<false>(a, cur, b, h, seg * 256, tid);
#pragma unroll 1
    for (int c = 0; c < 4; ++c) {
        dsum += hg_stage<false>(cur, lds, tid);
        if (c < 3) hg_load<false>(a, cur, b, h, seg * 256 + 64 * (c + 1), tid);
        hg_update(S, lds, wave, lane);
        __syncthreads();
    }
    float* U = (float*)(a.ws + WS_UHG) + (size_t)u * 16384;
#pragma unroll
    for (int j = 0; j < 2; ++j)
#pragma unroll
        for (int i = 0; i < 16; ++i) U[(32 * kt + crow(i, hh)) * 128 + 32 * (2 * (wave & 1) + j) + r] = S[j][i];
    if (tid < 128) ((float*)(a.ws + WS_DK))[u * 128 + tid] = __expf(dsum);
}
__device__ __forceinline__ void hg_passC(const Args& a, LAS unsigned char* lds, int u, int tid, int wave, int lane) {
    const int bh = u >> 5, seg = u & 31, b = bh >> 2, h = bh & 3, kt = wave >> 1, hh = lane >> 5, r = lane & 31;
    LAS bf16* QS = (LAS bf16*)(lds + HG_QS); LAS bf16* KS = (LAS bf16*)(lds + HG_KS); LAS bf16* VT = (LAS bf16*)(lds + HG_VT);
    LAS bf16* ST = (LAS bf16*)(lds + HG_ST); LAS bf16* ATT = (LAS bf16*)(lds + HG_ATT); LAS float* EBM = (LAS float*)(lds + HG_EBM); LAS float* O = (LAS float*)(lds + HG_QS);
    const bf16* P = (const bf16*)(a.ws + WS_P); bf16* MIX = (bf16*)(a.ws + WS_MIX); const float* nw = a.in[I_HGNW];
    f32x16 S[2];
    { const float* SI = (const float*)(a.ws + WS_SHG) + (size_t)u * 16384;
#pragma unroll
      for (int j = 0; j < 2; ++j)
#pragma unroll
        for (int i = 0; i < 16; ++i) S[j][i] = SI[(32 * kt + crow(i, hh)) * 128 + 32 * (2 * (wave & 1) + j) + r]; }
    HgWide cur; hg_load<true>(a, cur, b, h, seg * 256, tid);
#pragma unroll 1
    for (int c = 0; c < 4; ++c) {
        const int t0 = seg * 256 + 64 * c;
        hg_stage<true>(cur, lds, tid);
        if (c < 3) hg_load<true>(a, cur, b, h, t0 + 64, tid);
#pragma unroll
        for (int g = 0; g < 4; ++g) { const int kb = 32 * kt + 8 * g + 4 * hh; const f32x4 e = *(const LAS f32x4*)(EBM + kb);
#pragma unroll
            for (int j = 0; j < 2; ++j) st8(ST + (32 * (2 * (wave & 1) + j) + r) * LDA + kb, S[j][4 * g] * e.x, S[j][4 * g + 1] * e.y, S[j][4 * g + 2] * e.z, S[j][4 * g + 3] * e.w); }
        if (wave < 3) { const int ti = (wave + 1) >> 1, si = wave >> 1;
            f32x16 at = zero16(); mma32(at, QS + 32 * ti * LDA, LDA, KS + 32 * si * LDA, LDA, 8, lane);
#pragma unroll
            for (int i = 0; i < 16; ++i) { const int t = 32 * ti + crow(i, hh), s = 32 * si + r; ATT[t * LDT + s] = (bf16)f2bf(s <= t ? at[i] : 0.f); } }
        __syncthreads();
        const int ti = wave >> 2, vj = wave & 3;
        f32x16 o = zero16();
        mma32(o, ATT + 32 * ti * LDT, LDT, VT + 32 * vj * LDT, LDT, 2 * (ti + 1), lane);
        mma32(o, QS + 32 * ti * LDA, LDA, ST + 32 * vj * LDA, LDA, 8, lane);
        hg_update(S, lds, wave, lane);
        __syncthreads();
#pragma unroll
        for (int i = 0; i < 16; ++i) O[(32 * ti + crow(i, hh)) * 132 + 32 * vj + r] = o[i];
        __syncthreads();
        { const int tt = tid >> 3, c16 = tid & 7; const size_t row = (size_t)b * SEQ + t0 + tt;
          float o[16]; float ss = 0.f;
#pragma unroll
          for (int q = 0; q < 4; ++q) { const f32x4 v = *(const LAS f32x4*)(O + tt * 132 + 16 * c16 + 4 * q); o[4 * q] = v.x; o[4 * q + 1] = v.y; o[4 * q + 2] = v.z; o[4 * q + 3] = v.w; ss += (v.x * v.x + v.y * v.y) + (v.z * v.z + v.w * v.w); }
          ss += __shfl_xor(ss, 1); ss += __shfl_xor(ss, 2); ss += __shfl_xor(ss, 4);
          const float rstd = rsqrtf(ss * (1.0f / 128.0f) + EPS);
          const bf16* gp = P + row * NPROJ + PC_G + h * 128 + 16 * c16; const v4u g0 = __builtin_nontemporal_load((const v4u*)gp), g1 = __builtin_nontemporal_load((const v4u*)(gp + 8)); const unsigned gw[8] = {g0.x, g0.y, g0.z, g0.w, g1.x, g1.y, g1.z, g1.w};
          unsigned ow[8];
#pragma unroll
          for (int j = 0; j < 8; ++j) ow[j] = pk2(o[2 * j] * rstd * nw[16 * c16 + 2 * j] * bfw(gw[j], 0), o[2 * j + 1] * rstd * nw[16 * c16 + 2 * j + 1] * bfw(gw[j], 1));
          bf16* mp = MIX + row * D + h * 128 + 16 * c16; *(v4u*)mp = (v4u){ow[0], ow[1], ow[2], ow[3]}; *(v4u*)(mp + 8) = (v4u){ow[4], ow[5], ow[6], ow[7]}; }
        __syncthreads();
    }
}

constexpr int SD_ACUM = 104448, SD_DTV = 106496, SD_SSQ = 108544, SD_CB = 109568;
__device__ __forceinline__ void ssd_scan_dt(const Args& a, LAS unsigned char* lds, size_t row0, int g, int wave, int lane) {
    LAS float* ACUM = (LAS float*)(lds + SD_ACUM); LAS float* DTV = (LAS float*)(lds + SD_DTV);
    if (wave < 4) { const float* DT = (const float*)(a.ws + WS_DT); const float A = -__expf(a.in[I_ALOG][g * 4 + wave]);
        const float d0 = DT[(row0 + 2 * lane) * 8 + g * 4 + wave], d1 = DT[(row0 + 2 * lane + 1) * 8 + g * 4 + wave];
        const float p0 = d0 * A, p1 = p0 + d1 * A; float incl = p1;
#pragma unroll
        for (int o = 1; o < 64; o <<= 1) { const float t = __shfl_up(incl, o); if (lane >= o) incl += t; }
        const float excl = incl - p1;
        ACUM[wave * 128 + 2 * lane] = excl + p0; ACUM[wave * 128 + 2 * lane + 1] = incl; DTV[wave * 128 + 2 * lane] = d0; DTV[wave * 128 + 2 * lane + 1] = d1; }
}
template <int NT> __device__ __forceinline__ void conv_run(const Args& a, int b, int tp0, int ch, float (&out)[NT]) {
    const bf16* Pb = (const bf16*)(a.ws + WS_P) + (size_t)b * SEQ * NPROJ + PC_X;
    const float w0 = a.in[I_CONVW][ch], w1 = a.in[I_CONVW][1024 + ch], w2 = a.in[I_CONVW][2048 + ch], w3 = a.in[I_CONVW][3072 + ch], cb = a.in[I_CONVB][ch];
    const unsigned o0 = (unsigned)tp0 * NPROJ + (unsigned)ch;
    float x0 = (tp0 >= 3) ? bf2f(Pb[o0 - 3u * NPROJ]) : 0.f, x1 = (tp0 >= 2) ? bf2f(Pb[o0 - 2u * NPROJ]) : 0.f, x2 = (tp0 >= 1) ? bf2f(Pb[o0 - 1u * NPROJ]) : 0.f;
#pragma unroll
    for (int i = 0; i < NT; ++i) { const float x3 = bf2f(Pb[o0 + (unsigned)i * NPROJ]); out[i] = silu_f(cb + w0 * x0 + w1 * x1 + w2 * x2 + w3 * x3); x0 = x1; x1 = x2; x2 = x3; }
}
#ifdef PROBE_A
#define SUBSTAMP(k) do { if (blockIdx.x == 0 && threadIdx.x == 0) { const unsigned long long t_ = __builtin_amdgcn_s_memrealtime(); volatile LAS unsigned* M_ = (volatile LAS unsigned*)(lds + MISC_OFF); M_[16 + 2 * (k)] = (unsigned)t_; M_[17 + 2 * (k)] = (unsigned)(t_ >> 32); } } while (0)
#else
#define SUBSTAMP(k) do { } while (0)
#endif
template <bool NATURAL, bool NT = false, int NTOK = 8> __device__ __forceinline__ void conv8x8(const Args& a, int b, int tp0, int ch0, LAS bf16* dst, const float* sc) {
    const bf16* Pb = (const bf16*)(a.ws + WS_P) + (size_t)b * SEQ * NPROJ + PC_X + ch0;
    const float* cw = a.in[I_CONVW] + ch0; const float* cbp = a.in[I_CONVB] + ch0;
    float w[4][8], bias[8];
#pragma unroll
    for (int q = 0; q < 4; ++q) { const f32x4 lo = *(const f32x4*)(cw + q * 1024), hi = *(const f32x4*)(cw + q * 1024 + 4);
        w[q][0] = lo.x; w[q][1] = lo.y; w[q][2] = lo.z; w[q][3] = lo.w; w[q][4] = hi.x; w[q][5] = hi.y; w[q][6] = hi.z; w[q][7] = hi.w; }
    { const f32x4 lo = *(const f32x4*)cbp, hi = *(const f32x4*)(cbp + 4); bias[0] = lo.x; bias[1] = lo.y; bias[2] = lo.z; bias[3] = lo.w; bias[4] = hi.x; bias[5] = hi.y; bias[6] = hi.z; bias[7] = hi.w; }
    v4u raw[NTOK + 3];
#pragma unroll
    for (int i = 0; i < NTOK + 3; ++i) { const int tp = tp0 - 3 + i; const v4u* rp = (const v4u*)(Pb + (size_t)(unsigned)(tp < 0 ? 0 : tp) * NPROJ); raw[i] = (tp >= 0) ? (NT ? __builtin_nontemporal_load(rp) : *rp) : (v4u){0u, 0u, 0u, 0u}; }
    unsigned pkT[8][NTOK / 2];
#pragma unroll
    for (int tok = 0; tok < NTOK; ++tok) { float o[8];
#pragma unroll
        for (int c = 0; c < 8; ++c) { float v = bias[c];
#pragma unroll
            for (int q = 0; q < 4; ++q) v += w[q][c] * bfw(raw[tok + q][c >> 1], c & 1);
            o[c] = silu_f(v); }
        if (NATURAL) { v4u ov; ov.x = pk2(o[0], o[1]); ov.y = pk2(o[2], o[3]); ov.z = pk2(o[4], o[5]); ov.w = pk2(o[6], o[7]); *(LAS v4u*)(dst + tok * LDA) = ov; }
        else {
#pragma unroll
            for (int c = 0; c < 8; ++c) { const unsigned hb = f2bf(o[c] * sc[tok]); pkT[c][tok >> 1] = (tok & 1) ? (pkT[c][tok >> 1] | (hb << 16)) : hb; } } }
    if (!NATURAL) {
#pragma unroll
        for (int c = 0; c < 8; ++c) {
            if (NTOK == 8) { v4u ov; ov.x = pkT[c][0]; ov.y = pkT[c][1]; ov.z = pkT[c][NTOK == 8 ? 2 : 0]; ov.w = pkT[c][NTOK == 8 ? 3 : 0]; *(LAS v4u*)(dst + c * LDA) = ov; }
            else *(LAS unsigned long long*)(dst + c * LDA) = (unsigned long long)pkT[c][0] | ((unsigned long long)pkT[c][1] << 32); } }
}
constexpr int SC_CM = 0, SC_BM = 34816, SC_XT = 69632, SC_SIN = 87040, SC_YS = 104448, SC_ACUM = 139264, SC_DTV = 141312;
__device__ __forceinline__ void ssd_scan_dt_at(const Args& a, LAS unsigned char* lds, int acum_off, int dtv_off, size_t row0, int g, int wave, int lane) {
    LAS float* ACUM = (LAS float*)(lds + acum_off); LAS float* DTV = (LAS float*)(lds + dtv_off);
    if (wave < 4) { const float* DT = (const float*)(a.ws + WS_DT); const float A = -__expf(a.in[I_ALOG][g * 4 + wave]);
        const float d0 = DT[(row0 + 2 * lane) * 8 + g * 4 + wave], d1 = DT[(row0 + 2 * lane + 1) * 8 + g * 4 + wave];
        const float p0 = d0 * A, p1 = p0 + d1 * A; float incl = p1;
#pragma unroll
        for (int o = 1; o < 64; o <<= 1) { const float t = __shfl_up(incl, o); if (lane >= o) incl += t; }
        const float excl = incl - p1;
        ACUM[wave * 128 + 2 * lane] = excl + p0; ACUM[wave * 128 + 2 * lane + 1] = incl; DTV[wave * 128 + 2 * lane] = d0; DTV[wave * 128 + 2 * lane + 1] = d1; }
}
__device__ __forceinline__ void ssd_passA(const Args& a, LAS unsigned char* lds, int u, int tid, int wave, int lane) {
    const int bg = u >> 6, c = u & 63, b = bg >> 1, g = bg & 1, t0 = c * 128; const size_t row0 = (size_t)b * SEQ + t0;
    LAS bf16* XDT = (LAS bf16*)lds; LAS bf16* BMT = (LAS bf16*)(lds + 69632); LAS float* ACUM = (LAS float*)(lds + SD_ACUM); LAS float* DTV = (LAS float*)(lds + SD_DTV);
    ssd_scan_dt(a, lds, row0, g, wave, lane);
    __syncthreads();
#pragma unroll 1
    for (int task = tid; task < 768; task += NTHR) {
        int task_o = task; asm volatile("" : "+v"(task_o));
        const int cg = task_o >> 4, tb = task_o & 15; float sc[8];
        if (cg < 32) { const int hd = cg >> 3; const float al = ACUM[hd * 128 + 127];
#pragma unroll
            for (int i = 0; i < 8; ++i) sc[i] = DTV[hd * 128 + 8 * tb + i] * __expf(al - ACUM[hd * 128 + 8 * tb + i]);
            conv8x8<false>(a, b, t0 + 8 * tb, g * 256 + 8 * cg, XDT + (8 * cg) * LDA + 8 * tb, sc); }
        else {
#pragma unroll
            for (int i = 0; i < 8; ++i) sc[i] = 1.0f;
            conv8x8<false>(a, b, t0 + 8 * tb, 512 + g * 128 + 8 * (cg - 32), BMT + (8 * (cg - 32)) * LDA + 8 * tb, sc); }
    }
    __syncthreads();
    const int hd = wave >> 1, pt = wave & 1, hh = lane >> 5, r = lane & 31;
    float* U = (float*)(a.ws + WS_USSD) + (size_t)u * 32768;
#pragma unroll
    for (int nt = 0; nt < 4; ++nt) { f32x16 acc = zero16(); mma32(acc, XDT + (hd * 64 + 32 * pt) * LDA, LDA, BMT + 32 * nt * LDA, LDA, 8, lane);
#pragma unroll
        for (int i = 0; i < 16; ++i) U[(hd * 64 + 32 * pt + crow(i, hh)) * 128 + 32 * nt + r] = acc[i]; }
    if (tid < 4) ((float*)(a.ws + WS_DEC))[u * 4 + tid] = __expf(ACUM[tid * 128 + 127]);
    __syncthreads();
}
constexpr int S2_CM = 0, S2_CBT = 34816, S2_BUF = 55296, S2_BUFSZ = 34816, S2_BM = S2_BUF + S2_BUFSZ, S2_YS = 124928, S2_ACUM = 143360, S2_DTV = 145408;
__device__ __forceinline__ void ssd_stage_head(const Args& a, LAS unsigned char* lds, int u, int b, int g, int t0, int hd, int buf, int tid256, const float* ones) {
    LAS bf16* XT = (LAS bf16*)(lds + S2_BUF + buf * S2_BUFSZ); LAS bf16* SIN = XT + 64 * LDA;
    const int c8 = tid256 & 7, tb = tid256 >> 3;
    conv8x8<false, false, 4>(a, b, t0 + 4 * tb, g * 256 + hd * 64 + 8 * c8, XT + (8 * c8) * LDA + 4 * tb, ones);
    const v4u* src = (const v4u*)((const bf16*)(a.ws + WS_SSSD) + (size_t)u * 32768) + (unsigned)(hd * 64 * 16);
#pragma unroll
    for (int j = 0; j < 4; ++j) { const int piece = tid256 + 256 * j, pr = piece >> 4, c = piece & 15; *(LAS v4u*)(SIN + pr * LDA + 8 * c) = __builtin_nontemporal_load(src + piece); }
}
__device__ __forceinline__ void ssd_passC(const Args& a, LAS unsigned char* lds, int u, int tid, int wave, int lane) {
    const int bg = u >> 6, c = u & 63, b = bg >> 1, g = bg & 1, t0 = c * 128; const size_t row0 = (size_t)b * SEQ + t0;
    LAS bf16* CM = (LAS bf16*)(lds + S2_CM); LAS bf16* BM = (LAS bf16*)(lds + S2_BM); LAS unsigned char* CBT = lds + S2_CBT;
    LAS bf16* YS = (LAS bf16*)(lds + S2_YS); LAS float* ACUM = (LAS float*)(lds + S2_ACUM); LAS float* DTV = (LAS float*)(lds + S2_DTV);
    const bf16* P = (const bf16*)(a.ws + WS_P); bf16* MIX = (bf16*)(a.ws + WS_MIX);
    float ones[4];
#pragma unroll
    for (int i = 0; i < 4; ++i) ones[i] = 1.0f;
    ssd_scan_dt_at(a, lds, S2_ACUM, S2_DTV, row0, g, wave, lane);
    { const int c8 = tid & 31, tb = tid >> 5;
      conv8x8<true>(a, b, t0 + 8 * tb, (c8 < 16) ? (512 + g * 128 + 8 * c8) : (768 + g * 128 + 8 * (c8 - 16)), ((c8 < 16) ? (BM + 8 * c8) : (CM + 8 * (c8 - 16))) + 8 * tb * LDA, nullptr); }
    __syncthreads();
    for (int idx = wave; idx < 10; idx += NWAVES) { const int ti = (idx >= 6) ? 3 : (idx >= 3) ? 2 : (idx >= 1) ? 1 : 0, si = idx - ti * (ti + 1) / 2;
        f32x16 cbT = zero16(); mma32(cbT, BM + 32 * si * LDA, LDA, CM + 32 * ti * LDA, LDA, 8, lane);
        v4u o0, o1; o0.x = pk2(cbT[0], cbT[1]); o0.y = pk2(cbT[2], cbT[3]); o0.z = pk2(cbT[4], cbT[5]); o0.w = pk2(cbT[6], cbT[7]); o1.x = pk2(cbT[8], cbT[9]); o1.y = pk2(cbT[10], cbT[11]); o1.z = pk2(cbT[12], cbT[13]); o1.w = pk2(cbT[14], cbT[15]);
        *(LAS v4u*)(CBT + idx * 2048 + lane * 32) = o0; *(LAS v4u*)(CBT + idx * 2048 + lane * 32 + 16) = o1; }
    if (tid < 256) ssd_stage_head(a, lds, u, b, g, t0, 0, 0, tid, ones);
    __syncthreads();
    const int ti = (wave < 4) ? (wave >> 1) : (3 - ((wave - 4) >> 1)), pj = wave & 1;
    const int et = tid >> 2, epq = tid & 3;
    float ssq = 0.f;
    const bf16* Pz = P + (row0 + et) * NPROJ + PC_Z + g * 256 + 16 * epq;
    bf16* Mo = MIX + (row0 + et) * D + 512 + g * 256 + 16 * epq;
    SUBSTAMP(15);
#pragma unroll 1
    for (int hd = 0; hd < 4; ++hd) {
        int tid_o = tid; asm volatile("" : "+v"(tid_o));
        const int lane = tid_o & 63, hh = lane >> 5, r = lane & 31;
        const LAS bf16* XT = (const LAS bf16*)(lds + S2_BUF + (hd & 1) * S2_BUFSZ); const LAS bf16* SIN = XT + 64 * LDA;
        const v4u z0 = __builtin_nontemporal_load((const v4u*)(Pz + hd * 64)), z1 = __builtin_nontemporal_load((const v4u*)(Pz + hd * 64 + 8));
        const float Dh = a.in[I_SSMD][g * 4 + hd];
        f32x16 yi = zero16(), yo = zero16();
        const int t = 32 * ti + r; const float at = ACUM[hd * 128 + t];
        for (int si = 0; si <= ti; ++si) {
            const LAS unsigned char* cp = CBT + (ti * (ti + 1) / 2 + si) * 2048 + lane * 32; const v4u c0 = *(const LAS v4u*)cp, c1 = *(const LAS v4u*)(cp + 16);
            const unsigned cw[8] = {c0.x, c0.y, c0.z, c0.w, c1.x, c1.y, c1.z, c1.w};
            float sv[16];
#pragma unroll
            for (int gq = 0; gq < 4; ++gq) { const int s0 = 32 * si + 8 * gq + 4 * hh;
                const f32x4 a4 = *(const LAS f32x4*)(ACUM + hd * 128 + s0), d4 = *(const LAS f32x4*)(DTV + hd * 128 + s0);
#pragma unroll
                for (int q = 0; q < 4; ++q) { const int i = 4 * gq + q, s = s0 + q; float v = (s <= t) ? bfw(cw[i >> 1], i & 1) * __expf(at - a4[q]) * d4[q] : 0.f; sv[i] = (s == t) ? v + Dh : v; } }
#pragma unroll
            for (int st = 0; st < 2; ++st) {
                v4u av;
                asm volatile("v_cvt_pk_bf16_f32 %0, %4, %5\n\tv_cvt_pk_bf16_f32 %1, %6, %7\n\tv_cvt_pk_bf16_f32 %2, %8, %9\n\tv_cvt_pk_bf16_f32 %3, %10, %11\n\ts_nop 1"
                             : "=&v"(av.x), "=&v"(av.y), "=&v"(av.z), "=&v"(av.w)
                             : "v"(sv[8 * st]), "v"(sv[8 * st + 1]), "v"(sv[8 * st + 2]), "v"(sv[8 * st + 3]), "v"(sv[8 * st + 4]), "v"(sv[8 * st + 5]), "v"(sv[8 * st + 6]), "v"(sv[8 * st + 7]));
                const LAS bf16* bp = XT + (32 * pj + r) * LDA + 32 * si + 16 * st + 4 * hh;
                const unsigned long long b0 = *(const LAS unsigned long long*)bp, b1 = *(const LAS unsigned long long*)(bp + 8);
                v4u bv; bv.x = (unsigned)b0; bv.y = (unsigned)(b0 >> 32); bv.z = (unsigned)b1; bv.w = (unsigned)(b1 >> 32);
                yi = __builtin_amdgcn_mfma_f32_32x32x16_bf16(__builtin_bit_cast(bf16x8, av), __builtin_bit_cast(bf16x8, bv), yi, 0, 0, 0);
            }
        }
        mma32(yo, CM + 32 * ti * LDA, LDA, SIN + 32 * pj * LDA, LDA, 8, lane);
#pragma unroll
        for (int i = 0; i < 16; ++i) { const int tt = 32 * ti + crow(i, hh); YS[tt * 72 + 32 * pj + r] = (bf16)f2bf(yi[i] + __expf(ACUM[hd * 128 + tt]) * yo[i]); }
        if (tid_o < 256 && hd < 3) ssd_stage_head(a, lds, u, b, g, t0, hd + 1, (hd + 1) & 1, tid_o, ones);
        __syncthreads();
        if (hd == 1) SUBSTAMP(20);
        { const LAS v4u* yp = (const LAS v4u*)(YS + et * 72 + 16 * epq); const v4u y0 = yp[0], y1 = yp[1];
          const unsigned yw[8] = {y0.x, y0.y, y0.z, y0.w, y1.x, y1.y, y1.z, y1.w}, zw[8] = {z0.x, z0.y, z0.z, z0.w, z1.x, z1.y, z1.z, z1.w};
          float y[16];
#pragma unroll
          for (int j = 0; j < 16; ++j) { y[j] = bfw(yw[j >> 1], j & 1) * bfw(zw[j >> 1], j & 1); ssq += y[j] * y[j]; }
          v4u o0, o1; o0.x = pk2(y[0], y[1]); o0.y = pk2(y[2], y[3]); o0.z = pk2(y[4], y[5]); o0.w = pk2(y[6], y[7]); o1.x = pk2(y[8], y[9]); o1.y = pk2(y[10], y[11]); o1.z = pk2(y[12], y[13]); o1.w = pk2(y[14], y[15]);
          *(v4u*)(Mo + hd * 64) = o0; *(v4u*)(Mo + hd * 64 + 8) = o1; }
        __syncthreads();
        SUBSTAMP(16 + hd);
    }
    ssq += __shfl_xor(ssq, 1); ssq += __shfl_xor(ssq, 2);
    const float rstd = rsqrtf(ssq * (1.0f / 256.0f) + EPS);
    const float* nw = a.in[I_SSMNW] + g * 256 + 16 * epq;
    v4u rb[8];
#pragma unroll
    for (int hd = 0; hd < 4; ++hd) { rb[2 * hd] = *(const v4u*)(Mo + hd * 64); rb[2 * hd + 1] = *(const v4u*)(Mo + hd * 64 + 8); }
#pragma unroll
    for (int hd = 0; hd < 4; ++hd) {
        const unsigned iw[8] = {rb[2 * hd].x, rb[2 * hd].y, rb[2 * hd].z, rb[2 * hd].w, rb[2 * hd + 1].x, rb[2 * hd + 1].y, rb[2 * hd + 1].z, rb[2 * hd + 1].w};
        float wv[16];
#pragma unroll
        for (int q = 0; q < 4; ++q) { const f32x4 v = *(const f32x4*)(nw + hd * 64 + 4 * q); wv[4 * q] = v.x; wv[4 * q + 1] = v.y; wv[4 * q + 2] = v.z; wv[4 * q + 3] = v.w; }
        unsigned ow[8];
#pragma unroll
        for (int j = 0; j < 8; ++j) ow[j] = pk2(bfw(iw[j], 0) * rstd * wv[2 * j], bfw(iw[j], 1) * rstd * wv[2 * j + 1]);
        *(v4u*)(Mo + hd * 64) = (v4u){ow[0], ow[1], ow[2], ow[3]}; *(v4u*)(Mo + hd * 64 + 8) = (v4u){ow[4], ow[5], ow[6], ow[7]};
    }
    __syncthreads();
}
__device__ __forceinline__ void mix_scan(const Args& a, int bid, int G, int tid) {
    typedef float f32x2 __attribute__((ext_vector_type(2)));
    for (int gt = bid * NTHR + tid; gt < 131072; gt += G * NTHR) {
        if (gt < 65536) { const int bh = gt >> 13, e2 = gt & 8191, k = e2 >> 6;
            const f32x2* U = (const f32x2*)(a.ws + WS_UHG) + (size_t)bh * 32 * 8192 + e2; f32x2* SI = (f32x2*)(a.ws + WS_SHG) + (size_t)bh * 32 * 8192 + e2; const float* DK = (const float*)(a.ws + WS_DK) + bh * 32 * 128 + k;
            f32x2 cur = {0.f, 0.f};
#pragma unroll 16
            for (int uu = 0; uu < 32; ++uu) { SI[(size_t)uu * 8192] = cur; cur = cur * DK[uu * 128] + __builtin_nontemporal_load(U + (size_t)uu * 8192); }
        } else { const int q = gt - 65536, bg = q >> 14, e2 = q & 16383, hd = e2 >> 12;
            const f32x2* U = (const f32x2*)(a.ws + WS_USSD) + (size_t)bg * 64 * 16384 + e2; unsigned* SI = (unsigned*)(a.ws + WS_SSSD) + (size_t)bg * 64 * 16384 + e2; const float* DEC = (const float*)(a.ws + WS_DEC) + bg * 64 * 4 + hd;
            f32x2 cur = {0.f, 0.f};
#pragma unroll 16
            for (int cc = 0; cc < 64; ++cc) { SI[(size_t)cc * 16384] = pk2(cur.x, cur.y); cur = cur * DEC[cc * 4] + __builtin_nontemporal_load(U + (size_t)cc * 16384); }
        }
    }
}

template <int HALF, int MASK> __device__ __forceinline__ void tr_step(float (&p)[32], int lane) {
    const bool up = (lane & MASK) != 0;
#pragma unroll
    for (int i = 0; i < HALF; ++i) { const float lo = p[i], hi = p[i + HALF]; const float send = up ? lo : hi, keep = up ? hi : lo; p[i] = keep + __shfl_xor(send, MASK); }
}
__device__ __forceinline__ void top4_store(float v, int lane, LAS int* SEL, LAS float* SELG, int ent) {
    float tv[4]; int ti[4];
#pragma unroll
    for (int k = 0; k < 4; ++k) { const float mx = wave_max(v); const unsigned long long bal = __ballot(v == mx); const int e = __builtin_ctzll(bal) >> 1;
        tv[k] = mx; ti[k] = e; v = ((lane >> 1) == e) ? -INFINITY : v; }
    const float e1 = __expf(tv[1] - tv[0]), e2 = __expf(tv[2] - tv[0]), e3 = __expf(tv[3] - tv[0]), inv = 1.0f / (1.0f + e1 + e2 + e3);
    if (lane < 4) { SEL[ent + lane] = (lane == 0) ? ti[0] : (lane == 1) ? ti[1] : (lane == 2) ? ti[2] : ti[3];
        SELG[ent + lane] = ((lane == 0) ? 1.0f : (lane == 1) ? e1 : (lane == 2) ? e2 : e3) * inv; }
}
constexpr int RT_WB = 0, RT_HB = 66048, RT_PITCH = 1032;
__device__ __forceinline__ void p5_router(const Args& a, LAS unsigned char* lds, int bid, int G, int tid, int wave, int lane) {
    unsigned char* ws = a.ws;
    LAS bf16* WB = (LAS bf16*)(lds + RT_WB); LAS bf16* HB = (LAS bf16*)(lds + RT_HB); LAS float* PART = (LAS float*)(lds + RT_HB);
    LAS float* A2 = (LAS float*)(lds + AUX_OFF + 1024); LAS float* S2 = A2 + 1024;
    LAS float* SELG = (LAS float*)(S2 + 1024); LAS float* LOGIT = SELG + 256;
    LAS int* SEL = (LAS int*)(lds + MISC_OFF + 2048); LAS int* LSL = SEL + 256;
    const float* modf = (const float*)(ws + WS_MODF);
    { const f32x4* rw4 = (const f32x4*)a.in[I_RW];
#pragma unroll 4
      for (int it = 0; it < 16; ++it) { const int q = tid + NTHR * it, k = q >> 3, e0 = (q & 7) * 4; const f32x4 w = rw4[q];
          WB[(e0 + 0) * RT_PITCH + k] = (bf16)f2bf(w.x); WB[(e0 + 1) * RT_PITCH + k] = (bf16)f2bf(w.y); WB[(e0 + 2) * RT_PITCH + k] = (bf16)f2bf(w.z); WB[(e0 + 3) * RT_PITCH + k] = (bf16)f2bf(w.w); } }
    const bf16* x1 = (const bf16*)(ws + WS_X1); bf16* H = (bf16*)(ws + WS_H);
    int* tok_e = (int*)(ws + WS_TOK); int* tok_ls = tok_e + M * 4; float* tok_g = (float*)(tok_ls + M * 4);
    int* blkcnt = (int*)(ws + WS_BLKCNT);
    for (int c = bid; c < NCHUNK; c += G) {
        const int b = c >> 7;
        __syncthreads();
        load_mod_AS(A2, S2, a.in[I_N2W], modf, 1, nullptr, b, 3 * 1024, tid);
        __syncthreads();
        unsigned long long hb[8][4];
        unsigned long long rwa[4];
        { const GAS unsigned long long* xa = (const GAS unsigned long long*)(x1 + (size_t)(c * 64 + wave * 8) * D) + lane;
#pragma unroll
          for (int j = 0; j < 4; ++j) rwa[j] = xa[64 * j]; }
#pragma unroll
        for (int r = 0; r < 8; ++r) {
            const int m0 = c * 64 + wave * 8 + r;
            f32x4 va[4]; float sa = 0.f;
#pragma unroll
            for (int j = 0; j < 4; ++j) { const unsigned long long wa = rwa[j];
                va[j] = (f32x4){bfw((unsigned)wa, 0), bfw((unsigned)wa, 1), bfw((unsigned)(wa >> 32), 0), bfw((unsigned)(wa >> 32), 1)};
                sa += (va[j].x * va[j].x + va[j].y * va[j].y) + (va[j].z * va[j].z + va[j].w * va[j].w); }
            if (r < 7) { const GAS unsigned long long* xa = (const GAS unsigned long long*)(x1 + (size_t)(m0 + 1) * D) + lane;
#pragma unroll
                for (int j = 0; j < 4; ++j) rwa[j] = xa[64 * j]; }
            const float ra = rsqrtf(wave_sum(sa) * (1.0f / D) + EPS);
#pragma unroll
            for (int j = 0; j < 4; ++j) {
                const f32x4 av = *(const LAS f32x4*)(A2 + 256 * j + 4 * lane), sv = *(const LAS f32x4*)(S2 + 256 * j + 4 * lane);
                const f32x4 h = va[j] * ra * av + sv;
#if MOE_FP8_G1
                ((GAS unsigned*)((unsigned char*)H + (size_t)m0 * D))[lane + 64 * j] = pk4_fp8(h.x * 8.f, h.y * 8.f, h.z * 8.f, h.w * 8.f);
#else
                ((GAS unsigned long long*)(H + (size_t)m0 * D))[lane + 64 * j] = (unsigned long long)pk2(h.x, h.y) | ((unsigned long long)pk2(h.z, h.w) << 32);
#endif
                hb[r][j] = (unsigned long long)pk2(h.x, h.y) | ((unsigned long long)pk2(h.z, h.w) << 32);
            }
        }
#pragma unroll
        for (int pass = 0; pass < 2; ++pass) {
            if ((wave >> 2) == pass) {
#pragma unroll
                for (int r = 0; r < 8; ++r)
#pragma unroll
                    for (int j = 0; j < 4; ++j) *(LAS unsigned long long*)(HB + ((wave & 3) * 8 + r) * RT_PITCH + 256 * j + 4 * lane) = hb[r][j]; }
            __syncthreads();
            f32x16 acc = zero16(); mma32(acc, HB + 128 * wave, RT_PITCH, WB + 128 * wave, RT_PITCH, 8, lane);
            __syncthreads();
#pragma unroll
            for (int i = 0; i < 16; ++i) PART[wave * 1024 + crow(i, lane >> 5) * 32 + (lane & 31)] = acc[i];
            __syncthreads();
#pragma unroll
            for (int q = 0; q < 2; ++q) { const int el = tid + NTHR * q; float sacc = 0.f;
#pragma unroll
                for (int w = 0; w < 8; ++w) sacc += PART[w * 1024 + el];
                LOGIT[(el >> 5) * 33 + (el & 31)] = sacc + a.in[I_RB][el & 31]; }
            __syncthreads();
            if (tid < 32) {
                float v[32];
#pragma unroll
                for (int e = 0; e < 32; ++e) v[e] = LOGIT[tid * 33 + e];
                float tv[4]; int ti[4];
#pragma unroll
                for (int k = 0; k < 4; ++k) { float best = v[0]; int bi = 0;
#pragma unroll
                    for (int e = 1; e < 32; ++e) { const bool gt = v[e] > best; best = gt ? v[e] : best; bi = gt ? e : bi; }
                    tv[k] = best; ti[k] = bi;
#pragma unroll
                    for (int e = 0; e < 32; ++e) v[e] = (e == bi) ? -INFINITY : v[e]; }
                const float e1 = __expf(tv[1] - tv[0]), e2 = __expf(tv[2] - tv[0]), e3 = __expf(tv[3] - tv[0]), inv = 1.0f / (1.0f + e1 + e2 + e3);
                const int ent = (32 * pass + tid) * 4;
                SEL[ent] = ti[0]; SEL[ent + 1] = ti[1]; SEL[ent + 2] = ti[2]; SEL[ent + 3] = ti[3];
                SELG[ent] = inv; SELG[ent + 1] = e1 * inv; SELG[ent + 2] = e2 * inv; SELG[ent + 3] = e3 * inv; }
        }
        __syncthreads();
        if (tid < 256 + 32) {
            const int mye = (tid < 256) ? SEL[tid] : (tid - 256), lim = (tid < 256) ? tid : 256; int cnt = 0;
#pragma unroll 4
            for (int j4 = 0; j4 < 64; ++j4) { const LAS int* sp = SEL + 4 * j4; const int s0 = sp[0], s1 = sp[1], s2 = sp[2], s3 = sp[3];
                cnt += (s0 == mye && 4 * j4 < lim) + (s1 == mye && 4 * j4 + 1 < lim) + (s2 == mye && 4 * j4 + 2 < lim) + (s3 == mye && 4 * j4 + 3 < lim); }
            if (tid < 256) LSL[tid] = cnt; else blkcnt[c * 32 + tid - 256] = cnt; }
        __syncthreads();
        if (tid < 256) { const size_t o = (size_t)c * 256 + tid; tok_e[o] = SEL[tid]; tok_ls[o] = LSL[tid]; tok_g[o] = SELG[tid]; }
    }
}

__device__ __forceinline__ void moe_tables(const Args& a, LAS unsigned char* lds, int c, int tid, int wave, int lane) {
    LAS int* TS = (LAS int*)(lds + MISC_OFF + 256); LAS int* RT2E = TS + 64; LAS int* BASE = (LAS int*)(lds + AUX_OFF); LAS int* PART = BASE + 64;
    const int* blkcnt = (const int*)(a.ws + WS_BLKCNT);
    { const int e = tid & 31, part = tid >> 5; int tot = 0, bs = 0;
#pragma unroll
      for (int i = 0; i < 16; ++i) { const int cc = part * 16 + i; const int v = blkcnt[cc * 32 + e]; tot += v; bs += (cc < c) ? v : 0; }
      PART[part * 32 + e] = tot; PART[512 + part * 32 + e] = bs; }
    __syncthreads();
    if (wave == 0) {
        int total = 0, base = 0;
        if (lane < 32) {
#pragma unroll
            for (int p = 0; p < 16; ++p) { total += PART[p * 32 + lane]; base += PART[512 + p * 32 + lane]; } }
        const int tiles = (lane < 32) ? ((total + 255) >> 8) : 0;
        int incl = tiles;
#pragma unroll
        for (int o = 1; o < 32; o <<= 1) { const int t = __shfl_up(incl, o); if (lane >= o) incl += t; }
        const int start = incl - tiles;
        if (lane < 32) { TS[lane] = start; BASE[lane] = start * 256 + base; for (int t = start; t < incl; ++t) RT2E[t] = lane; }
        if (lane == 31) TS[32] = incl;
    }
    __syncthreads();
}
__device__ __forceinline__ void p6_gather(const Args& a, LAS unsigned char* lds, int bid, int G, int tid, int wave, int lane) {
    unsigned char* ws = a.ws;
    LAS int* BASE = (LAS int*)(lds + AUX_OFF);
    const int* tok_e = (const int*)(ws + WS_TOK); const int* tok_ls = tok_e + M * 4; int* tok_pos = (int*)(ws + WS_TOK) + 3 * M * 4;
    const bf16* H = (const bf16*)(ws + WS_H); bf16* XG = (bf16*)(ws + WS_XG);
    if (bid >= NCHUNK) moe_tables(a, lds, NCHUNK, tid, wave, lane);
    for (int c = bid; c < NCHUNK; c += G) {
        __syncthreads();
        moe_tables(a, lds, c, tid, wave, lane);
        LAS int* POS = BASE + 1152;
        if (tid < 256) { const size_t o = (size_t)c * 256 + tid; const int pos = BASE[tok_e[o]] + tok_ls[o]; POS[tid] = pos; tok_pos[o] = pos; }
        __syncthreads();
#if MOE_FP8_G1
        { const unsigned char* Hc = (const unsigned char*)H + (size_t)(c * 64) * D; v4u rw[8];
#pragma unroll
          for (int t = 0; t < 8; ++t) rw[t] = ((const GAS v4u*)(Hc + (size_t)(wave * 8 + t) * D))[lane];
#pragma unroll
          for (int t = 0; t < 8; ++t)
#pragma unroll
            for (int k = 0; k < 4; ++k) ((GAS v4u*)((unsigned char*)XG + (size_t)POS[(wave * 8 + t) * 4 + k] * D))[lane] = rw[t]; }
#else
        for (int i = wave; i < 256; i += NWAVES) { const int pos = POS[i];
            const GAS v4u* src = (const GAS v4u*)(H + (size_t)(c * 64 + (i >> 2)) * D); GAS v4u* dst = (GAS v4u*)(XG + (size_t)pos * D);
            dst[lane] = src[lane]; dst[64 + lane] = src[64 + lane]; }
#endif
    }
}

__device__ __forceinline__ void p9_final(const Args& a, int bid, int G, int wave, int lane) {
    unsigned char* ws = a.ws;
    const bf16* x1 = (const bf16*)(ws + WS_X1); const bf16* Y = (const bf16*)(ws + WS_XG);
    const float* tok_g = (const float*)(ws + WS_TOK) + 2 * M * 4; const int* tok_pos = (const int*)(ws + WS_TOK) + 3 * M * 4;
    const float* modf = (const float*)(ws + WS_MODF); const float* fnw = a.in[I_FNW]; float* out = a.out;
    const int gw = bid * NWAVES + wave, NGW = G * NWAVES;
    int pos_n[4]; float gk_n[4];
    if (gw < M) {
#pragma unroll
        for (int k = 0; k < 4; ++k) { pos_n[k] = tok_pos[(size_t)gw * 4 + k]; gk_n[k] = tok_g[(size_t)gw * 4 + k]; } }
#pragma unroll 1
    for (int m = gw; m < M; m += NGW) {
        const int b = m >> 13; const float* g2 = modf + b * 6144 + 5 * 1024;
        int posv[4]; float gkv[4];
#pragma unroll
        for (int k = 0; k < 4; ++k) { posv[k] = pos_n[k]; gkv[k] = gk_n[k]; }
        if (m + NGW < M) {
#pragma unroll
            for (int k = 0; k < 4; ++k) { pos_n[k] = tok_pos[(size_t)(m + NGW) * 4 + k]; gk_n[k] = tok_g[(size_t)(m + NGW) * 4 + k]; } }
        f32x4 mo[4];
#pragma unroll
        for (int j = 0; j < 4; ++j) mo[j] = (f32x4){0.f, 0.f, 0.f, 0.f};
#pragma unroll
        for (int k = 0; k < 4; ++k) { const int pos = posv[k];
#if Y_FP8
            const float gk = gkv[k] * 0.125f;
            const GAS unsigned* yr = (const GAS unsigned*)((const unsigned char*)Y + (size_t)pos * D) + lane;
#pragma unroll
            for (int j = 0; j < 4; ++j) { const int w = (int)__builtin_nontemporal_load((const unsigned*)yr + 64 * j); typedef float f32x2 __attribute__((ext_vector_type(2)));
                const f32x2 lo = __builtin_amdgcn_cvt_pk_f32_fp8(w, false), hi = __builtin_amdgcn_cvt_pk_f32_fp8(w, true);
                mo[j].x += gk * lo.x; mo[j].y += gk * lo.y; mo[j].z += gk * hi.x; mo[j].w += gk * hi.y; }
#else
            const float gk = gkv[k];
            const GAS unsigned long long* yr = (const GAS unsigned long long*)(Y + (size_t)pos * D) + lane;
#pragma unroll
            for (int j = 0; j < 4; ++j) { const unsigned long long w = yr[64 * j]; const unsigned lo = (unsigned)w, hi = (unsigned)(w >> 32);
                mo[j].x += gk * __uint_as_float(lo << 16); mo[j].y += gk * __uint_as_float(lo & 0xffff0000u); mo[j].z += gk * __uint_as_float(hi << 16); mo[j].w += gk * __uint_as_float(hi & 0xffff0000u); }
#endif
        }
        const GAS unsigned long long* xr = (const GAS unsigned long long*)(x1 + (size_t)m * D) + lane;
        f32x4 v[4]; float ss = 0.f;
#pragma unroll
        for (int j = 0; j < 4; ++j) { const f32x4 gv = *(const f32x4*)(g2 + 256 * j + 4 * lane); const unsigned long long xw = __builtin_nontemporal_load((const unsigned long long*)xr + 64 * j);
            v[j] = (f32x4){bfw((unsigned)xw, 0), bfw((unsigned)xw, 1), bfw((unsigned)(xw >> 32), 0), bfw((unsigned)(xw >> 32), 1)} + gv * mo[j]; ss += (v[j].x * v[j].x + v[j].y * v[j].y) + (v[j].z * v[j].z + v[j].w * v[j].w); }
        const float rstd = rsqrtf(wave_sum(ss) * (1.0f / D) + EPS);
        GAS f32x4* orow = (GAS f32x4*)(out + (size_t)m * D) + lane;
#pragma unroll
        for (int j = 0; j < 4; ++j) { const f32x4 wv = *(const f32x4*)(fnw + 256 * j + 4 * lane); __builtin_nontemporal_store(v[j] * rstd * wv, (f32x4*)(out + (size_t)m * D) + lane + 64 * j); }
    }
}

#ifndef REP_MASK
#define REP_MASK 0
#endif
#define NREP(k) (((REP_MASK) >> (k)) & 1 ? 2 : 1)
#define REPB(k, rr) do { if ((rr) + 1 < NREP(k) && multi) { if ((k) >= 9) { LANE_TID(); xcd_barrier(bar, tid == 0); } else xcd_barrier(bar, tid == 0); } } while (0)
#ifndef SKEW_TICKS
#define SKEW_TICKS 0
#endif
#define PHASE_SKEW() do { if (SKEW_TICKS > 0) { const unsigned long long t0_ = __builtin_amdgcn_s_memrealtime(), w_ = (unsigned long long)(bid & 3) * SKEW_TICKS; while (__builtin_amdgcn_s_memrealtime() - t0_ < w_) __builtin_amdgcn_s_sleep(2); } } while (0)
#ifndef HG_CHUNKED
#define HG_CHUNKED 1
#endif
#ifndef SSD_CHUNKED
#define SSD_CHUNKED 1
#endif
constexpr int NPHASE = 12;
__global__ void __launch_bounds__(NTHR, 2) mk_fwd(Args args) {
    extern __shared__ __attribute__((aligned(16))) unsigned char lds_raw[];
    LAS unsigned char* lds = (LAS unsigned char*)lds_raw;
    const int tid = threadIdx.x, lane = tid & 63, wave = __builtin_amdgcn_readfirstlane(tid >> 6); __builtin_assume(wave >= 0 && wave < 8);
#define LANE_TID() int lane; asm volatile("v_mbcnt_lo_u32_b32 %0, -1, 0\n\tv_mbcnt_hi_u32_b32 %0, -1, %0" : "=v"(lane)); __builtin_assume(lane >= 0 && lane < 64); const int tid = wave * 64 + lane; (void)tid
    const int G = gridDim.x, bid = blockIdx.x;
    unsigned char* ws = args.ws;
    gu32* ctl = (gu32*)(ws + WS_CTL);
    volatile LAS unsigned* MISC = (volatile LAS unsigned*)(lds + MISC_OFF);
    if (tid < 64) MISC[tid] = 0u;
    __syncthreads();
    const int lo = args.ph_lo, hi = args.ph_hi;
    const bool multi = (hi - lo) > 1;
    XcdBarrier bar; bar.bar = (unsigned*)(ctl + CW_BAR); bar.x = 0; bar.st = nullptr;
    if (multi) bar = xcd_barrier_post((unsigned*)(ctl + CW_BAR), MISC + 8, tid == 0);
#define IN(k) (lo <= (k) && (k) < hi)
#ifdef PROBE_A
#ifndef PROBE_BUSY
#define PROBE_BUSY 0
#endif
#define STAMP(k) do { int tid_s; if ((k) >= 9) { LANE_TID(); tid_s = tid; } else tid_s = tid; if (tid_s == 0) { const unsigned long long t_ = __builtin_amdgcn_s_memrealtime(); MISC[16 + 2 * (k)] = (unsigned)t_; MISC[17 + 2 * (k)] = (unsigned)(t_ >> 32); } } while (0)
#define ARRIVE(k) do { int tid_s; if ((k) >= 9) { LANE_TID(); tid_s = tid; } else tid_s = tid; if (tid_s == 0 && (k) == PROBE_A) { const unsigned long long t_ = __builtin_amdgcn_s_memrealtime(); const unsigned long long s_ = ((unsigned long long)MISC[17 + 2 * (k)] << 32) | MISC[16 + 2 * (k)]; \
    const unsigned busy = (unsigned)(t_ - s_); atomicMax((unsigned*)ctl + 3000, busy); atomicAdd((unsigned*)ctl + 3064, busy); } } while (0)
#else
#define STAMP(k) do { } while (0)
#define ARRIVE(k) do { } while (0)
#endif
#define SEAM(k) do { ARRIVE(k); if (IN(k) && IN((k) + 1)) { if ((k) >= 8) { LANE_TID(); xcd_barrier(bar, tid == 0); } else xcd_barrier(bar, tid == 0); } STAMP((k) + 1); } while (0)

    STAMP(0);
    if (IN(0)) { for (int rr_ = 0; rr_ < NREP(0); ++rr_) { p0_prologue(args, lds, bid, G, tid, wave, lane);  REPB(0, rr_); } } SEAM(0);
    if (IN(1)) { for (int rr_ = 0; rr_ < NREP(1); ++rr_) { p1_norm(args, lds, bid, G, tid, wave, lane);  REPB(1, rr_); } } SEAM(1);
    if (IN(2)) { for (int rr_ = 0; rr_ < NREP(2); ++rr_) {
        pg8::Gemm g{(const pg8::bf16_t*)(ws + WS_H), (const pg8::bf16_t*)(ws + WS_WIN), M, NPROJ, D}; pg8::StaticOrder S; S.init(M, NPROJ, G, bid);
        pg8::EpiIn E{(pg8::bf16_t*)(ws + WS_P), (float*)(ws + WS_LF), args.in[I_LBL]};
#ifdef PROBE_G
        if (threadIdx.x == 0) MISC[61] = (PROBE_G == 2) ? 1u : 0u; __syncthreads();
#endif
        pg8::gemm_phase<pg8::EpiIn, pg8::StaticOrder, true, true>(lds, g, S, E, wave);
        __syncthreads(); p0_bg_items(args, lds, bid, G, tid, wave, lane);
     REPB(2, rr_); } } SEAM(2);
    if (IN(3)) { for (int rr_ = 0; rr_ < NREP(3); ++rr_) {
        for (int u = bid; u < 256; u += G) {
            __syncthreads();
#if HG_CHUNKED
            hg_passA(args, lds, u, tid, wave, lane);
            STAMP(14);
#endif
            __syncthreads();
#if SSD_CHUNKED
            ssd_passA(args, lds, u, tid, wave, lane);
#endif
        }
     REPB(3, rr_); } } SEAM(3);
    if (IN(4)) { for (int rr_ = 0; rr_ < NREP(4); ++rr_) { mix_scan(args, bid, G, tid);  REPB(4, rr_); } } SEAM(4);
    if (IN(5)) { for (int rr_ = 0; rr_ < NREP(5); ++rr_) {
        for (int u = bid; u < 256; u += G) {
            __syncthreads();
#if HG_CHUNKED
            hg_passC(args, lds, u, tid, wave, lane);
            STAMP(13);
#else
            if (u < 8) hgrn_naive(args, lds, u, tid, wave, lane);
#endif
            __syncthreads();
#if SSD_CHUNKED
            ssd_passC(args, lds, u, tid, wave, lane);
#else
            if (u >= 8 && u < 12) ssd_naive(args, lds, u - 8, tid, wave, lane);
#endif
        }
     REPB(5, rr_); } } SEAM(5);
    if (IN(6)) { for (int rr_ = 0; rr_ < NREP(6); ++rr_) {
        pg8::Gemm g{(const pg8::bf16_t*)(ws + WS_MIX), (const pg8::bf16_t*)(ws + WS_WOUT), M, D, D}; pg8::StaticOrder S; S.init(M, D, G, bid);
        pg8::EpiOut E{args.in[I_X], (pg8::bf16_t*)(ws + WS_X1), (const float*)(ws + WS_MODF) + 2 * 1024};
#ifdef PROBE_G
        if (threadIdx.x == 0) MISC[61] = (PROBE_G == 6) ? 1u : 0u; __syncthreads();
#endif
        pg8::gemm_phase<pg8::EpiOut, pg8::StaticOrder, true, true>(lds, g, S, E, wave);
     REPB(6, rr_); } } SEAM(6);
    if (IN(7)) { for (int rr_ = 0; rr_ < NREP(7); ++rr_) { p5_router(args, lds, bid, G, tid, wave, lane);  REPB(7, rr_); } } SEAM(7);
    if (IN(8)) { for (int rr_ = 0; rr_ < NREP(8); ++rr_) { p6_gather(args, lds, bid, G, tid, wave, lane);  REPB(8, rr_); } } SEAM(8);
    if (IN(9) || IN(10)) {
        if (!IN(8)) { LANE_TID(); moe_tables(args, lds, NCHUNK, tid, wave, lane); }
        const PG8_LAS int* TS = (const PG8_LAS int*)(lds + MISC_OFF + 256);
        const int R = __builtin_amdgcn_readfirstlane(TS[32]);
        int kmoe1 = MOE_FP8_G1 ? D / 2 : D, kmoe2 = MOE_FP8_G2 ? D / 2 : D; asm volatile("" : "+s"(kmoe1), "+s"(kmoe2));
        if (IN(9)) { for (int rr_ = 0; rr_ < NREP(9); ++rr_) { LANE_TID();
            pg8::Gemm g{(const pg8::bf16_t*)(ws + WS_XG), (const pg8::bf16_t*)(ws + WS_W1), R * 256, 2048, kmoe1};
            PHASE_SKEW();
            pg8::MoeOrder S{TS + 64, 8, R * 8, G, bid};
            pg8::EpiW1<MOE_FP8_G1 != 0, MOE_FP8_G2 != 0> E{(void*)(ws + WS_ACT), args.in[I_B1]};
#ifdef PROBE_G
        if (threadIdx.x == 0) MISC[61] = (PROBE_G == 9) ? 1u : 0u; __syncthreads();
#endif
            pg8::gemm_phase<pg8::EpiW1<MOE_FP8_G1 != 0, MOE_FP8_G2 != 0>, pg8::MoeOrder, true, true, MOE_FP8_G1 != 0>(lds, g, S, E, wave);
         REPB(9, rr_); } }
        SEAM(9);
        if (IN(10)) { for (int rr_ = 0; rr_ < NREP(10); ++rr_) { LANE_TID();
            pg8::Gemm g{(const pg8::bf16_t*)(ws + WS_ACT), (const pg8::bf16_t*)(ws + WS_W2), R * 256, 1024, kmoe2};
            PHASE_SKEW();
            pg8::MoeOrder S{TS + 64, 4, R * 4, G, bid};
            pg8::EpiW2<Y_FP8 != 0> E{(void*)(ws + WS_XG), args.in[I_B2], MOE_FP8_G2 ? (1.0f / 512.0f) : 1.0f};
#ifdef PROBE_G
        if (threadIdx.x == 0) MISC[61] = (PROBE_G == 10) ? 1u : 0u; __syncthreads();
#endif
            pg8::gemm_phase<pg8::EpiW2<Y_FP8 != 0>, pg8::MoeOrder, true, true, MOE_FP8_G2 != 0>(lds, g, S, E, wave);
         REPB(10, rr_); } }
    }
    SEAM(10);
    if (IN(11)) { for (int rr_ = 0; rr_ < NREP(11); ++rr_) { LANE_TID(); p9_final(args, bid, G, wave, lane);  REPB(11, rr_); } }
#ifdef PROBE_A
    STAMP(12);
    int lpr_; asm volatile("v_mbcnt_lo_u32_b32 %0, -1, 0\n\tv_mbcnt_hi_u32_b32 %0, -1, %0" : "=v"(lpr_)); if (bid == 0 && wave == 0 && lpr_ == 0) {
        const unsigned long long mx = __hip_atomic_load((unsigned*)ctl + 3000, __ATOMIC_RELAXED, __HIP_MEMORY_SCOPE_AGENT);
        const unsigned long long sp = ((((unsigned long long)MISC[17 + 2 * (PROBE_A + 1)] << 32) | MISC[16 + 2 * (PROBE_A + 1)]) - (((unsigned long long)MISC[17 + 2 * PROBE_A] << 32) | MISC[16 + 2 * PROBE_A]));
#ifndef PROBE_B
#define PROBE_B (PROBE_A + 1)
#endif
        const unsigned long long sp2 = ((((unsigned long long)MISC[17 + 2 * (PROBE_B)] << 32) | MISC[16 + 2 * (PROBE_B)]) - (((unsigned long long)MISC[17 + 2 * PROBE_A] << 32) | MISC[16 + 2 * PROBE_A]));
#ifdef PROBE_G
        const unsigned long long wait = 64ull * (unsigned long long)MISC[60], t0 = __builtin_amdgcn_s_memrealtime();
#else
        (void)sp; const unsigned long long wait = 64ull * (PROBE_BUSY ? mx : sp2), t0 = __builtin_amdgcn_s_memrealtime();
#endif
        while (__builtin_amdgcn_s_memrealtime() - t0 < wait) __builtin_amdgcn_s_sleep(4);
    }
#endif
#undef IN
#undef SEAM
}

#ifndef MK_N_LAUNCHES
#define MK_N_LAUNCHES 1
#endif
extern "C" void kernel_launch(void* const* d_in, const int* in_sizes, int n_in, void* d_out, int out_size, void* d_ws, size_t ws_size, hipStream_t stream) {
    static int grid = 0;
    if (grid == 0) {
        if (n_in != 23 || out_size != M * D || ws_size < WS_END) { fprintf(stderr, "kernel_launch: unexpected shapes (n_in %d out %d ws %zu)\n", n_in, out_size, ws_size); grid = -1; return; }
        int dev = 0, cus = 0;
        if (hipGetDevice(&dev) != hipSuccess || hipDeviceGetAttribute(&cus, hipDeviceAttributeMultiprocessorCount, dev) != hipSuccess) { grid = -1; return; }
        if (hipFuncSetAttribute((const void*)mk_fwd, hipFuncAttributeMaxDynamicSharedMemorySize, LDS_BYTES) != hipSuccess) { fprintf(stderr, "kernel_launch: hipFuncSetAttribute failed\n"); grid = -1; return; }
        int per_cu = 0;
        if (hipOccupancyMaxActiveBlocksPerMultiprocessor(&per_cu, (const void*)mk_fwd, NTHR, LDS_BYTES) != hipSuccess || per_cu < 1) fprintf(stderr, "kernel_launch: occupancy query says %d\n", per_cu);
        (void)hipGetLastError();
        grid = cus;
    }
    if (grid < 0) return;
    (void)hipMemsetAsync((char*)d_ws + WS_CTL, 0, CTL_ZERO_BYTES, stream);
    Args a{};
    for (int i = 0; i < 23; ++i) a.in[i] = (const float*)d_in[i];
    a.out = (float*)d_out; a.ws = (unsigned char*)d_ws;
    if (MK_N_LAUNCHES == 1) { a.ph_lo = 0; a.ph_hi = NPHASE; hipLaunchKernelGGL(mk_fwd, dim3(grid), dim3(NTHR), LDS_BYTES, stream, a); }
    else for (int p = 0; p < NPHASE; ++p) { a.ph_lo = p; a.ph_hi = p + 1; hipLaunchKernelGGL(mk_fwd, dim3(grid), dim3(NTHR), LDS_BYTES, stream, a); }
}
```

```cpp
#include <hip/hip_runtime.h>
#include <cstdio>
#include <cstdint>
namespace pg8 {
#define PG8_LAS __attribute__((address_space(3)))
typedef unsigned short bf16_t;
typedef short bf16x8 __attribute__((ext_vector_type(8)));
typedef float f32x4 __attribute__((ext_vector_type(4)));
typedef unsigned u32x4 __attribute__((ext_vector_type(4)));
constexpr int BM = 256, BK = 64, HALF = 128, HTB = HALF * BK * 2  , STAGE_BYTES = 8 * HTB, NXCD = 8, WGM = 8;

__host__ __device__ __forceinline__ int lds_byte(int r, int c) { const int st = (r >> 4) * 2 + (c >> 5), rr = r & 15, cc = c & 31, ob = rr * 64 + cc * 2; return st * 1024 + (ob ^ (((ob >> 9) & 1) << 5)); }
__host__ __device__ __forceinline__ void stage_rc(int b, int& R, int& C) { const int st = b / 1024, sb = b % 1024, swz = sb ^ (((sb >> 9) & 1) << 5); R = (st >> 1) * 16 + swz / 64; C = (st & 1) * 32 + (swz % 64) / 2; }
__host__ __device__ __forceinline__ int perm32(int rho) { const int n = rho >> 4, i = rho & 15; return 8 * (i >> 2) + 4 * n + (i & 3); }

struct Unit { int pm, pn; };
struct Gemm { const bf16_t* A; const bf16_t* Bt; int M, N, K; };

struct StaticOrder {
    int nM, nN, nwg, G, c;
    __host__ __device__ void init(int M, int N, int G_, int c_) { nM = M / BM; nN = N / BM; nwg = nM * nN; G = G_; c = c_; }
    __host__ __device__ bool next(int i, Unit& u) const {
        const int L = i * G + c; if (L >= nwg) return false;
        int wgid = L; { const int q = nwg / NXCD, r = nwg % NXCD, xcd = wgid % NXCD, off = wgid / NXCD; wgid = (xcd < r ? xcd * (q + 1) : r * (q + 1) + (xcd - r) * q) + off; }
        const int nig = WGM * nN, gid = wgid / nig, fm = gid * WGM, gsz = (nM - fm) < WGM ? (nM - fm) : WGM;
        u.pm = fm + ((wgid % nig) % gsz); u.pn = (wgid % nig) / gsz; return true;
    }
    __device__ __forceinline__ void a_ready(const Unit&) const {}
    __device__ __forceinline__ void done(const Unit&) const {}
};

__device__ __forceinline__ unsigned cvt_pk_bf16(float lo, float hi) { unsigned r; asm volatile("v_cvt_pk_bf16_f32 %0, %1, %2" : "=v"(r) : "v"(lo), "v"(hi)); return r; }
typedef float f32x2 __attribute__((ext_vector_type(2)));
typedef int v8i32 __attribute__((ext_vector_type(8)));
__device__ __forceinline__ v8i32 cat8(bf16x8 lo, bf16x8 hi) { typedef short s16x16 __attribute__((ext_vector_type(16))); return __builtin_bit_cast(v8i32, __builtin_shufflevector(lo, hi, 0, 1, 2, 3, 4, 5, 6, 7, 8, 9, 10, 11, 12, 13, 14, 15)); }
template <class Epi, class Sched, bool ALIGN_EPI = false, bool SP2 = false, bool F8 = false>
__device__ __forceinline__ void gemm_phase(PG8_LAS unsigned char* lds, const Gemm g, const Sched& S, const Epi& E, int wid) {
    int lane; asm volatile("v_mbcnt_lo_u32_b32 %0, -1, 0\n\tv_mbcnt_hi_u32_b32 %0, -1, %0" : "=v"(lane)); __builtin_assume(lane >= 0 && lane < 64); __builtin_assume(wid >= 0 && wid < 8);
    const int tid = wid * 64 + lane, wr = wid >> 2, wc = wid & 3, fr = lane & 15, fq = lane >> 4;
    const int K = g.K, nt = K / BK;
    unsigned voffA[2], voffB[2];
#pragma unroll
    for (int i = 0; i < 2; ++i) { int R, C; stage_rc(tid * 16 + i * 8192, R, C); const int Rb = Epi::PERM ? ((R & ~31) + perm32(R & 31)) : R;
        voffA[i] = (unsigned)(R * K + C) * 2u; voffB[i] = (unsigned)(Rb * K + C) * 2u; }
    const unsigned kstep = (unsigned)(BK * 2);
    const unsigned hstep = (unsigned)HALF * (unsigned)K * 2u;
    const unsigned tstep = 2u * hstep;
    const unsigned ldsw = (unsigned)wid * 1024u;
    const int aoff = lds_byte(wr * 64 + fr, fq * 8), boff = lds_byte(wc * 32 + fr, fq * 8);
#define PG8_SA(b, h) (((b) * 2 + (h)) * HTB)
#define PG8_SB(b, h) ((4 + (b) * 2 + (h)) * HTB)
#define PG8_STAGE(bufoff, gbase, voff) do { _Pragma("unroll") for (int _i = 0; _i < 2; ++_i) \
        __builtin_amdgcn_global_load_lds((const unsigned*)((const char*)(gbase) + (voff)[_i]), (PG8_LAS unsigned*)(lds + (bufoff) + ldsw + _i * 8192), 16, 0, 0); } while (0)
#define PG8_LDA(dst, b, h) do { _Pragma("unroll") for (int m = 0; m < 4; ++m) _Pragma("unroll") for (int k = 0; k < 2; ++k) dst[m][k] = *(const PG8_LAS bf16x8*)(lds + PG8_SA(b, h) + aoff + m * 2048 + k * 1024); } while (0)
#define PG8_LDB(dst, b, h) do { _Pragma("unroll") for (int n = 0; n < 2; ++n) _Pragma("unroll") for (int k = 0; k < 2; ++k) dst[n][k] = *(const PG8_LAS bf16x8*)(lds + PG8_SB(b, h) + boff + n * 2048 + k * 1024); } while (0)
#define PG8_MMA(ai, bj, At, Bt) do { __builtin_amdgcn_s_setprio(1); _Pragma("unroll") for (int m = 0; m < 4; ++m) _Pragma("unroll") for (int n = 0; n < 2; ++n) { \
        if constexpr (F8) acc[ai][bj][m][n] = __builtin_amdgcn_mfma_scale_f32_16x16x128_f8f6f4(cat8(Bt[n][0], Bt[n][1]), cat8(At[m][0], At[m][1]), acc[ai][bj][m][n], 0, 0, 0, 0, 0, 0); \
        else { _Pragma("unroll") for (int k = 0; k < 2; ++k) acc[ai][bj][m][n] = __builtin_amdgcn_mfma_f32_16x16x32_bf16(Bt[n][k], At[m][k], acc[ai][bj][m][n], 0, 0, 0); } } __builtin_amdgcn_s_setprio(0); } while (0)
#define PG8_WAIT_V(n) asm volatile("s_waitcnt vmcnt(" #n ")" ::: "memory")
#define PG8_WAIT_L(n) asm volatile("s_waitcnt lgkmcnt(" #n ")" ::: "memory")
#define PG8_BAR __builtin_amdgcn_s_barrier()
#define PG8_SCHED __builtin_amdgcn_sched_barrier(0)
    Unit cur, nxt; int ui = 0;
    if (!S.next(0, cur)) return;
    f32x4 acc[2][2][4][2];
#pragma unroll
    for (int a = 0; a < 2; ++a)
#pragma unroll
        for (int b = 0; b < 2; ++b)
#pragma unroll
            for (int m = 0; m < 4; ++m)
#pragma unroll
                for (int n = 0; n < 2; ++n) acc[a][b][m][n] = (f32x4){0.f, 0.f, 0.f, 0.f};
    bf16x8 At[4][2], B0[2][2], B1[2][2];
    const char* cA = (const char*)g.A + (size_t)((unsigned)cur.pm * tstep); const char* cB = (const char*)g.Bt + (size_t)((unsigned)cur.pn * tstep);
    S.a_ready(cur);
    if constexpr (SP2) {
        PG8_STAGE(PG8_SB(0, 0), cB, voffB); PG8_STAGE(PG8_SB(0, 1), cB + hstep, voffB); PG8_STAGE(PG8_SA(0, 0), cA, voffA); PG8_STAGE(PG8_SA(0, 1), cA + hstep, voffA);
        if (wr == 1) PG8_BAR;
        PG8_WAIT_V(2); PG8_BAR;
        PG8_STAGE(PG8_SB(1, 0), cB + kstep, voffB); PG8_STAGE(PG8_SA(1, 0), cA + kstep, voffA); PG8_STAGE(PG8_SB(1, 1), cB + hstep + kstep, voffB);
        PG8_WAIT_V(6); PG8_BAR;
    } else {
        PG8_STAGE(PG8_SB(0, 0), cB, voffB); PG8_STAGE(PG8_SA(0, 0), cA, voffA); PG8_STAGE(PG8_SB(0, 1), cB + hstep, voffB); PG8_STAGE(PG8_SA(0, 1), cA + hstep, voffA);
        if (wr == 1) PG8_BAR;
        PG8_WAIT_V(4); PG8_BAR;
        PG8_STAGE(PG8_SB(1, 0), cB + kstep, voffB); PG8_STAGE(PG8_SA(1, 0), cA + kstep, voffA); PG8_STAGE(PG8_SB(1, 1), cB + hstep + kstep, voffB);
        PG8_WAIT_V(6); PG8_BAR;
    }
    for (;;) {
        const bool has_next = S.next(ui + 1, nxt);
        const char* nA = has_next ? (const char*)g.A + (size_t)((unsigned)nxt.pm * tstep) : cA; const char* nB = has_next ? (const char*)g.Bt + (size_t)((unsigned)nxt.pn * tstep) : cB;
        _Pragma("unroll 1") for (int t = 0; t < nt; t += 2) {
            const bool last = (t == nt - 2);
            const char* a1 = cA + (size_t)((unsigned)(t + 1) * kstep);
            const char* a2 = last ? nA : cA + (size_t)((unsigned)(t + 2) * kstep); const char* b2 = last ? nB : cB + (size_t)((unsigned)(t + 2) * kstep);
            const char* a3 = a2 + kstep; const char* b3 = b2 + kstep;
            const char* a1h = a1 + hstep; const char* a2h = a2 + hstep; const char* b2h = b2 + hstep; const char* b3h = b3 + hstep;
            asm volatile("" : "+s"(a1h), "+s"(a2), "+s"(a2h), "+s"(b2), "+s"(b2h), "+s"(a3), "+s"(b3), "+s"(b3h));
            if (last && has_next) S.a_ready(nxt);
            if constexpr (SP2) {
            PG8_LDB(B0, 0, 0); PG8_LDB(B1, 0, 1); PG8_SCHED; PG8_LDA(At, 0, 0); PG8_STAGE(PG8_SA(1, 1), a1h, voffA);
            PG8_WAIT_V(8); PG8_WAIT_L(0); PG8_BAR; PG8_MMA(0, 0, At, B0); PG8_MMA(0, 1, At, B1); PG8_BAR; PG8_SCHED;
            PG8_LDA(At, 0, 1); PG8_STAGE(PG8_SB(0, 0), b2, voffB); PG8_STAGE(PG8_SB(0, 1), b2h, voffB); PG8_STAGE(PG8_SA(0, 0), a2, voffA);
            PG8_WAIT_V(8); PG8_WAIT_L(0); PG8_BAR; PG8_MMA(1, 0, At, B0); PG8_MMA(1, 1, At, B1); PG8_BAR; PG8_SCHED;
            PG8_LDB(B0, 1, 0); PG8_LDB(B1, 1, 1); PG8_SCHED; PG8_LDA(At, 1, 0); PG8_STAGE(PG8_SA(0, 1), a2h, voffA);
            PG8_WAIT_V(8); PG8_WAIT_L(0); PG8_BAR; PG8_MMA(0, 0, At, B0); PG8_MMA(0, 1, At, B1); PG8_BAR; PG8_SCHED;
            PG8_LDA(At, 1, 1); PG8_STAGE(PG8_SB(1, 0), b3, voffB); PG8_STAGE(PG8_SB(1, 1), b3h, voffB); PG8_STAGE(PG8_SA(1, 0), a3, voffA);
            PG8_WAIT_V(8); PG8_WAIT_L(0); PG8_BAR; PG8_MMA(1, 0, At, B0); PG8_MMA(1, 1, At, B1); PG8_BAR; PG8_SCHED;
            } else {
            PG8_LDB(B0, 0, 0); PG8_SCHED; PG8_LDA(At, 0, 0); PG8_STAGE(PG8_SA(1, 1), a1h, voffA);
            PG8_WAIT_L(8); PG8_BAR; PG8_WAIT_L(0); PG8_MMA(0, 0, At, B0); PG8_BAR; PG8_SCHED;
            PG8_LDB(B1, 0, 1); PG8_STAGE(PG8_SB(0, 0), b2, voffB);
            PG8_BAR; PG8_WAIT_L(0); PG8_MMA(0, 1, At, B1); PG8_BAR;
            PG8_LDA(At, 0, 1); PG8_STAGE(PG8_SA(0, 0), a2, voffA);
            PG8_BAR; PG8_WAIT_L(0); PG8_MMA(1, 0, At, B0); PG8_BAR; PG8_SCHED;
            PG8_STAGE(PG8_SB(0, 1), b2h, voffB);
            PG8_WAIT_V(6); PG8_BAR; PG8_MMA(1, 1, At, B1); PG8_BAR;
            PG8_LDB(B0, 1, 0); PG8_SCHED; PG8_LDA(At, 1, 0); PG8_STAGE(PG8_SA(0, 1), a2h, voffA);
            PG8_WAIT_L(8); PG8_BAR; PG8_WAIT_L(0); PG8_MMA(0, 0, At, B0); PG8_BAR; PG8_SCHED;
            PG8_LDB(B1, 1, 1); PG8_STAGE(PG8_SB(1, 0), b3, voffB);
            PG8_BAR; PG8_WAIT_L(0); PG8_MMA(0, 1, At, B1); PG8_BAR;
            PG8_LDA(At, 1, 1); PG8_STAGE(PG8_SA(1, 0), a3, voffA);
            PG8_BAR; PG8_WAIT_L(0); PG8_MMA(1, 0, At, B0); PG8_BAR; PG8_SCHED;
            PG8_STAGE(PG8_SB(1, 1), b3h, voffB);
            PG8_WAIT_V(6); PG8_BAR; PG8_MMA(1, 1, At, B1); PG8_BAR;
            }
        }
#ifdef PROBE_G
        unsigned long long tk_ = 0; if (wid == 0) tk_ = __builtin_amdgcn_s_memrealtime();
#endif
        if constexpr (ALIGN_EPI) { if (wr == 0) PG8_BAR; }
        if constexpr (!Epi::AFTER_DRAIN) { int l2_; asm volatile("v_mbcnt_lo_u32_b32 %0, -1, 0\n\tv_mbcnt_hi_u32_b32 %0, -1, %0" : "=v"(l2_)); const int fr_o = l2_ & 15, fq_o = l2_ >> 4;
            Unit cu_ = cur; asm volatile("" : "+s"(cu_.pm), "+s"(cu_.pn));
            E(acc, cu_, wr, wc, fr_o, fq_o); S.done(cur); }
#ifdef PROBE_G
        if (wid == 0 && lane == 0 && *(volatile PG8_LAS unsigned*)(lds + 147456 + 4 * 61) != 0u) *(volatile PG8_LAS unsigned*)(lds + 147456 + 4 * 60) += (unsigned)(__builtin_amdgcn_s_memrealtime() - tk_);
#endif
        if (!has_next) break;
#pragma unroll
        for (int a = 0; a < 2; ++a)
#pragma unroll
            for (int b = 0; b < 2; ++b)
#pragma unroll
                for (int m = 0; m < 4; ++m)
#pragma unroll
                    for (int n = 0; n < 2; ++n) acc[a][b][m][n] = (f32x4){0.f, 0.f, 0.f, 0.f};
        cur = nxt; cA = nA; cB = nB; ++ui;
        if constexpr (ALIGN_EPI) { if (wr == 1) PG8_BAR; }
    }
    PG8_WAIT_V(0);
    if constexpr (!ALIGN_EPI) { if (wr == 0) PG8_BAR; }
    PG8_BAR;
    if constexpr (Epi::AFTER_DRAIN) { E.fused(acc, cur, wr, wc, fr, fq, lds, wid, lane); S.done(cur); }
#undef PG8_SA
#undef PG8_SB
#undef PG8_STAGE
#undef PG8_LDA
#undef PG8_LDB
#undef PG8_MMA
#undef PG8_WAIT_V
#undef PG8_WAIT_L
#undef PG8_BAR
#undef PG8_SCHED
}
}
#define GAS __attribute__((address_space(1)))
#define LAS __attribute__((address_space(3)))
typedef unsigned short bf16;
typedef unsigned v4u __attribute__((ext_vector_type(4)));
typedef float f32x4 __attribute__((ext_vector_type(4)));
typedef short bf16x8 __attribute__((ext_vector_type(8)));
typedef GAS unsigned gu32;
typedef GAS unsigned long long gu64;
#define RLX_AGENT __ATOMIC_RELAXED, __HIP_MEMORY_SCOPE_AGENT
#define LDS_WAIT() asm volatile("s_waitcnt lgkmcnt(0)" ::: "memory")
#define VM_WAIT() asm volatile("s_waitcnt vmcnt(0)" ::: "memory")
__device__ __forceinline__ unsigned long long rt() { return __builtin_amdgcn_s_memrealtime(); }
__device__ __forceinline__ unsigned f2bf(float f) { unsigned u = __builtin_bit_cast(unsigned, f); return (u + 0x7fffu + ((u >> 16) & 1u)) >> 16; }
__device__ __forceinline__ unsigned pk2(float lo, float hi) { return f2bf(lo) | (f2bf(hi) << 16); }
#define XB_TMO      128
#define XB_XCNT(j)  (256  + 64 * (j))
#define XB_XSUB(j)  (1280 + 64 * (j))
#define XB_XGEN(j)  (2304 + 64 * (j))
#define XB_TOP      3328
#define XB_TOPGEN   3392
#define XCD_BAR_WORDS 3456
#define XB_SPIN_CAP (1u << 18)

__device__ __forceinline__ unsigned xb_ld(unsigned* p)              { return __hip_atomic_load(p, __ATOMIC_RELAXED, __HIP_MEMORY_SCOPE_AGENT); }
__device__ __forceinline__ unsigned xb_add(unsigned* p, unsigned v) { return __hip_atomic_fetch_add(p, v, __ATOMIC_RELAXED, __HIP_MEMORY_SCOPE_AGENT); }
__device__ __forceinline__ unsigned xb_xcc_id() { return (unsigned)__builtin_amdgcn_s_getreg((3 << 11) | 20) & 0xFu; }
#define XB_SPIN(cond, bar) do { unsigned _sp = 0; while (cond) { __builtin_amdgcn_s_sleep(1); \
    if ((++_sp & 255u) == 0u) { if (xb_ld(&(bar)[XB_TMO])) break; if (_sp > XB_SPIN_CAP) { atomicAdd(&(bar)[XB_TMO], 1u); break; } } } } while (0)

struct XcdBarrier {
    unsigned* bar; unsigned x;
    volatile LAS unsigned* st;
};

__device__ __forceinline__ XcdBarrier xcd_barrier_post(unsigned* bar, volatile LAS unsigned* st, bool t0) {
    XcdBarrier b; b.bar = bar; b.x = xb_xcc_id(); b.st = st;
    if (t0) (void)xb_add(&bar[XB_XCNT(b.x)], 1u);
    return b;
}
__device__ __forceinline__ void xcd_barrier_complete(unsigned* bar, unsigned x, unsigned& nloc, unsigned& nx) {
    const unsigned G = gridDim.x * gridDim.y * gridDim.z;
    unsigned sum, cnt, mine, sp = 0u;
    for (;;) {
        sum = 0u; cnt = 0u; mine = 0u;
#pragma unroll
        for (unsigned j = 0; j < 16; ++j) { const unsigned c = xb_ld(&bar[XB_XCNT(j)]); sum += c; cnt += (c > 0u) ? 1u : 0u; mine = (j == x) ? c : mine; }
        if (sum == G) break;
        __builtin_amdgcn_s_sleep(1);
        if ((++sp & 255u) == 0u) { if (xb_ld(&bar[XB_TMO])) break; if (sp > XB_SPIN_CAP) { atomicAdd(&bar[XB_TMO], 1u); break; } }
    }
    nloc = mine > 0u ? mine : 1u; nx = cnt > 0u ? cnt : 1u;
}

__device__ __forceinline__ void xcd_barrier(const XcdBarrier& b, bool t0) {
    asm volatile("s_waitcnt vmcnt(0)" ::: "memory");
    __syncthreads();
    if (t0) {
        unsigned* bar = b.bar;
        __builtin_amdgcn_s_waitcnt(0);
        unsigned nloc = b.st[0], nx = b.st[1];
        if (nloc == 0u) { xcd_barrier_complete(bar, b.x, nloc, nx); b.st[0] = nloc; b.st[1] = nx; }
        const unsigned old = xb_add(&bar[XB_XSUB(b.x)], 1u);
        const unsigned gen = old / nloc;
        if (old + 1u == (gen + 1u) * nloc) {
            __builtin_amdgcn_fence(__ATOMIC_RELEASE, "agent");
            asm volatile("s_waitcnt vmcnt(0)" ::: "memory");
            const unsigned og = xb_add(&bar[XB_TOP], 1u);
            const unsigned tg = og / nx;
            if (og + 1u == (tg + 1u) * nx) xb_add(&bar[XB_TOPGEN], 1u);
            else XB_SPIN(xb_ld(&bar[XB_TOPGEN]) == tg, bar);
            __builtin_amdgcn_fence(__ATOMIC_ACQUIRE, "agent");
            xb_add(&bar[XB_XGEN(b.x)], 1u);
            asm volatile("s_waitcnt vmcnt(0)" ::: "memory");
        } else {
            XB_SPIN(xb_ld(&bar[XB_XGEN(b.x)]) == gen, bar);
            __builtin_amdgcn_fence(__ATOMIC_ACQUIRE, "agent");
            asm volatile("s_waitcnt vmcnt(0)" ::: "memory");
        }
    }
    __syncthreads();
}
#ifndef Y_FP8
#define Y_FP8 1
#endif
#ifndef MOE_FP8_G1
#define MOE_FP8_G1 1
#endif
#ifndef MOE_FP8_G2
#define MOE_FP8_G2 1
#endif

constexpr int NB = 2, SEQ = 8192, D = 1024, M = NB * SEQ;
constexpr int NPROJ = 3584, IN_COLS = 3592;
constexpr int NE = 32, TOPK = 4, DFF = 1024;
constexpr int NROWS_MAX = M * TOPK + NE * 256;
constexpr int MAXRT = NROWS_MAX / 256;
constexpr float EPS = 1e-6f;
constexpr int PC_Q = 0, PC_K = 512, PC_V = 1024, PC_G = 1536, PC_Z = 2048, PC_X = 2560;
constexpr int NCHUNK = M / 64;
constexpr int NWAVES = 8, NTHR = 512;

constexpr size_t MiB = 1u << 20;
constexpr size_t WS_CTL = 0, CTL_ZERO_BYTES = 32768;
constexpr size_t WS_MODP = 1 * MiB;
constexpr size_t WS_MODF = WS_MODP + 512 * 1024;
constexpr size_t WS_BLKCNT = WS_MODF + 256 * 1024;
constexpr size_t WS_DT = 2 * MiB;
constexpr size_t WS_TOK = 3 * MiB;
constexpr size_t WS_WIN = 4 * MiB, WS_WOUT = 11 * MiB, WS_W1 = 16 * MiB, WS_W2 = 144 * MiB;
constexpr size_t WS_H = 208 * MiB, WS_P = 240 * MiB, WS_LF = 352 * MiB, WS_MIX = 384 * MiB, WS_X1 = 416 * MiB;
constexpr size_t WS_XG = 480 * MiB, WS_ACT = 624 * MiB, WS_END = 768 * MiB;
constexpr int CW_TMO = 0, CW_BAR = 4096;

constexpr int RING_BYTES = 131072, AUX_OFF = RING_BYTES  , MISC_OFF = 147456, LDS_BYTES = 151552;

struct Args { const float* in[23]; float* out; unsigned char* ws; int ph_lo, ph_hi; };
enum { I_X = 0, I_C, I_ADAW, I_ADAB, I_N1W, I_WIN, I_LBL, I_HGNW, I_ALOG, I_DTB, I_SSMD, I_CONVW, I_CONVB, I_SSMNW, I_WOUT, I_N2W, I_RW, I_RB, I_W1, I_B1, I_W2, I_B2, I_FNW };

__device__ __forceinline__ float bf2f(bf16 v) { return __uint_as_float(((unsigned)v) << 16); }
__device__ __forceinline__ float wave_sum(float v) {
#pragma unroll
    for (int o = 1; o < 64; o <<= 1) v += __shfl_xor(v, o);
    return v;
}
__device__ __forceinline__ float wave_max(float v) {
#pragma unroll
    for (int o = 1; o < 64; o <<= 1) v = fmaxf(v, __shfl_xor(v, o));
    return v;
}
__device__ __forceinline__ float sigmoid_f(float x) { return __builtin_amdgcn_rcpf(1.0f + __expf(-x)); }
__device__ __forceinline__ float silu_f(float x) { return x * sigmoid_f(x); }

namespace pg8 {
struct EpiIn {
    static constexpr bool PERM = true, AFTER_DRAIN = false;
    bf16_t* P; float* LF; const float* lbl;
    __device__ __forceinline__ void operator()(const f32x4 (&acc)[2][2][4][2], const Unit& u, int wr, int wc, int fr, int fq) const {
        const int row0 = u.pm * BM + wr * 64 + fr, col0 = u.pn * BM + wc * 32 + 8 * fq;
        const int mode = (u.pn < 2) ? 1 : (u.pn < 4) ? 2 : (u.pn < 6) ? 0 : (u.pn < 10) ? 1 : 0;
        if (mode == 2) {
            float oml[2][8];
#pragma unroll
            for (int bj = 0; bj < 2; ++bj)
#pragma unroll
                for (int j = 0; j < 8; ++j) { const int cf = col0 + bj * HALF + j - 512; const float l0 = lbl[cf], l1 = lbl[512 + cf]; oml[bj][j] = 1.0f - 1.0f / (1.0f + __expf(l1 - l0)); }
#pragma unroll
            for (int ai = 0; ai < 2; ++ai)
#pragma unroll
                for (int m = 0; m < 4; ++m) { const size_t r = (size_t)(row0 + ai * HALF + m * 16);
#pragma unroll
                    for (int bj = 0; bj < 2; ++bj) { float kv[8], lf[8];
#pragma unroll
                        for (int j = 0; j < 8; ++j) { const float f = acc[ai][bj][m][j >> 2][j & 3]; const float k = oml[bj][j] * sigmoid_f(-f); kv[j] = k; lf[j] = __logf(1.0f - k); }
                        u32x4 w; w.x = cvt_pk_bf16(kv[0], kv[1]); w.y = cvt_pk_bf16(kv[2], kv[3]); w.z = cvt_pk_bf16(kv[4], kv[5]); w.w = cvt_pk_bf16(kv[6], kv[7]);
                        *(u32x4*)(P + r * NPROJ + col0 + bj * HALF) = w;
                        float* lp = LF + r * 512 + (col0 + bj * HALF - 512);
                        *(f32x4*)lp = (f32x4){lf[0], lf[1], lf[2], lf[3]}; *(f32x4*)(lp + 4) = (f32x4){lf[4], lf[5], lf[6], lf[7]}; } }
        } else {
#pragma unroll
            for (int ai = 0; ai < 2; ++ai)
#pragma unroll
                for (int m = 0; m < 4; ++m) { bf16_t* rowp = P + (size_t)(row0 + ai * HALF + m * 16) * NPROJ + col0;
#pragma unroll
                    for (int bj = 0; bj < 2; ++bj) { f32x4 v0 = acc[ai][bj][m][0], v1 = acc[ai][bj][m][1];
                        if (mode == 1) {
#pragma unroll
                            for (int j = 0; j < 4; ++j) { v0[j] = silu_f(v0[j]); v1[j] = silu_f(v1[j]); } }
                        u32x4 w; w.x = cvt_pk_bf16(v0[0], v0[1]); w.y = cvt_pk_bf16(v0[2], v0[3]); w.z = cvt_pk_bf16(v1[0], v1[1]); w.w = cvt_pk_bf16(v1[2], v1[3]);
                        *(u32x4*)(rowp + bj * HALF) = w; } }
        }
    }
};
struct EpiOut {
    static constexpr bool PERM = true, AFTER_DRAIN = false;
    const float* x; bf16_t* x1; const float* g1;
    __device__ __forceinline__ void operator()(const f32x4 (&acc)[2][2][4][2], const Unit& u, int wr, int wc, int fr, int fq) const {
        const int row0 = u.pm * BM + wr * 64 + fr, col0 = u.pn * BM + wc * 32 + 8 * fq;
        const float* gb = g1 + ((u.pm * BM) >> 13) * 6144 + col0;
        f32x4 gv[2][2];
#pragma unroll
        for (int bj = 0; bj < 2; ++bj)
#pragma unroll
            for (int n = 0; n < 2; ++n) gv[bj][n] = *(const f32x4*)(gb + bj * HALF + 4 * n);
#pragma unroll
        for (int ai = 0; ai < 2; ++ai)
#pragma unroll
            for (int m = 0; m < 4; ++m) { const size_t off = (size_t)(row0 + ai * HALF + m * 16) * D + col0;
#pragma unroll
                for (int bj = 0; bj < 2; ++bj) { const f32x4 x0 = *(const f32x4*)(x + off + bj * HALF), x1v = *(const f32x4*)(x + off + bj * HALF + 4);
                    const f32x4 v0 = x0 + gv[bj][0] * acc[ai][bj][m][0], v1 = x1v + gv[bj][1] * acc[ai][bj][m][1];
                    u32x4 w; w.x = cvt_pk_bf16(v0[0], v0[1]); w.y = cvt_pk_bf16(v0[2], v0[3]); w.z = cvt_pk_bf16(v1[0], v1[1]); w.w = cvt_pk_bf16(v1[2], v1[3]);
                    *(u32x4*)(x1 + off + bj * HALF) = w; } }
    }
};
__device__ __forceinline__ float sat8(float x) { return __builtin_amdgcn_fmed3f(x, -448.0f, 448.0f); }
__device__ __forceinline__ unsigned pk4_fp8(float a, float b, float c, float d) { int w = 0; w = __builtin_amdgcn_cvt_pk_fp8_f32(sat8(a), sat8(b), w, false); w = __builtin_amdgcn_cvt_pk_fp8_f32(sat8(c), sat8(d), w, true); return (unsigned)w; }
template <bool F8IN, bool F8> struct EpiW1 {
    static constexpr bool PERM = true, AFTER_DRAIN = false;
    void* ACT; const float* b1;
    __device__ __forceinline__ void operator()(const f32x4 (&acc)[2][2][4][2], const Unit& u, int wr, int wc, int fr, int fq) const {
        const int e = u.pn >> 3, pn = u.pn & 7;
        const int row0 = u.pm * BM + wr * 64 + fr, cj = pn * 128 + wc * 32 + 8 * fq;
        const float* bg = b1 + e * 2048 + cj; const float sc = F8IN ? (1.0f / 1024.0f) : 1.0f;
#pragma unroll
        for (int ai = 0; ai < 2; ++ai)
#pragma unroll
            for (int m = 0; m < 4; ++m) {
                asm volatile("" ::: "memory");
                const f32x4 bg0 = *(const f32x4*)bg, bg1 = *(const f32x4*)(bg + 4), bl0 = *(const f32x4*)(bg + 1024), bl1 = *(const f32x4*)(bg + 1028);
                f32x4 g0 = acc[ai][0][m][0] * sc + bg0, g1 = acc[ai][0][m][1] * sc + bg1, l0 = acc[ai][1][m][0] * sc + bl0, l1 = acc[ai][1][m][1] * sc + bl1;
                float o[8];
                const float osc = F8 ? 4.0f : 1.0f;
#pragma unroll
                for (int j = 0; j < 4; ++j) {
                    float g = fminf(g0[j], 7.0f), l = __builtin_amdgcn_fmed3f(l0[j], -7.0f, 7.0f); o[j] = (g * osc) * __builtin_amdgcn_rcpf(1.0f + __builtin_amdgcn_exp2f(g * (-1.702f * 1.44269504f))) * (l + 1.0f);
                    g = fminf(g1[j], 7.0f); l = __builtin_amdgcn_fmed3f(l1[j], -7.0f, 7.0f); o[4 + j] = (g * osc) * __builtin_amdgcn_rcpf(1.0f + __builtin_amdgcn_exp2f(g * (-1.702f * 1.44269504f))) * (l + 1.0f); }
                const size_t off = (size_t)(row0 + ai * HALF + m * 16) * DFF + cj;
                if (F8) { typedef unsigned u32x2 __attribute__((ext_vector_type(2))); u32x2 w; int w0 = 0, w1 = 0;
                    w0 = __builtin_amdgcn_cvt_pk_fp8_f32(o[0], o[1], w0, false); w0 = __builtin_amdgcn_cvt_pk_fp8_f32(o[2], o[3], w0, true); w1 = __builtin_amdgcn_cvt_pk_fp8_f32(o[4], o[5], w1, false); w1 = __builtin_amdgcn_cvt_pk_fp8_f32(o[6], o[7], w1, true);
                    w.x = (unsigned)w0; w.y = (unsigned)w1; *(u32x2*)((unsigned char*)ACT + off) = w; }
                else { u32x4 w; w.x = cvt_pk_bf16(o[0], o[1]); w.y = cvt_pk_bf16(o[2], o[3]); w.z = cvt_pk_bf16(o[4], o[5]); w.w = cvt_pk_bf16(o[6], o[7]);
                    *(u32x4*)((bf16_t*)ACT + off) = w; } }
    }
};
template <bool Y8> struct EpiW2 {
    static constexpr bool PERM = true, AFTER_DRAIN = false;
    void* Y; const float* b2; float sc;
    __device__ __forceinline__ void operator()(const f32x4 (&acc)[2][2][4][2], const Unit& u, int wr, int wc, int fr, int fq) const {
        const int e = u.pn >> 2, pn = u.pn & 3;
        const int row0 = u.pm * BM + wr * 64 + fr, col0 = pn * BM + wc * 32 + 8 * fq;
        const float* bb = b2 + e * 1024 + col0;
        f32x4 bv[2][2];
#pragma unroll
        for (int bj = 0; bj < 2; ++bj) { bv[bj][0] = *(const f32x4*)(bb + bj * HALF); bv[bj][1] = *(const f32x4*)(bb + bj * HALF + 4); }
#pragma unroll
        for (int ai = 0; ai < 2; ++ai)
#pragma unroll
            for (int m = 0; m < 4; ++m) { const size_t off = (size_t)(row0 + ai * HALF + m * 16) * D + col0;
#pragma unroll
                for (int bj = 0; bj < 2; ++bj) { const f32x4 v0 = acc[ai][bj][m][0] * sc + bv[bj][0], v1 = acc[ai][bj][m][1] * sc + bv[bj][1];
                    if (Y8) { typedef unsigned u32x2 __attribute__((ext_vector_type(2))); u32x2 w; w.x = pk4_fp8(v0[0] * 8.f, v0[1] * 8.f, v0[2] * 8.f, v0[3] * 8.f); w.y = pk4_fp8(v1[0] * 8.f, v1[1] * 8.f, v1[2] * 8.f, v1[3] * 8.f);
                        *(u32x2*)((unsigned char*)Y + off + bj * HALF) = w; }
                    else { u32x4 w; w.x = cvt_pk_bf16(v0[0], v0[1]); w.y = cvt_pk_bf16(v0[2], v0[3]); w.z = cvt_pk_bf16(v1[0], v1[1]); w.w = cvt_pk_bf16(v1[2], v1[3]);
                        *(u32x4*)((bf16_t*)Y + off + bj * HALF) = w; } } }
    }
};
struct InProjOrder {
    int c;
    __device__ __forceinline__ bool next(int i, Unit& u) const { const int pn = (c >> 6) + 4 * i; if (pn >= NPROJ / BM) return false; u.pm = c & 63; u.pn = pn; return true; }
    __device__ __forceinline__ void a_ready(const Unit&) const {}
    __device__ __forceinline__ void done(const Unit&) const {}
};
struct MoeOrder {
    const PG8_LAS int* rt2e; int NT, nwg, G, c;
    __device__ __forceinline__ bool next(int i, Unit& u) const {
        const int L = i * G + c; if (L >= nwg) return false;
        int wgid = L; { const int q = nwg / NXCD, r = nwg % NXCD, xcd = wgid % NXCD, off = wgid / NXCD; wgid = (xcd < r ? xcd * (q + 1) : r * (q + 1) + (xcd - r) * q) + off; }
        const int rt = wgid / NT, pn = wgid % NT; const int e = __builtin_amdgcn_readfirstlane(rt2e[rt]);
        u.pm = rt; u.pn = e * NT + pn; return true;
    }
    __device__ __forceinline__ void a_ready(const Unit&) const {}
    __device__ __forceinline__ void done(const Unit&) const {}
};
}

using pg8::pk4_fp8;
__device__ __forceinline__ void transpose_item(const float* __restrict__ W, int ldw, int k0, int c0, bf16* WT, int drow0, LAS float* scr, int lane) {
#pragma unroll 8
    for (int i = 0; i < 32; ++i) { const int kk = 2 * i + (lane >> 5); scr[kk * 33 + (lane & 31)] = W[(size_t)(k0 + kk) * ldw + c0 + (lane & 31)]; }
    LDS_WAIT(); asm volatile("" ::: "memory");
    const int c = lane & 7;
#pragma unroll
    for (int j = 0; j < 4; ++j) { const int n = (lane >> 3) + 8 * j; const LAS float* s = scr + (8 * c) * 33 + n;
        v4u o; o.x = pk2(s[0 * 33], s[1 * 33]); o.y = pk2(s[2 * 33], s[3 * 33]); o.z = pk2(s[4 * 33], s[5 * 33]); o.w = pk2(s[6 * 33], s[7 * 33]);
        *(GAS v4u*)(WT + (size_t)(drow0 + n) * 1024 + k0 + 8 * c) = o; }
    LDS_WAIT(); asm volatile("" ::: "memory");
}
__device__ __forceinline__ void transpose_item8(const float* __restrict__ W, int ldw, int k0, int c0, unsigned char* WT, int drow0, float scale, LAS float* scr, int lane) {
#pragma unroll 8
    for (int i = 0; i < 32; ++i) { const int kk = 2 * i + (lane >> 5); scr[kk * 33 + (lane & 31)] = W[(size_t)(k0 + kk) * ldw + c0 + (lane & 31)]; }
    LDS_WAIT(); asm volatile("" ::: "memory");
    const int n = lane >> 1, hf = lane & 1; const LAS float* s = scr + (32 * hf) * 33 + n;
    v4u o0, o1;
    o0.x = pk4_fp8(s[0 * 33] * scale, s[1 * 33] * scale, s[2 * 33] * scale, s[3 * 33] * scale); o0.y = pk4_fp8(s[4 * 33] * scale, s[5 * 33] * scale, s[6 * 33] * scale, s[7 * 33] * scale);
    o0.z = pk4_fp8(s[8 * 33] * scale, s[9 * 33] * scale, s[10 * 33] * scale, s[11 * 33] * scale); o0.w = pk4_fp8(s[12 * 33] * scale, s[13 * 33] * scale, s[14 * 33] * scale, s[15 * 33] * scale);
    o1.x = pk4_fp8(s[16 * 33] * scale, s[17 * 33] * scale, s[18 * 33] * scale, s[19 * 33] * scale); o1.y = pk4_fp8(s[20 * 33] * scale, s[21 * 33] * scale, s[22 * 33] * scale, s[23 * 33] * scale);
    o1.z = pk4_fp8(s[24 * 33] * scale, s[25 * 33] * scale, s[26 * 33] * scale, s[27 * 33] * scale); o1.w = pk4_fp8(s[28 * 33] * scale, s[29 * 33] * scale, s[30 * 33] * scale, s[31 * 33] * scale);
    GAS v4u* dst = (GAS v4u*)(WT + (size_t)(drow0 + n) * 1024 + k0 + 32 * hf); dst[0] = o0; dst[1] = o1;
    LDS_WAIT(); asm volatile("" ::: "memory");
}
template <bool F8> __device__ __forceinline__ void p0_item(const float* __restrict__ W, int ldw, int k0, int c0, unsigned char* WT, int drow0, int rowb, float scale, LAS unsigned char* T, int tid, int wave, int lane) {
    constexpr int NB = F8 ? 2 : 1, TS = 516;
    const int l32 = lane & 31, hf = lane >> 5;
#pragma unroll 1
    for (int batch = 0; batch < NB; ++batch) {
        const int kb = batch * 256 + wave * 32;
        f32x4 v[4][4];
#pragma unroll
        for (int i = 0; i < 4; ++i)
#pragma unroll
            for (int j = 0; j < 4; ++j) v[i][j] = __builtin_nontemporal_load((const f32x4*)(W + (size_t)(k0 + kb + 4 * (2 * i + hf) + j) * ldw + c0 + 4 * l32));
#pragma unroll
        for (int i = 0; i < 4; ++i) { const int kk = kb + 4 * (2 * i + hf);
#pragma unroll
            for (int c = 0; c < 4; ++c) { LAS unsigned char* tp = T + (4 * l32 + c) * TS + (F8 ? kk : 2 * kk);
                if (F8) *(LAS unsigned*)tp = pk4_fp8(v[i][0][c] * scale, v[i][1][c] * scale, v[i][2][c] * scale, v[i][3][c] * scale);
                else { *(LAS unsigned*)tp = pk2(v[i][0][c], v[i][1][c]); *(LAS unsigned*)(tp + 4) = pk2(v[i][2][c], v[i][3][c]); } } }
    }
    __syncthreads();
#pragma unroll
    for (int i = 0; i < 8; ++i) { const int piece = tid + NTHR * i, n = piece >> 5, c = piece & 31; const LAS unsigned* tp = (const LAS unsigned*)(T + n * TS + 16 * c);
        v4u o; o.x = tp[0]; o.y = tp[1]; o.z = tp[2]; o.w = tp[3];
        *(GAS v4u*)(WT + (size_t)(drow0 + n) * rowb + (F8 ? k0 : 2 * k0) + 16 * c) = o; }
    __syncthreads();
}
constexpr int KB1 = MOE_FP8_G1 ? 2 : 4, KB2 = MOE_FP8_G2 ? 2 : 4, I_E1 = NE * 16 * KB1, I_E2 = NE * 8 * KB2, N_EXP_ITEMS = I_E1 + I_E2;
constexpr int N_BG_ITEMS = 0;
__device__ __forceinline__ void p0_expert_item(const Args& a, LAS unsigned char* lds, int it, int tid, int wave, int lane) {
    unsigned char* ws = a.ws;
    if (it < I_E1) { const int e = it / (16 * KB1), r2 = it % (16 * KB1), nb = r2 / KB1, kb = r2 % KB1, c0 = 128 * nb;
        const int drow = e * 2048 + ((c0 < 1024) ? (256 * (c0 >> 7)) : (256 * ((c0 - 1024) >> 7) + 128));
        p0_item<MOE_FP8_G1 != 0>(a.in[I_W1] + (size_t)e * 1024 * 2048, 2048, (MOE_FP8_G1 ? 512 : 256) * kb, c0, ws + WS_W1, drow, MOE_FP8_G1 ? 1024 : 2048, 128.0f, lds, tid, wave, lane); }
    else { const int r = it - I_E1, e = r / (8 * KB2), r2 = r % (8 * KB2), nb = r2 / KB2, kb = r2 % KB2;
        p0_item<MOE_FP8_G2 != 0>(a.in[I_W2] + (size_t)e * 1024 * 1024, 1024, (MOE_FP8_G2 ? 512 : 256) * kb, 128 * nb, ws + WS_W2, e * 1024 + 128 * nb, MOE_FP8_G2 ? 1024 : 2048, 128.0f, lds, tid, wave, lane); }
}
struct P0Src { const float* W; int ldw, k0, c0, drow; unsigned char* WT; };
__device__ __forceinline__ P0Src p0_expert_src(const Args& a, int it) {
    P0Src s;
    if (it < I_E1) { const int e = it / (16 * KB1), r2 = it % (16 * KB1), nb = r2 / KB1, kb = r2 % KB1, c0 = 128 * nb;
        s.W = a.in[I_W1] + (size_t)e * 1024 * 2048; s.ldw = 2048; s.k0 = 512 * kb; s.c0 = c0; s.drow = e * 2048 + ((c0 < 1024) ? (256 * (c0 >> 7)) : (256 * ((c0 - 1024) >> 7) + 128)); s.WT = a.ws + WS_W1; }
    else { const int r = it - I_E1, e = r / (8 * KB2), r2 = r % (8 * KB2), nb = r2 / KB2, kb = r2 % KB2;
        s.W = a.in[I_W2] + (size_t)e * 1024 * 1024; s.ldw = 1024; s.k0 = 512 * kb; s.c0 = 128 * nb; s.drow = e * 1024 + 128 * nb; s.WT = a.ws + WS_W2; }
    return s;
}
__device__ __forceinline__ void p0_load_batch(f32x4 (&v)[4][4], const P0Src& s, int batch, int wave, int lane) {
    const int l32 = lane & 31, hf = lane >> 5, kb = batch * 256 + wave * 32;
#pragma unroll
    for (int i = 0; i < 4; ++i)
#pragma unroll
        for (int j = 0; j < 4; ++j) v[i][j] = __builtin_nontemporal_load((const f32x4*)(s.W + (size_t)(s.k0 + kb + 4 * (2 * i + hf) + j) * s.ldw + s.c0 + 4 * l32));
}
__device__ __forceinline__ void p0_pack_batch8(const f32x4 (&v)[4][4], int batch, LAS unsigned char* T, int wave, int lane) {
    const int l32 = lane & 31, hf = lane >> 5, kb = batch * 256 + wave * 32;
#pragma unroll
    for (int i = 0; i < 4; ++i) { const int kk = kb + 4 * (2 * i + hf);
#pragma unroll
        for (int c = 0; c < 4; ++c) { const int n = 4 * l32 + c; *(LAS unsigned*)(T + n * 516 + 4 * ((kk >> 2) ^ ((n >> 5) & 3))) = pk4_fp8(v[i][0][c] * 128.0f, v[i][1][c] * 128.0f, v[i][2][c] * 128.0f, v[i][3][c] * 128.0f); } }
}
__device__ __forceinline__ void p0_expert_items_pipelined(const Args& a, LAS unsigned char* T, int bid, int G, int n_items, int tid, int wave, int lane) {
    if (bid >= n_items) return;
    f32x4 vA[4][4], vB[4][4];
    P0Src cur = p0_expert_src(a, bid);
    p0_load_batch(vA, cur, 0, wave, lane);
#pragma unroll 1
    for (int it = bid; it < n_items; it += G) {
        p0_load_batch(vB, cur, 1, wave, lane);
        p0_pack_batch8(vA, 0, T, wave, lane);
        const int nx = it + G; const P0Src nxt = p0_expert_src(a, nx < n_items ? nx : it);
        if (nx < n_items) p0_load_batch(vA, nxt, 0, wave, lane);
        p0_pack_batch8(vB, 1, T, wave, lane);
        __syncthreads();
#pragma unroll
        for (int i = 0; i < 8; ++i) { const int piece = tid + NTHR * i, n = piece >> 5, c = piece & 31, sw = (n >> 5) & 3; const LAS unsigned* tp = (const LAS unsigned*)(T + n * 516 + 16 * c);
            v4u o; o.x = tp[0 ^ sw]; o.y = tp[1 ^ sw]; o.z = tp[2 ^ sw]; o.w = tp[3 ^ sw];
            *(GAS v4u*)(cur.WT + (size_t)(cur.drow + n) * 1024 + cur.k0 + 16 * c) = o; }
        __syncthreads();
        cur = nxt;
    }
}
#ifndef DEFER_EXPERT_CVT
#define DEFER_EXPERT_CVT 1
#endif
#ifndef CVT_IN_A
#define CVT_IN_A 0
#endif
__device__ __forceinline__ void deferred_cvt_items(const Args& a, LAS unsigned char* lds, int bid, int G, int h, int tid, int wave, int lane) {
    if (!(DEFER_EXPERT_CVT && G == 256)) return;
    constexpr int PER = N_EXP_ITEMS / 256;
    const int j0 = h ? CVT_IN_A : 0, j1 = h ? PER : CVT_IN_A;
    if (MOE_FP8_G1 && MOE_FP8_G2) { if (j1 > j0) p0_expert_items_pipelined(a, lds, bid + 256 * j0, 256, 256 * j1, tid, wave, lane); }
    else for (int j = j0; j < j1; ++j) p0_expert_item(a, lds, bid + 256 * j, tid, wave, lane);
}
__device__ __forceinline__ void p0_bg_items(const Args& a, LAS unsigned char* lds, int bid, int G, int tid, int wave, int lane) {
    if (G == 256 && bid >= 128) { for (int j = 0; j < N_BG_ITEMS / 128; ++j) p0_expert_item(a, lds, N_EXP_ITEMS - N_BG_ITEMS + (bid - 128) + 128 * j, tid, wave, lane); }
}
__device__ __forceinline__ void p0_prologue(const Args& a, LAS unsigned char* lds, int bid, int G, int tid, int wave, int lane) {
    unsigned char* ws = a.ws;
    { const int gw = (G - 1 - bid) * NWAVES + wave, NGW = G * NWAVES;
      for (int it = gw; it < 192; it += NGW) {
        const int nc = it % 24, kc = it / 24, n = nc * 256 + 4 * lane;
        const float* W = a.in[I_ADAW]; const float* c = a.in[I_C];
        f32x4 a0 = {0.f, 0.f, 0.f, 0.f}, a1 = {0.f, 0.f, 0.f, 0.f};
#pragma unroll 8
        for (int kk = 0; kk < 128; ++kk) { const int k = kc * 128 + kk; const f32x4 w = __builtin_nontemporal_load((const f32x4*)(W + (size_t)k * 6144 + n));
            const float c0 = silu_f(c[k]), c1 = silu_f(c[1024 + k]); a0 += c0 * w; a1 += c1 * w; }
        float* mp = (float*)(ws + WS_MODP);
        *(f32x4*)(mp + (size_t)(kc * 2 + 0) * 6144 + n) = a0; *(f32x4*)(mp + (size_t)(kc * 2 + 1) * 6144 + n) = a1;
      } }
    constexpr int I_IN = 28 * 4, I_OUT = 8 * 4;
    const int n_p0 = (G == 256) ? (N_EXP_ITEMS - N_BG_ITEMS) : N_EXP_ITEMS;
    if (!(DEFER_EXPERT_CVT && G == 256)) {
    if (MOE_FP8_G1 && MOE_FP8_G2) p0_expert_items_pipelined(a, lds, bid, G, n_p0, tid, wave, lane);
    else for (int it = bid; it < n_p0; it += G) p0_expert_item(a, lds, it, tid, wave, lane);
    }
    for (int it = bid; it < I_IN + I_OUT; it += G) {
        if (it < I_IN) { const int nb = it >> 2, kb = it & 3; p0_item<false>(a.in[I_WIN], IN_COLS, 256 * kb, 128 * nb, ws + WS_WIN, 128 * nb, 2048, 1.0f, lds, tid, wave, lane); }
        else { const int r = it - I_IN, nb = r >> 2, kb = r & 3; p0_item<false>(a.in[I_WOUT], D, 256 * kb, 128 * nb, ws + WS_WOUT, 128 * nb, 2048, 1.0f, lds, tid, wave, lane); }
    }
}

__device__ __forceinline__ void load_mod_AS(LAS float* A, LAS float* S, const float* normw, const float* src, int nparts, const float* bias, int b, int shift_off, int tid) {
    for (int k = tid; k < 1024; k += NTHR) {
        float sh = bias ? bias[shift_off + k] : 0.f, sc = bias ? bias[shift_off + 1024 + k] : 0.f;
        for (int p = 0; p < nparts; ++p) { const float* q = src + (size_t)(p * 2 + b) * 6144 + shift_off; sh += q[k]; sc += q[1024 + k]; }
        A[k] = normw[k] * (1.0f + sc); S[k] = sh;
    }
}
__device__ __forceinline__ float softplus_f(float x) { return fmaxf(x, 0.f) + log1pf(__expf(-fabsf(x))); }

__device__ __forceinline__ void p1_norm(const Args& a, LAS unsigned char* lds, int bid, int G, int tid, int wave, int lane) {
    unsigned char* ws = a.ws;
    LAS float* A1 = (LAS float*)(lds); LAS float* S1 = A1 + 1024; LAS float* WDT = S1 + 1024;
    const float* modp = (const float*)(ws + WS_MODP);
    for (int idx = bid * NTHR + tid; idx < 2 * 6144; idx += G * NTHR) { const int b = idx / 6144, n = idx % 6144; float s = a.in[I_ADAB][n];
        for (int p = 0; p < 8; ++p) s += modp[(size_t)(p * 2 + b) * 6144 + n];
        ((float*)(ws + WS_MODF))[idx] = s; }
    for (int idx = tid; idx < 8192; idx += NTHR) { const int k = idx >> 3, jj = idx & 7; WDT[jj * 1024 + k] = a.in[I_WIN][(size_t)k * IN_COLS + NPROJ + jj]; }
    const float* x = a.in[I_X]; bf16* H = (bf16*)(ws + WS_H); float* DT = (float*)(ws + WS_DT);
    for (int c = bid; c < NCHUNK; c += G) {
        const int b = c >> 7;
        __syncthreads();
        load_mod_AS(A1, S1, a.in[I_N1W], modp, 8, a.in[I_ADAB], b, 0, tid);
        __syncthreads();
        f32x4 vn[4];
        { const GAS f32x4* xr = (const GAS f32x4*)(x + (size_t)(c * 64 + wave * 8) * D) + lane;
#pragma unroll
          for (int j = 0; j < 4; ++j) vn[j] = __builtin_nontemporal_load((const f32x4*)xr + 64 * j); }
#pragma unroll 1
        for (int r = 0; r < 8; ++r) {
            const int m = c * 64 + wave * 8 + r;
            f32x4 v[4]; float ss = 0.f;
#pragma unroll
            for (int j = 0; j < 4; ++j) { v[j] = vn[j]; ss += (v[j].x * v[j].x + v[j].y * v[j].y) + (v[j].z * v[j].z + v[j].w * v[j].w); }
            if (r < 7) { const GAS f32x4* xr = (const GAS f32x4*)(x + (size_t)(m + 1) * D) + lane;
#pragma unroll
                for (int j = 0; j < 4; ++j) vn[j] = __builtin_nontemporal_load((const f32x4*)xr + 64 * j); }
            const float rstd = rsqrtf(wave_sum(ss) * (1.0f / D) + EPS);
            float dacc[8];
#pragma unroll
            for (int jj = 0; jj < 8; ++jj) dacc[jj] = 0.f;
            GAS unsigned long long* o8 = (GAS unsigned long long*)(H + (size_t)m * D) + lane;
#pragma unroll
            for (int j = 0; j < 4; ++j) {
                const f32x4 av = *(const LAS f32x4*)(A1 + 256 * j + 4 * lane), sv = *(const LAS f32x4*)(S1 + 256 * j + 4 * lane);
                const f32x4 h = v[j] * rstd * av + sv;
                o8[64 * j] = (unsigned long long)pk2(h.x, h.y) | ((unsigned long long)pk2(h.z, h.w) << 32);
#pragma unroll
                for (int jj = 0; jj < 8; ++jj) { const f32x4 w = *(const LAS f32x4*)(WDT + jj * 1024 + 256 * j + 4 * lane); dacc[jj] += (h.x * w.x + h.y * w.y) + (h.z * w.z + h.w * w.w); }
            }
            { const bool u5 = (lane & 32) != 0, u4 = (lane & 16) != 0, u3 = (lane & 8) != 0; float p4[4], p2[2], p1;
#pragma unroll
              for (int i = 0; i < 4; ++i) { const float lo = dacc[i], hi = dacc[i + 4]; p4[i] = (u5 ? hi : lo) + __shfl_xor(u5 ? lo : hi, 32); }
#pragma unroll
              for (int i = 0; i < 2; ++i) { const float lo = p4[i], hi = p4[i + 2]; p2[i] = (u4 ? hi : lo) + __shfl_xor(u4 ? lo : hi, 16); }
              { const float lo = p2[0], hi = p2[1]; p1 = (u3 ? hi : lo) + __shfl_xor(u3 ? lo : hi, 8); }
              p1 += __shfl_xor(p1, 4); p1 += __shfl_xor(p1, 2); p1 += __shfl_xor(p1, 1);
              const int col = lane >> 3;
              if ((lane & 7) == 0) DT[(size_t)m * 8 + col] = softplus_f(p1 + a.in[I_DTB][col]); }
        }
    }
}

__device__ __forceinline__ void hgrn_naive(const Args& a, LAS unsigned char* lds, int bh, int tid, int wave, int lane) {
    unsigned char* ws = a.ws;
    const int b = bh >> 2, h = bh & 3, j = tid & 127, kq = tid >> 7;
    LAS float* FE = (LAS float*)lds; LAS float* KK = FE + 2048; LAS float* QQ = KK + 2048; LAS float* VV = QQ + 2048; LAS float* RED = VV + 2048;
    const bf16* P = (const bf16*)(ws + WS_P); const float* LF = (const float*)(ws + WS_LF); bf16* MIX = (bf16*)(ws + WS_MIX);
    const float* nw = a.in[I_HGNW];
    float S[32];
#pragma unroll
    for (int i = 0; i < 32; ++i) S[i] = 0.f;
    for (int t0 = 0; t0 < SEQ; t0 += 16) {
        for (int idx = tid; idx < 2048; idx += NTHR) { const int tt = idx >> 7, k = idx & 127; const size_t row = (size_t)b * SEQ + t0 + tt;
            FE[idx] = __expf(LF[row * 512 + h * 128 + k]); KK[idx] = bf2f(P[row * NPROJ + PC_K + h * 128 + k]);
            QQ[idx] = bf2f(P[row * NPROJ + PC_Q + h * 128 + k]); VV[idx] = bf2f(P[row * NPROJ + PC_V + h * 128 + k]); }
        __syncthreads();
#pragma unroll 1
        for (int tt = 0; tt < 16; ++tt) {
            const float vj = VV[tt * 128 + j]; float p = 0.f;
#pragma unroll
            for (int i4 = 0; i4 < 8; ++i4) {
                const f32x4 f4 = *(const LAS f32x4*)(FE + tt * 128 + 32 * kq + 4 * i4), k4 = *(const LAS f32x4*)(KK + tt * 128 + 32 * kq + 4 * i4), q4 = *(const LAS f32x4*)(QQ + tt * 128 + 32 * kq + 4 * i4);
#pragma unroll
                for (int c = 0; c < 4; ++c) { S[4 * i4 + c] = f4[c] * S[4 * i4 + c] + k4[c] * vj; p += S[4 * i4 + c] * q4[c]; }
            }
            RED[(kq * 16 + tt) * 128 + j] = p;
        }
        __syncthreads();
#pragma unroll
        for (int r = 0; r < 2; ++r) { const int tt = 2 * wave + r; const size_t row = (size_t)b * SEQ + t0 + tt;
            float o0 = 0.f, o1 = 0.f;
#pragma unroll
            for (int q = 0; q < 4; ++q) { o0 += RED[(q * 16 + tt) * 128 + lane]; o1 += RED[(q * 16 + tt) * 128 + 64 + lane]; }
            const float rstd = rsqrtf(wave_sum(o0 * o0 + o1 * o1) * (1.0f / 128.0f) + EPS);
            MIX[row * D + h * 128 + lane] = (bf16)f2bf(o0 * rstd * nw[lane] * bf2f(P[row * NPROJ + PC_G + h * 128 + lane]));
            MIX[row * D + h * 128 + 64 + lane] = (bf16)f2bf(o1 * rstd * nw[64 + lane] * bf2f(P[row * NPROJ + PC_G + h * 128 + 64 + lane])); }
    }
}
__device__ __forceinline__ void ssd_naive(const Args& a, LAS unsigned char* lds, int bg, int tid, int wave, int lane) {
    unsigned char* ws = a.ws;
    const int b = bg >> 1, g = bg & 1, p = tid & 63, hl = wave >> 1, nh = wave & 1;
    LAS float* XS = (LAS float*)lds; LAS float* BM = XS + 4096; LAS float* CM = BM + 2048; LAS float* DTL = CM + 2048; LAS float* DEC = DTL + 64; LAS float* RED = DEC + 64;
    const bf16* P = (const bf16*)(ws + WS_P); const float* DT = (const float*)(ws + WS_DT); bf16* MIX = (bf16*)(ws + WS_MIX);
    const float* cw = a.in[I_CONVW]; const float* cb = a.in[I_CONVB];
    float hS[64];
#pragma unroll
    for (int i = 0; i < 64; ++i) hS[i] = 0.f;
    for (int t0 = 0; t0 < SEQ; t0 += 16) {
        for (int idx = tid; idx < 16 * 512; idx += NTHR) { const int tt = idx >> 9, cc = idx & 511, t = t0 + tt;
            const int ch = (cc < 256) ? (g * 256 + cc) : (cc < 384) ? (512 + g * 128 + (cc - 256)) : (768 + g * 128 + (cc - 384));
            float v = cb[ch];
#pragma unroll
            for (int w = 0; w < 4; ++w) { const int ts = t - 3 + w; if (ts >= 0) v += bf2f(P[((size_t)b * SEQ + ts) * NPROJ + PC_X + ch]) * cw[w * 1024 + ch]; }
            v = silu_f(v);
            if (cc < 256) XS[tt * 256 + cc] = v; else if (cc < 384) BM[tt * 128 + cc - 256] = v; else CM[tt * 128 + cc - 384] = v; }
        if (tid < 64) { const int tt = tid >> 2, hh = tid & 3; const float dtv = DT[((size_t)b * SEQ + t0 + tt) * 8 + g * 4 + hh]; DTL[tid] = dtv; DEC[tid] = __expf(-dtv * __expf(a.in[I_ALOG][g * 4 + hh])); }
        __syncthreads();
#pragma unroll 1
        for (int tt = 0; tt < 16; ++tt) {
            const float dec = DEC[tt * 4 + hl], xdt = XS[tt * 256 + hl * 64 + p] * DTL[tt * 4 + hl]; float y = 0.f;
#pragma unroll
            for (int i4 = 0; i4 < 16; ++i4) { const f32x4 B4 = *(const LAS f32x4*)(BM + tt * 128 + nh * 64 + 4 * i4), C4 = *(const LAS f32x4*)(CM + tt * 128 + nh * 64 + 4 * i4);
#pragma unroll
                for (int c = 0; c < 4; ++c) { hS[4 * i4 + c] = dec * hS[4 * i4 + c] + xdt * B4[c]; y += hS[4 * i4 + c] * C4[c]; } }
            RED[(nh * 16 + tt) * 256 + hl * 64 + p] = y;
        }
        __syncthreads();
#pragma unroll
        for (int r = 0; r < 2; ++r) { const int tt = 2 * wave + r; const size_t row = (size_t)b * SEQ + t0 + tt;
            float yv[4], ss = 0.f;
#pragma unroll
            for (int i = 0; i < 4; ++i) { const int c = lane + 64 * i; float y = RED[tt * 256 + c] + RED[(16 + tt) * 256 + c] + a.in[I_SSMD][g * 4 + i] * XS[tt * 256 + c];
                y *= bf2f(P[row * NPROJ + PC_Z + g * 256 + c]); yv[i] = y; ss += y * y; }
            const float rstd = rsqrtf(wave_sum(ss) * (1.0f / 256.0f) + EPS);
#pragma unroll
            for (int i = 0; i < 4; ++i) { const int c = lane + 64 * i; MIX[row * D + 512 + g * 256 + c] = (bf16)f2bf(yv[i] * rstd * a.in[I_SSMNW][g * 256 + c]); }
        }
        __syncthreads();
    }
}


typedef float f32x16 __attribute__((ext_vector_type(16)));
constexpr size_t WS_UHG = 480 * MiB, WS_SHG = 496 * MiB, WS_USSD = 512 * MiB, WS_SSSD = 544 * MiB, WS_DK = 560 * MiB, WS_DEC = 561 * MiB;
constexpr int LDA = 136, LDT = 72;

__device__ __forceinline__ int crow(int i, int hh) { return (i & 3) + 8 * (i >> 2) + 4 * hh; }
__device__ __forceinline__ void mma32(f32x16& acc, const LAS bf16* A, int lda, const LAS bf16* Bt, int ldb, int nsteps, int lane) {
    const LAS bf16* ap = A + (lane & 31) * lda + 8 * (lane >> 5);
    const LAS bf16* bp = Bt + (lane & 31) * ldb + 8 * (lane >> 5);
    for (int s = 0; s < nsteps; ++s) {
        const bf16x8 av = *(const LAS bf16x8*)(ap + 16 * s), bv = *(const LAS bf16x8*)(bp + 16 * s);
        acc = __builtin_amdgcn_mfma_f32_32x32x16_bf16(av, bv, acc, 0, 0, 0);
    }
}
__device__ __forceinline__ f32x16 zero16() { f32x16 z;
#pragma unroll
    for (int i = 0; i < 16; ++i) z[i] = 0.f; return z; }
__device__ __forceinline__ void st8(LAS bf16* p, float a, float b, float c, float d) { *(LAS unsigned long long*)p = (unsigned long long)pk2(a, b) | ((unsigned long long)pk2(c, d) << 32); }
__device__ __forceinline__ void st16x(LAS bf16* p, const float* v) {
    v4u a, b; a.x = pk2(v[0], v[1]); a.y = pk2(v[2], v[3]); a.z = pk2(v[4], v[5]); a.w = pk2(v[6], v[7]); b.x = pk2(v[8], v[9]); b.y = pk2(v[10], v[11]); b.z = pk2(v[12], v[13]); b.w = pk2(v[14], v[15]);
    *(LAS v4u*)p = a; *(LAS v4u*)(p + 8) = b; }

__device__ __forceinline__ float bfw(unsigned w, int hi) { return __uint_as_float(hi ? (w & 0xffff0000u) : (w << 16)); }
constexpr int HG_QS = 0, HG_KS = 17408, HG_KDT = 34816, HG_VT = 53248, HG_ST = 71680, HG_ATT = 106496, HG_QT = 115712, HG_EBM = 117760, HG_EBL = 118272;
constexpr int HG_VRAW = 118784;
struct HgWide { v4u q[2], k[2], v[2]; float lf[16]; };
template <bool FULL> __device__ __forceinline__ void hg_load(const Args& a, HgWide& r, int b, int h, int t0, int tid) {
    const bf16* P = (const bf16*)(a.ws + WS_P) + ((size_t)b * SEQ + t0) * NPROJ + h * 128;
#pragma unroll
    for (int i = 0; i < 2; ++i) { const int piece = tid + NTHR * i; const unsigned o = (unsigned)(piece >> 4) * NPROJ + 8u * (unsigned)(piece & 15);
        r.k[i] = *(const v4u*)(P + o + PC_K); r.v[i] = *(const v4u*)(P + o + PC_V); if (FULL) r.q[i] = *(const v4u*)(P + o + PC_Q); }
    const int k = tid & 127, tq = tid >> 7;
    const float* LF = (const float*)(a.ws + WS_LF) + ((size_t)b * SEQ + t0 + 16 * tq) * 512 + h * 128;
#pragma unroll
    for (int i = 0; i < 16; ++i) r.lf[i] = LF[(unsigned)i * 512 + (unsigned)k];
}
template <bool FULL> __device__ __forceinline__ float hg_stage(const HgWide& r, LAS unsigned char* lds, int tid) {
    LAS bf16* QS = (LAS bf16*)(lds + HG_QS); LAS bf16* KS = (LAS bf16*)(lds + HG_KS); LAS bf16* KDT = (LAS bf16*)(lds + HG_KDT); LAS bf16* VT = (LAS bf16*)(lds + HG_VT); LAS bf16* VR = (LAS bf16*)(lds + HG_VRAW);
    LAS float* QT = (LAS float*)(lds + HG_QT); LAS float* EBM = (LAS float*)(lds + HG_EBM); LAS float* EBL = (LAS float*)(lds + HG_EBL);
#pragma unroll
    for (int i = 0; i < 2; ++i) { const int piece = tid + NTHR * i; const int o = (piece >> 4) * LDA + 8 * (piece & 15);
        *(LAS v4u*)(KS + o) = r.k[i]; *(LAS v4u*)(VR + o) = r.v[i]; if (FULL) *(LAS v4u*)(QS + o) = r.q[i]; }
    const int k = tid & 127, tq = tid >> 7;
    float cum[16]; float run = 0.f;
#pragma unroll
    for (int i = 0; i < 16; ++i) { run += r.lf[i]; cum[i] = run; }
    QT[tq * 128 + k] = run;
    __syncthreads();
    const float q0 = QT[k], q1 = QT[128 + k], q2 = QT[256 + k], q3 = QT[384 + k];
    const float off = (tq > 0 ? q0 : 0.f) + (tq > 1 ? q1 : 0.f) + (tq > 2 ? q2 : 0.f), bmid = q0 + q1, blast = (q0 + q1) + (q2 + q3);
    float kd[16], vv[16];
#pragma unroll
    for (int i = 0; i < 16; ++i) { const float bt = off + cum[i]; const int e = (16 * tq + i) * LDA + k; const float kk = bf2f(KS[e]); vv[i] = bf2f(VR[e]); kd[i] = kk * __expf(blast - bt);
        if (FULL) { QS[e] = (bf16)f2bf(bf2f(QS[e]) * __expf(bt - bmid)); KS[e] = (bf16)f2bf(kk * __expf(bmid - bt)); } }
    st16x(KDT + k * LDT + 16 * tq, kd); st16x(VT + k * LDT + 16 * tq, vv);
    if (tq == 0) { EBL[k] = __expf(blast); if (FULL) EBM[k] = __expf(bmid); }
    __syncthreads();
    return blast;
}
__device__ __forceinline__ void hg_update(f32x16 (&S)[2], LAS unsigned char* lds, int wave, int lane) {
    const LAS bf16* KDT = (const LAS bf16*)(lds + HG_KDT); const LAS bf16* VT = (const LAS bf16*)(lds + HG_VT); const LAS float* EBL = (const LAS float*)(lds + HG_EBL);
    const int kt = wave >> 1, hh = lane >> 5;
#pragma unroll
    for (int g = 0; g < 4; ++g) { const f32x4 e = *(const LAS f32x4*)(EBL + 32 * kt + 8 * g + 4 * hh);
#pragma unroll
        for (int j = 0; j < 2; ++j) { S[j][4 * g + 0] *= e.x; S[j][4 * g + 1] *= e.y; S[j][4 * g + 2] *= e.z; S[j][4 * g + 3] *= e.w; } }
#pragma unroll
    for (int j = 0; j < 2; ++j) mma32(S[j], KDT + 32 * kt * LDT, LDT, VT + 32 * (2 * (wave & 1) + j) * LDT, LDT, 4, lane);
}
__device__ __forceinline__ void hg_passA(const Args& a, LAS unsigned char* lds, int u, int tid, int wave, int lane) {
    const int bh = u >> 5, seg = u & 31, b = bh >> 2, h = bh & 3, kt = wave >> 1, hh = lane >> 5, r = lane & 31;
    f32x16 S[2]; S[0] = zero16(); S[1] = zero16();
    float dsum = 0.f;
    HgWide cur; hg_load<false>(a, cur, b, h, seg * 256, tid);
#pragma unroll 1
    for (int c = 0; c < 4; ++c) {
        dsum += hg_stage<false>(cur, lds, tid);
        if (c < 3) hg_load<false>(a, cur, b, h, seg * 256 + 64 * (c + 1), tid);
        hg_update(S, lds, wave, lane);
    }
    float* U = (float*)(a.ws + WS_UHG) + (size_t)u * 16384;
#pragma unroll
    for (int j = 0; j < 2; ++j)
#pragma unroll
        for (int i = 0; i < 16; ++i) U[(32 * kt + crow(i, hh)) * 128 + 32 * (2 * (wave & 1) + j) + r] = S[j][i];
    if (tid < 128) ((float*)(a.ws + WS_DK))[u * 128 + tid] = __expf(dsum);
}
__device__ __forceinline__ void hg_passC(const Args& a, LAS unsigned char* lds, int u, int tid, int wave, int lane) {
    const int bh = u >> 5, seg = u & 31, b = bh >> 2, h = bh & 3, kt = wave >> 1, hh = lane >> 5, r = lane & 31;
    LAS bf16* QS = (LAS bf16*)(lds + HG_QS); LAS bf16* KS = (LAS bf16*)(lds + HG_KS); LAS bf16* VT = (LAS bf16*)(lds + HG_VT);
    LAS bf16* ST = (LAS bf16*)(lds + HG_ST); LAS bf16* ATT = (LAS bf16*)(lds + HG_ATT); LAS float* EBM = (LAS float*)(lds + HG_EBM); LAS float* O = (LAS float*)(lds + HG_ST);
    const bf16* P = (const bf16*)(a.ws + WS_P); bf16* MIX = (bf16*)(a.ws + WS_MIX); const float* nw = a.in[I_HGNW];
    f32x16 S[2];
    { const float* SI = (const float*)(a.ws + WS_SHG) + (size_t)u * 16384;
#pragma unroll
      for (int j = 0; j < 2; ++j)
#pragma unroll
        for (int i = 0; i < 16; ++i) S[j][i] = SI[(32 * kt + crow(i, hh)) * 128 + 32 * (2 * (wave & 1) + j) + r]; }
    HgWide cur; hg_load<true>(a, cur, b, h, seg * 256, tid);
#pragma unroll 1
    for (int c = 0; c < 4; ++c) {
        const int t0 = seg * 256 + 64 * c;
        hg_stage<true>(cur, lds, tid);
        if (c < 3) hg_load<true>(a, cur, b, h, t0 + 64, tid);
#pragma unroll
        for (int g = 0; g < 4; ++g) { const int kb = 32 * kt + 8 * g + 4 * hh; const f32x4 e = *(const LAS f32x4*)(EBM + kb);
#pragma unroll
            for (int j = 0; j < 2; ++j) st8(ST + (32 * (2 * (wave & 1) + j) + r) * LDA + kb, S[j][4 * g] * e.x, S[j][4 * g + 1] * e.y, S[j][4 * g + 2] * e.z, S[j][4 * g + 3] * e.w); }
        if (wave < 3) { const int ti = (wave + 1) >> 1, si = wave >> 1;
            f32x16 at = zero16(); mma32(at, QS + 32 * ti * LDA, LDA, KS + 32 * si * LDA, LDA, 8, lane);
#pragma unroll
            for (int i = 0; i < 16; ++i) { const int t = 32 * ti + crow(i, hh), s = 32 * si + r; ATT[t * LDT + s] = (bf16)f2bf(s <= t ? at[i] : 0.f); } }
        __syncthreads();
        const int ti = wave >> 2, vj = wave & 3;
        f32x16 o = zero16();
        mma32(o, ATT + 32 * ti * LDT, LDT, VT + 32 * vj * LDT, LDT, 2 * (ti + 1), lane);
        mma32(o, QS + 32 * ti * LDA, LDA, ST + 32 * vj * LDA, LDA, 8, lane);
        hg_update(S, lds, wave, lane);
        __syncthreads();
#pragma unroll
        for (int i = 0; i < 16; ++i) O[(32 * ti + crow(i, hh)) * 132 + 32 * vj + r] = o[i];
        __syncthreads();
        { const int tt = tid >> 3, c16 = tid & 7; const size_t row = (size_t)b * SEQ + t0 + tt;
          float o[16]; float ss = 0.f;
#pragma unroll
          for (int q = 0; q < 4; ++q) { const f32x4 v = *(const LAS f32x4*)(O + tt * 132 + 16 * c16 + 4 * q); o[4 * q] = v.x; o[4 * q + 1] = v.y; o[4 * q + 2] = v.z; o[4 * q + 3] = v.w; ss += (v.x * v.x + v.y * v.y) + (v.z * v.z + v.w * v.w); }
          ss += __shfl_xor(ss, 1); ss += __shfl_xor(ss, 2); ss += __shfl_xor(ss, 4);
          const float rstd = rsqrtf(ss * (1.0f / 128.0f) + EPS);
          const bf16* gp = P + row * NPROJ + PC_G + h * 128 + 16 * c16; const v4u g0 = __builtin_nontemporal_load((const v4u*)gp), g1 = __builtin_nontemporal_load((const v4u*)(gp + 8)); const unsigned gw[8] = {g0.x, g0.y, g0.z, g0.w, g1.x, g1.y, g1.z, g1.w};
          unsigned ow[8];
#pragma unroll
          for (int j = 0; j < 8; ++j) ow[j] = pk2(o[2 * j] * rstd * nw[16 * c16 + 2 * j] * bfw(gw[j], 0), o[2 * j + 1] * rstd * nw[16 * c16 + 2 * j + 1] * bfw(gw[j], 1));
          bf16* mp = MIX + row * D + h * 128 + 16 * c16; *(v4u*)mp = (v4u){ow[0], ow[1], ow[2], ow[3]}; *(v4u*)(mp + 8) = (v4u){ow[4], ow[5], ow[6], ow[7]}; }
    }
    __syncthreads();
}

constexpr int SD_ACUM = 104448, SD_DTV = 106496, SD_SSQ = 108544, SD_CB = 109568;
__device__ __forceinline__ void ssd_scan_dt(const Args& a, LAS unsigned char* lds, size_t row0, int g, int wave, int lane) {
    LAS float* ACUM = (LAS float*)(lds + SD_ACUM); LAS float* DTV = (LAS float*)(lds + SD_DTV);
    if (wave < 4) { const float* DT = (const float*)(a.ws + WS_DT); const float A = -__expf(a.in[I_ALOG][g * 4 + wave]);
        const float d0 = DT[(row0 + 2 * lane) * 8 + g * 4 + wave], d1 = DT[(row0 + 2 * lane + 1) * 8 + g * 4 + wave];
        const float p0 = d0 * A, p1 = p0 + d1 * A; float incl = p1;
#pragma unroll
        for (int o = 1; o < 64; o <<= 1) { const float t = __shfl_up(incl, o); if (lane >= o) incl += t; }
        const float excl = incl - p1;
        ACUM[wave * 128 + 2 * lane] = excl + p0; ACUM[wave * 128 + 2 * lane + 1] = incl; DTV[wave * 128 + 2 * lane] = d0; DTV[wave * 128 + 2 * lane + 1] = d1; }
}
template <int NT> __device__ __forceinline__ void conv_run(const Args& a, int b, int tp0, int ch, float (&out)[NT]) {
    const bf16* Pb = (const bf16*)(a.ws + WS_P) + (size_t)b * SEQ * NPROJ + PC_X;
    const float w0 = a.in[I_CONVW][ch], w1 = a.in[I_CONVW][1024 + ch], w2 = a.in[I_CONVW][2048 + ch], w3 = a.in[I_CONVW][3072 + ch], cb = a.in[I_CONVB][ch];
    const unsigned o0 = (unsigned)tp0 * NPROJ + (unsigned)ch;
    float x0 = (tp0 >= 3) ? bf2f(Pb[o0 - 3u * NPROJ]) : 0.f, x1 = (tp0 >= 2) ? bf2f(Pb[o0 - 2u * NPROJ]) : 0.f, x2 = (tp0 >= 1) ? bf2f(Pb[o0 - 1u * NPROJ]) : 0.f;
#pragma unroll
    for (int i = 0; i < NT; ++i) { const float x3 = bf2f(Pb[o0 + (unsigned)i * NPROJ]); out[i] = silu_f(cb + w0 * x0 + w1 * x1 + w2 * x2 + w3 * x3); x0 = x1; x1 = x2; x2 = x3; }
}
#ifdef PROBE_A
#define SUBSTAMP(k) do { if (blockIdx.x == 0 && threadIdx.x == 0) { const unsigned long long t_ = __builtin_amdgcn_s_memrealtime(); volatile LAS unsigned* M_ = (volatile LAS unsigned*)(lds + MISC_OFF); M_[16 + 2 * (k)] = (unsigned)t_; M_[17 + 2 * (k)] = (unsigned)(t_ >> 32); } } while (0)
#else
#define SUBSTAMP(k) do { } while (0)
#endif
template <bool NATURAL, bool NT = false, int NTOK = 8> __device__ __forceinline__ void conv8x8(const Args& a, int b, int tp0, int ch0, LAS bf16* dst, const float* sc) {
    const bf16* Pb = (const bf16*)(a.ws + WS_P) + (size_t)b * SEQ * NPROJ + PC_X + ch0;
    const float* cw = a.in[I_CONVW] + ch0; const float* cbp = a.in[I_CONVB] + ch0;
    float w[4][8], bias[8];
#pragma unroll
    for (int q = 0; q < 4; ++q) { const f32x4 lo = *(const f32x4*)(cw + q * 1024), hi = *(const f32x4*)(cw + q * 1024 + 4);
        w[q][0] = lo.x; w[q][1] = lo.y; w[q][2] = lo.z; w[q][3] = lo.w; w[q][4] = hi.x; w[q][5] = hi.y; w[q][6] = hi.z; w[q][7] = hi.w; }
    { const f32x4 lo = *(const f32x4*)cbp, hi = *(const f32x4*)(cbp + 4); bias[0] = lo.x; bias[1] = lo.y; bias[2] = lo.z; bias[3] = lo.w; bias[4] = hi.x; bias[5] = hi.y; bias[6] = hi.z; bias[7] = hi.w; }
    v4u raw[NTOK + 3];
#pragma unroll
    for (int i = 0; i < NTOK + 3; ++i) { const int tp = tp0 - 3 + i; const v4u* rp = (const v4u*)(Pb + (size_t)(unsigned)(tp < 0 ? 0 : tp) * NPROJ); raw[i] = (tp >= 0) ? (NT ? __builtin_nontemporal_load(rp) : *rp) : (v4u){0u, 0u, 0u, 0u}; }
    unsigned pkT[8][NTOK / 2];
#pragma unroll
    for (int tok = 0; tok < NTOK; ++tok) { float o[8];
#pragma unroll
        for (int c = 0; c < 8; ++c) { float v = bias[c];
#pragma unroll
            for (int q = 0; q < 4; ++q) v += w[q][c] * bfw(raw[tok + q][c >> 1], c & 1);
            o[c] = silu_f(v); }
        if (NATURAL) { v4u ov; ov.x = pk2(o[0], o[1]); ov.y = pk2(o[2], o[3]); ov.z = pk2(o[4], o[5]); ov.w = pk2(o[6], o[7]); *(LAS v4u*)(dst + tok * LDA) = ov; }
        else {
#pragma unroll
            for (int c = 0; c < 8; ++c) { const unsigned hb = f2bf(o[c] * sc[tok]); pkT[c][tok >> 1] = (tok & 1) ? (pkT[c][tok >> 1] | (hb << 16)) : hb; } } }
    if (!NATURAL) {
#pragma unroll
        for (int c = 0; c < 8; ++c) {
            if (NTOK == 8) { v4u ov; ov.x = pkT[c][0]; ov.y = pkT[c][1]; ov.z = pkT[c][NTOK == 8 ? 2 : 0]; ov.w = pkT[c][NTOK == 8 ? 3 : 0]; *(LAS v4u*)(dst + c * LDA) = ov; }
            else *(LAS unsigned long long*)(dst + c * LDA) = (unsigned long long)pkT[c][0] | ((unsigned long long)pkT[c][1] << 32); } }
}
constexpr int SC_CM = 0, SC_BM = 34816, SC_XT = 69632, SC_SIN = 87040, SC_YS = 104448, SC_ACUM = 139264, SC_DTV = 141312;
__device__ __forceinline__ void ssd_scan_dt_at(const Args& a, LAS unsigned char* lds, int acum_off, int dtv_off, size_t row0, int g, int wave, int lane) {
    LAS float* ACUM = (LAS float*)(lds + acum_off); LAS float* DTV = (LAS float*)(lds + dtv_off);
    if (wave < 4) { const float* DT = (const float*)(a.ws + WS_DT); const float A = -__expf(a.in[I_ALOG][g * 4 + wave]);
        const float d0 = DT[(row0 + 2 * lane) * 8 + g * 4 + wave], d1 = DT[(row0 + 2 * lane + 1) * 8 + g * 4 + wave];
        const float p0 = d0 * A, p1 = p0 + d1 * A; float incl = p1;
#pragma unroll
        for (int o = 1; o < 64; o <<= 1) { const float t = __shfl_up(incl, o); if (lane >= o) incl += t; }
        const float excl = incl - p1;
        ACUM[wave * 128 + 2 * lane] = excl + p0; ACUM[wave * 128 + 2 * lane + 1] = incl; DTV[wave * 128 + 2 * lane] = d0; DTV[wave * 128 + 2 * lane + 1] = d1; }
}
__device__ __forceinline__ void ssd_passA(const Args& a, LAS unsigned char* lds, int u, int tid, int wave, int lane) {
    const int bg = u >> 6, c = u & 63, b = bg >> 1, g = bg & 1, t0 = c * 128; const size_t row0 = (size_t)b * SEQ + t0;
    LAS bf16* XDT = (LAS bf16*)lds; LAS bf16* BMT = (LAS bf16*)(lds + 69632); LAS float* ACUM = (LAS float*)(lds + SD_ACUM); LAS float* DTV = (LAS float*)(lds + SD_DTV);
    ssd_scan_dt(a, lds, row0, g, wave, lane);
    __syncthreads();
#pragma unroll 1
    for (int task = tid; task < 768; task += NTHR) {
        int task_o = task; asm volatile("" : "+v"(task_o));
        const int cg = task_o >> 4, tb = task_o & 15; float sc[8];
        if (cg < 32) { const int hd = cg >> 3; const float al = ACUM[hd * 128 + 127];
#pragma unroll
            for (int i = 0; i < 8; ++i) sc[i] = DTV[hd * 128 + 8 * tb + i] * __expf(al - ACUM[hd * 128 + 8 * tb + i]);
            conv8x8<false>(a, b, t0 + 8 * tb, g * 256 + 8 * cg, XDT + (8 * cg) * LDA + 8 * tb, sc); }
        else {
#pragma unroll
            for (int i = 0; i < 8; ++i) sc[i] = 1.0f;
            conv8x8<false>(a, b, t0 + 8 * tb, 512 + g * 128 + 8 * (cg - 32), BMT + (8 * (cg - 32)) * LDA + 8 * tb, sc); }
    }
    __syncthreads();
    const int hd = wave >> 1, pt = wave & 1, hh = lane >> 5, r = lane & 31;
    float* U = (float*)(a.ws + WS_USSD) + (size_t)u * 32768;
#pragma unroll
    for (int nt = 0; nt < 4; ++nt) { f32x16 acc = zero16(); mma32(acc, XDT + (hd * 64 + 32 * pt) * LDA, LDA, BMT + 32 * nt * LDA, LDA, 8, lane);
#pragma unroll
        for (int i = 0; i < 16; ++i) U[(hd * 64 + 32 * pt + crow(i, hh)) * 128 + 32 * nt + r] = acc[i]; }
    if (tid < 4) ((float*)(a.ws + WS_DEC))[u * 4 + tid] = __expf(ACUM[tid * 128 + 127]);
    __syncthreads();
}
constexpr int S2_CM = 0, S2_CBT = 34816, S2_BUF = 55296, S2_BUFSZ = 34816, S2_BM = S2_BUF + S2_BUFSZ, S2_YS = 124928, S2_ACUM = 143360, S2_DTV = 145408;
__device__ __forceinline__ void ssd_stage_head(const Args& a, LAS unsigned char* lds, int u, int b, int g, int t0, int hd, int buf, int tid256, const float* ones) {
    LAS bf16* XT = (LAS bf16*)(lds + S2_BUF + buf * S2_BUFSZ); LAS bf16* SIN = XT + 64 * LDA;
    const int c8 = tid256 & 7, tb = tid256 >> 3;
    conv8x8<false, false, 4>(a, b, t0 + 4 * tb, g * 256 + hd * 64 + 8 * c8, XT + (8 * c8) * LDA + 4 * tb, ones);
    const v4u* src = (const v4u*)((const bf16*)(a.ws + WS_SSSD) + (size_t)u * 32768) + (unsigned)(hd * 64 * 16);
#pragma unroll
    for (int j = 0; j < 4; ++j) { const int piece = tid256 + 256 * j, pr = piece >> 4, c = piece & 15; *(LAS v4u*)(SIN + pr * LDA + 8 * c) = __builtin_nontemporal_load(src + piece); }
}
__device__ __forceinline__ void ssd_passC(const Args& a, LAS unsigned char* lds, int u, int tid, int wave, int lane) {
    const int bg = u >> 6, c = u & 63, b = bg >> 1, g = bg & 1, t0 = c * 128; const size_t row0 = (size_t)b * SEQ + t0;
    LAS bf16* CM = (LAS bf16*)(lds + S2_CM); LAS bf16* BM = (LAS bf16*)(lds + S2_BM); LAS unsigned char* CBT = lds + S2_CBT;
    LAS bf16* YS = (LAS bf16*)(lds + S2_YS); LAS float* ACUM = (LAS float*)(lds + S2_ACUM); LAS float* DTV = (LAS float*)(lds + S2_DTV);
    const bf16* P = (const bf16*)(a.ws + WS_P); bf16* MIX = (bf16*)(a.ws + WS_MIX);
    float ones[4];
#pragma unroll
    for (int i = 0; i < 4; ++i) ones[i] = 1.0f;
    ssd_scan_dt_at(a, lds, S2_ACUM, S2_DTV, row0, g, wave, lane);
    { const int c8 = tid & 31, tb = tid >> 5;
      conv8x8<true>(a, b, t0 + 8 * tb, (c8 < 16) ? (512 + g * 128 + 8 * c8) : (768 + g * 128 + 8 * (c8 - 16)), ((c8 < 16) ? (BM + 8 * c8) : (CM + 8 * (c8 - 16))) + 8 * tb * LDA, nullptr); }
    __syncthreads();
    for (int idx = wave; idx < 10; idx += NWAVES) { const int ti = (idx >= 6) ? 3 : (idx >= 3) ? 2 : (idx >= 1) ? 1 : 0, si = idx - ti * (ti + 1) / 2;
        f32x16 cbT = zero16(); mma32(cbT, BM + 32 * si * LDA, LDA, CM + 32 * ti * LDA, LDA, 8, lane);
        v4u o0, o1; o0.x = pk2(cbT[0], cbT[1]); o0.y = pk2(cbT[2], cbT[3]); o0.z = pk2(cbT[4], cbT[5]); o0.w = pk2(cbT[6], cbT[7]); o1.x = pk2(cbT[8], cbT[9]); o1.y = pk2(cbT[10], cbT[11]); o1.z = pk2(cbT[12], cbT[13]); o1.w = pk2(cbT[14], cbT[15]);
        *(LAS v4u*)(CBT + idx * 2048 + lane * 32) = o0; *(LAS v4u*)(CBT + idx * 2048 + lane * 32 + 16) = o1; }
    if (tid < 256) ssd_stage_head(a, lds, u, b, g, t0, 0, 0, tid, ones);
    __syncthreads();
    const int ti = (wave < 4) ? (wave >> 1) : (3 - ((wave - 4) >> 1)), pj = wave & 1;
    const int et = tid >> 2, epq = tid & 3;
    float ssq = 0.f;
    const bf16* Pz = P + (row0 + et) * NPROJ + PC_Z + g * 256 + 16 * epq;
    bf16* Mo = MIX + (row0 + et) * D + 512 + g * 256 + 16 * epq;
    SUBSTAMP(15);
#pragma unroll 1
    for (int hd = 0; hd < 4; ++hd) {
        int tid_o = tid; asm volatile("" : "+v"(tid_o));
        const int lane = tid_o & 63, hh = lane >> 5, r = lane & 31;
        const LAS bf16* XT = (const LAS bf16*)(lds + S2_BUF + (hd & 1) * S2_BUFSZ); const LAS bf16* SIN = XT + 64 * LDA;
        const v4u z0 = __builtin_nontemporal_load((const v4u*)(Pz + hd * 64)), z1 = __builtin_nontemporal_load((const v4u*)(Pz + hd * 64 + 8));
        const float Dh = a.in[I_SSMD][g * 4 + hd];
        f32x16 yi = zero16(), yo = zero16();
        const int t = 32 * ti + r; const float at = ACUM[hd * 128 + t];
        for (int si = 0; si <= ti; ++si) {
            const LAS unsigned char* cp = CBT + (ti * (ti + 1) / 2 + si) * 2048 + lane * 32; const v4u c0 = *(const LAS v4u*)cp, c1 = *(const LAS v4u*)(cp + 16);
            const unsigned cw[8] = {c0.x, c0.y, c0.z, c0.w, c1.x, c1.y, c1.z, c1.w};
            float sv[16];
#pragma unroll
            for (int gq = 0; gq < 4; ++gq) { const int s0 = 32 * si + 8 * gq + 4 * hh;
                const f32x4 a4 = *(const LAS f32x4*)(ACUM + hd * 128 + s0), d4 = *(const LAS f32x4*)(DTV + hd * 128 + s0);
#pragma unroll
                for (int q = 0; q < 4; ++q) { const int i = 4 * gq + q, s = s0 + q; float v = (s <= t) ? bfw(cw[i >> 1], i & 1) * __expf(at - a4[q]) * d4[q] : 0.f; sv[i] = (s == t) ? v + Dh : v; } }
#pragma unroll
            for (int st = 0; st < 2; ++st) {
                v4u av;
                asm volatile("v_cvt_pk_bf16_f32 %0, %4, %5\n\tv_cvt_pk_bf16_f32 %1, %6, %7\n\tv_cvt_pk_bf16_f32 %2, %8, %9\n\tv_cvt_pk_bf16_f32 %3, %10, %11\n\ts_nop 1"
                             : "=&v"(av.x), "=&v"(av.y), "=&v"(av.z), "=&v"(av.w)
                             : "v"(sv[8 * st]), "v"(sv[8 * st + 1]), "v"(sv[8 * st + 2]), "v"(sv[8 * st + 3]), "v"(sv[8 * st + 4]), "v"(sv[8 * st + 5]), "v"(sv[8 * st + 6]), "v"(sv[8 * st + 7]));
                const LAS bf16* bp = XT + (32 * pj + r) * LDA + 32 * si + 16 * st + 4 * hh;
                const unsigned long long b0 = *(const LAS unsigned long long*)bp, b1 = *(const LAS unsigned long long*)(bp + 8);
                v4u bv; bv.x = (unsigned)b0; bv.y = (unsigned)(b0 >> 32); bv.z = (unsigned)b1; bv.w = (unsigned)(b1 >> 32);
                yi = __builtin_amdgcn_mfma_f32_32x32x16_bf16(__builtin_bit_cast(bf16x8, av), __builtin_bit_cast(bf16x8, bv), yi, 0, 0, 0);
            }
        }
        mma32(yo, CM + 32 * ti * LDA, LDA, SIN + 32 * pj * LDA, LDA, 8, lane);
#pragma unroll
        for (int i = 0; i < 16; ++i) { const int tt = 32 * ti + crow(i, hh); YS[tt * 72 + 32 * pj + r] = (bf16)f2bf(yi[i] + __expf(ACUM[hd * 128 + tt]) * yo[i]); }
        if (tid_o < 256 && hd < 3) ssd_stage_head(a, lds, u, b, g, t0, hd + 1, (hd + 1) & 1, tid_o, ones);
        __syncthreads();
        if (hd == 1) SUBSTAMP(20);
        { const LAS v4u* yp = (const LAS v4u*)(YS + et * 72 + 16 * epq); const v4u y0 = yp[0], y1 = yp[1];
          const unsigned yw[8] = {y0.x, y0.y, y0.z, y0.w, y1.x, y1.y, y1.z, y1.w}, zw[8] = {z0.x, z0.y, z0.z, z0.w, z1.x, z1.y, z1.z, z1.w};
          float y[16];
#pragma unroll
          for (int j = 0; j < 16; ++j) { y[j] = bfw(yw[j >> 1], j & 1) * bfw(zw[j >> 1], j & 1); ssq += y[j] * y[j]; }
          v4u o0, o1; o0.x = pk2(y[0], y[1]); o0.y = pk2(y[2], y[3]); o0.z = pk2(y[4], y[5]); o0.w = pk2(y[6], y[7]); o1.x = pk2(y[8], y[9]); o1.y = pk2(y[10], y[11]); o1.z = pk2(y[12], y[13]); o1.w = pk2(y[14], y[15]);
          *(v4u*)(Mo + hd * 64) = o0; *(v4u*)(Mo + hd * 64 + 8) = o1; }
        __syncthreads();
        SUBSTAMP(16 + hd);
    }
    ssq += __shfl_xor(ssq, 1); ssq += __shfl_xor(ssq, 2);
    const float rstd = rsqrtf(ssq * (1.0f / 256.0f) + EPS);
    const float* nw = a.in[I_SSMNW] + g * 256 + 16 * epq;
    v4u rb[8];
#pragma unroll
    for (int hd = 0; hd < 4; ++hd) { rb[2 * hd] = *(const v4u*)(Mo + hd * 64); rb[2 * hd + 1] = *(const v4u*)(Mo + hd * 64 + 8); }
#pragma unroll
    for (int hd = 0; hd < 4; ++hd) {
        const unsigned iw[8] = {rb[2 * hd].x, rb[2 * hd].y, rb[2 * hd].z, rb[2 * hd].w, rb[2 * hd + 1].x, rb[2 * hd + 1].y, rb[2 * hd + 1].z, rb[2 * hd + 1].w};
        float wv[16];
#pragma unroll
        for (int q = 0; q < 4; ++q) { const f32x4 v = *(const f32x4*)(nw + hd * 64 + 4 * q); wv[4 * q] = v.x; wv[4 * q + 1] = v.y; wv[4 * q + 2] = v.z; wv[4 * q + 3] = v.w; }
        unsigned ow[8];
#pragma unroll
        for (int j = 0; j < 8; ++j) ow[j] = pk2(bfw(iw[j], 0) * rstd * wv[2 * j], bfw(iw[j], 1) * rstd * wv[2 * j + 1]);
        *(v4u*)(Mo + hd * 64) = (v4u){ow[0], ow[1], ow[2], ow[3]}; *(v4u*)(Mo + hd * 64 + 8) = (v4u){ow[4], ow[5], ow[6], ow[7]};
    }
    __syncthreads();
}
__device__ __forceinline__ void mix_scan(const Args& a, int bid, int G, int tid) {
    typedef float f32x2 __attribute__((ext_vector_type(2)));
    for (int gt = bid * NTHR + tid; gt < 131072; gt += G * NTHR) {
        if (gt < 65536) { const int bh = gt >> 13, e2 = gt & 8191, k = e2 >> 6;
            const f32x2* U = (const f32x2*)(a.ws + WS_UHG) + (size_t)bh * 32 * 8192 + e2; f32x2* SI = (f32x2*)(a.ws + WS_SHG) + (size_t)bh * 32 * 8192 + e2; const float* DK = (const float*)(a.ws + WS_DK) + bh * 32 * 128 + k;
            f32x2 cur = {0.f, 0.f};
#pragma unroll 16
            for (int uu = 0; uu < 32; ++uu) { SI[(size_t)uu * 8192] = cur; cur = cur * DK[uu * 128] + __builtin_nontemporal_load(U + (size_t)uu * 8192); }
        } else { const int q = gt - 65536, bg = q >> 14, e2 = q & 16383, hd = e2 >> 12;
            const f32x2* U = (const f32x2*)(a.ws + WS_USSD) + (size_t)bg * 64 * 16384 + e2; unsigned* SI = (unsigned*)(a.ws + WS_SSSD) + (size_t)bg * 64 * 16384 + e2; const float* DEC = (const float*)(a.ws + WS_DEC) + bg * 64 * 4 + hd;
            f32x2 cur = {0.f, 0.f};
#pragma unroll 16
            for (int cc = 0; cc < 64; ++cc) { SI[(size_t)cc * 16384] = pk2(cur.x, cur.y); cur = cur * DEC[cc * 4] + __builtin_nontemporal_load(U + (size_t)cc * 16384); }
        }
    }
}

template <int HALF, int MASK> __device__ __forceinline__ void tr_step(float (&p)[32], int lane) {
    const bool up = (lane & MASK) != 0;
#pragma unroll
    for (int i = 0; i < HALF; ++i) { const float lo = p[i], hi = p[i + HALF]; const float send = up ? lo : hi, keep = up ? hi : lo; p[i] = keep + __shfl_xor(send, MASK); }
}
__device__ __forceinline__ void top4_store(float v, int lane, LAS int* SEL, LAS float* SELG, int ent) {
    float tv[4]; int ti[4];
#pragma unroll
    for (int k = 0; k < 4; ++k) { const float mx = wave_max(v); const unsigned long long bal = __ballot(v == mx); const int e = __builtin_ctzll(bal) >> 1;
        tv[k] = mx; ti[k] = e; v = ((lane >> 1) == e) ? -INFINITY : v; }
    const float e1 = __expf(tv[1] - tv[0]), e2 = __expf(tv[2] - tv[0]), e3 = __expf(tv[3] - tv[0]), inv = 1.0f / (1.0f + e1 + e2 + e3);
    if (lane < 4) { SEL[ent + lane] = (lane == 0) ? ti[0] : (lane == 1) ? ti[1] : (lane == 2) ? ti[2] : ti[3];
        SELG[ent + lane] = ((lane == 0) ? 1.0f : (lane == 1) ? e1 : (lane == 2) ? e2 : e3) * inv; }
}
constexpr int RT_WB = 0, RT_HB = 66048, RT_PITCH = 1032;
__device__ __forceinline__ void p5_router(const Args& a, LAS unsigned char* lds, int bid, int G, int tid, int wave, int lane) {
    unsigned char* ws = a.ws;
    LAS bf16* WB = (LAS bf16*)(lds + RT_WB); LAS bf16* HB = (LAS bf16*)(lds + RT_HB); LAS float* PART = (LAS float*)(lds + RT_HB);
    LAS float* A2 = (LAS float*)(lds + AUX_OFF + 1024); LAS float* S2 = A2 + 1024;
    LAS float* SELG = (LAS float*)(S2 + 1024); LAS float* LOGIT = SELG + 256;
    LAS int* SEL = (LAS int*)(lds + MISC_OFF + 2048); LAS int* LSL = SEL + 256;
    const float* modf = (const float*)(ws + WS_MODF);
    { const f32x4* rw4 = (const f32x4*)a.in[I_RW];
#pragma unroll 4
      for (int it = 0; it < 16; ++it) { const int q = tid + NTHR * it, k = q >> 3, e0 = (q & 7) * 4; const f32x4 w = rw4[q];
          WB[(e0 + 0) * RT_PITCH + k] = (bf16)f2bf(w.x); WB[(e0 + 1) * RT_PITCH + k] = (bf16)f2bf(w.y); WB[(e0 + 2) * RT_PITCH + k] = (bf16)f2bf(w.z); WB[(e0 + 3) * RT_PITCH + k] = (bf16)f2bf(w.w); } }
    const bf16* x1 = (const bf16*)(ws + WS_X1); bf16* H = (bf16*)(ws + WS_H);
    int* tok_e = (int*)(ws + WS_TOK); int* tok_ls = tok_e + M * 4; float* tok_g = (float*)(tok_ls + M * 4);
    int* blkcnt = (int*)(ws + WS_BLKCNT);
    for (int c = bid; c < NCHUNK; c += G) {
        const int b = c >> 7;
        __syncthreads();
        load_mod_AS(A2, S2, a.in[I_N2W], modf, 1, nullptr, b, 3 * 1024, tid);
        __syncthreads();
        unsigned long long hb[8][4];
        unsigned long long rwa[4];
        { const GAS unsigned long long* xa = (const GAS unsigned long long*)(x1 + (size_t)(c * 64 + wave * 8) * D) + lane;
#pragma unroll
          for (int j = 0; j < 4; ++j) rwa[j] = xa[64 * j]; }
#pragma unroll
        for (int r = 0; r < 8; ++r) {
            const int m0 = c * 64 + wave * 8 + r;
            f32x4 va[4]; float sa = 0.f;
#pragma unroll
            for (int j = 0; j < 4; ++j) { const unsigned long long wa = rwa[j];
                va[j] = (f32x4){bfw((unsigned)wa, 0), bfw((unsigned)wa, 1), bfw((unsigned)(wa >> 32), 0), bfw((unsigned)(wa >> 32), 1)};
                sa += (va[j].x * va[j].x + va[j].y * va[j].y) + (va[j].z * va[j].z + va[j].w * va[j].w); }
            if (r < 7) { const GAS unsigned long long* xa = (const GAS unsigned long long*)(x1 + (size_t)(m0 + 1) * D) + lane;
#pragma unroll
                for (int j = 0; j < 4; ++j) rwa[j] = xa[64 * j]; }
            const float ra = rsqrtf(wave_sum(sa) * (1.0f / D) + EPS);
#pragma unroll
            for (int j = 0; j < 4; ++j) {
                const f32x4 av = *(const LAS f32x4*)(A2 + 256 * j + 4 * lane), sv = *(const LAS f32x4*)(S2 + 256 * j + 4 * lane);
                const f32x4 h = va[j] * ra * av + sv;
#if MOE_FP8_G1
                ((GAS unsigned*)((unsigned char*)H + (size_t)m0 * D))[lane + 64 * j] = pk4_fp8(h.x * 8.f, h.y * 8.f, h.z * 8.f, h.w * 8.f);
#else
                ((GAS unsigned long long*)(H + (size_t)m0 * D))[lane + 64 * j] = (unsigned long long)pk2(h.x, h.y) | ((unsigned long long)pk2(h.z, h.w) << 32);
#endif
                hb[r][j] = (unsigned long long)pk2(h.x, h.y) | ((unsigned long long)pk2(h.z, h.w) << 32);
            }
        }
#pragma unroll
        for (int pass = 0; pass < 2; ++pass) {
            if ((wave >> 2) == pass) {
#pragma unroll
                for (int r = 0; r < 8; ++r)
#pragma unroll
                    for (int j = 0; j < 4; ++j) *(LAS unsigned long long*)(HB + ((wave & 3) * 8 + r) * RT_PITCH + 256 * j + 4 * lane) = hb[r][j]; }
            __syncthreads();
            f32x16 acc = zero16(); mma32(acc, HB + 128 * wave, RT_PITCH, WB + 128 * wave, RT_PITCH, 8, lane);
            __syncthreads();
#pragma unroll
            for (int i = 0; i < 16; ++i) PART[wave * 1024 + crow(i, lane >> 5) * 32 + (lane & 31)] = acc[i];
            __syncthreads();
#pragma unroll
            for (int q = 0; q < 2; ++q) { const int el = tid + NTHR * q; float sacc = 0.f;
#pragma unroll
                for (int w = 0; w < 8; ++w) sacc += PART[w * 1024 + el];
                LOGIT[(el >> 5) * 33 + (el & 31)] = sacc + a.in[I_RB][el & 31]; }
            __syncthreads();
            if (tid < 32) {
                float v[32];
#pragma unroll
                for (int e = 0; e < 32; ++e) v[e] = LOGIT[tid * 33 + e];
                float tv[4]; int ti[4];
#pragma unroll
                for (int k = 0; k < 4; ++k) { float best = v[0]; int bi = 0;
#pragma unroll
                    for (int e = 1; e < 32; ++e) { const bool gt = v[e] > best; best = gt ? v[e] : best; bi = gt ? e : bi; }
                    tv[k] = best; ti[k] = bi;
#pragma unroll
                    for (int e = 0; e < 32; ++e) v[e] = (e == bi) ? -INFINITY : v[e]; }
                const float e1 = __expf(tv[1] - tv[0]), e2 = __expf(tv[2] - tv[0]), e3 = __expf(tv[3] - tv[0]), inv = 1.0f / (1.0f + e1 + e2 + e3);
                const int ent = (32 * pass + tid) * 4;
                SEL[ent] = ti[0]; SEL[ent + 1] = ti[1]; SEL[ent + 2] = ti[2]; SEL[ent + 3] = ti[3];
                SELG[ent] = inv; SELG[ent + 1] = e1 * inv; SELG[ent + 2] = e2 * inv; SELG[ent + 3] = e3 * inv; }
        }
        __syncthreads();
        if (tid < 256 + 32) {
            const int mye = (tid < 256) ? SEL[tid] : (tid - 256), lim = (tid < 256) ? tid : 256; int cnt = 0;
#pragma unroll 4
            for (int j4 = 0; j4 < 64; ++j4) { const LAS int* sp = SEL + 4 * j4; const int s0 = sp[0], s1 = sp[1], s2 = sp[2], s3 = sp[3];
                cnt += (s0 == mye && 4 * j4 < lim) + (s1 == mye && 4 * j4 + 1 < lim) + (s2 == mye && 4 * j4 + 2 < lim) + (s3 == mye && 4 * j4 + 3 < lim); }
            if (tid < 256) LSL[tid] = cnt; else blkcnt[c * 32 + tid - 256] = cnt; }
        __syncthreads();
        if (tid < 256) { const size_t o = (size_t)c * 256 + tid; tok_e[o] = SEL[tid]; tok_ls[o] = LSL[tid]; tok_g[o] = SELG[tid]; }
    }
}

__device__ __forceinline__ void moe_tables(const Args& a, LAS unsigned char* lds, int c, int tid, int wave, int lane) {
    LAS int* TS = (LAS int*)(lds + MISC_OFF + 256); LAS int* RT2E = TS + 64; LAS int* BASE = (LAS int*)(lds + AUX_OFF); LAS int* PART = BASE + 64;
    const int* blkcnt = (const int*)(a.ws + WS_BLKCNT);
    { const int e = tid & 31, part = tid >> 5; int tot = 0, bs = 0;
#pragma unroll
      for (int i = 0; i < 16; ++i) { const int cc = part * 16 + i; const int v = blkcnt[cc * 32 + e]; tot += v; bs += (cc < c) ? v : 0; }
      PART[part * 32 + e] = tot; PART[512 + part * 32 + e] = bs; }
    __syncthreads();
    if (wave == 0) {
        int total = 0, base = 0;
        if (lane < 32) {
#pragma unroll
            for (int p = 0; p < 16; ++p) { total += PART[p * 32 + lane]; base += PART[512 + p * 32 + lane]; } }
        const int tiles = (lane < 32) ? ((total + 255) >> 8) : 0;
        int incl = tiles;
#pragma unroll
        for (int o = 1; o < 32; o <<= 1) { const int t = __shfl_up(incl, o); if (lane >= o) incl += t; }
        const int start = incl - tiles;
        if (lane < 32) { TS[lane] = start; BASE[lane] = start * 256 + base; for (int t = start; t < incl; ++t) RT2E[t] = lane; }
        if (lane == 31) TS[32] = incl;
    }
    __syncthreads();
}
__device__ __forceinline__ void p6_gather(const Args& a, LAS unsigned char* lds, int bid, int G, int tid, int wave, int lane) {
    unsigned char* ws = a.ws;
    LAS int* BASE = (LAS int*)(lds + AUX_OFF);
    const int* tok_e = (const int*)(ws + WS_TOK); const int* tok_ls = tok_e + M * 4; int* tok_pos = (int*)(ws + WS_TOK) + 3 * M * 4;
    const bf16* H = (const bf16*)(ws + WS_H); bf16* XG = (bf16*)(ws + WS_XG);
    if (bid >= NCHUNK) moe_tables(a, lds, NCHUNK, tid, wave, lane);
    for (int c = bid; c < NCHUNK; c += G) {
        __syncthreads();
        moe_tables(a, lds, c, tid, wave, lane);
        LAS int* POS = BASE + 1152;
        if (tid < 256) { const size_t o = (size_t)c * 256 + tid; const int pos = BASE[tok_e[o]] + tok_ls[o]; POS[tid] = pos; tok_pos[o] = pos; }
        __syncthreads();
#if MOE_FP8_G1
        { const unsigned char* Hc = (const unsigned char*)H + (size_t)(c * 64) * D; v4u rw[8];
#pragma unroll
          for (int t = 0; t < 8; ++t) rw[t] = ((const GAS v4u*)(Hc + (size_t)(wave * 8 + t) * D))[lane];
#pragma unroll
          for (int t = 0; t < 8; ++t)
#pragma unroll
            for (int k = 0; k < 4; ++k) ((GAS v4u*)((unsigned char*)XG + (size_t)POS[(wave * 8 + t) * 4 + k] * D))[lane] = rw[t]; }
#else
        for (int i = wave; i < 256; i += NWAVES) { const int pos = POS[i];
            const GAS v4u* src = (const GAS v4u*)(H + (size_t)(c * 64 + (i >> 2)) * D); GAS v4u* dst = (GAS v4u*)(XG + (size_t)pos * D);
            dst[lane] = src[lane]; dst[64 + lane] = src[64 + lane]; }
#endif
    }
}

__device__ __forceinline__ void p9_final(const Args& a, int bid, int G, int wave, int lane) {
    unsigned char* ws = a.ws;
    const bf16* x1 = (const bf16*)(ws + WS_X1); const bf16* Y = (const bf16*)(ws + WS_XG);
    const float* tok_g = (const float*)(ws + WS_TOK) + 2 * M * 4; const int* tok_pos = (const int*)(ws + WS_TOK) + 3 * M * 4;
    const float* modf = (const float*)(ws + WS_MODF); const float* fnw = a.in[I_FNW]; float* out = a.out;
    const int gw = bid * NWAVES + wave, NGW = G * NWAVES;
    int pos_n[4]; float gk_n[4];
    if (gw < M) {
#pragma unroll
        for (int k = 0; k < 4; ++k) { pos_n[k] = tok_pos[(size_t)gw * 4 + k]; gk_n[k] = tok_g[(size_t)gw * 4 + k]; } }
#pragma unroll 1
    for (int m = gw; m < M; m += NGW) {
        const int b = m >> 13; const float* g2 = modf + b * 6144 + 5 * 1024;
        int posv[4]; float gkv[4];
#pragma unroll
        for (int k = 0; k < 4; ++k) { posv[k] = pos_n[k]; gkv[k] = gk_n[k]; }
        if (m + NGW < M) {
#pragma unroll
            for (int k = 0; k < 4; ++k) { pos_n[k] = tok_pos[(size_t)(m + NGW) * 4 + k]; gk_n[k] = tok_g[(size_t)(m + NGW) * 4 + k]; } }
        f32x4 mo[4];
#pragma unroll
        for (int j = 0; j < 4; ++j) mo[j] = (f32x4){0.f, 0.f, 0.f, 0.f};
#pragma unroll
        for (int k = 0; k < 4; ++k) { const int pos = posv[k];
#if Y_FP8
            const float gk = gkv[k] * 0.125f;
            const GAS unsigned* yr = (const GAS unsigned*)((const unsigned char*)Y + (size_t)pos * D) + lane;
#pragma unroll
            for (int j = 0; j < 4; ++j) { const int w = (int)__builtin_nontemporal_load((const unsigned*)yr + 64 * j); typedef float f32x2 __attribute__((ext_vector_type(2)));
                const f32x2 lo = __builtin_amdgcn_cvt_pk_f32_fp8(w, false), hi = __builtin_amdgcn_cvt_pk_f32_fp8(w, true);
                mo[j].x += gk * lo.x; mo[j].y += gk * lo.y; mo[j].z += gk * hi.x; mo[j].w += gk * hi.y; }
#else
            const float gk = gkv[k];
            const GAS unsigned long long* yr = (const GAS unsigned long long*)(Y + (size_t)pos * D) + lane;
#pragma unroll
            for (int j = 0; j < 4; ++j) { const unsigned long long w = yr[64 * j]; const unsigned lo = (unsigned)w, hi = (unsigned)(w >> 32);
                mo[j].x += gk * __uint_as_float(lo << 16); mo[j].y += gk * __uint_as_float(lo & 0xffff0000u); mo[j].z += gk * __uint_as_float(hi << 16); mo[j].w += gk * __uint_as_float(hi & 0xffff0000u); }
#endif
        }
        const GAS unsigned long long* xr = (const GAS unsigned long long*)(x1 + (size_t)m * D) + lane;
        f32x4 v[4]; float ss = 0.f;
#pragma unroll
        for (int j = 0; j < 4; ++j) { const f32x4 gv = *(const f32x4*)(g2 + 256 * j + 4 * lane); const unsigned long long xw = __builtin_nontemporal_load((const unsigned long long*)xr + 64 * j);
            v[j] = (f32x4){bfw((unsigned)xw, 0), bfw((unsigned)xw, 1), bfw((unsigned)(xw >> 32), 0), bfw((unsigned)(xw >> 32), 1)} + gv * mo[j]; ss += (v[j].x * v[j].x + v[j].y * v[j].y) + (v[j].z * v[j].z + v[j].w * v[j].w); }
        const float rstd = rsqrtf(wave_sum(ss) * (1.0f / D) + EPS);
        GAS f32x4* orow = (GAS f32x4*)(out + (size_t)m * D) + lane;
#pragma unroll
        for (int j = 0; j < 4; ++j) { const f32x4 wv = *(const f32x4*)(fnw + 256 * j + 4 * lane); __builtin_nontemporal_store(v[j] * rstd * wv, (f32x4*)(out + (size_t)m * D) + lane + 64 * j); }
    }
}

#ifndef REP_MASK
#define REP_MASK 0
#endif
#define NREP(k) (((REP_MASK) >> (k)) & 1 ? 2 : 1)
#define REPB(k, rr) do { if ((rr) + 1 < NREP(k) && multi) { if ((k) >= 9) { LANE_TID(); xcd_barrier(bar, tid == 0); } else xcd_barrier(bar, tid == 0); } } while (0)
#ifndef SKEW_TICKS
#define SKEW_TICKS 0
#endif
#define PHASE_SKEW() do { if (SKEW_TICKS > 0) { const unsigned long long t0_ = __builtin_amdgcn_s_memrealtime(), w_ = (unsigned long long)(bid & 3) * SKEW_TICKS; while (__builtin_amdgcn_s_memrealtime() - t0_ < w_) __builtin_amdgcn_s_sleep(2); } } while (0)
#ifndef HG_CHUNKED
#define HG_CHUNKED 1
#endif
#ifndef SSD_CHUNKED
#define SSD_CHUNKED 1
#endif
constexpr int NPHASE = 12;
__global__ void __launch_bounds__(NTHR, 2) mk_fwd(Args args) {
    extern __shared__ __attribute__((aligned(16))) unsigned char lds_raw[];
    LAS unsigned char* lds = (LAS unsigned char*)lds_raw;
    const int tid = threadIdx.x, lane = tid & 63, wave = __builtin_amdgcn_readfirstlane(tid >> 6); __builtin_assume(wave >= 0 && wave < 8);
#define LANE_TID() int lane; asm volatile("v_mbcnt_lo_u32_b32 %0, -1, 0\n\tv_mbcnt_hi_u32_b32 %0, -1, %0" : "=v"(lane)); __builtin_assume(lane >= 0 && lane < 64); const int tid = wave * 64 + lane; (void)tid
    const int G = gridDim.x, bid = blockIdx.x;
    unsigned char* ws = args.ws;
    gu32* ctl = (gu32*)(ws + WS_CTL);
    volatile LAS unsigned* MISC = (volatile LAS unsigned*)(lds + MISC_OFF);
    if (tid < 64) MISC[tid] = 0u;
    __syncthreads();
    const int lo = args.ph_lo, hi = args.ph_hi;
    const bool multi = (hi - lo) > 1;
    XcdBarrier bar; bar.bar = (unsigned*)(ctl + CW_BAR); bar.x = 0; bar.st = nullptr;
    if (multi) bar = xcd_barrier_post((unsigned*)(ctl + CW_BAR), MISC + 8, tid == 0);
#define IN(k) (lo <= (k) && (k) < hi)
#ifdef PROBE_A
#ifndef PROBE_BUSY
#define PROBE_BUSY 0
#endif
#define STAMP(k) do { int tid_s; if ((k) >= 9) { LANE_TID(); tid_s = tid; } else tid_s = tid; if (tid_s == 0) { const unsigned long long t_ = __builtin_amdgcn_s_memrealtime(); MISC[16 + 2 * (k)] = (unsigned)t_; MISC[17 + 2 * (k)] = (unsigned)(t_ >> 32); } } while (0)
#define ARRIVE(k) do { int tid_s; if ((k) >= 9) { LANE_TID(); tid_s = tid; } else tid_s = tid; if (tid_s == 0 && (k) == PROBE_A) { const unsigned long long t_ = __builtin_amdgcn_s_memrealtime(); const unsigned long long s_ = ((unsigned long long)MISC[17 + 2 * (k)] << 32) | MISC[16 + 2 * (k)]; \
    const unsigned busy = (unsigned)(t_ - s_); atomicMax((unsigned*)ctl + 3000, busy); atomicAdd((unsigned*)ctl + 3064, busy); } } while (0)
#else
#define STAMP(k) do { } while (0)
#define ARRIVE(k) do { } while (0)
#endif
#define SEAM(k) do { ARRIVE(k); if (IN(k) && IN((k) + 1)) { if ((k) >= 8) { LANE_TID(); xcd_barrier(bar, tid == 0); } else xcd_barrier(bar, tid == 0); } STAMP((k) + 1); } while (0)

    STAMP(0);
    if (IN(0)) { for (int rr_ = 0; rr_ < NREP(0); ++rr_) { p0_prologue(args, lds, bid, G, tid, wave, lane);  REPB(0, rr_); } } SEAM(0);
    if (IN(1)) { for (int rr_ = 0; rr_ < NREP(1); ++rr_) { p1_norm(args, lds, bid, G, tid, wave, lane);  REPB(1, rr_); } } SEAM(1);
    if (IN(2)) { for (int rr_ = 0; rr_ < NREP(2); ++rr_) {
        pg8::Gemm g{(const pg8::bf16_t*)(ws + WS_H), (const pg8::bf16_t*)(ws + WS_WIN), M, NPROJ, D}; pg8::StaticOrder S; S.init(M, NPROJ, G, bid);
        pg8::EpiIn E{(pg8::bf16_t*)(ws + WS_P), (float*)(ws + WS_LF), args.in[I_LBL]};
#ifdef PROBE_G
        if (threadIdx.x == 0) MISC[61] = (PROBE_G == 2) ? 1u : 0u; __syncthreads();
#endif
        pg8::gemm_phase<pg8::EpiIn, pg8::StaticOrder, true, true>(lds, g, S, E, wave);
        __syncthreads(); p0_bg_items(args, lds, bid, G, tid, wave, lane);
     REPB(2, rr_); } } SEAM(2);
    if (IN(3)) { for (int rr_ = 0; rr_ < NREP(3); ++rr_) {
        const int cpos = bid % 3;
        if (cpos == 0) { int tq5_ = tid; asm volatile("" : "+v"(tq5_)); deferred_cvt_items(args, lds, bid, G, 0, tq5_, wave, tq5_ & 63); }
        for (int u = bid; u < 256; u += G) {
            __syncthreads();
#if HG_CHUNKED
            { int tq1_ = tid; asm volatile("" : "+v"(tq1_)); hg_passA(args, lds, u, tq1_, wave, tq1_ & 63); }
            STAMP(14);
#endif
            __syncthreads();
            if (cpos == 1 && u == bid) { int tq6_ = tid; asm volatile("" : "+v"(tq6_)); deferred_cvt_items(args, lds, bid, G, 0, tq6_, wave, tq6_ & 63); }
            __syncthreads();
#if SSD_CHUNKED
            { int tq2_ = tid; asm volatile("" : "+v"(tq2_)); ssd_passA(args, lds, u, tq2_, wave, tq2_ & 63); }
#endif
        }
        __syncthreads();
        if (cpos == 2) { int tq7_ = tid; asm volatile("" : "+v"(tq7_)); deferred_cvt_items(args, lds, bid, G, 0, tq7_, wave, tq7_ & 63); }
     REPB(3, rr_); } } SEAM(3);
    if (IN(4)) { for (int rr_ = 0; rr_ < NREP(4); ++rr_) { mix_scan(args, bid, G, tid);  REPB(4, rr_); } } SEAM(4);
    if (IN(5)) { for (int rr_ = 0; rr_ < NREP(5); ++rr_) {
        const int cpos = bid % 3;
        if (cpos == 0) { int tq8_ = tid; asm volatile("" : "+v"(tq8_)); deferred_cvt_items(args, lds, bid, G, 1, tq8_, wave, tq8_ & 63); }
        for (int u = bid; u < 256; u += G) {
            __syncthreads();
#if HG_CHUNKED
            { int tq3_ = tid; asm volatile("" : "+v"(tq3_)); hg_passC(args, lds, u, tq3_, wave, tq3_ & 63); }
            STAMP(13);
#else
            if (u < 8) hgrn_naive(args, lds, u, tid, wave, lane);
#endif
            __syncthreads();
            if (cpos == 1 && u == bid) { int tq9_ = tid; asm volatile("" : "+v"(tq9_)); deferred_cvt_items(args, lds, bid, G, 1, tq9_, wave, tq9_ & 63); }
            __syncthreads();
#if SSD_CHUNKED
            { int tq4_ = tid; asm volatile("" : "+v"(tq4_)); ssd_passC(args, lds, u, tq4_, wave, tq4_ & 63); }
#else
            if (u >= 8 && u < 12) ssd_naive(args, lds, u - 8, tid, wave, lane);
#endif
        }
        __syncthreads();
        if (cpos == 2) { int tq10_ = tid; asm volatile("" : "+v"(tq10_)); deferred_cvt_items(args, lds, bid, G, 1, tq10_, wave, tq10_ & 63); }
     REPB(5, rr_); } } SEAM(5);
    if (IN(6)) { for (int rr_ = 0; rr_ < NREP(6); ++rr_) {
        pg8::Gemm g{(const pg8::bf16_t*)(ws + WS_MIX), (const pg8::bf16_t*)(ws + WS_WOUT), M, D, D}; pg8::StaticOrder S; S.init(M, D, G, bid);
        pg8::EpiOut E{args.in[I_X], (pg8::bf16_t*)(ws + WS_X1), (const float*)(ws + WS_MODF) + 2 * 1024};
#ifdef PROBE_G
        if (threadIdx.x == 0) MISC[61] = (PROBE_G == 6) ? 1u : 0u; __syncthreads();
#endif
        pg8::gemm_phase<pg8::EpiOut, pg8::StaticOrder, true, true>(lds, g, S, E, wave);
     REPB(6, rr_); } } SEAM(6);
    if (IN(7)) { for (int rr_ = 0; rr_ < NREP(7); ++rr_) { p5_router(args, lds, bid, G, tid, wave, lane);  REPB(7, rr_); } } SEAM(7);
    if (IN(8)) { for (int rr_ = 0; rr_ < NREP(8); ++rr_) { p6_gather(args, lds, bid, G, tid, wave, lane);  REPB(8, rr_); } } SEAM(8);
    if (IN(9) || IN(10)) {
        if (!IN(8)) { LANE_TID(); moe_tables(args, lds, NCHUNK, tid, wave, lane); }
        const PG8_LAS int* TS = (const PG8_LAS int*)(lds + MISC_OFF + 256);
        const int R = __builtin_amdgcn_readfirstlane(TS[32]);
        int kmoe1 = MOE_FP8_G1 ? D / 2 : D, kmoe2 = MOE_FP8_G2 ? D / 2 : D; asm volatile("" : "+s"(kmoe1), "+s"(kmoe2));
        if (IN(9)) { for (int rr_ = 0; rr_ < NREP(9); ++rr_) { LANE_TID();
            pg8::Gemm g{(const pg8::bf16_t*)(ws + WS_XG), (const pg8::bf16_t*)(ws + WS_W1), R * 256, 2048, kmoe1};
            PHASE_SKEW();
            pg8::MoeOrder S{TS + 64, 8, R * 8, G, bid};
            pg8::EpiW1<MOE_FP8_G1 != 0, MOE_FP8_G2 != 0> E{(void*)(ws + WS_ACT), args.in[I_B1]};
#ifdef PROBE_G
        if (threadIdx.x == 0) MISC[61] = (PROBE_G == 9) ? 1u : 0u; __syncthreads();
#endif
            pg8::gemm_phase<pg8::EpiW1<MOE_FP8_G1 != 0, MOE_FP8_G2 != 0>, pg8::MoeOrder, true, true, MOE_FP8_G1 != 0>(lds, g, S, E, wave);
         REPB(9, rr_); } }
        SEAM(9);
        if (IN(10)) { for (int rr_ = 0; rr_ < NREP(10); ++rr_) { LANE_TID();
            pg8::Gemm g{(const pg8::bf16_t*)(ws + WS_ACT), (const pg8::bf16_t*)(ws + WS_W2), R * 256, 1024, kmoe2};
            PHASE_SKEW();
            pg8::MoeOrder S{TS + 64, 4, R * 4, G, bid};
            pg8::EpiW2<Y_FP8 != 0> E{(void*)(ws + WS_XG), args.in[I_B2], MOE_FP8_G2 ? (1.0f / 512.0f) : 1.0f};
#ifdef PROBE_G
        if (threadIdx.x == 0) MISC[61] = (PROBE_G == 10) ? 1u : 0u; __syncthreads();
#endif
            pg8::gemm_phase<pg8::EpiW2<Y_FP8 != 0>, pg8::MoeOrder, true, true, MOE_FP8_G2 != 0>(lds, g, S, E, wave);
         REPB(10, rr_); } }
    }
    SEAM(10);
    if (IN(11)) { for (int rr_ = 0; rr_ < NREP(11); ++rr_) { LANE_TID(); p9_final(args, bid, G, wave, lane);  REPB(11, rr_); } }
#ifdef PROBE_A
    STAMP(12);
    int lpr_; asm volatile("v_mbcnt_lo_u32_b32 %0, -1, 0\n\tv_mbcnt_hi_u32_b32 %0, -1, %0" : "=v"(lpr_)); if (bid == 0 && wave == 0 && lpr_ == 0) {
        const unsigned long long mx = __hip_atomic_load((unsigned*)ctl + 3000, __ATOMIC_RELAXED, __HIP_MEMORY_SCOPE_AGENT);
        const unsigned long long sp = ((((unsigned long long)MISC[17 + 2 * (PROBE_A + 1)] << 32) | MISC[16 + 2 * (PROBE_A + 1)]) - (((unsigned long long)MISC[17 + 2 * PROBE_A] << 32) | MISC[16 + 2 * PROBE_A]));
#ifndef PROBE_B
#define PROBE_B (PROBE_A + 1)
#endif
        const unsigned long long sp2 = ((((unsigned long long)MISC[17 + 2 * (PROBE_B)] << 32) | MISC[16 + 2 * (PROBE_B)]) - (((unsigned long long)MISC[17 + 2 * PROBE_A] << 32) | MISC[16 + 2 * PROBE_A]));
#ifdef PROBE_G
        const unsigned long long wait = 64ull * (unsigned long long)MISC[60], t0 = __builtin_amdgcn_s_memrealtime();
#else
        (void)sp; const unsigned long long wait = 64ull * (PROBE_BUSY ? mx : sp2), t0 = __builtin_amdgcn_s_memrealtime();
#endif
        while (__builtin_amdgcn_s_memrealtime() - t0 < wait) __builtin_amdgcn_s_sleep(4);
    }
#endif
#undef IN
#undef SEAM
}

#ifndef MK_N_LAUNCHES
#define MK_N_LAUNCHES 1
#endif
extern "C" void kernel_launch(void* const* d_in, const int* in_sizes, int n_in, void* d_out, int out_size, void* d_ws, size_t ws_size, hipStream_t stream) {
    static int grid = 0;
    if (grid == 0) {
        if (n_in != 23 || out_size != M * D || ws_size < WS_END) { fprintf(stderr, "kernel_launch: unexpected shapes (n_in %d out %d ws %zu)\n", n_in, out_size, ws_size); grid = -1; return; }
        int dev = 0, cus = 0;
        if (hipGetDevice(&dev) != hipSuccess || hipDeviceGetAttribute(&cus, hipDeviceAttributeMultiprocessorCount, dev) != hipSuccess) { grid = -1; return; }
        if (hipFuncSetAttribute((const void*)mk_fwd, hipFuncAttributeMaxDynamicSharedMemorySize, LDS_BYTES) != hipSuccess) { fprintf(stderr, "kernel_launch: hipFuncSetAttribute failed\n"); grid = -1; return; }
        int per_cu = 0;
        if (hipOccupancyMaxActiveBlocksPerMultiprocessor(&per_cu, (const void*)mk_fwd, NTHR, LDS_BYTES) != hipSuccess || per_cu < 1) fprintf(stderr, "kernel_launch: occupancy query says %d\n", per_cu);
        (void)hipGetLastError();
        grid = cus;
    }
    if (grid < 0) return;
    (void)hipMemsetAsync((char*)d_ws + WS_CTL, 0, CTL_ZERO_BYTES, stream);
    Args a{};
    for (int i = 0; i < 23; ++i) a.in[i] = (const float*)d_in[i];
    a.out = (float*)d_out; a.ws = (unsigned char*)d_ws;
    if (MK_N_LAUNCHES == 1) { a.ph_lo = 0; a.ph_hi = NPHASE; hipLaunchKernelGGL(mk_fwd, dim3(grid), dim3(NTHR), LDS_BYTES, stream, a); }
    else for (int p = 0; p < NPHASE; ++p) { a.ph_lo = p; a.ph_hi = p + 1; hipLaunchKernelGGL(mk_fwd, dim3(grid), dim3(NTHR), LDS_BYTES, stream, a); }
}
```

```cpp
#include <hip/hip_runtime.h>
#include <cstdio>
#include <cstdint>
namespace pg8 {
#define PG8_LAS __attribute__((address_space(3)))
typedef unsigned short bf16_t;
typedef short bf16x8 __attribute__((ext_vector_type(8)));
typedef float f32x4 __attribute__((ext_vector_type(4)));
typedef unsigned u32x4 __attribute__((ext_vector_type(4)));
constexpr int BM = 256, BK = 64, HALF = 128, HTB = HALF * BK * 2  , STAGE_BYTES = 8 * HTB, NXCD = 8, WGM = 8;

__host__ __device__ __forceinline__ int lds_byte(int r, int c) { const int st = (r >> 4) * 2 + (c >> 5), rr = r & 15, cc = c & 31, ob = rr * 64 + cc * 2; return st * 1024 + (ob ^ (((ob >> 9) & 1) << 5)); }
__host__ __device__ __forceinline__ void stage_rc(int b, int& R, int& C) { const int st = b / 1024, sb = b % 1024, swz = sb ^ (((sb >> 9) & 1) << 5); R = (st >> 1) * 16 + swz / 64; C = (st & 1) * 32 + (swz % 64) / 2; }
__host__ __device__ __forceinline__ int perm32(int rho) { const int n = rho >> 4, i = rho & 15; return 8 * (i >> 2) + 4 * n + (i & 3); }

struct Unit { int pm, pn; };
struct Gemm { const bf16_t* A; const bf16_t* Bt; int M, N, K; };

struct StaticOrder {
    int nM, nN, nwg, G, c;
    __host__ __device__ void init(int M, int N, int G_, int c_) { nM = M / BM; nN = N / BM; nwg = nM * nN; G = G_; c = c_; }
    __host__ __device__ bool next(int i, Unit& u) const {
        const int L = i * G + c; if (L >= nwg) return false;
        int wgid = L; { const int q = nwg / NXCD, r = nwg % NXCD, xcd = wgid % NXCD, off = wgid / NXCD; wgid = (xcd < r ? xcd * (q + 1) : r * (q + 1) + (xcd - r) * q) + off; }
        const int nig = WGM * nN, gid = wgid / nig, fm = gid * WGM, gsz = (nM - fm) < WGM ? (nM - fm) : WGM;
        u.pm = fm + ((wgid % nig) % gsz); u.pn = (wgid % nig) / gsz; return true;
    }
    __device__ __forceinline__ void a_ready(const Unit&) const {}
    __device__ __forceinline__ void done(const Unit&) const {}
};

__device__ __forceinline__ unsigned cvt_pk_bf16(float lo, float hi) { unsigned r; asm volatile("v_cvt_pk_bf16_f32 %0, %1, %2" : "=v"(r) : "v"(lo), "v"(hi)); return r; }
typedef float f32x2 __attribute__((ext_vector_type(2)));
typedef int v8i32 __attribute__((ext_vector_type(8)));
__device__ __forceinline__ v8i32 cat8(bf16x8 lo, bf16x8 hi) { typedef short s16x16 __attribute__((ext_vector_type(16))); return __builtin_bit_cast(v8i32, __builtin_shufflevector(lo, hi, 0, 1, 2, 3, 4, 5, 6, 7, 8, 9, 10, 11, 12, 13, 14, 15)); }
template <class Epi, class Sched, bool ALIGN_EPI = false, bool SP2 = false, bool F8 = false>
__device__ __forceinline__ void gemm_phase(PG8_LAS unsigned char* lds, const Gemm g, const Sched& S, const Epi& E, int wid) {
    int lane; asm volatile("v_mbcnt_lo_u32_b32 %0, -1, 0\n\tv_mbcnt_hi_u32_b32 %0, -1, %0" : "=v"(lane)); __builtin_assume(lane >= 0 && lane < 64); __builtin_assume(wid >= 0 && wid < 8);
    const int tid = wid * 64 + lane, wr = wid >> 2, wc = wid & 3, fr = lane & 15, fq = lane >> 4;
    const int K = g.K, nt = K / BK;
    unsigned voffA[2], voffB[2];
#pragma unroll
    for (int i = 0; i < 2; ++i) { int R, C; stage_rc(tid * 16 + i * 8192, R, C); const int Rb = Epi::PERM ? ((R & ~31) + perm32(R & 31)) : R;
        voffA[i] = (unsigned)(R * K + C) * 2u; voffB[i] = (unsigned)(Rb * K + C) * 2u; }
    const unsigned kstep = (unsigned)(BK * 2);
    const unsigned hstep = (unsigned)HALF * (unsigned)K * 2u;
    const unsigned tstep = 2u * hstep;
    const unsigned ldsw = (unsigned)wid * 1024u;
    const int aoff = lds_byte(wr * 64 + fr, fq * 8), boff = lds_byte(wc * 32 + fr, fq * 8);
#define PG8_SA(b, h) (((b) * 2 + (h)) * HTB)
#define PG8_SB(b, h) ((4 + (b) * 2 + (h)) * HTB)
#define PG8_STAGE(bufoff, gbase, voff) do { _Pragma("unroll") for (int _i = 0; _i < 2; ++_i) \
        __builtin_amdgcn_global_load_lds((const unsigned*)((const char*)(gbase) + (voff)[_i]), (PG8_LAS unsigned*)(lds + (bufoff) + ldsw + _i * 8192), 16, 0, 0); } while (0)
#define PG8_LDA(dst, b, h) do { _Pragma("unroll") for (int m = 0; m < 4; ++m) _Pragma("unroll") for (int k = 0; k < 2; ++k) dst[m][k] = *(const PG8_LAS bf16x8*)(lds + PG8_SA(b, h) + aoff + m * 2048 + k * 1024); } while (0)
#define PG8_LDB(dst, b, h) do { _Pragma("unroll") for (int n = 0; n < 2; ++n) _Pragma("unroll") for (int k = 0; k < 2; ++k) dst[n][k] = *(const PG8_LAS bf16x8*)(lds + PG8_SB(b, h) + boff + n * 2048 + k * 1024); } while (0)
#define PG8_MMA(ai, bj, At, Bt) do { __builtin_amdgcn_s_setprio(1); _Pragma("unroll") for (int m = 0; m < 4; ++m) _Pragma("unroll") for (int n = 0; n < 2; ++n) { \
        if constexpr (F8) acc[ai][bj][m][n] = __builtin_amdgcn_mfma_scale_f32_16x16x128_f8f6f4(cat8(Bt[n][0], Bt[n][1]), cat8(At[m][0], At[m][1]), acc[ai][bj][m][n], 0, 0, 0, 0, 0, 0); \
        else { _Pragma("unroll") for (int k = 0; k < 2; ++k) acc[ai][bj][m][n] = __builtin_amdgcn_mfma_f32_16x16x32_bf16(Bt[n][k], At[m][k], acc[ai][bj][m][n], 0, 0, 0); } } __builtin_amdgcn_s_setprio(0); } while (0)
#define PG8_WAIT_V(n) asm volatile("s_waitcnt vmcnt(" #n ")" ::: "memory")
#define PG8_WAIT_L(n) asm volatile("s_waitcnt lgkmcnt(" #n ")" ::: "memory")
#define PG8_BAR __builtin_amdgcn_s_barrier()
#define PG8_SCHED __builtin_amdgcn_sched_barrier(0)
    Unit cur, nxt; int ui = 0;
    if (!S.next(0, cur)) return;
    f32x4 acc[2][2][4][2];
#pragma unroll
    for (int a = 0; a < 2; ++a)
#pragma unroll
        for (int b = 0; b < 2; ++b)
#pragma unroll
            for (int m = 0; m < 4; ++m)
#pragma unroll
                for (int n = 0; n < 2; ++n) acc[a][b][m][n] = (f32x4){0.f, 0.f, 0.f, 0.f};
    bf16x8 At[4][2], B0[2][2], B1[2][2];
    const char* cA = (const char*)g.A + (size_t)((unsigned)cur.pm * tstep); const char* cB = (const char*)g.Bt + (size_t)((unsigned)cur.pn * tstep);
    S.a_ready(cur);
    if constexpr (SP2) {
        PG8_STAGE(PG8_SB(0, 0), cB, voffB); PG8_STAGE(PG8_SB(0, 1), cB + hstep, voffB); PG8_STAGE(PG8_SA(0, 0), cA, voffA); PG8_STAGE(PG8_SA(0, 1), cA + hstep, voffA);
        if (wr == 1) PG8_BAR;
        PG8_WAIT_V(2); PG8_BAR;
        PG8_STAGE(PG8_SB(1, 0), cB + kstep, voffB); PG8_STAGE(PG8_SA(1, 0), cA + kstep, voffA); PG8_STAGE(PG8_SB(1, 1), cB + hstep + kstep, voffB);
        PG8_WAIT_V(6); PG8_BAR;
    } else {
        PG8_STAGE(PG8_SB(0, 0), cB, voffB); PG8_STAGE(PG8_SA(0, 0), cA, voffA); PG8_STAGE(PG8_SB(0, 1), cB + hstep, voffB); PG8_STAGE(PG8_SA(0, 1), cA + hstep, voffA);
        if (wr == 1) PG8_BAR;
        PG8_WAIT_V(4); PG8_BAR;
        PG8_STAGE(PG8_SB(1, 0), cB + kstep, voffB); PG8_STAGE(PG8_SA(1, 0), cA + kstep, voffA); PG8_STAGE(PG8_SB(1, 1), cB + hstep + kstep, voffB);
        PG8_WAIT_V(6); PG8_BAR;
    }
    for (;;) {
        const bool has_next = S.next(ui + 1, nxt);
        const char* nA = has_next ? (const char*)g.A + (size_t)((unsigned)nxt.pm * tstep) : cA; const char* nB = has_next ? (const char*)g.Bt + (size_t)((unsigned)nxt.pn * tstep) : cB;
        _Pragma("unroll 1") for (int t = 0; t < nt; t += 2) {
            const bool last = (t == nt - 2);
            const char* a1 = cA + (size_t)((unsigned)(t + 1) * kstep);
            const char* a2 = last ? nA : cA + (size_t)((unsigned)(t + 2) * kstep); const char* b2 = last ? nB : cB + (size_t)((unsigned)(t + 2) * kstep);
            const char* a3 = a2 + kstep; const char* b3 = b2 + kstep;
            const char* a1h = a1 + hstep; const char* a2h = a2 + hstep; const char* b2h = b2 + hstep; const char* b3h = b3 + hstep;
            asm volatile("" : "+s"(a1h), "+s"(a2), "+s"(a2h), "+s"(b2), "+s"(b2h), "+s"(a3), "+s"(b3), "+s"(b3h));
            if (last && has_next) S.a_ready(nxt);
            if constexpr (SP2) {
            PG8_LDB(B0, 0, 0); PG8_LDB(B1, 0, 1); PG8_SCHED; PG8_LDA(At, 0, 0); PG8_STAGE(PG8_SA(1, 1), a1h, voffA);
            PG8_WAIT_V(8); PG8_WAIT_L(0); PG8_BAR; PG8_MMA(0, 0, At, B0); PG8_MMA(0, 1, At, B1); PG8_BAR; PG8_SCHED;
            PG8_LDA(At, 0, 1); PG8_STAGE(PG8_SB(0, 0), b2, voffB); PG8_STAGE(PG8_SB(0, 1), b2h, voffB); PG8_STAGE(PG8_SA(0, 0), a2, voffA);
            PG8_WAIT_V(8); PG8_WAIT_L(0); PG8_BAR; PG8_MMA(1, 0, At, B0); PG8_MMA(1, 1, At, B1); PG8_BAR; PG8_SCHED;
            PG8_LDB(B0, 1, 0); PG8_LDB(B1, 1, 1); PG8_SCHED; PG8_LDA(At, 1, 0); PG8_STAGE(PG8_SA(0, 1), a2h, voffA);
            PG8_WAIT_V(8); PG8_WAIT_L(0); PG8_BAR; PG8_MMA(0, 0, At, B0); PG8_MMA(0, 1, At, B1); PG8_BAR; PG8_SCHED;
            PG8_LDA(At, 1, 1); PG8_STAGE(PG8_SB(1, 0), b3, voffB); PG8_STAGE(PG8_SB(1, 1), b3h, voffB); PG8_STAGE(PG8_SA(1, 0), a3, voffA);
            PG8_WAIT_V(8); PG8_WAIT_L(0); PG8_BAR; PG8_MMA(1, 0, At, B0); PG8_MMA(1, 1, At, B1); PG8_BAR; PG8_SCHED;
            } else {
            PG8_LDB(B0, 0, 0); PG8_SCHED; PG8_LDA(At, 0, 0); PG8_STAGE(PG8_SA(1, 1), a1h, voffA);
            PG8_WAIT_L(8); PG8_BAR; PG8_WAIT_L(0); PG8_MMA(0, 0, At, B0); PG8_BAR; PG8_SCHED;
            PG8_LDB(B1, 0, 1); PG8_STAGE(PG8_SB(0, 0), b2, voffB);
            PG8_BAR; PG8_WAIT_L(0); PG8_MMA(0, 1, At, B1); PG8_BAR;
            PG8_LDA(At, 0, 1); PG8_STAGE(PG8_SA(0, 0), a2, voffA);
            PG8_BAR; PG8_WAIT_L(0); PG8_MMA(1, 0, At, B0); PG8_BAR; PG8_SCHED;
            PG8_STAGE(PG8_SB(0, 1), b2h, voffB);
            PG8_WAIT_V(6); PG8_BAR; PG8_MMA(1, 1, At, B1); PG8_BAR;
            PG8_LDB(B0, 1, 0); PG8_SCHED; PG8_LDA(At, 1, 0); PG8_STAGE(PG8_SA(0, 1), a2h, voffA);
            PG8_WAIT_L(8); PG8_BAR; PG8_WAIT_L(0); PG8_MMA(0, 0, At, B0); PG8_BAR; PG8_SCHED;
            PG8_LDB(B1, 1, 1); PG8_STAGE(PG8_SB(1, 0), b3, voffB);
            PG8_BAR; PG8_WAIT_L(0); PG8_MMA(0, 1, At, B1); PG8_BAR;
            PG8_LDA(At, 1, 1); PG8_STAGE(PG8_SA(1, 0), a3, voffA);
            PG8_BAR; PG8_WAIT_L(0); PG8_MMA(1, 0, At, B0); PG8_BAR; PG8_SCHED;
            PG8_STAGE(PG8_SB(1, 1), b3h, voffB);
            PG8_WAIT_V(6); PG8_BAR; PG8_MMA(1, 1, At, B1); PG8_BAR;
            }
        }
#ifdef PROBE_G
        unsigned long long tk_ = 0; if (wid == 0) tk_ = __builtin_amdgcn_s_memrealtime();
#endif
        if constexpr (ALIGN_EPI) { if (wr == 0) PG8_BAR; }
        if constexpr (!Epi::AFTER_DRAIN) { int l2_; asm volatile("v_mbcnt_lo_u32_b32 %0, -1, 0\n\tv_mbcnt_hi_u32_b32 %0, -1, %0" : "=v"(l2_)); const int fr_o = l2_ & 15, fq_o = l2_ >> 4;
            Unit cu_ = cur; asm volatile("" : "+s"(cu_.pm), "+s"(cu_.pn));
            E(acc, cu_, wr, wc, fr_o, fq_o); S.done(cur); }
#ifdef PROBE_G
        if (wid == 0 && lane == 0 && *(volatile PG8_LAS unsigned*)(lds + 147456 + 4 * 61) != 0u) *(volatile PG8_LAS unsigned*)(lds + 147456 + 4 * 60) += (unsigned)(__builtin_amdgcn_s_memrealtime() - tk_);
#endif
        if (!has_next) break;
#pragma unroll
        for (int a = 0; a < 2; ++a)
#pragma unroll
            for (int b = 0; b < 2; ++b)
#pragma unroll
                for (int m = 0; m < 4; ++m)
#pragma unroll
                    for (int n = 0; n < 2; ++n) acc[a][b][m][n] = (f32x4){0.f, 0.f, 0.f, 0.f};
        cur = nxt; cA = nA; cB = nB; ++ui;
        if constexpr (ALIGN_EPI) { if (wr == 1) PG8_BAR; }
    }
    PG8_WAIT_V(0);
    if constexpr (!ALIGN_EPI) { if (wr == 0) PG8_BAR; }
    PG8_BAR;
    if constexpr (Epi::AFTER_DRAIN) { E.fused(acc, cur, wr, wc, fr, fq, lds, wid, lane); S.done(cur); }
#undef PG8_SA
#undef PG8_SB
#undef PG8_STAGE
#undef PG8_LDA
#undef PG8_LDB
#undef PG8_MMA
#undef PG8_WAIT_V
#undef PG8_WAIT_L
#undef PG8_BAR
#undef PG8_SCHED
}
}
#define GAS __attribute__((address_space(1)))
#define LAS __attribute__((address_space(3)))
typedef unsigned short bf16;
typedef unsigned v4u __attribute__((ext_vector_type(4)));
typedef float f32x4 __attribute__((ext_vector_type(4)));
typedef short bf16x8 __attribute__((ext_vector_type(8)));
typedef GAS unsigned gu32;
typedef GAS unsigned long long gu64;
#define RLX_AGENT __ATOMIC_RELAXED, __HIP_MEMORY_SCOPE_AGENT
#define LDS_WAIT() asm volatile("s_waitcnt lgkmcnt(0)" ::: "memory")
#define VM_WAIT() asm volatile("s_waitcnt vmcnt(0)" ::: "memory")
__device__ __forceinline__ unsigned long long rt() { return __builtin_amdgcn_s_memrealtime(); }
__device__ __forceinline__ unsigned f2bf(float f) { unsigned u = __builtin_bit_cast(unsigned, f); return (u + 0x7fffu + ((u >> 16) & 1u)) >> 16; }
__device__ __forceinline__ unsigned pk2(float lo, float hi) { return f2bf(lo) | (f2bf(hi) << 16); }
#define XB_TMO      128
#define XB_XCNT(j)  (256  + 64 * (j))
#define XB_XSUB(j)  (1280 + 64 * (j))
#define XB_XGEN(j)  (2304 + 64 * (j))
#define XB_TOP      3328
#define XB_TOPGEN   3392
#define XCD_BAR_WORDS 3456
#define XB_SPIN_CAP (1u << 18)

__device__ __forceinline__ unsigned xb_ld(unsigned* p)              { return __hip_atomic_load(p, __ATOMIC_RELAXED, __HIP_MEMORY_SCOPE_AGENT); }
__device__ __forceinline__ unsigned xb_add(unsigned* p, unsigned v) { return __hip_atomic_fetch_add(p, v, __ATOMIC_RELAXED, __HIP_MEMORY_SCOPE_AGENT); }
__device__ __forceinline__ unsigned xb_xcc_id() { return (unsigned)__builtin_amdgcn_s_getreg((3 << 11) | 20) & 0xFu; }
#define XB_SPIN(cond, bar) do { unsigned _sp = 0; while (cond) { __builtin_amdgcn_s_sleep(1); \
    if ((++_sp & 255u) == 0u) { if (xb_ld(&(bar)[XB_TMO])) break; if (_sp > XB_SPIN_CAP) { atomicAdd(&(bar)[XB_TMO], 1u); break; } } } } while (0)

struct XcdBarrier {
    unsigned* bar; unsigned x;
    volatile LAS unsigned* st;
};

__device__ __forceinline__ XcdBarrier xcd_barrier_post(unsigned* bar, volatile LAS unsigned* st, bool t0) {
    XcdBarrier b; b.bar = bar; b.x = xb_xcc_id(); b.st = st;
    if (t0) (void)xb_add(&bar[XB_XCNT(b.x)], 1u);
    return b;
}
__device__ __forceinline__ void xcd_barrier_complete(unsigned* bar, unsigned x, unsigned& nloc, unsigned& nx) {
    const unsigned G = gridDim.x * gridDim.y * gridDim.z;
    unsigned sum, cnt, mine, sp = 0u;
    for (;;) {
        sum = 0u; cnt = 0u; mine = 0u;
#pragma unroll
        for (unsigned j = 0; j < 16; ++j) { const unsigned c = xb_ld(&bar[XB_XCNT(j)]); sum += c; cnt += (c > 0u) ? 1u : 0u; mine = (j == x) ? c : mine; }
        if (sum == G) break;
        __builtin_amdgcn_s_sleep(1);
        if ((++sp & 255u) == 0u) { if (xb_ld(&bar[XB_TMO])) break; if (sp > XB_SPIN_CAP) { atomicAdd(&bar[XB_TMO], 1u); break; } }
    }
    nloc = mine > 0u ? mine : 1u; nx = cnt > 0u ? cnt : 1u;
}

__device__ __forceinline__ void xcd_barrier(const XcdBarrier& b, bool t0) {
    asm volatile("s_waitcnt vmcnt(0)" ::: "memory");
    __syncthreads();
    if (t0) {
        unsigned* bar = b.bar;
        __builtin_amdgcn_s_waitcnt(0);
        unsigned nloc = b.st[0], nx = b.st[1];
        if (nloc == 0u) { xcd_barrier_complete(bar, b.x, nloc, nx); b.st[0] = nloc; b.st[1] = nx; }
        const unsigned old = xb_add(&bar[XB_XSUB(b.x)], 1u);
        const unsigned gen = old / nloc;
        if (old + 1u == (gen + 1u) * nloc) {
            __builtin_amdgcn_fence(__ATOMIC_RELEASE, "agent");
            asm volatile("s_waitcnt vmcnt(0)" ::: "memory");
            const unsigned og = xb_add(&bar[XB_TOP], 1u);
            const unsigned tg = og / nx;
            if (og + 1u == (tg + 1u) * nx) xb_add(&bar[XB_TOPGEN], 1u);
            else XB_SPIN(xb_ld(&bar[XB_TOPGEN]) == tg, bar);
            __builtin_amdgcn_fence(__ATOMIC_ACQUIRE, "agent");
            xb_add(&bar[XB_XGEN(b.x)], 1u);
            asm volatile("s_waitcnt vmcnt(0)" ::: "memory");
        } else {
            XB_SPIN(xb_ld(&bar[XB_XGEN(b.x)]) == gen, bar);
            __builtin_amdgcn_fence(__ATOMIC_ACQUIRE, "agent");
            asm volatile("s_waitcnt vmcnt(0)" ::: "memory");
        }
    }
    __syncthreads();
}
#ifndef Y_FP8
#define Y_FP8 1
#endif
#ifndef MOE_FP8_G1
#define MOE_FP8_G1 1
#endif
#ifndef MOE_FP8_G2
#define MOE_FP8_G2 1
#endif

constexpr int NB = 2, SEQ = 8192, D = 1024, M = NB * SEQ;
constexpr int NPROJ = 3584, IN_COLS = 3592;
constexpr int NE = 32, TOPK = 4, DFF = 1024;
constexpr int NROWS_MAX = M * TOPK + NE * 256;
constexpr int MAXRT = NROWS_MAX / 256;
constexpr float EPS = 1e-6f;
constexpr int PC_Q = 0, PC_K = 512, PC_V = 1024, PC_G = 1536, PC_Z = 2048, PC_X = 2560;
constexpr int NCHUNK = M / 64;
constexpr int NWAVES = 8, NTHR = 512;

constexpr size_t MiB = 1u << 20;
constexpr size_t WS_CTL = 0, CTL_ZERO_BYTES = 32768;
constexpr size_t WS_MODP = 1 * MiB;
constexpr size_t WS_MODF = WS_MODP + 512 * 1024;
constexpr size_t WS_BLKCNT = WS_MODF + 256 * 1024;
constexpr size_t WS_DT = 2 * MiB;
constexpr size_t WS_TOK = 3 * MiB;
constexpr size_t WS_WIN = 4 * MiB, WS_WOUT = 11 * MiB, WS_W1 = 16 * MiB, WS_W2 = 144 * MiB;
constexpr size_t WS_H = 208 * MiB, WS_P = 240 * MiB, WS_LF = 352 * MiB, WS_MIX = 384 * MiB, WS_X1 = 416 * MiB;
constexpr size_t WS_XG = 480 * MiB, WS_ACT = 624 * MiB, WS_END = 768 * MiB;
constexpr int CW_TMO = 0, CW_BAR = 4096;

constexpr int RING_BYTES = 131072, AUX_OFF = RING_BYTES  , MISC_OFF = 147456, LDS_BYTES = 151552;

struct Args { const float* in[23]; float* out; unsigned char* ws; int ph_lo, ph_hi; };
enum { I_X = 0, I_C, I_ADAW, I_ADAB, I_N1W, I_WIN, I_LBL, I_HGNW, I_ALOG, I_DTB, I_SSMD, I_CONVW, I_CONVB, I_SSMNW, I_WOUT, I_N2W, I_RW, I_RB, I_W1, I_B1, I_W2, I_B2, I_FNW };

__device__ __forceinline__ float bf2f(bf16 v) { return __uint_as_float(((unsigned)v) << 16); }
__device__ __forceinline__ float wave_sum(float v) {
#pragma unroll
    for (int o = 1; o < 64; o <<= 1) v += __shfl_xor(v, o);
    return v;
}
__device__ __forceinline__ float wave_max(float v) {
#pragma unroll
    for (int o = 1; o < 64; o <<= 1) v = fmaxf(v, __shfl_xor(v, o));
    return v;
}
__device__ __forceinline__ float sigmoid_f(float x) { return __builtin_amdgcn_rcpf(1.0f + __expf(-x)); }
__device__ __forceinline__ float silu_f(float x) { return x * sigmoid_f(x); }

namespace pg8 {
struct EpiIn {
    static constexpr bool PERM = true, AFTER_DRAIN = false;
    bf16_t* P; float* LF; const float* lbl;
    __device__ __forceinline__ void operator()(const f32x4 (&acc)[2][2][4][2], const Unit& u, int wr, int wc, int fr, int fq) const {
        const int row0 = u.pm * BM + wr * 64 + fr, col0 = u.pn * BM + wc * 32 + 8 * fq;
        const int mode = (u.pn < 2) ? 1 : (u.pn < 4) ? 2 : (u.pn < 6) ? 0 : (u.pn < 10) ? 1 : 0;
        if (mode == 2) {
            float oml[2][8];
#pragma unroll
            for (int bj = 0; bj < 2; ++bj)
#pragma unroll
                for (int j = 0; j < 8; ++j) { const int cf = col0 + bj * HALF + j - 512; const float l0 = lbl[cf], l1 = lbl[512 + cf]; oml[bj][j] = 1.0f - 1.0f / (1.0f + __expf(l1 - l0)); }
#pragma unroll
            for (int ai = 0; ai < 2; ++ai)
#pragma unroll
                for (int m = 0; m < 4; ++m) { const size_t r = (size_t)(row0 + ai * HALF + m * 16);
#pragma unroll
                    for (int bj = 0; bj < 2; ++bj) { float kv[8], lf[8];
#pragma unroll
                        for (int j = 0; j < 8; ++j) { const float f = acc[ai][bj][m][j >> 2][j & 3]; const float k = oml[bj][j] * sigmoid_f(-f); kv[j] = k; lf[j] = __logf(1.0f - k); }
                        u32x4 w; w.x = cvt_pk_bf16(kv[0], kv[1]); w.y = cvt_pk_bf16(kv[2], kv[3]); w.z = cvt_pk_bf16(kv[4], kv[5]); w.w = cvt_pk_bf16(kv[6], kv[7]);
                        *(u32x4*)(P + r * NPROJ + col0 + bj * HALF) = w;
                        float* lp = LF + r * 512 + (col0 + bj * HALF - 512);
                        *(f32x4*)lp = (f32x4){lf[0], lf[1], lf[2], lf[3]}; *(f32x4*)(lp + 4) = (f32x4){lf[4], lf[5], lf[6], lf[7]}; } }
        } else {
#pragma unroll
            for (int ai = 0; ai < 2; ++ai)
#pragma unroll
                for (int m = 0; m < 4; ++m) { bf16_t* rowp = P + (size_t)(row0 + ai * HALF + m * 16) * NPROJ + col0;
#pragma unroll
                    for (int bj = 0; bj < 2; ++bj) { f32x4 v0 = acc[ai][bj][m][0], v1 = acc[ai][bj][m][1];
                        if (mode == 1) {
#pragma unroll
                            for (int j = 0; j < 4; ++j) { v0[j] = silu_f(v0[j]); v1[j] = silu_f(v1[j]); } }
                        u32x4 w; w.x = cvt_pk_bf16(v0[0], v0[1]); w.y = cvt_pk_bf16(v0[2], v0[3]); w.z = cvt_pk_bf16(v1[0], v1[1]); w.w = cvt_pk_bf16(v1[2], v1[3]);
                        *(u32x4*)(rowp + bj * HALF) = w; } }
        }
    }
};
struct EpiOut {
    static constexpr bool PERM = true, AFTER_DRAIN = false;
    const float* x; bf16_t* x1; const float* g1;
    __device__ __forceinline__ void operator()(const f32x4 (&acc)[2][2][4][2], const Unit& u, int wr, int wc, int fr, int fq) const {
        const int row0 = u.pm * BM + wr * 64 + fr, col0 = u.pn * BM + wc * 32 + 8 * fq;
        const float* gb = g1 + ((u.pm * BM) >> 13) * 6144 + col0;
        f32x4 gv[2][2];
#pragma unroll
        for (int bj = 0; bj < 2; ++bj)
#pragma unroll
            for (int n = 0; n < 2; ++n) gv[bj][n] = *(const f32x4*)(gb + bj * HALF + 4 * n);
#pragma unroll
        for (int ai = 0; ai < 2; ++ai)
#pragma unroll
            for (int m = 0; m < 4; ++m) { const size_t off = (size_t)(row0 + ai * HALF + m * 16) * D + col0;
#pragma unroll
                for (int bj = 0; bj < 2; ++bj) { const f32x4 x0 = *(const f32x4*)(x + off + bj * HALF), x1v = *(const f32x4*)(x + off + bj * HALF + 4);
                    const f32x4 v0 = x0 + gv[bj][0] * acc[ai][bj][m][0], v1 = x1v + gv[bj][1] * acc[ai][bj][m][1];
                    u32x4 w; w.x = cvt_pk_bf16(v0[0], v0[1]); w.y = cvt_pk_bf16(v0[2], v0[3]); w.z = cvt_pk_bf16(v1[0], v1[1]); w.w = cvt_pk_bf16(v1[2], v1[3]);
                    *(u32x4*)(x1 + off + bj * HALF) = w; } }
    }
};
__device__ __forceinline__ float sat8(float x) { return __builtin_amdgcn_fmed3f(x, -448.0f, 448.0f); }
__device__ __forceinline__ unsigned pk4_fp8(float a, float b, float c, float d) { int w = 0; w = __builtin_amdgcn_cvt_pk_fp8_f32(sat8(a), sat8(b), w, false); w = __builtin_amdgcn_cvt_pk_fp8_f32(sat8(c), sat8(d), w, true); return (unsigned)w; }
template <bool F8IN, bool F8> struct EpiW1 {
    static constexpr bool PERM = true, AFTER_DRAIN = false;
    void* ACT; const float* b1;
    __device__ __forceinline__ void operator()(const f32x4 (&acc)[2][2][4][2], const Unit& u, int wr, int wc, int fr, int fq) const {
        const int e = u.pn >> 3, pn = u.pn & 7;
        const int row0 = u.pm * BM + wr * 64 + fr, cj = pn * 128 + wc * 32 + 8 * fq;
        const float* bg = b1 + e * 2048 + cj; const float sc = F8IN ? (1.0f / 1024.0f) : 1.0f;
#pragma unroll
        for (int ai = 0; ai < 2; ++ai)
#pragma unroll
            for (int m = 0; m < 4; ++m) {
                asm volatile("" ::: "memory");
                const f32x4 bg0 = *(const f32x4*)bg, bg1 = *(const f32x4*)(bg + 4), bl0 = *(const f32x4*)(bg + 1024), bl1 = *(const f32x4*)(bg + 1028);
                f32x4 g0 = acc[ai][0][m][0] * sc + bg0, g1 = acc[ai][0][m][1] * sc + bg1, l0 = acc[ai][1][m][0] * sc + bl0, l1 = acc[ai][1][m][1] * sc + bl1;
                float o[8];
                const float osc = F8 ? 4.0f : 1.0f;
#pragma unroll
                for (int j = 0; j < 4; ++j) {
                    float g = fminf(g0[j], 7.0f), l = __builtin_amdgcn_fmed3f(l0[j], -7.0f, 7.0f); o[j] = (g * osc) * __builtin_amdgcn_rcpf(1.0f + __builtin_amdgcn_exp2f(g * (-1.702f * 1.44269504f))) * (l + 1.0f);
                    g = fminf(g1[j], 7.0f); l = __builtin_amdgcn_fmed3f(l1[j], -7.0f, 7.0f); o[4 + j] = (g * osc) * __builtin_amdgcn_rcpf(1.0f + __builtin_amdgcn_exp2f(g * (-1.702f * 1.44269504f))) * (l + 1.0f); }
                const size_t off = (size_t)(row0 + ai * HALF + m * 16) * DFF + cj;
                if (F8) { typedef unsigned u32x2 __attribute__((ext_vector_type(2))); u32x2 w; int w0 = 0, w1 = 0;
                    w0 = __builtin_amdgcn_cvt_pk_fp8_f32(o[0], o[1], w0, false); w0 = __builtin_amdgcn_cvt_pk_fp8_f32(o[2], o[3], w0, true); w1 = __builtin_amdgcn_cvt_pk_fp8_f32(o[4], o[5], w1, false); w1 = __builtin_amdgcn_cvt_pk_fp8_f32(o[6], o[7], w1, true);
                    w.x = (unsigned)w0; w.y = (unsigned)w1; *(u32x2*)((unsigned char*)ACT + off) = w; }
                else { u32x4 w; w.x = cvt_pk_bf16(o[0], o[1]); w.y = cvt_pk_bf16(o[2], o[3]); w.z = cvt_pk_bf16(o[4], o[5]); w.w = cvt_pk_bf16(o[6], o[7]);
                    *(u32x4*)((bf16_t*)ACT + off) = w; } }
    }
};
template <bool Y8> struct EpiW2 {
    static constexpr bool PERM = true, AFTER_DRAIN = false;
    void* Y; const float* b2; float sc;
    __device__ __forceinline__ void operator()(const f32x4 (&acc)[2][2][4][2], const Unit& u, int wr, int wc, int fr, int fq) const {
        const int e = u.pn >> 2, pn = u.pn & 3;
        const int row0 = u.pm * BM + wr * 64 + fr, col0 = pn * BM + wc * 32 + 8 * fq;
        const float* bb = b2 + e * 1024 + col0;
        f32x4 bv[2][2];
#pragma unroll
        for (int bj = 0; bj < 2; ++bj) { bv[bj][0] = *(const f32x4*)(bb + bj * HALF); bv[bj][1] = *(const f32x4*)(bb + bj * HALF + 4); }
#pragma unroll
        for (int ai = 0; ai < 2; ++ai)
#pragma unroll
            for (int m = 0; m < 4; ++m) { const size_t off = (size_t)(row0 + ai * HALF + m * 16) * D + col0;
#pragma unroll
                for (int bj = 0; bj < 2; ++bj) { const f32x4 v0 = acc[ai][bj][m][0] * sc + bv[bj][0], v1 = acc[ai][bj][m][1] * sc + bv[bj][1];
                    if (Y8) { typedef unsigned u32x2 __attribute__((ext_vector_type(2))); u32x2 w; w.x = pk4_fp8(v0[0] * 8.f, v0[1] * 8.f, v0[2] * 8.f, v0[3] * 8.f); w.y = pk4_fp8(v1[0] * 8.f, v1[1] * 8.f, v1[2] * 8.f, v1[3] * 8.f);
                        *(u32x2*)((unsigned char*)Y + off + bj * HALF) = w; }
                    else { u32x4 w; w.x = cvt_pk_bf16(v0[0], v0[1]); w.y = cvt_pk_bf16(v0[2], v0[3]); w.z = cvt_pk_bf16(v1[0], v1[1]); w.w = cvt_pk_bf16(v1[2], v1[3]);
                        *(u32x4*)((bf16_t*)Y + off + bj * HALF) = w; } } }
    }
};
struct InProjOrder {
    int c;
    __device__ __forceinline__ bool next(int i, Unit& u) const { const int pn = (c >> 6) + 4 * i; if (pn >= NPROJ / BM) return false; u.pm = c & 63; u.pn = pn; return true; }
    __device__ __forceinline__ void a_ready(const Unit&) const {}
    __device__ __forceinline__ void done(const Unit&) const {}
};
struct MoeOrder {
    const PG8_LAS int* rt2e; int NT, nwg, G, c;
    __device__ __forceinline__ bool next(int i, Unit& u) const {
        const int L = i * G + c; if (L >= nwg) return false;
        int wgid = L; { const int q = nwg / NXCD, r = nwg % NXCD, xcd = wgid % NXCD, off = wgid / NXCD; wgid = (xcd < r ? xcd * (q + 1) : r * (q + 1) + (xcd - r) * q) + off; }
        const int rt = wgid / NT, pn = wgid % NT; const int e = __builtin_amdgcn_readfirstlane(rt2e[rt]);
        u.pm = rt; u.pn = e * NT + pn; return true;
    }
    __device__ __forceinline__ void a_ready(const Unit&) const {}
    __device__ __forceinline__ void done(const Unit&) const {}
};
}

using pg8::pk4_fp8;
__device__ __forceinline__ void transpose_item(const float* __restrict__ W, int ldw, int k0, int c0, bf16* WT, int drow0, LAS float* scr, int lane) {
#pragma unroll 8
    for (int i = 0; i < 32; ++i) { const int kk = 2 * i + (lane >> 5); scr[kk * 33 + (lane & 31)] = W[(size_t)(k0 + kk) * ldw + c0 + (lane & 31)]; }
    LDS_WAIT(); asm volatile("" ::: "memory");
    const int c = lane & 7;
#pragma unroll
    for (int j = 0; j < 4; ++j) { const int n = (lane >> 3) + 8 * j; const LAS float* s = scr + (8 * c) * 33 + n;
        v4u o; o.x = pk2(s[0 * 33], s[1 * 33]); o.y = pk2(s[2 * 33], s[3 * 33]); o.z = pk2(s[4 * 33], s[5 * 33]); o.w = pk2(s[6 * 33], s[7 * 33]);
        *(GAS v4u*)(WT + (size_t)(drow0 + n) * 1024 + k0 + 8 * c) = o; }
    LDS_WAIT(); asm volatile("" ::: "memory");
}
__device__ __forceinline__ void transpose_item8(const float* __restrict__ W, int ldw, int k0, int c0, unsigned char* WT, int drow0, float scale, LAS float* scr, int lane) {
#pragma unroll 8
    for (int i = 0; i < 32; ++i) { const int kk = 2 * i + (lane >> 5); scr[kk * 33 + (lane & 31)] = W[(size_t)(k0 + kk) * ldw + c0 + (lane & 31)]; }
    LDS_WAIT(); asm volatile("" ::: "memory");
    const int n = lane >> 1, hf = lane & 1; const LAS float* s = scr + (32 * hf) * 33 + n;
    v4u o0, o1;
    o0.x = pk4_fp8(s[0 * 33] * scale, s[1 * 33] * scale, s[2 * 33] * scale, s[3 * 33] * scale); o0.y = pk4_fp8(s[4 * 33] * scale, s[5 * 33] * scale, s[6 * 33] * scale, s[7 * 33] * scale);
    o0.z = pk4_fp8(s[8 * 33] * scale, s[9 * 33] * scale, s[10 * 33] * scale, s[11 * 33] * scale); o0.w = pk4_fp8(s[12 * 33] * scale, s[13 * 33] * scale, s[14 * 33] * scale, s[15 * 33] * scale);
    o1.x = pk4_fp8(s[16 * 33] * scale, s[17 * 33] * scale, s[18 * 33] * scale, s[19 * 33] * scale); o1.y = pk4_fp8(s[20 * 33] * scale, s[21 * 33] * scale, s[22 * 33] * scale, s[23 * 33] * scale);
    o1.z = pk4_fp8(s[24 * 33] * scale, s[25 * 33] * scale, s[26 * 33] * scale, s[27 * 33] * scale); o1.w = pk4_fp8(s[28 * 33] * scale, s[29 * 33] * scale, s[30 * 33] * scale, s[31 * 33] * scale);
    GAS v4u* dst = (GAS v4u*)(WT + (size_t)(drow0 + n) * 1024 + k0 + 32 * hf); dst[0] = o0; dst[1] = o1;
    LDS_WAIT(); asm volatile("" ::: "memory");
}
template <bool F8> __device__ __forceinline__ void p0_item(const float* __restrict__ W, int ldw, int k0, int c0, unsigned char* WT, int drow0, int rowb, float scale, LAS unsigned char* T, int tid, int wave, int lane) {
    constexpr int NB = F8 ? 2 : 1, TS = 516;
    const int l32 = lane & 31, hf = lane >> 5;
#pragma unroll 1
    for (int batch = 0; batch < NB; ++batch) {
        const int kb = batch * 256 + wave * 32;
        f32x4 v[4][4];
#pragma unroll
        for (int i = 0; i < 4; ++i)
#pragma unroll
            for (int j = 0; j < 4; ++j) v[i][j] = __builtin_nontemporal_load((const f32x4*)(W + (size_t)(k0 + kb + 4 * (2 * i + hf) + j) * ldw + c0 + 4 * l32));
#pragma unroll
        for (int i = 0; i < 4; ++i) { const int kk = kb + 4 * (2 * i + hf);
#pragma unroll
            for (int c = 0; c < 4; ++c) { LAS unsigned char* tp = T + (4 * l32 + c) * TS + (F8 ? kk : 2 * kk);
                if (F8) *(LAS unsigned*)tp = pk4_fp8(v[i][0][c] * scale, v[i][1][c] * scale, v[i][2][c] * scale, v[i][3][c] * scale);
                else { *(LAS unsigned*)tp = pk2(v[i][0][c], v[i][1][c]); *(LAS unsigned*)(tp + 4) = pk2(v[i][2][c], v[i][3][c]); } } }
    }
    __syncthreads();
#pragma unroll
    for (int i = 0; i < 8; ++i) { const int piece = tid + NTHR * i, n = piece >> 5, c = piece & 31; const LAS unsigned* tp = (const LAS unsigned*)(T + n * TS + 16 * c);
        v4u o; o.x = tp[0]; o.y = tp[1]; o.z = tp[2]; o.w = tp[3];
        *(GAS v4u*)(WT + (size_t)(drow0 + n) * rowb + (F8 ? k0 : 2 * k0) + 16 * c) = o; }
    __syncthreads();
}
constexpr int KB1 = MOE_FP8_G1 ? 2 : 4, KB2 = MOE_FP8_G2 ? 2 : 4, I_E1 = NE * 16 * KB1, I_E2 = NE * 8 * KB2, N_EXP_ITEMS = I_E1 + I_E2;
constexpr int N_BG_ITEMS = 0;
__device__ __forceinline__ void p0_expert_item(const Args& a, LAS unsigned char* lds, int it, int tid, int wave, int lane) {
    unsigned char* ws = a.ws;
    if (it < I_E1) { const int e = it / (16 * KB1), r2 = it % (16 * KB1), nb = r2 / KB1, kb = r2 % KB1, c0 = 128 * nb;
        const int drow = e * 2048 + ((c0 < 1024) ? (256 * (c0 >> 7)) : (256 * ((c0 - 1024) >> 7) + 128));
        p0_item<MOE_FP8_G1 != 0>(a.in[I_W1] + (size_t)e * 1024 * 2048, 2048, (MOE_FP8_G1 ? 512 : 256) * kb, c0, ws + WS_W1, drow, MOE_FP8_G1 ? 1024 : 2048, 128.0f, lds, tid, wave, lane); }
    else { const int r = it - I_E1, e = r / (8 * KB2), r2 = r % (8 * KB2), nb = r2 / KB2, kb = r2 % KB2;
        p0_item<MOE_FP8_G2 != 0>(a.in[I_W2] + (size_t)e * 1024 * 1024, 1024, (MOE_FP8_G2 ? 512 : 256) * kb, 128 * nb, ws + WS_W2, e * 1024 + 128 * nb, MOE_FP8_G2 ? 1024 : 2048, 128.0f, lds, tid, wave, lane); }
}
struct P0Src { const float* W; int ldw, k0, c0, drow; unsigned char* WT; };
__device__ __forceinline__ P0Src p0_expert_src(const Args& a, int it) {
    P0Src s;
    if (it < I_E1) { const int e = it / (16 * KB1), r2 = it % (16 * KB1), nb = r2 / KB1, kb = r2 % KB1, c0 = 128 * nb;
        s.W = a.in[I_W1] + (size_t)e * 1024 * 2048; s.ldw = 2048; s.k0 = 512 * kb; s.c0 = c0; s.drow = e * 2048 + ((c0 < 1024) ? (256 * (c0 >> 7)) : (256 * ((c0 - 1024) >> 7) + 128)); s.WT = a.ws + WS_W1; }
    else { const int r = it - I_E1, e = r / (8 * KB2), r2 = r % (8 * KB2), nb = r2 / KB2, kb = r2 % KB2;
        s.W = a.in[I_W2] + (size_t)e * 1024 * 1024; s.ldw = 1024; s.k0 = 512 * kb; s.c0 = 128 * nb; s.drow = e * 1024 + 128 * nb; s.WT = a.ws + WS_W2; }
    return s;
}
__device__ __forceinline__ void p0_load_batch(f32x4 (&v)[4][4], const P0Src& s, int batch, int wave, int lane) {
    const int l32 = lane & 31, hf = lane >> 5, kb = batch * 256 + wave * 32;
#pragma unroll
    for (int i = 0; i < 4; ++i)
#pragma unroll
        for (int j = 0; j < 4; ++j) v[i][j] = __builtin_nontemporal_load((const f32x4*)(s.W + (size_t)(s.k0 + kb + 4 * (2 * i + hf) + j) * s.ldw + s.c0 + 4 * l32));
}
__device__ __forceinline__ void p0_pack_batch8(const f32x4 (&v)[4][4], int batch, LAS unsigned char* T, int wave, int lane) {
    const int l32 = lane & 31, hf = lane >> 5, kb = batch * 256 + wave * 32;
#pragma unroll
    for (int i = 0; i < 4; ++i) { const int kk = kb + 4 * (2 * i + hf);
#pragma unroll
        for (int c = 0; c < 4; ++c) { const int n = 4 * l32 + c; *(LAS unsigned*)(T + n * 516 + 4 * ((kk >> 2) ^ ((n >> 5) & 3))) = pk4_fp8(v[i][0][c] * 128.0f, v[i][1][c] * 128.0f, v[i][2][c] * 128.0f, v[i][3][c] * 128.0f); } }
}
__device__ __forceinline__ void p0_expert_items_pipelined(const Args& a, LAS unsigned char* T, int bid, int G, int n_items, int tid, int wave, int lane) {
    if (bid >= n_items) return;
    f32x4 vA[4][4], vB[4][4];
    P0Src cur = p0_expert_src(a, bid);
    p0_load_batch(vA, cur, 0, wave, lane);
#pragma unroll 1
    for (int it = bid; it < n_items; it += G) {
        p0_load_batch(vB, cur, 1, wave, lane);
        p0_pack_batch8(vA, 0, T, wave, lane);
        const int nx = it + G; const P0Src nxt = p0_expert_src(a, nx < n_items ? nx : it);
        if (nx < n_items) p0_load_batch(vA, nxt, 0, wave, lane);
        p0_pack_batch8(vB, 1, T, wave, lane);
        __syncthreads();
#pragma unroll
        for (int i = 0; i < 8; ++i) { const int piece = tid + NTHR * i, n = piece >> 5, c = piece & 31, sw = (n >> 5) & 3; const LAS unsigned* tp = (const LAS unsigned*)(T + n * 516 + 16 * c);
            v4u o; o.x = tp[0 ^ sw]; o.y = tp[1 ^ sw]; o.z = tp[2 ^ sw]; o.w = tp[3 ^ sw];
            *(GAS v4u*)(cur.WT + (size_t)(cur.drow + n) * 1024 + cur.k0 + 16 * c) = o; }
        __syncthreads();
        cur = nxt;
    }
}
#ifndef DEFER_EXPERT_CVT
#define DEFER_EXPERT_CVT 1
#endif
#ifndef CVT_IN_A
#define CVT_IN_A 0
#endif
__device__ __forceinline__ void deferred_cvt_items(const Args& a, LAS unsigned char* lds, int bid, int G, int h, int tid, int wave, int lane) {
    if (!(DEFER_EXPERT_CVT && G == 256)) return;
    constexpr int PER = N_EXP_ITEMS / 256;
    const int j0 = h ? CVT_IN_A : 0, j1 = h ? PER : CVT_IN_A;
    if (MOE_FP8_G1 && MOE_FP8_G2) { if (j1 > j0) p0_expert_items_pipelined(a, lds, bid + 256 * j0, 256, 256 * j1, tid, wave, lane); }
    else for (int j = j0; j < j1; ++j) p0_expert_item(a, lds, bid + 256 * j, tid, wave, lane);
}
__device__ __forceinline__ void p0_bg_items(const Args& a, LAS unsigned char* lds, int bid, int G, int tid, int wave, int lane) {
    if (G == 256 && bid >= 128) { for (int j = 0; j < N_BG_ITEMS / 128; ++j) p0_expert_item(a, lds, N_EXP_ITEMS - N_BG_ITEMS + (bid - 128) + 128 * j, tid, wave, lane); }
}
__device__ __forceinline__ void p0_prologue(const Args& a, LAS unsigned char* lds, int bid, int G, int tid, int wave, int lane) {
    unsigned char* ws = a.ws;
    {
      for (int it = (G == 256) ? ((bid >= 144 && wave < 2) ? (bid - 144) * 2 + wave : 192) : ((wave == 0) ? bid : 192); it < 192; it += (G == 256 ? 192 : G)) {
        const int nc = it % 24, kc = it / 24, n = nc * 256 + 4 * lane;
        const float* W = a.in[I_ADAW]; const float* c = a.in[I_C];
        f32x4 a0 = {0.f, 0.f, 0.f, 0.f}, a1 = {0.f, 0.f, 0.f, 0.f};
#pragma unroll 8
        for (int kk = 0; kk < 128; ++kk) { const int k = kc * 128 + kk; const f32x4 w = __builtin_nontemporal_load((const f32x4*)(W + (size_t)k * 6144 + n));
            const float c0 = silu_f(c[k]), c1 = silu_f(c[1024 + k]); a0 += c0 * w; a1 += c1 * w; }
        float* mp = (float*)(ws + WS_MODP);
        *(f32x4*)(mp + (size_t)(kc * 2 + 0) * 6144 + n) = a0; *(f32x4*)(mp + (size_t)(kc * 2 + 1) * 6144 + n) = a1;
      } }
    constexpr int I_IN = 28 * 4, I_OUT = 8 * 4;
    const int n_p0 = (G == 256) ? (N_EXP_ITEMS - N_BG_ITEMS) : N_EXP_ITEMS;
    if (!(DEFER_EXPERT_CVT && G == 256)) {
    if (MOE_FP8_G1 && MOE_FP8_G2) p0_expert_items_pipelined(a, lds, bid, G, n_p0, tid, wave, lane);
    else for (int it = bid; it < n_p0; it += G) p0_expert_item(a, lds, it, tid, wave, lane);
    }
    for (int it = bid; it < I_IN + I_OUT; it += G) {
        if (it < I_IN) { const int nb = it >> 2, kb = it & 3; p0_item<false>(a.in[I_WIN], IN_COLS, 256 * kb, 128 * nb, ws + WS_WIN, 128 * nb, 2048, 1.0f, lds, tid, wave, lane); }
        else { const int r = it - I_IN, nb = r >> 2, kb = r & 3; p0_item<false>(a.in[I_WOUT], D, 256 * kb, 128 * nb, ws + WS_WOUT, 128 * nb, 2048, 1.0f, lds, tid, wave, lane); }
    }
}

__device__ __forceinline__ void load_mod_AS(LAS float* A, LAS float* S, const float* normw, const float* src, int nparts, const float* bias, int b, int shift_off, int tid) {
    for (int k = tid; k < 1024; k += NTHR) {
        float sh = bias ? bias[shift_off + k] : 0.f, sc = bias ? bias[shift_off + 1024 + k] : 0.f;
        for (int p = 0; p < nparts; ++p) { const float* q = src + (size_t)(p * 2 + b) * 6144 + shift_off; sh += q[k]; sc += q[1024 + k]; }
        A[k] = normw[k] * (1.0f + sc); S[k] = sh;
    }
}
__device__ __forceinline__ float softplus_f(float x) { return fmaxf(x, 0.f) + log1pf(__expf(-fabsf(x))); }

__device__ __forceinline__ void p1_norm(const Args& a, LAS unsigned char* lds, int bid, int G, int tid, int wave, int lane) {
    unsigned char* ws = a.ws;
    LAS float* A1 = (LAS float*)(lds); LAS float* S1 = A1 + 1024; LAS float* WDT = S1 + 1024;
    const float* modp = (const float*)(ws + WS_MODP);
    for (int idx = bid * NTHR + tid; idx < 2 * 6144; idx += G * NTHR) { const int b = idx / 6144, n = idx % 6144; float s = a.in[I_ADAB][n];
        for (int p = 0; p < 8; ++p) s += modp[(size_t)(p * 2 + b) * 6144 + n];
        ((float*)(ws + WS_MODF))[idx] = s; }
    for (int idx = tid; idx < 8192; idx += NTHR) { const int k = idx >> 3, jj = idx & 7; WDT[jj * 1024 + k] = a.in[I_WIN][(size_t)k * IN_COLS + NPROJ + jj]; }
    const float* x = a.in[I_X]; bf16* H = (bf16*)(ws + WS_H); float* DT = (float*)(ws + WS_DT);
    for (int c = bid; c < NCHUNK; c += G) {
        const int b = c >> 7;
        __syncthreads();
        load_mod_AS(A1, S1, a.in[I_N1W], modp, 8, a.in[I_ADAB], b, 0, tid);
        __syncthreads();
        f32x4 vn[4];
        { const GAS f32x4* xr = (const GAS f32x4*)(x + (size_t)(c * 64 + wave * 8) * D) + lane;
#pragma unroll
          for (int j = 0; j < 4; ++j) vn[j] = __builtin_nontemporal_load((const f32x4*)xr + 64 * j); }
#pragma unroll 1
        for (int r = 0; r < 8; ++r) {
            const int m = c * 64 + wave * 8 + r;
            f32x4 v[4]; float ss = 0.f;
#pragma unroll
            for (int j = 0; j < 4; ++j) { v[j] = vn[j]; ss += (v[j].x * v[j].x + v[j].y * v[j].y) + (v[j].z * v[j].z + v[j].w * v[j].w); }
            if (r < 7) { const GAS f32x4* xr = (const GAS f32x4*)(x + (size_t)(m + 1) * D) + lane;
#pragma unroll
                for (int j = 0; j < 4; ++j) vn[j] = __builtin_nontemporal_load((const f32x4*)xr + 64 * j); }
            const float rstd = rsqrtf(wave_sum(ss) * (1.0f / D) + EPS);
            float dacc[8];
#pragma unroll
            for (int jj = 0; jj < 8; ++jj) dacc[jj] = 0.f;
            GAS unsigned long long* o8 = (GAS unsigned long long*)(H + (size_t)m * D) + lane;
#pragma unroll
            for (int j = 0; j < 4; ++j) {
                const f32x4 av = *(const LAS f32x4*)(A1 + 256 * j + 4 * lane), sv = *(const LAS f32x4*)(S1 + 256 * j + 4 * lane);
                const f32x4 h = v[j] * rstd * av + sv;
                o8[64 * j] = (unsigned long long)pk2(h.x, h.y) | ((unsigned long long)pk2(h.z, h.w) << 32);
#pragma unroll
                for (int jj = 0; jj < 8; ++jj) { const f32x4 w = *(const LAS f32x4*)(WDT + jj * 1024 + 256 * j + 4 * lane); dacc[jj] += (h.x * w.x + h.y * w.y) + (h.z * w.z + h.w * w.w); }
            }
            { const bool u5 = (lane & 32) != 0, u4 = (lane & 16) != 0, u3 = (lane & 8) != 0; float p4[4], p2[2], p1;
#pragma unroll
              for (int i = 0; i < 4; ++i) { const float lo = dacc[i], hi = dacc[i + 4]; p4[i] = (u5 ? hi : lo) + __shfl_xor(u5 ? lo : hi, 32); }
#pragma unroll
              for (int i = 0; i < 2; ++i) { const float lo = p4[i], hi = p4[i + 2]; p2[i] = (u4 ? hi : lo) + __shfl_xor(u4 ? lo : hi, 16); }
              { const float lo = p2[0], hi = p2[1]; p1 = (u3 ? hi : lo) + __shfl_xor(u3 ? lo : hi, 8); }
              p1 += __shfl_xor(p1, 4); p1 += __shfl_xor(p1, 2); p1 += __shfl_xor(p1, 1);
              const int col = lane >> 3;
              if ((lane & 7) == 0) DT[(size_t)m * 8 + col] = softplus_f(p1 + a.in[I_DTB][col]); }
        }
    }
}

__device__ __forceinline__ void hgrn_naive(const Args& a, LAS unsigned char* lds, int bh, int tid, int wave, int lane) {
    unsigned char* ws = a.ws;
    const int b = bh >> 2, h = bh & 3, j = tid & 127, kq = tid >> 7;
    LAS float* FE = (LAS float*)lds; LAS float* KK = FE + 2048; LAS float* QQ = KK + 2048; LAS float* VV = QQ + 2048; LAS float* RED = VV + 2048;
    const bf16* P = (const bf16*)(ws + WS_P); const float* LF = (const float*)(ws + WS_LF); bf16* MIX = (bf16*)(ws + WS_MIX);
    const float* nw = a.in[I_HGNW];
    float S[32];
#pragma unroll
    for (int i = 0; i < 32; ++i) S[i] = 0.f;
    for (int t0 = 0; t0 < SEQ; t0 += 16) {
        for (int idx = tid; idx < 2048; idx += NTHR) { const int tt = idx >> 7, k = idx & 127; const size_t row = (size_t)b * SEQ + t0 + tt;
            FE[idx] = __expf(LF[row * 512 + h * 128 + k]); KK[idx] = bf2f(P[row * NPROJ + PC_K + h * 128 + k]);
            QQ[idx] = bf2f(P[row * NPROJ + PC_Q + h * 128 + k]); VV[idx] = bf2f(P[row * NPROJ + PC_V + h * 128 + k]); }
        __syncthreads();
#pragma unroll 1
        for (int tt = 0; tt < 16; ++tt) {
            const float vj = VV[tt * 128 + j]; float p = 0.f;
#pragma unroll
            for (int i4 = 0; i4 < 8; ++i4) {
                const f32x4 f4 = *(const LAS f32x4*)(FE + tt * 128 + 32 * kq + 4 * i4), k4 = *(const LAS f32x4*)(KK + tt * 128 + 32 * kq + 4 * i4), q4 = *(const LAS f32x4*)(QQ + tt * 128 + 32 * kq + 4 * i4);
#pragma unroll
                for (int c = 0; c < 4; ++c) { S[4 * i4 + c] = f4[c] * S[4 * i4 + c] + k4[c] * vj; p += S[4 * i4 + c] * q4[c]; }
            }
            RED[(kq * 16 + tt) * 128 + j] = p;
        }
        __syncthreads();
#pragma unroll
        for (int r = 0; r < 2; ++r) { const int tt = 2 * wave + r; const size_t row = (size_t)b * SEQ + t0 + tt;
            float o0 = 0.f, o1 = 0.f;
#pragma unroll
            for (int q = 0; q < 4; ++q) { o0 += RED[(q * 16 + tt) * 128 + lane]; o1 += RED[(q * 16 + tt) * 128 + 64 + lane]; }
            const float rstd = rsqrtf(wave_sum(o0 * o0 + o1 * o1) * (1.0f / 128.0f) + EPS);
            MIX[row * D + h * 128 + lane] = (bf16)f2bf(o0 * rstd * nw[lane] * bf2f(P[row * NPROJ + PC_G + h * 128 + lane]));
            MIX[row * D + h * 128 + 64 + lane] = (bf16)f2bf(o1 * rstd * nw[64 + lane] * bf2f(P[row * NPROJ + PC_G + h * 128 + 64 + lane])); }
    }
}
__device__ __forceinline__ void ssd_naive(const Args& a, LAS unsigned char* lds, int bg, int tid, int wave, int lane) {
    unsigned char* ws = a.ws;
    const int b = bg >> 1, g = bg & 1, p = tid & 63, hl = wave >> 1, nh = wave & 1;
    LAS float* XS = (LAS float*)lds; LAS float* BM = XS + 4096; LAS float* CM = BM + 2048; LAS float* DTL = CM + 2048; LAS float* DEC = DTL + 64; LAS float* RED = DEC + 64;
    const bf16* P = (const bf16*)(ws + WS_P); const float* DT = (const float*)(ws + WS_DT); bf16* MIX = (bf16*)(ws + WS_MIX);
    const float* cw = a.in[I_CONVW]; const float* cb = a.in[I_CONVB];
    float hS[64];
#pragma unroll
    for (int i = 0; i < 64; ++i) hS[i] = 0.f;
    for (int t0 = 0; t0 < SEQ; t0 += 16) {
        for (int idx = tid; idx < 16 * 512; idx += NTHR) { const int tt = idx >> 9, cc = idx & 511, t = t0 + tt;
            const int ch = (cc < 256) ? (g * 256 + cc) : (cc < 384) ? (512 + g * 128 + (cc - 256)) : (768 + g * 128 + (cc - 384));
            float v = cb[ch];
#pragma unroll
            for (int w = 0; w < 4; ++w) { const int ts = t - 3 + w; if (ts >= 0) v += bf2f(P[((size_t)b * SEQ + ts) * NPROJ + PC_X + ch]) * cw[w * 1024 + ch]; }
            v = silu_f(v);
            if (cc < 256) XS[tt * 256 + cc] = v; else if (cc < 384) BM[tt * 128 + cc - 256] = v; else CM[tt * 128 + cc - 384] = v; }
        if (tid < 64) { const int tt = tid >> 2, hh = tid & 3; const float dtv = DT[((size_t)b * SEQ + t0 + tt) * 8 + g * 4 + hh]; DTL[tid] = dtv; DEC[tid] = __expf(-dtv * __expf(a.in[I_ALOG][g * 4 + hh])); }
        __syncthreads();
#pragma unroll 1
        for (int tt = 0; tt < 16; ++tt) {
            const float dec = DEC[tt * 4 + hl], xdt = XS[tt * 256 + hl * 64 + p] * DTL[tt * 4 + hl]; float y = 0.f;
#pragma unroll
            for (int i4 = 0; i4 < 16; ++i4) { const f32x4 B4 = *(const LAS f32x4*)(BM + tt * 128 + nh * 64 + 4 * i4), C4 = *(const LAS f32x4*)(CM + tt * 128 + nh * 64 + 4 * i4);
#pragma unroll
                for (int c = 0; c < 4; ++c) { hS[4 * i4 + c] = dec * hS[4 * i4 + c] + xdt * B4[c]; y += hS[4 * i4 + c] * C4[c]; } }
            RED[(nh * 16 + tt) * 256 + hl * 64 + p] = y;
        }
        __syncthreads();
#pragma unroll
        for (int r = 0; r < 2; ++r) { const int tt = 2 * wave + r; const size_t row = (size_t)b * SEQ + t0 + tt;
            float yv[4], ss = 0.f;
#pragma unroll
            for (int i = 0; i < 4; ++i) { const int c = lane + 64 * i; float y = RED[tt * 256 + c] + RED[(16 + tt) * 256 + c] + a.in[I_SSMD][g * 4 + i] * XS[tt * 256 + c];
                y *= bf2f(P[row * NPROJ + PC_Z + g * 256 + c]); yv[i] = y; ss += y * y; }
            const float rstd = rsqrtf(wave_sum(ss) * (1.0f / 256.0f) + EPS);
#pragma unroll
            for (int i = 0; i < 4; ++i) { const int c = lane + 64 * i; MIX[row * D + 512 + g * 256 + c] = (bf16)f2bf(yv[i] * rstd * a.in[I_SSMNW][g * 256 + c]); }
        }
        __syncthreads();
    }
}


typedef float f32x16 __attribute__((ext_vector_type(16)));
constexpr size_t WS_UHG = 480 * MiB, WS_SHG = 496 * MiB, WS_USSD = 512 * MiB, WS_SSSD = 544 * MiB, WS_DK = 560 * MiB, WS_DEC = 561 * MiB;
constexpr int LDA = 136, LDT = 72;

__device__ __forceinline__ int crow(int i, int hh) { return (i & 3) + 8 * (i >> 2) + 4 * hh; }
__device__ __forceinline__ void mma32(f32x16& acc, const LAS bf16* A, int lda, const LAS bf16* Bt, int ldb, int nsteps, int lane) {
    const LAS bf16* ap = A + (lane & 31) * lda + 8 * (lane >> 5);
    const LAS bf16* bp = Bt + (lane & 31) * ldb + 8 * (lane >> 5);
    for (int s = 0; s < nsteps; ++s) {
        const bf16x8 av = *(const LAS bf16x8*)(ap + 16 * s), bv = *(const LAS bf16x8*)(bp + 16 * s);
        acc = __builtin_amdgcn_mfma_f32_32x32x16_bf16(av, bv, acc, 0, 0, 0);
    }
}
__device__ __forceinline__ f32x16 zero16() { f32x16 z;
#pragma unroll
    for (int i = 0; i < 16; ++i) z[i] = 0.f; return z; }
__device__ __forceinline__ void st8(LAS bf16* p, float a, float b, float c, float d) { *(LAS unsigned long long*)p = (unsigned long long)pk2(a, b) | ((unsigned long long)pk2(c, d) << 32); }
__device__ __forceinline__ void st16x(LAS bf16* p, const float* v) {
    v4u a, b; a.x = pk2(v[0], v[1]); a.y = pk2(v[2], v[3]); a.z = pk2(v[4], v[5]); a.w = pk2(v[6], v[7]); b.x = pk2(v[8], v[9]); b.y = pk2(v[10], v[11]); b.z = pk2(v[12], v[13]); b.w = pk2(v[14], v[15]);
    *(LAS v4u*)p = a; *(LAS v4u*)(p + 8) = b; }

__device__ __forceinline__ float bfw(unsigned w, int hi) { return __uint_as_float(hi ? (w & 0xffff0000u) : (w << 16)); }
constexpr int HG_QS = 0, HG_KS = 17408, HG_KDT = 34816, HG_VT = 53248, HG_ST = 71680, HG_ATT = 106496, HG_QT = 115712, HG_EBM = 117760, HG_EBL = 118272;
constexpr int HG_VRAW = 118784;
struct HgWide { v4u q[2], k[2], v[2]; float lf[16]; };
template <bool FULL> __device__ __forceinline__ void hg_load(const Args& a, HgWide& r, int b, int h, int t0, int tid) {
    const bf16* P = (const bf16*)(a.ws + WS_P) + ((size_t)b * SEQ + t0) * NPROJ + h * 128;
#pragma unroll
    for (int i = 0; i < 2; ++i) { const int piece = tid + NTHR * i; const unsigned o = (unsigned)(piece >> 4) * NPROJ + 8u * (unsigned)(piece & 15);
        r.k[i] = *(const v4u*)(P + o + PC_K); r.v[i] = *(const v4u*)(P + o + PC_V); if (FULL) r.q[i] = *(const v4u*)(P + o + PC_Q); }
    const int k = tid & 127, tq = tid >> 7;
    const float* LF = (const float*)(a.ws + WS_LF) + ((size_t)b * SEQ + t0 + 16 * tq) * 512 + h * 128;
#pragma unroll
    for (int i = 0; i < 16; ++i) r.lf[i] = LF[(unsigned)i * 512 + (unsigned)k];
}
template <bool FULL> __device__ __forceinline__ float hg_stage(const HgWide& r, LAS unsigned char* lds, int tid) {
    LAS bf16* QS = (LAS bf16*)(lds + HG_QS); LAS bf16* KS = (LAS bf16*)(lds + HG_KS); LAS bf16* KDT = (LAS bf16*)(lds + HG_KDT); LAS bf16* VT = (LAS bf16*)(lds + HG_VT); LAS bf16* VR = (LAS bf16*)(lds + HG_VRAW);
    LAS float* QT = (LAS float*)(lds + HG_QT); LAS float* EBM = (LAS float*)(lds + HG_EBM); LAS float* EBL = (LAS float*)(lds + HG_EBL);
#pragma unroll
    for (int i = 0; i < 2; ++i) { const int piece = tid + NTHR * i; const int o = (piece >> 4) * LDA + 8 * (piece & 15);
        *(LAS v4u*)(KS + o) = r.k[i]; *(LAS v4u*)(VR + o) = r.v[i]; if (FULL) *(LAS v4u*)(QS + o) = r.q[i]; }
    const int k = tid & 127, tq = tid >> 7;
    float cum[16]; float run = 0.f;
#pragma unroll
    for (int i = 0; i < 16; ++i) { run += r.lf[i]; cum[i] = run; }
    QT[tq * 128 + k] = run;
    __syncthreads();
    const float q0 = QT[k], q1 = QT[128 + k], q2 = QT[256 + k], q3 = QT[384 + k];
    const float off = (tq > 0 ? q0 : 0.f) + (tq > 1 ? q1 : 0.f) + (tq > 2 ? q2 : 0.f), bmid = q0 + q1, blast = (q0 + q1) + (q2 + q3);
    float kd[16], vv[16];
#pragma unroll
    for (int i = 0; i < 16; ++i) { const float bt = off + cum[i]; const int e = (16 * tq + i) * LDA + k; const float kk = bf2f(KS[e]); vv[i] = bf2f(VR[e]); kd[i] = kk * __expf(blast - bt);
        if (FULL) { QS[e] = (bf16)f2bf(bf2f(QS[e]) * __expf(bt - bmid)); KS[e] = (bf16)f2bf(kk * __expf(bmid - bt)); } }
    st16x(KDT + k * LDT + 16 * tq, kd); st16x(VT + k * LDT + 16 * tq, vv);
    if (tq == 0) { EBL[k] = __expf(blast); if (FULL) EBM[k] = __expf(bmid); }
    __syncthreads();
    return blast;
}
__device__ __forceinline__ void hg_update(f32x16 (&S)[2], LAS unsigned char* lds, int wave, int lane) {
    const LAS bf16* KDT = (const LAS bf16*)(lds + HG_KDT); const LAS bf16* VT = (const LAS bf16*)(lds + HG_VT); const LAS float* EBL = (const LAS float*)(lds + HG_EBL);
    const int kt = wave >> 1, hh = lane >> 5;
#pragma unroll
    for (int g = 0; g < 4; ++g) { const f32x4 e = *(const LAS f32x4*)(EBL + 32 * kt + 8 * g + 4 * hh);
#pragma unroll
        for (int j = 0; j < 2; ++j) { S[j][4 * g + 0] *= e.x; S[j][4 * g + 1] *= e.y; S[j][4 * g + 2] *= e.z; S[j][4 * g + 3] *= e.w; } }
#pragma unroll
    for (int j = 0; j < 2; ++j) mma32(S[j], KDT + 32 * kt * LDT, LDT, VT + 32 * (2 * (wave & 1) + j) * LDT, LDT, 4, lane);
}
__device__ __forceinline__ void hg_passA(const Args& a, LAS unsigned char* lds, int u, int tid, int wave, int lane) {
    const int bh = u >> 5, seg = u & 31, b = bh >> 2, h = bh & 3, kt = wave >> 1, hh = lane >> 5, r = lane & 31;
    f32x16 S[2]; S[0] = zero16(); S[1] = zero16();
    float dsum = 0.f;
    HgWide cur; hg_load<false>(a, cur, b, h, seg * 256, tid);
#pragma unroll 1
    for (int c = 0; c < 4; ++c) {
        dsum += hg_stage<false>(cur, lds, tid);
        if (c < 3) hg_load<false>(a, cur, b, h, seg * 256 + 64 * (c + 1), tid);
        hg_update(S, lds, wave, lane);
    }
    float* U = (float*)(a.ws + WS_UHG) + (size_t)u * 16384;
#pragma unroll
    for (int j = 0; j < 2; ++j)
#pragma unroll
        for (int i = 0; i < 16; ++i) U[(32 * kt + crow(i, hh)) * 128 + 32 * (2 * (wave & 1) + j) + r] = S[j][i];
    if (tid < 128) ((float*)(a.ws + WS_DK))[u * 128 + tid] = __expf(dsum);
}
__device__ __forceinline__ void hg_passC(const Args& a, LAS unsigned char* lds, int u, int tid, int wave, int lane) {
    const int bh = u >> 5, seg = u & 31, b = bh >> 2, h = bh & 3, kt = wave >> 1, hh = lane >> 5, r = lane & 31;
    LAS bf16* QS = (LAS bf16*)(lds + HG_QS); LAS bf16* KS = (LAS bf16*)(lds + HG_KS); LAS bf16* VT = (LAS bf16*)(lds + HG_VT);
    LAS bf16* ST = (LAS bf16*)(lds + HG_ST); LAS bf16* ATT = (LAS bf16*)(lds + HG_ATT); LAS float* EBM = (LAS float*)(lds + HG_EBM); LAS float* O = (LAS float*)(lds + HG_ST);
    const bf16* P = (const bf16*)(a.ws + WS_P); bf16* MIX = (bf16*)(a.ws + WS_MIX); const float* nw = a.in[I_HGNW];
    f32x16 S[2];
    { const float* SI = (const float*)(a.ws + WS_SHG) + (size_t)u * 16384;
#pragma unroll
      for (int j = 0; j < 2; ++j)
#pragma unroll
        for (int i = 0; i < 16; ++i) S[j][i] = SI[(32 * kt + crow(i, hh)) * 128 + 32 * (2 * (wave & 1) + j) + r]; }
    HgWide cur; hg_load<true>(a, cur, b, h, seg * 256, tid);
#pragma unroll 1
    for (int c = 0; c < 4; ++c) {
        const int t0 = seg * 256 + 64 * c;
        hg_stage<true>(cur, lds, tid);
        if (c < 3) hg_load<true>(a, cur, b, h, t0 + 64, tid);
#pragma unroll
        for (int g = 0; g < 4; ++g) { const int kb = 32 * kt + 8 * g + 4 * hh; const f32x4 e = *(const LAS f32x4*)(EBM + kb);
#pragma unroll
            for (int j = 0; j < 2; ++j) st8(ST + (32 * (2 * (wave & 1) + j) + r) * LDA + kb, S[j][4 * g] * e.x, S[j][4 * g + 1] * e.y, S[j][4 * g + 2] * e.z, S[j][4 * g + 3] * e.w); }
        if (wave < 3) { const int ti = (wave + 1) >> 1, si = wave >> 1;
            f32x16 at = zero16(); mma32(at, QS + 32 * ti * LDA, LDA, KS + 32 * si * LDA, LDA, 8, lane);
#pragma unroll
            for (int i = 0; i < 16; ++i) { const int t = 32 * ti + crow(i, hh), s = 32 * si + r; ATT[t * LDT + s] = (bf16)f2bf(s <= t ? at[i] : 0.f); } }
        __syncthreads();
        const int ti = wave >> 2, vj = wave & 3;
        f32x16 o = zero16();
        mma32(o, ATT + 32 * ti * LDT, LDT, VT + 32 * vj * LDT, LDT, 2 * (ti + 1), lane);
        mma32(o, QS + 32 * ti * LDA, LDA, ST + 32 * vj * LDA, LDA, 8, lane);
        hg_update(S, lds, wave, lane);
        __syncthreads();
#pragma unroll
        for (int i = 0; i < 16; ++i) O[(32 * ti + crow(i, hh)) * 132 + 32 * vj + r] = o[i];
        __syncthreads();
        { const int tt = tid >> 3, c16 = tid & 7; const size_t row = (size_t)b * SEQ + t0 + tt;
          float o[16]; float ss = 0.f;
#pragma unroll
          for (int q = 0; q < 4; ++q) { const f32x4 v = *(const LAS f32x4*)(O + tt * 132 + 16 * c16 + 4 * q); o[4 * q] = v.x; o[4 * q + 1] = v.y; o[4 * q + 2] = v.z; o[4 * q + 3] = v.w; ss += (v.x * v.x + v.y * v.y) + (v.z * v.z + v.w * v.w); }
          ss += __shfl_xor(ss, 1); ss += __shfl_xor(ss, 2); ss += __shfl_xor(ss, 4);
          const float rstd = rsqrtf(ss * (1.0f / 128.0f) + EPS);
          const bf16* gp = P + row * NPROJ + PC_G + h * 128 + 16 * c16; const v4u g0 = __builtin_nontemporal_load((const v4u*)gp), g1 = __builtin_nontemporal_load((const v4u*)(gp + 8)); const unsigned gw[8] = {g0.x, g0.y, g0.z, g0.w, g1.x, g1.y, g1.z, g1.w};
          unsigned ow[8];
#pragma unroll
          for (int j = 0; j < 8; ++j) ow[j] = pk2(o[2 * j] * rstd * nw[16 * c16 + 2 * j] * bfw(gw[j], 0), o[2 * j + 1] * rstd * nw[16 * c16 + 2 * j + 1] * bfw(gw[j], 1));
          bf16* mp = MIX + row * D + h * 128 + 16 * c16; *(v4u*)mp = (v4u){ow[0], ow[1], ow[2], ow[3]}; *(v4u*)(mp + 8) = (v4u){ow[4], ow[5], ow[6], ow[7]}; }
    }
    __syncthreads();
}

constexpr int SD_ACUM = 104448, SD_DTV = 106496, SD_SSQ = 108544, SD_CB = 109568;
__device__ __forceinline__ void ssd_scan_dt(const Args& a, LAS unsigned char* lds, size_t row0, int g, int wave, int lane) {
    LAS float* ACUM = (LAS float*)(lds + SD_ACUM); LAS float* DTV = (LAS float*)(lds + SD_DTV);
    if (wave < 4) { const float* DT = (const float*)(a.ws + WS_DT); const float A = -__expf(a.in[I_ALOG][g * 4 + wave]);
        const float d0 = DT[(row0 + 2 * lane) * 8 + g * 4 + wave], d1 = DT[(row0 + 2 * lane + 1) * 8 + g * 4 + wave];
        const float p0 = d0 * A, p1 = p0 + d1 * A; float incl = p1;
#pragma unroll
        for (int o = 1; o < 64; o <<= 1) { const float t = __shfl_up(incl, o); if (lane >= o) incl += t; }
        const float excl = incl - p1;
        ACUM[wave * 128 + 2 * lane] = excl + p0; ACUM[wave * 128 + 2 * lane + 1] = incl; DTV[wave * 128 + 2 * lane] = d0; DTV[wave * 128 + 2 * lane + 1] = d1; }
}
template <int NT> __device__ __forceinline__ void conv_run(const Args& a, int b, int tp0, int ch, float (&out)[NT]) {
    const bf16* Pb = (const bf16*)(a.ws + WS_P) + (size_t)b * SEQ * NPROJ + PC_X;
    const float w0 = a.in[I_CONVW][ch], w1 = a.in[I_CONVW][1024 + ch], w2 = a.in[I_CONVW][2048 + ch], w3 = a.in[I_CONVW][3072 + ch], cb = a.in[I_CONVB][ch];
    const unsigned o0 = (unsigned)tp0 * NPROJ + (unsigned)ch;
    float x0 = (tp0 >= 3) ? bf2f(Pb[o0 - 3u * NPROJ]) : 0.f, x1 = (tp0 >= 2) ? bf2f(Pb[o0 - 2u * NPROJ]) : 0.f, x2 = (tp0 >= 1) ? bf2f(Pb[o0 - 1u * NPROJ]) : 0.f;
#pragma unroll
    for (int i = 0; i < NT; ++i) { const float x3 = bf2f(Pb[o0 + (unsigned)i * NPROJ]); out[i] = silu_f(cb + w0 * x0 + w1 * x1 + w2 * x2 + w3 * x3); x0 = x1; x1 = x2; x2 = x3; }
}
#ifdef PROBE_A
#define SUBSTAMP(k) do { if (blockIdx.x == 0 && threadIdx.x == 0) { const unsigned long long t_ = __builtin_amdgcn_s_memrealtime(); volatile LAS unsigned* M_ = (volatile LAS unsigned*)(lds + MISC_OFF); M_[16 + 2 * (k)] = (unsigned)t_; M_[17 + 2 * (k)] = (unsigned)(t_ >> 32); } } while (0)
#else
#define SUBSTAMP(k) do { } while (0)
#endif
template <bool NATURAL, bool NT = false, int NTOK = 8> __device__ __forceinline__ void conv8x8(const Args& a, int b, int tp0, int ch0, LAS bf16* dst, const float* sc) {
    const bf16* Pb = (const bf16*)(a.ws + WS_P) + (size_t)b * SEQ * NPROJ + PC_X + ch0;
    const float* cw = a.in[I_CONVW] + ch0; const float* cbp = a.in[I_CONVB] + ch0;
    float w[4][8], bias[8];
#pragma unroll
    for (int q = 0; q < 4; ++q) { const f32x4 lo = *(const f32x4*)(cw + q * 1024), hi = *(const f32x4*)(cw + q * 1024 + 4);
        w[q][0] = lo.x; w[q][1] = lo.y; w[q][2] = lo.z; w[q][3] = lo.w; w[q][4] = hi.x; w[q][5] = hi.y; w[q][6] = hi.z; w[q][7] = hi.w; }
    { const f32x4 lo = *(const f32x4*)cbp, hi = *(const f32x4*)(cbp + 4); bias[0] = lo.x; bias[1] = lo.y; bias[2] = lo.z; bias[3] = lo.w; bias[4] = hi.x; bias[5] = hi.y; bias[6] = hi.z; bias[7] = hi.w; }
    v4u raw[NTOK + 3];
#pragma unroll
    for (int i = 0; i < NTOK + 3; ++i) { const int tp = tp0 - 3 + i; const v4u* rp = (const v4u*)(Pb + (size_t)(unsigned)(tp < 0 ? 0 : tp) * NPROJ); raw[i] = (tp >= 0) ? (NT ? __builtin_nontemporal_load(rp) : *rp) : (v4u){0u, 0u, 0u, 0u}; }
    unsigned pkT[8][NTOK / 2];
#pragma unroll
    for (int tok = 0; tok < NTOK; ++tok) { float o[8];
#pragma unroll
        for (int c = 0; c < 8; ++c) { float v = bias[c];
#pragma unroll
            for (int q = 0; q < 4; ++q) v += w[q][c] * bfw(raw[tok + q][c >> 1], c & 1);
            o[c] = silu_f(v); }
        if (NATURAL) { v4u ov; ov.x = pk2(o[0], o[1]); ov.y = pk2(o[2], o[3]); ov.z = pk2(o[4], o[5]); ov.w = pk2(o[6], o[7]); *(LAS v4u*)(dst + tok * LDA) = ov; }
        else {
#pragma unroll
            for (int c = 0; c < 8; ++c) { const unsigned hb = f2bf(o[c] * sc[tok]); pkT[c][tok >> 1] = (tok & 1) ? (pkT[c][tok >> 1] | (hb << 16)) : hb; } } }
    if (!NATURAL) {
#pragma unroll
        for (int c = 0; c < 8; ++c) {
            if (NTOK == 8) { v4u ov; ov.x = pkT[c][0]; ov.y = pkT[c][1]; ov.z = pkT[c][NTOK == 8 ? 2 : 0]; ov.w = pkT[c][NTOK == 8 ? 3 : 0]; *(LAS v4u*)(dst + c * LDA) = ov; }
            else *(LAS unsigned long long*)(dst + c * LDA) = (unsigned long long)pkT[c][0] | ((unsigned long long)pkT[c][1] << 32); } }
}
constexpr int SC_CM = 0, SC_BM = 34816, SC_XT = 69632, SC_SIN = 87040, SC_YS = 104448, SC_ACUM = 139264, SC_DTV = 141312;
__device__ __forceinline__ void ssd_scan_dt_at(const Args& a, LAS unsigned char* lds, int acum_off, int dtv_off, size_t row0, int g, int wave, int lane) {
    LAS float* ACUM = (LAS float*)(lds + acum_off); LAS float* DTV = (LAS float*)(lds + dtv_off);
    if (wave < 4) { const float* DT = (const float*)(a.ws + WS_DT); const float A = -__expf(a.in[I_ALOG][g * 4 + wave]);
        const float d0 = DT[(row0 + 2 * lane) * 8 + g * 4 + wave], d1 = DT[(row0 + 2 * lane + 1) * 8 + g * 4 + wave];
        const float p0 = d0 * A, p1 = p0 + d1 * A; float incl = p1;
#pragma unroll
        for (int o = 1; o < 64; o <<= 1) { const float t = __shfl_up(incl, o); if (lane >= o) incl += t; }
        const float excl = incl - p1;
        ACUM[wave * 128 + 2 * lane] = excl + p0; ACUM[wave * 128 + 2 * lane + 1] = incl; DTV[wave * 128 + 2 * lane] = d0; DTV[wave * 128 + 2 * lane + 1] = d1; }
}
__device__ __forceinline__ void ssd_passA(const Args& a, LAS unsigned char* lds, int u, int tid, int wave, int lane) {
    const int bg = u >> 6, c = u & 63, b = bg >> 1, g = bg & 1, t0 = c * 128; const size_t row0 = (size_t)b * SEQ + t0;
    LAS bf16* XDT = (LAS bf16*)lds; LAS bf16* BMT = (LAS bf16*)(lds + 69632); LAS float* ACUM = (LAS float*)(lds + SD_ACUM); LAS float* DTV = (LAS float*)(lds + SD_DTV);
    ssd_scan_dt(a, lds, row0, g, wave, lane);
    __syncthreads();
#pragma unroll 1
    for (int task = tid; task < 768; task += NTHR) {
        int task_o = task; asm volatile("" : "+v"(task_o));
        const int cg = task_o >> 4, tb = task_o & 15; float sc[8];
        if (cg < 32) { const int hd = cg >> 3; const float al = ACUM[hd * 128 + 127];
#pragma unroll
            for (int i = 0; i < 8; ++i) sc[i] = DTV[hd * 128 + 8 * tb + i] * __expf(al - ACUM[hd * 128 + 8 * tb + i]);
            conv8x8<false>(a, b, t0 + 8 * tb, g * 256 + 8 * cg, XDT + (8 * cg) * LDA + 8 * tb, sc); }
        else {
#pragma unroll
            for (int i = 0; i < 8; ++i) sc[i] = 1.0f;
            conv8x8<false>(a, b, t0 + 8 * tb, 512 + g * 128 + 8 * (cg - 32), BMT + (8 * (cg - 32)) * LDA + 8 * tb, sc); }
    }
    __syncthreads();
    const int hd = wave >> 1, pt = wave & 1, hh = lane >> 5, r = lane & 31;
    float* U = (float*)(a.ws + WS_USSD) + (size_t)u * 32768;
#pragma unroll
    for (int nt = 0; nt < 4; ++nt) { f32x16 acc = zero16(); mma32(acc, XDT + (hd * 64 + 32 * pt) * LDA, LDA, BMT + 32 * nt * LDA, LDA, 8, lane);
#pragma unroll
        for (int i = 0; i < 16; ++i) U[(hd * 64 + 32 * pt + crow(i, hh)) * 128 + 32 * nt + r] = acc[i]; }
    if (tid < 4) ((float*)(a.ws + WS_DEC))[u * 4 + tid] = __expf(ACUM[tid * 128 + 127]);
    __syncthreads();
}
constexpr int S2_CM = 0, S2_CBT = 34816, S2_BUF = 55296, S2_BUFSZ = 34816, S2_BM = S2_BUF + S2_BUFSZ, S2_YS = 124928, S2_ACUM = 143360, S2_DTV = 145408;
__device__ __forceinline__ void ssd_stage_head(const Args& a, LAS unsigned char* lds, int u, int b, int g, int t0, int hd, int buf, int tid256, const float* ones) {
    LAS bf16* XT = (LAS bf16*)(lds + S2_BUF + buf * S2_BUFSZ); LAS bf16* SIN = XT + 64 * LDA;
    const int c8 = tid256 & 7, tb = tid256 >> 3;
    conv8x8<false, false, 4>(a, b, t0 + 4 * tb, g * 256 + hd * 64 + 8 * c8, XT + (8 * c8) * LDA + 4 * tb, ones);
    const v4u* src = (const v4u*)((const bf16*)(a.ws + WS_SSSD) + (size_t)u * 32768) + (unsigned)(hd * 64 * 16);
#pragma unroll
    for (int j = 0; j < 4; ++j) { const int piece = tid256 + 256 * j, pr = piece >> 4, c = piece & 15; *(LAS v4u*)(SIN + pr * LDA + 8 * c) = __builtin_nontemporal_load(src + piece); }
}
__device__ __forceinline__ void ssd_passC(const Args& a, LAS unsigned char* lds, int u, int tid, int wave, int lane) {
    const int bg = u >> 6, c = u & 63, b = bg >> 1, g = bg & 1, t0 = c * 128; const size_t row0 = (size_t)b * SEQ + t0;
    LAS bf16* CM = (LAS bf16*)(lds + S2_CM); LAS bf16* BM = (LAS bf16*)(lds + S2_BM); LAS unsigned char* CBT = lds + S2_CBT;
    LAS bf16* YS = (LAS bf16*)(lds + S2_YS); LAS float* ACUM = (LAS float*)(lds + S2_ACUM); LAS float* DTV = (LAS float*)(lds + S2_DTV);
    const bf16* P = (const bf16*)(a.ws + WS_P); bf16* MIX = (bf16*)(a.ws + WS_MIX);
    float ones[4];
#pragma unroll
    for (int i = 0; i < 4; ++i) ones[i] = 1.0f;
    ssd_scan_dt_at(a, lds, S2_ACUM, S2_DTV, row0, g, wave, lane);
    { const int c8 = tid & 31, tb = tid >> 5;
      conv8x8<true>(a, b, t0 + 8 * tb, (c8 < 16) ? (512 + g * 128 + 8 * c8) : (768 + g * 128 + 8 * (c8 - 16)), ((c8 < 16) ? (BM + 8 * c8) : (CM + 8 * (c8 - 16))) + 8 * tb * LDA, nullptr); }
    __syncthreads();
    for (int idx = wave; idx < 10; idx += NWAVES) { const int ti = (idx >= 6) ? 3 : (idx >= 3) ? 2 : (idx >= 1) ? 1 : 0, si = idx - ti * (ti + 1) / 2;
        f32x16 cbT = zero16(); mma32(cbT, BM + 32 * si * LDA, LDA, CM + 32 * ti * LDA, LDA, 8, lane);
        v4u o0, o1; o0.x = pk2(cbT[0], cbT[1]); o0.y = pk2(cbT[2], cbT[3]); o0.z = pk2(cbT[4], cbT[5]); o0.w = pk2(cbT[6], cbT[7]); o1.x = pk2(cbT[8], cbT[9]); o1.y = pk2(cbT[10], cbT[11]); o1.z = pk2(cbT[12], cbT[13]); o1.w = pk2(cbT[14], cbT[15]);
        *(LAS v4u*)(CBT + idx * 2048 + lane * 32) = o0; *(LAS v4u*)(CBT + idx * 2048 + lane * 32 + 16) = o1; }
    if (tid < 256) ssd_stage_head(a, lds, u, b, g, t0, 0, 0, tid, ones);
    __syncthreads();
    const int ti = (wave < 4) ? (wave >> 1) : (3 - ((wave - 4) >> 1)), pj = wave & 1;
    const int et = tid >> 2, epq = tid & 3;
    float ssq = 0.f;
    const bf16* Pz = P + (row0 + et) * NPROJ + PC_Z + g * 256 + 16 * epq;
    bf16* Mo = MIX + (row0 + et) * D + 512 + g * 256 + 16 * epq;
    SUBSTAMP(15);
#pragma unroll 1
    for (int hd = 0; hd < 4; ++hd) {
        int tid_o = tid; asm volatile("" : "+v"(tid_o));
        const int lane = tid_o & 63, hh = lane >> 5, r = lane & 31;
        const LAS bf16* XT = (const LAS bf16*)(lds + S2_BUF + (hd & 1) * S2_BUFSZ); const LAS bf16* SIN = XT + 64 * LDA;
        const v4u z0 = __builtin_nontemporal_load((const v4u*)(Pz + hd * 64)), z1 = __builtin_nontemporal_load((const v4u*)(Pz + hd * 64 + 8));
        const float Dh = a.in[I_SSMD][g * 4 + hd];
        f32x16 yi = zero16(), yo = zero16();
        const int t = 32 * ti + r; const float at = ACUM[hd * 128 + t];
        for (int si = 0; si <= ti; ++si) {
            const LAS unsigned char* cp = CBT + (ti * (ti + 1) / 2 + si) * 2048 + lane * 32; const v4u c0 = *(const LAS v4u*)cp, c1 = *(const LAS v4u*)(cp + 16);
            const unsigned cw[8] = {c0.x, c0.y, c0.z, c0.w, c1.x, c1.y, c1.z, c1.w};
            float sv[16];
#pragma unroll
            for (int gq = 0; gq < 4; ++gq) { const int s0 = 32 * si + 8 * gq + 4 * hh;
                const f32x4 a4 = *(const LAS f32x4*)(ACUM + hd * 128 + s0), d4 = *(const LAS f32x4*)(DTV + hd * 128 + s0);
#pragma unroll
                for (int q = 0; q < 4; ++q) { const int i = 4 * gq + q, s = s0 + q; float v = (s <= t) ? bfw(cw[i >> 1], i & 1) * __expf(at - a4[q]) * d4[q] : 0.f; sv[i] = (s == t) ? v + Dh : v; } }
#pragma unroll
            for (int st = 0; st < 2; ++st) {
                v4u av;
                asm volatile("v_cvt_pk_bf16_f32 %0, %4, %5\n\tv_cvt_pk_bf16_f32 %1, %6, %7\n\tv_cvt_pk_bf16_f32 %2, %8, %9\n\tv_cvt_pk_bf16_f32 %3, %10, %11\n\ts_nop 1"
                             : "=&v"(av.x), "=&v"(av.y), "=&v"(av.z), "=&v"(av.w)
                             : "v"(sv[8 * st]), "v"(sv[8 * st + 1]), "v"(sv[8 * st + 2]), "v"(sv[8 * st + 3]), "v"(sv[8 * st + 4]), "v"(sv[8 * st + 5]), "v"(sv[8 * st + 6]), "v"(sv[8 * st + 7]));
                const LAS bf16* bp = XT + (32 * pj + r) * LDA + 32 * si + 16 * st + 4 * hh;
                const unsigned long long b0 = *(const LAS unsigned long long*)bp, b1 = *(const LAS unsigned long long*)(bp + 8);
                v4u bv; bv.x = (unsigned)b0; bv.y = (unsigned)(b0 >> 32); bv.z = (unsigned)b1; bv.w = (unsigned)(b1 >> 32);
                yi = __builtin_amdgcn_mfma_f32_32x32x16_bf16(__builtin_bit_cast(bf16x8, av), __builtin_bit_cast(bf16x8, bv), yi, 0, 0, 0);
            }
        }
        mma32(yo, CM + 32 * ti * LDA, LDA, SIN + 32 * pj * LDA, LDA, 8, lane);
#pragma unroll
        for (int i = 0; i < 16; ++i) { const int tt = 32 * ti + crow(i, hh); YS[tt * 72 + 32 * pj + r] = (bf16)f2bf(yi[i] + __expf(ACUM[hd * 128 + tt]) * yo[i]); }
        if (tid_o < 256 && hd < 3) ssd_stage_head(a, lds, u, b, g, t0, hd + 1, (hd + 1) & 1, tid_o, ones);
        __syncthreads();
        if (hd == 1) SUBSTAMP(20);
        { const LAS v4u* yp = (const LAS v4u*)(YS + et * 72 + 16 * epq); const v4u y0 = yp[0], y1 = yp[1];
          const unsigned yw[8] = {y0.x, y0.y, y0.z, y0.w, y1.x, y1.y, y1.z, y1.w}, zw[8] = {z0.x, z0.y, z0.z, z0.w, z1.x, z1.y, z1.z, z1.w};
          float y[16];
#pragma unroll
          for (int j = 0; j < 16; ++j) { y[j] = bfw(yw[j >> 1], j & 1) * bfw(zw[j >> 1], j & 1); ssq += y[j] * y[j]; }
          v4u o0, o1; o0.x = pk2(y[0], y[1]); o0.y = pk2(y[2], y[3]); o0.z = pk2(y[4], y[5]); o0.w = pk2(y[6], y[7]); o1.x = pk2(y[8], y[9]); o1.y = pk2(y[10], y[11]); o1.z = pk2(y[12], y[13]); o1.w = pk2(y[14], y[15]);
          *(v4u*)(Mo + hd * 64) = o0; *(v4u*)(Mo + hd * 64 + 8) = o1; }
        __syncthreads();
        SUBSTAMP(16 + hd);
    }
    ssq += __shfl_xor(ssq, 1); ssq += __shfl_xor(ssq, 2);
    const float rstd = rsqrtf(ssq * (1.0f / 256.0f) + EPS);
    const float* nw = a.in[I_SSMNW] + g * 256 + 16 * epq;
    v4u rb[8];
#pragma unroll
    for (int hd = 0; hd < 4; ++hd) { rb[2 * hd] = *(const v4u*)(Mo + hd * 64); rb[2 * hd + 1] = *(const v4u*)(Mo + hd * 64 + 8); }
#pragma unroll
    for (int hd = 0; hd < 4; ++hd) {
        const unsigned iw[8] = {rb[2 * hd].x, rb[2 * hd].y, rb[2 * hd].z, rb[2 * hd].w, rb[2 * hd + 1].x, rb[2 * hd + 1].y, rb[2 * hd + 1].z, rb[2 * hd + 1].w};
        float wv[16];
#pragma unroll
        for (int q = 0; q < 4; ++q) { const f32x4 v = *(const f32x4*)(nw + hd * 64 + 4 * q); wv[4 * q] = v.x; wv[4 * q + 1] = v.y; wv[4 * q + 2] = v.z; wv[4 * q + 3] = v.w; }
        unsigned ow[8];
#pragma unroll
        for (int j = 0; j < 8; ++j) ow[j] = pk2(bfw(iw[j], 0) * rstd * wv[2 * j], bfw(iw[j], 1) * rstd * wv[2 * j + 1]);
        *(v4u*)(Mo + hd * 64) = (v4u){ow[0], ow[1], ow[2], ow[3]}; *(v4u*)(Mo + hd * 64 + 8) = (v4u){ow[4], ow[5], ow[6], ow[7]};
    }
    __syncthreads();
}
__device__ __forceinline__ void mix_scan(const Args& a, int bid, int G, int tid) {
    typedef float f32x2 __attribute__((ext_vector_type(2)));
    for (int gt = bid * NTHR + tid; gt < 131072; gt += G * NTHR) {
        if (gt < 65536) { const int bh = gt >> 13, e2 = gt & 8191, k = e2 >> 6;
            const f32x2* U = (const f32x2*)(a.ws + WS_UHG) + (size_t)bh * 32 * 8192 + e2; f32x2* SI = (f32x2*)(a.ws + WS_SHG) + (size_t)bh * 32 * 8192 + e2; const float* DK = (const float*)(a.ws + WS_DK) + bh * 32 * 128 + k;
            f32x2 cur = {0.f, 0.f};
#pragma unroll 16
            for (int uu = 0; uu < 32; ++uu) { SI[(size_t)uu * 8192] = cur; cur = cur * DK[uu * 128] + __builtin_nontemporal_load(U + (size_t)uu * 8192); }
        } else { const int q = gt - 65536, bg = q >> 14, e2 = q & 16383, hd = e2 >> 12;
            const f32x2* U = (const f32x2*)(a.ws + WS_USSD) + (size_t)bg * 64 * 16384 + e2; unsigned* SI = (unsigned*)(a.ws + WS_SSSD) + (size_t)bg * 64 * 16384 + e2; const float* DEC = (const float*)(a.ws + WS_DEC) + bg * 64 * 4 + hd;
            f32x2 cur = {0.f, 0.f};
#pragma unroll 16
            for (int cc = 0; cc < 64; ++cc) { SI[(size_t)cc * 16384] = pk2(cur.x, cur.y); cur = cur * DEC[cc * 4] + __builtin_nontemporal_load(U + (size_t)cc * 16384); }
        }
    }
}

template <int HALF, int MASK> __device__ __forceinline__ void tr_step(float (&p)[32], int lane) {
    const bool up = (lane & MASK) != 0;
#pragma unroll
    for (int i = 0; i < HALF; ++i) { const float lo = p[i], hi = p[i + HALF]; const float send = up ? lo : hi, keep = up ? hi : lo; p[i] = keep + __shfl_xor(send, MASK); }
}
__device__ __forceinline__ void top4_store(float v, int lane, LAS int* SEL, LAS float* SELG, int ent) {
    float tv[4]; int ti[4];
#pragma unroll
    for (int k = 0; k < 4; ++k) { const float mx = wave_max(v); const unsigned long long bal = __ballot(v == mx); const int e = __builtin_ctzll(bal) >> 1;
        tv[k] = mx; ti[k] = e; v = ((lane >> 1) == e) ? -INFINITY : v; }
    const float e1 = __expf(tv[1] - tv[0]), e2 = __expf(tv[2] - tv[0]), e3 = __expf(tv[3] - tv[0]), inv = 1.0f / (1.0f + e1 + e2 + e3);
    if (lane < 4) { SEL[ent + lane] = (lane == 0) ? ti[0] : (lane == 1) ? ti[1] : (lane == 2) ? ti[2] : ti[3];
        SELG[ent + lane] = ((lane == 0) ? 1.0f : (lane == 1) ? e1 : (lane == 2) ? e2 : e3) * inv; }
}
constexpr int RT_WB = 0, RT_HB = 66048, RT_PITCH = 1032;
__device__ __forceinline__ void p5_router(const Args& a, LAS unsigned char* lds, int bid, int G, int tid, int wave, int lane) {
    unsigned char* ws = a.ws;
    LAS bf16* WB = (LAS bf16*)(lds + RT_WB); LAS bf16* HB = (LAS bf16*)(lds + RT_HB); LAS float* PART = (LAS float*)(lds + RT_HB);
    LAS float* A2 = (LAS float*)(lds + AUX_OFF + 1024); LAS float* S2 = A2 + 1024;
    LAS float* SELG = (LAS float*)(S2 + 1024); LAS float* LOGIT = SELG + 256;
    LAS int* SEL = (LAS int*)(lds + MISC_OFF + 2048); LAS int* LSL = SEL + 256;
    const float* modf = (const float*)(ws + WS_MODF);
    { const f32x4* rw4 = (const f32x4*)a.in[I_RW];
#pragma unroll 4
      for (int it = 0; it < 16; ++it) { const int q = tid + NTHR * it, k = q >> 3, e0 = (q & 7) * 4; const f32x4 w = rw4[q];
          WB[(e0 + 0) * RT_PITCH + k] = (bf16)f2bf(w.x); WB[(e0 + 1) * RT_PITCH + k] = (bf16)f2bf(w.y); WB[(e0 + 2) * RT_PITCH + k] = (bf16)f2bf(w.z); WB[(e0 + 3) * RT_PITCH + k] = (bf16)f2bf(w.w); } }
    const bf16* x1 = (const bf16*)(ws + WS_X1); bf16* H = (bf16*)(ws + WS_H);
    int* tok_e = (int*)(ws + WS_TOK); int* tok_ls = tok_e + M * 4; float* tok_g = (float*)(tok_ls + M * 4);
    int* blkcnt = (int*)(ws + WS_BLKCNT);
    for (int c = bid; c < NCHUNK; c += G) {
        const int b = c >> 7;
        __syncthreads();
        load_mod_AS(A2, S2, a.in[I_N2W], modf, 1, nullptr, b, 3 * 1024, tid);
        __syncthreads();
        unsigned long long hb[8][4];
        unsigned long long rwa[4];
        { const GAS unsigned long long* xa = (const GAS unsigned long long*)(x1 + (size_t)(c * 64 + wave * 8) * D) + lane;
#pragma unroll
          for (int j = 0; j < 4; ++j) rwa[j] = xa[64 * j]; }
#pragma unroll
        for (int r = 0; r < 8; ++r) {
            const int m0 = c * 64 + wave * 8 + r;
            f32x4 va[4]; float sa = 0.f;
#pragma unroll
            for (int j = 0; j < 4; ++j) { const unsigned long long wa = rwa[j];
                va[j] = (f32x4){bfw((unsigned)wa, 0), bfw((unsigned)wa, 1), bfw((unsigned)(wa >> 32), 0), bfw((unsigned)(wa >> 32), 1)};
                sa += (va[j].x * va[j].x + va[j].y * va[j].y) + (va[j].z * va[j].z + va[j].w * va[j].w); }
            if (r < 7) { const GAS unsigned long long* xa = (const GAS unsigned long long*)(x1 + (size_t)(m0 + 1) * D) + lane;
#pragma unroll
                for (int j = 0; j < 4; ++j) rwa[j] = xa[64 * j]; }
            const float ra = rsqrtf(wave_sum(sa) * (1.0f / D) + EPS);
#pragma unroll
            for (int j = 0; j < 4; ++j) {
                const f32x4 av = *(const LAS f32x4*)(A2 + 256 * j + 4 * lane), sv = *(const LAS f32x4*)(S2 + 256 * j + 4 * lane);
                const f32x4 h = va[j] * ra * av + sv;
#if MOE_FP8_G1
                ((GAS unsigned*)((unsigned char*)H + (size_t)m0 * D))[lane + 64 * j] = pk4_fp8(h.x * 8.f, h.y * 8.f, h.z * 8.f, h.w * 8.f);
#else
                ((GAS unsigned long long*)(H + (size_t)m0 * D))[lane + 64 * j] = (unsigned long long)pk2(h.x, h.y) | ((unsigned long long)pk2(h.z, h.w) << 32);
#endif
                hb[r][j] = (unsigned long long)pk2(h.x, h.y) | ((unsigned long long)pk2(h.z, h.w) << 32);
            }
        }
#pragma unroll
        for (int pass = 0; pass < 2; ++pass) {
            if ((wave >> 2) == pass) {
#pragma unroll
                for (int r = 0; r < 8; ++r)
#pragma unroll
                    for (int j = 0; j < 4; ++j) *(LAS unsigned long long*)(HB + ((wave & 3) * 8 + r) * RT_PITCH + 256 * j + 4 * lane) = hb[r][j]; }
            __syncthreads();
            f32x16 acc = zero16(); mma32(acc, HB + 128 * wave, RT_PITCH, WB + 128 * wave, RT_PITCH, 8, lane);
            __syncthreads();
#pragma unroll
            for (int i = 0; i < 16; ++i) PART[wave * 1024 + crow(i, lane >> 5) * 32 + (lane & 31)] = acc[i];
            __syncthreads();
#pragma unroll
            for (int q = 0; q < 2; ++q) { const int el = tid + NTHR * q; float sacc = 0.f;
#pragma unroll
                for (int w = 0; w < 8; ++w) sacc += PART[w * 1024 + el];
                LOGIT[(el >> 5) * 33 + (el & 31)] = sacc + a.in[I_RB][el & 31]; }
            __syncthreads();
            if (tid < 32) {
                float v[32];
#pragma unroll
                for (int e = 0; e < 32; ++e) v[e] = LOGIT[tid * 33 + e];
                float tv[4]; int ti[4];
#pragma unroll
                for (int k = 0; k < 4; ++k) { float best = v[0]; int bi = 0;
#pragma unroll
                    for (int e = 1; e < 32; ++e) { const bool gt = v[e] > best; best = gt ? v[e] : best; bi = gt ? e : bi; }
                    tv[k] = best; ti[k] = bi;
#pragma unroll
                    for (int e = 0; e < 32; ++e) v[e] = (e == bi) ? -INFINITY : v[e]; }
                const float e1 = __expf(tv[1] - tv[0]), e2 = __expf(tv[2] - tv[0]), e3 = __expf(tv[3] - tv[0]), inv = 1.0f / (1.0f + e1 + e2 + e3);
                const int ent = (32 * pass + tid) * 4;
                SEL[ent] = ti[0]; SEL[ent + 1] = ti[1]; SEL[ent + 2] = ti[2]; SEL[ent + 3] = ti[3];
                SELG[ent] = inv; SELG[ent + 1] = e1 * inv; SELG[ent + 2] = e2 * inv; SELG[ent + 3] = e3 * inv; }
        }
        __syncthreads();
        if (tid < 256 + 32) {
            const int mye = (tid < 256) ? SEL[tid] : (tid - 256), lim = (tid < 256) ? tid : 256; int cnt = 0;
#pragma unroll 4
            for (int j4 = 0; j4 < 64; ++j4) { const LAS int* sp = SEL + 4 * j4; const int s0 = sp[0], s1 = sp[1], s2 = sp[2], s3 = sp[3];
                cnt += (s0 == mye && 4 * j4 < lim) + (s1 == mye && 4 * j4 + 1 < lim) + (s2 == mye && 4 * j4 + 2 < lim) + (s3 == mye && 4 * j4 + 3 < lim); }
            if (tid < 256) LSL[tid] = cnt; else blkcnt[c * 32 + tid - 256] = cnt; }
        __syncthreads();
        if (tid < 256) { const size_t o = (size_t)c * 256 + tid; tok_e[o] = SEL[tid]; tok_ls[o] = LSL[tid]; tok_g[o] = SELG[tid]; }
    }
}

__device__ __forceinline__ void moe_tables(const Args& a, LAS unsigned char* lds, int c, int tid, int wave, int lane) {
    LAS int* TS = (LAS int*)(lds + MISC_OFF + 256); LAS int* RT2E = TS + 64; LAS int* BASE = (LAS int*)(lds + AUX_OFF); LAS int* PART = BASE + 64;
    const int* blkcnt = (const int*)(a.ws + WS_BLKCNT);
    { const int e = tid & 31, part = tid >> 5; int tot = 0, bs = 0;
#pragma unroll
      for (int i = 0; i < 16; ++i) { const int cc = part * 16 + i; const int v = blkcnt[cc * 32 + e]; tot += v; bs += (cc < c) ? v : 0; }
      PART[part * 32 + e] = tot; PART[512 + part * 32 + e] = bs; }
    __syncthreads();
    if (wave == 0) {
        int total = 0, base = 0;
        if (lane < 32) {
#pragma unroll
            for (int p = 0; p < 16; ++p) { total += PART[p * 32 + lane]; base += PART[512 + p * 32 + lane]; } }
        const int tiles = (lane < 32) ? ((total + 255) >> 8) : 0;
        int incl = tiles;
#pragma unroll
        for (int o = 1; o < 32; o <<= 1) { const int t = __shfl_up(incl, o); if (lane >= o) incl += t; }
        const int start = incl - tiles;
        if (lane < 32) { TS[lane] = start; BASE[lane] = start * 256 + base; for (int t = start; t < incl; ++t) RT2E[t] = lane; }
        if (lane == 31) TS[32] = incl;
    }
    __syncthreads();
}
__device__ __forceinline__ void p6_gather(const Args& a, LAS unsigned char* lds, int bid, int G, int tid, int wave, int lane) {
    unsigned char* ws = a.ws;
    LAS int* BASE = (LAS int*)(lds + AUX_OFF);
    const int* tok_e = (const int*)(ws + WS_TOK); const int* tok_ls = tok_e + M * 4; int* tok_pos = (int*)(ws + WS_TOK) + 3 * M * 4;
    const bf16* H = (const bf16*)(ws + WS_H); bf16* XG = (bf16*)(ws + WS_XG);
    if (bid >= NCHUNK) moe_tables(a, lds, NCHUNK, tid, wave, lane);
    for (int c = bid; c < NCHUNK; c += G) {
        __syncthreads();
        moe_tables(a, lds, c, tid, wave, lane);
        LAS int* POS = BASE + 1152;
        if (tid < 256) { const size_t o = (size_t)c * 256 + tid; const int pos = BASE[tok_e[o]] + tok_ls[o]; POS[tid] = pos; tok_pos[o] = pos; }
        __syncthreads();
#if MOE_FP8_G1
        { const unsigned char* Hc = (const unsigned char*)H + (size_t)(c * 64) * D; v4u rw[8];
#pragma unroll
          for (int t = 0; t < 8; ++t) rw[t] = ((const GAS v4u*)(Hc + (size_t)(wave * 8 + t) * D))[lane];
#pragma unroll
          for (int t = 0; t < 8; ++t)
#pragma unroll
            for (int k = 0; k < 4; ++k) ((GAS v4u*)((unsigned char*)XG + (size_t)POS[(wave * 8 + t) * 4 + k] * D))[lane] = rw[t]; }
#else
        for (int i = wave; i < 256; i += NWAVES) { const int pos = POS[i];
            const GAS v4u* src = (const GAS v4u*)(H + (size_t)(c * 64 + (i >> 2)) * D); GAS v4u* dst = (GAS v4u*)(XG + (size_t)pos * D);
            dst[lane] = src[lane]; dst[64 + lane] = src[64 + lane]; }
#endif
    }
}

__device__ __forceinline__ void p9_final(const Args& a, int bid, int G, int wave, int lane) {
    unsigned char* ws = a.ws;
    const bf16* x1 = (const bf16*)(ws + WS_X1); const bf16* Y = (const bf16*)(ws + WS_XG);
    const float* tok_g = (const float*)(ws + WS_TOK) + 2 * M * 4; const int* tok_pos = (const int*)(ws + WS_TOK) + 3 * M * 4;
    const float* modf = (const float*)(ws + WS_MODF); const float* fnw = a.in[I_FNW]; float* out = a.out;
    const int gw = bid * NWAVES + wave, NGW = G * NWAVES;
    int pos_n[4]; float gk_n[4];
    if (gw < M) {
#pragma unroll
        for (int k = 0; k < 4; ++k) { pos_n[k] = tok_pos[(size_t)gw * 4 + k]; gk_n[k] = tok_g[(size_t)gw * 4 + k]; } }
#pragma unroll 1
    for (int m = gw; m < M; m += NGW) {
        const int b = m >> 13; const float* g2 = modf + b * 6144 + 5 * 1024;
        int posv[4]; float gkv[4];
#pragma unroll
        for (int k = 0; k < 4; ++k) { posv[k] = pos_n[k]; gkv[k] = gk_n[k]; }
        if (m + NGW < M) {
#pragma unroll
            for (int k = 0; k < 4; ++k) { pos_n[k] = tok_pos[(size_t)(m + NGW) * 4 + k]; gk_n[k] = tok_g[(size_t)(m + NGW) * 4 + k]; } }
        f32x4 mo[4];
#pragma unroll
        for (int j = 0; j < 4; ++j) mo[j] = (f32x4){0.f, 0.f, 0.f, 0.f};
#pragma unroll
        for (int k = 0; k < 4; ++k) { const int pos = posv[k];
#if Y_FP8
            const float gk = gkv[k] * 0.125f;
            const GAS unsigned* yr = (const GAS unsigned*)((const unsigned char*)Y + (size_t)pos * D) + lane;
#pragma unroll
            for (int j = 0; j < 4; ++j) { const int w = (int)__builtin_nontemporal_load((const unsigned*)yr + 64 * j); typedef float f32x2 __attribute__((ext_vector_type(2)));
                const f32x2 lo = __builtin_amdgcn_cvt_pk_f32_fp8(w, false), hi = __builtin_amdgcn_cvt_pk_f32_fp8(w, true);
                mo[j].x += gk * lo.x; mo[j].y += gk * lo.y; mo[j].z += gk * hi.x; mo[j].w += gk * hi.y; }
#else
            const float gk = gkv[k];
            const GAS unsigned long long* yr = (const GAS unsigned long long*)(Y + (size_t)pos * D) + lane;
#pragma unroll
            for (int j = 0; j < 4; ++j) { const unsigned long long w = yr[64 * j]; const unsigned lo = (unsigned)w, hi = (unsigned)(w >> 32);
                mo[j].x += gk * __uint_as_float(lo << 16); mo[j].y += gk * __uint_as_float(lo & 0xffff0000u); mo[j].z += gk * __uint_as_float(hi << 16); mo[j].w += gk * __uint_as_float(hi & 0xffff0000u); }
#endif
        }
        const GAS unsigned long long* xr = (const GAS unsigned long long*)(x1 + (size_t)m * D) + lane;
        f32x4 v[4]; float ss = 0.f;
#pragma unroll
        for (int j = 0; j < 4; ++j) { const f32x4 gv = *(const f32x4*)(g2 + 256 * j + 4 * lane); const unsigned long long xw = __builtin_nontemporal_load((const unsigned long long*)xr + 64 * j);
            v[j] = (f32x4){bfw((unsigned)xw, 0), bfw((unsigned)xw, 1), bfw((unsigned)(xw >> 32), 0), bfw((unsigned)(xw >> 32), 1)} + gv * mo[j]; ss += (v[j].x * v[j].x + v[j].y * v[j].y) + (v[j].z * v[j].z + v[j].w * v[j].w); }
        const float rstd = rsqrtf(wave_sum(ss) * (1.0f / D) + EPS);
        GAS f32x4* orow = (GAS f32x4*)(out + (size_t)m * D) + lane;
#pragma unroll
        for (int j = 0; j < 4; ++j) { const f32x4 wv = *(const f32x4*)(fnw + 256 * j + 4 * lane); __builtin_nontemporal_store(v[j] * rstd * wv, (f32x4*)(out + (size_t)m * D) + lane + 64 * j); }
    }
}

#ifndef REP_MASK
#define REP_MASK 0
#endif
#define NREP(k) (((REP_MASK) >> (k)) & 1 ? 2 : 1)
#define REPB(k, rr) do { if ((rr) + 1 < NREP(k) && multi) { if ((k) >= 9) { LANE_TID(); xcd_barrier(bar, tid == 0); } else xcd_barrier(bar, tid == 0); } } while (0)
#ifndef SKEW_TICKS
#define SKEW_TICKS 0
#endif
#define PHASE_SKEW() do { if (SKEW_TICKS > 0) { const unsigned long long t0_ = __builtin_amdgcn_s_memrealtime(), w_ = (unsigned long long)(bid & 3) * SKEW_TICKS; while (__builtin_amdgcn_s_memrealtime() - t0_ < w_) __builtin_amdgcn_s_sleep(2); } } while (0)
#ifndef HG_CHUNKED
#define HG_CHUNKED 1
#endif
#ifndef SSD_CHUNKED
#define SSD_CHUNKED 1
#endif
constexpr int NPHASE = 12;
__global__ void __launch_bounds__(NTHR, 2) mk_fwd(Args args) {
    extern __shared__ __attribute__((aligned(16))) unsigned char lds_raw[];
    LAS unsigned char* lds = (LAS unsigned char*)lds_raw;
    const int tid = threadIdx.x, lane = tid & 63, wave = __builtin_amdgcn_readfirstlane(tid >> 6); __builtin_assume(wave >= 0 && wave < 8);
#define LANE_TID() int lane; asm volatile("v_mbcnt_lo_u32_b32 %0, -1, 0\n\tv_mbcnt_hi_u32_b32 %0, -1, %0" : "=v"(lane)); __builtin_assume(lane >= 0 && lane < 64); const int tid = wave * 64 + lane; (void)tid
    const int G = gridDim.x, bid = blockIdx.x;
    unsigned char* ws = args.ws;
    gu32* ctl = (gu32*)(ws + WS_CTL);
    volatile LAS unsigned* MISC = (volatile LAS unsigned*)(lds + MISC_OFF);
    if (tid < 64) MISC[tid] = 0u;
    __syncthreads();
    const int lo = args.ph_lo, hi = args.ph_hi;
    const bool multi = (hi - lo) > 1;
    XcdBarrier bar; bar.bar = (unsigned*)(ctl + CW_BAR); bar.x = 0; bar.st = nullptr;
    if (multi) bar = xcd_barrier_post((unsigned*)(ctl + CW_BAR), MISC + 8, tid == 0);
#define IN(k) (lo <= (k) && (k) < hi)
#ifdef PROBE_A
#ifndef PROBE_BUSY
#define PROBE_BUSY 0
#endif
#define STAMP(k) do { int tid_s; if ((k) >= 9) { LANE_TID(); tid_s = tid; } else tid_s = tid; if (tid_s == 0) { const unsigned long long t_ = __builtin_amdgcn_s_memrealtime(); MISC[16 + 2 * (k)] = (unsigned)t_; MISC[17 + 2 * (k)] = (unsigned)(t_ >> 32); } } while (0)
#define ARRIVE(k) do { int tid_s; if ((k) >= 9) { LANE_TID(); tid_s = tid; } else tid_s = tid; if (tid_s == 0 && (k) == PROBE_A) { const unsigned long long t_ = __builtin_amdgcn_s_memrealtime(); const unsigned long long s_ = ((unsigned long long)MISC[17 + 2 * (k)] << 32) | MISC[16 + 2 * (k)]; \
    const unsigned busy = (unsigned)(t_ - s_); atomicMax((unsigned*)ctl + 3000, busy); atomicAdd((unsigned*)ctl + 3064, busy); } } while (0)
#else
#define STAMP(k) do { } while (0)
#define ARRIVE(k) do { } while (0)
#endif
#define SEAM(k) do { ARRIVE(k); if (IN(k) && IN((k) + 1)) { if ((k) >= 8) { LANE_TID(); xcd_barrier(bar, tid == 0); } else xcd_barrier(bar, tid == 0); } STAMP((k) + 1); } while (0)

    STAMP(0);
    if (IN(0)) { for (int rr_ = 0; rr_ < NREP(0); ++rr_) { p0_prologue(args, lds, bid, G, tid, wave, lane);  REPB(0, rr_); } } SEAM(0);
    if (IN(1)) { for (int rr_ = 0; rr_ < NREP(1); ++rr_) { p1_norm(args, lds, bid, G, tid, wave, lane);  REPB(1, rr_); } } SEAM(1);
    if (IN(2)) { for (int rr_ = 0; rr_ < NREP(2); ++rr_) {
        pg8::Gemm g{(const pg8::bf16_t*)(ws + WS_H), (const pg8::bf16_t*)(ws + WS_WIN), M, NPROJ, D}; pg8::StaticOrder S; S.init(M, NPROJ, G, bid);
        pg8::EpiIn E{(pg8::bf16_t*)(ws + WS_P), (float*)(ws + WS_LF), args.in[I_LBL]};
#ifdef PROBE_G
        if (threadIdx.x == 0) MISC[61] = (PROBE_G == 2) ? 1u : 0u; __syncthreads();
#endif
        pg8::gemm_phase<pg8::EpiIn, pg8::StaticOrder, true, true>(lds, g, S, E, wave);
        __syncthreads(); p0_bg_items(args, lds, bid, G, tid, wave, lane);
     REPB(2, rr_); } } SEAM(2);
    if (IN(3)) { for (int rr_ = 0; rr_ < NREP(3); ++rr_) {
        const int cpos = bid % 3;
        if (cpos == 0) { int tq5_ = tid; asm volatile("" : "+v"(tq5_)); deferred_cvt_items(args, lds, bid, G, 0, tq5_, wave, tq5_ & 63); }
        for (int u = bid; u < 256; u += G) {
            __syncthreads();
#if HG_CHUNKED
            { int tq1_ = tid; asm volatile("" : "+v"(tq1_)); hg_passA(args, lds, u, tq1_, wave, tq1_ & 63); }
            STAMP(14);
#endif
            __syncthreads();
            if (cpos == 1 && u == bid) { int tq6_ = tid; asm volatile("" : "+v"(tq6_)); deferred_cvt_items(args, lds, bid, G, 0, tq6_, wave, tq6_ & 63); }
            __syncthreads();
#if SSD_CHUNKED
            { int tq2_ = tid; asm volatile("" : "+v"(tq2_)); ssd_passA(args, lds, u, tq2_, wave, tq2_ & 63); }
#endif
        }
        __syncthreads();
        if (cpos == 2) { int tq7_ = tid; asm volatile("" : "+v"(tq7_)); deferred_cvt_items(args, lds, bid, G, 0, tq7_, wave, tq7_ & 63); }
     REPB(3, rr_); } } SEAM(3);
    if (IN(4)) { for (int rr_ = 0; rr_ < NREP(4); ++rr_) { mix_scan(args, bid, G, tid);  REPB(4, rr_); } } SEAM(4);
    if (IN(5)) { for (int rr_ = 0; rr_ < NREP(5); ++rr_) {
        const int cpos = bid % 3;
        if (cpos == 0) { int tq8_ = tid; asm volatile("" : "+v"(tq8_)); deferred_cvt_items(args, lds, bid, G, 1, tq8_, wave, tq8_ & 63); }
        for (int u = bid; u < 256; u += G) {
            __syncthreads();
#if HG_CHUNKED
            { int tq3_ = tid; asm volatile("" : "+v"(tq3_)); hg_passC(args, lds, u, tq3_, wave, tq3_ & 63); }
            STAMP(13);
#else
            if (u < 8) hgrn_naive(args, lds, u, tid, wave, lane);
#endif
            __syncthreads();
            if (cpos == 1 && u == bid) { int tq9_ = tid; asm volatile("" : "+v"(tq9_)); deferred_cvt_items(args, lds, bid, G, 1, tq9_, wave, tq9_ & 63); }
            __syncthreads();
#if SSD_CHUNKED
            { int tq4_ = tid; asm volatile("" : "+v"(tq4_)); ssd_passC(args, lds, u, tq4_, wave, tq4_ & 63); }
#else
            if (u >= 8 && u < 12) ssd_naive(args, lds, u - 8, tid, wave, lane);
#endif
        }
        __syncthreads();
        if (cpos == 2) { int tq10_ = tid; asm volatile("" : "+v"(tq10_)); deferred_cvt_items(args, lds, bid, G, 1, tq10_, wave, tq10_ & 63); }
     REPB(5, rr_); } } SEAM(5);
    if (IN(6)) { for (int rr_ = 0; rr_ < NREP(6); ++rr_) {
        pg8::Gemm g{(const pg8::bf16_t*)(ws + WS_MIX), (const pg8::bf16_t*)(ws + WS_WOUT), M, D, D}; pg8::StaticOrder S; S.init(M, D, G, bid);
        pg8::EpiOut E{args.in[I_X], (pg8::bf16_t*)(ws + WS_X1), (const float*)(ws + WS_MODF) + 2 * 1024};
#ifdef PROBE_G
        if (threadIdx.x == 0) MISC[61] = (PROBE_G == 6) ? 1u : 0u; __syncthreads();
#endif
        pg8::gemm_phase<pg8::EpiOut, pg8::StaticOrder, true, true>(lds, g, S, E, wave);
     REPB(6, rr_); } } SEAM(6);
    if (IN(7)) { for (int rr_ = 0; rr_ < NREP(7); ++rr_) { p5_router(args, lds, bid, G, tid, wave, lane);  REPB(7, rr_); } } SEAM(7);
    if (IN(8)) { for (int rr_ = 0; rr_ < NREP(8); ++rr_) { p6_gather(args, lds, bid, G, tid, wave, lane);  REPB(8, rr_); } } SEAM(8);
    if (IN(9) || IN(10)) {
        if (!IN(8)) { LANE_TID(); moe_tables(args, lds, NCHUNK, tid, wave, lane); }
        const PG8_LAS int* TS = (const PG8_LAS int*)(lds + MISC_OFF + 256);
        const int R = __builtin_amdgcn_readfirstlane(TS[32]);
        int kmoe1 = MOE_FP8_G1 ? D / 2 : D, kmoe2 = MOE_FP8_G2 ? D / 2 : D; asm volatile("" : "+s"(kmoe1), "+s"(kmoe2));
        if (IN(9)) { for (int rr_ = 0; rr_ < NREP(9); ++rr_) { LANE_TID();
            pg8::Gemm g{(const pg8::bf16_t*)(ws + WS_XG), (const pg8::bf16_t*)(ws + WS_W1), R * 256, 2048, kmoe1};
            PHASE_SKEW();
            pg8::MoeOrder S{TS + 64, 8, R * 8, G, bid};
            pg8::EpiW1<MOE_FP8_G1 != 0, MOE_FP8_G2 != 0> E{(void*)(ws + WS_ACT), args.in[I_B1]};
#ifdef PROBE_G
        if (threadIdx.x == 0) MISC[61] = (PROBE_G == 9) ? 1u : 0u; __syncthreads();
#endif
            pg8::gemm_phase<pg8::EpiW1<MOE_FP8_G1 != 0, MOE_FP8_G2 != 0>, pg8::MoeOrder, true, true, MOE_FP8_G1 != 0>(lds, g, S, E, wave);
         REPB(9, rr_); } }
        SEAM(9);
        if (IN(10)) { for (int rr_ = 0; rr_ < NREP(10); ++rr_) { LANE_TID();
            pg8::Gemm g{(const pg8::bf16_t*)(ws + WS_ACT), (const pg8::bf16_t*)(ws + WS_W2), R * 256, 1024, kmoe2};
            PHASE_SKEW();
            pg8::MoeOrder S{TS + 64, 4, R * 4, G, bid};
            pg8::EpiW2<Y_FP8 != 0> E{(void*)(ws + WS_XG), args.in[I_B2], MOE_FP8_G2 ? (1.0f / 512.0f) : 1.0f};
#ifdef PROBE_G
        if (threadIdx.x == 0) MISC[61] = (PROBE_G == 10) ? 1u : 0u; __syncthreads();
#endif
            pg8::gemm_phase<pg8::EpiW2<Y_FP8 != 0>, pg8::MoeOrder, true, true, MOE_FP8_G2 != 0>(lds, g, S, E, wave);
         REPB(10, rr_); } }
    }
    SEAM(10);
    if (IN(11)) { for (int rr_ = 0; rr_ < NREP(11); ++rr_) { LANE_TID(); p9_final(args, bid, G, wave, lane);  REPB(11, rr_); } }
#ifdef PROBE_A
    STAMP(12);
    int lpr_; asm volatile("v_mbcnt_lo_u32_b32 %0, -1, 0\n\tv_mbcnt_hi_u32_b32 %0, -1, %0" : "=v"(lpr_)); if (bid == 0 && wave == 0 && lpr_ == 0) {
        const unsigned long long mx = __hip_atomic_load((unsigned*)ctl + 3000, __ATOMIC_RELAXED, __HIP_MEMORY_SCOPE_AGENT);
        const unsigned long long sp = ((((unsigned long long)MISC[17 + 2 * (PROBE_A + 1)] << 32) | MISC[16 + 2 * (PROBE_A + 1)]) - (((unsigned long long)MISC[17 + 2 * PROBE_A] << 32) | MISC[16 + 2 * PROBE_A]));
#ifndef PROBE_B
#define PROBE_B (PROBE_A + 1)
#endif
        const unsigned long long sp2 = ((((unsigned long long)MISC[17 + 2 * (PROBE_B)] << 32) | MISC[16 + 2 * (PROBE_B)]) - (((unsigned long long)MISC[17 + 2 * PROBE_A] << 32) | MISC[16 + 2 * PROBE_A]));
#ifdef PROBE_G
        const unsigned long long wait = 64ull * (unsigned long long)MISC[60], t0 = __builtin_amdgcn_s_memrealtime();
#else
        (void)sp; const unsigned long long wait = 64ull * (PROBE_BUSY ? mx : sp2), t0 = __builtin_amdgcn_s_memrealtime();
#endif
        while (__builtin_amdgcn_s_memrealtime() - t0 < wait) __builtin_amdgcn_s_sleep(4);
    }
#endif
#undef IN
#undef SEAM
}

#ifndef MK_N_LAUNCHES
#define MK_N_LAUNCHES 1
#endif
extern "C" void kernel_launch(void* const* d_in, const int* in_sizes, int n_in, void* d_out, int out_size, void* d_ws, size_t ws_size, hipStream_t stream) {
    static int grid = 0;
    if (grid == 0) {
        if (n_in != 23 || out_size != M * D || ws_size < WS_END) { fprintf(stderr, "kernel_launch: unexpected shapes (n_in %d out %d ws %zu)\n", n_in, out_size, ws_size); grid = -1; return; }
        int dev = 0, cus = 0;
        if (hipGetDevice(&dev) != hipSuccess || hipDeviceGetAttribute(&cus, hipDeviceAttributeMultiprocessorCount, dev) != hipSuccess) { grid = -1; return; }
        if (hipFuncSetAttribute((const void*)mk_fwd, hipFuncAttributeMaxDynamicSharedMemorySize, LDS_BYTES) != hipSuccess) { fprintf(stderr, "kernel_launch: hipFuncSetAttribute failed\n"); grid = -1; return; }
        int per_cu = 0;
        if (hipOccupancyMaxActiveBlocksPerMultiprocessor(&per_cu, (const void*)mk_fwd, NTHR, LDS_BYTES) != hipSuccess || per_cu < 1) fprintf(stderr, "kernel_launch: occupancy query says %d\n", per_cu);
        (void)hipGetLastError();
        grid = cus;
    }
    if (grid < 0) return;
    (void)hipMemsetAsync((char*)d_ws + WS_CTL, 0, CTL_ZERO_BYTES, stream);
    Args a{};
    for (int i = 0; i < 23; ++i) a.in[i] = (const float*)d_in[i];
    a.out = (float*)d_out; a.ws = (unsigned char*)d_ws;
    if (MK_N_LAUNCHES == 1) { a.ph_lo = 0; a.ph_hi = NPHASE; hipLaunchKernelGGL(mk_fwd, dim3(grid), dim3(NTHR), LDS_BYTES, stream, a); }
    else for (int p = 0; p < NPHASE; ++p) { a.ph_lo = p; a.ph_hi = p + 1; hipLaunchKernelGGL(mk_fwd, dim3(grid), dim3(NTHR), LDS_BYTES, stream, a); }
}
```

```cpp
#include <hip/hip_runtime.h>
#include <cstdio>
#include <cstdint>
namespace pg8 {
#define PG8_LAS __attribute__((address_space(3)))
typedef unsigned short bf16_t;
typedef short bf16x8 __attribute__((ext_vector_type(8)));
typedef float f32x4 __attribute__((ext_vector_type(4)));
typedef unsigned u32x4 __attribute__((ext_vector_type(4)));
constexpr int BM = 256, BK = 64, HALF = 128, HTB = HALF * BK * 2  , STAGE_BYTES = 8 * HTB, NXCD = 8, WGM = 8;

__host__ __device__ __forceinline__ int lds_byte(int r, int c) { const int st = (r >> 4) * 2 + (c >> 5), rr = r & 15, cc = c & 31, ob = rr * 64 + cc * 2; return st * 1024 + (ob ^ (((ob >> 9) & 1) << 5)); }
__host__ __device__ __forceinline__ void stage_rc(int b, int& R, int& C) { const int st = b / 1024, sb = b % 1024, swz = sb ^ (((sb >> 9) & 1) << 5); R = (st >> 1) * 16 + swz / 64; C = (st & 1) * 32 + (swz % 64) / 2; }
__host__ __device__ __forceinline__ int perm32(int rho) { const int n = rho >> 4, i = rho & 15; return 8 * (i >> 2) + 4 * n + (i & 3); }

struct Unit { int pm, pn; };
struct Gemm { const bf16_t* A; const bf16_t* Bt; int M, N, K; };

struct StaticOrder {
    int nM, nN, nwg, G, c;
    __host__ __device__ void init(int M, int N, int G_, int c_) { nM = M / BM; nN = N / BM; nwg = nM * nN; G = G_; c = c_; }
    __host__ __device__ bool next(int i, Unit& u) const {
        const int L = i * G + c; if (L >= nwg) return false;
        int wgid = L; { const int q = nwg / NXCD, r = nwg % NXCD, xcd = wgid % NXCD, off = wgid / NXCD; wgid = (xcd < r ? xcd * (q + 1) : r * (q + 1) + (xcd - r) * q) + off; }
        const int nig = WGM * nN, gid = wgid / nig, fm = gid * WGM, gsz = (nM - fm) < WGM ? (nM - fm) : WGM;
        u.pm = fm + ((wgid % nig) % gsz); u.pn = (wgid % nig) / gsz; return true;
    }
    __device__ __forceinline__ void a_ready(const Unit&) const {}
    __device__ __forceinline__ void done(const Unit&) const {}
};

__device__ __forceinline__ unsigned cvt_pk_bf16(float lo, float hi) { unsigned r; asm volatile("v_cvt_pk_bf16_f32 %0, %1, %2" : "=v"(r) : "v"(lo), "v"(hi)); return r; }
typedef float f32x2 __attribute__((ext_vector_type(2)));
typedef int v8i32 __attribute__((ext_vector_type(8)));
__device__ __forceinline__ v8i32 cat8(bf16x8 lo, bf16x8 hi) { typedef short s16x16 __attribute__((ext_vector_type(16))); return __builtin_bit_cast(v8i32, __builtin_shufflevector(lo, hi, 0, 1, 2, 3, 4, 5, 6, 7, 8, 9, 10, 11, 12, 13, 14, 15)); }
template <class Epi, class Sched, bool ALIGN_EPI = false, bool SP2 = false, bool F8 = false>
__device__ __forceinline__ void gemm_phase(PG8_LAS unsigned char* lds, const Gemm g, const Sched& S, const Epi& E, int wid) {
    int lane; asm volatile("v_mbcnt_lo_u32_b32 %0, -1, 0\n\tv_mbcnt_hi_u32_b32 %0, -1, %0" : "=v"(lane)); __builtin_assume(lane >= 0 && lane < 64); __builtin_assume(wid >= 0 && wid < 8);
    const int tid = wid * 64 + lane, wr = wid >> 2, wc = wid & 3, fr = lane & 15, fq = lane >> 4;
    const int K = g.K, nt = K / BK;
    unsigned voffA[2], voffB[2];
#pragma unroll
    for (int i = 0; i < 2; ++i) { int R, C; stage_rc(tid * 16 + i * 8192, R, C); const int Rb = Epi::PERM ? ((R & ~31) + perm32(R & 31)) : R;
        voffA[i] = (unsigned)(R * K + C) * 2u; voffB[i] = (unsigned)(Rb * K + C) * 2u; }
    const unsigned kstep = (unsigned)(BK * 2);
    const unsigned hstep = (unsigned)HALF * (unsigned)K * 2u;
    const unsigned tstep = 2u * hstep;
    const unsigned ldsw = (unsigned)wid * 1024u;
    const int aoff = lds_byte(wr * 64 + fr, fq * 8), boff = lds_byte(wc * 32 + fr, fq * 8);
#define PG8_SA(b, h) (((b) * 2 + (h)) * HTB)
#define PG8_SB(b, h) ((4 + (b) * 2 + (h)) * HTB)
#define PG8_STAGE(bufoff, gbase, voff) do { _Pragma("unroll") for (int _i = 0; _i < 2; ++_i) \
        __builtin_amdgcn_global_load_lds((const unsigned*)((const char*)(gbase) + (voff)[_i]), (PG8_LAS unsigned*)(lds + (bufoff) + ldsw + _i * 8192), 16, 0, 0); } while (0)
#define PG8_LDA(dst, b, h) do { _Pragma("unroll") for (int m = 0; m < 4; ++m) _Pragma("unroll") for (int k = 0; k < 2; ++k) dst[m][k] = *(const PG8_LAS bf16x8*)(lds + PG8_SA(b, h) + aoff + m * 2048 + k * 1024); } while (0)
#define PG8_LDB(dst, b, h) do { _Pragma("unroll") for (int n = 0; n < 2; ++n) _Pragma("unroll") for (int k = 0; k < 2; ++k) dst[n][k] = *(const PG8_LAS bf16x8*)(lds + PG8_SB(b, h) + boff + n * 2048 + k * 1024); } while (0)
#define PG8_MMA(ai, bj, At, Bt) do { __builtin_amdgcn_s_setprio(1); _Pragma("unroll") for (int m = 0; m < 4; ++m) _Pragma("unroll") for (int n = 0; n < 2; ++n) { \
        if constexpr (F8) acc[ai][bj][m][n] = __builtin_amdgcn_mfma_scale_f32_16x16x128_f8f6f4(cat8(Bt[n][0], Bt[n][1]), cat8(At[m][0], At[m][1]), acc[ai][bj][m][n], 0, 0, 0, 0, 0, 0); \
        else { _Pragma("unroll") for (int k = 0; k < 2; ++k) acc[ai][bj][m][n] = __builtin_amdgcn_mfma_f32_16x16x32_bf16(Bt[n][k], At[m][k], acc[ai][bj][m][n], 0, 0, 0); } } __builtin_amdgcn_s_setprio(0); } while (0)
#define PG8_WAIT_V(n) asm volatile("s_waitcnt vmcnt(" #n ")" ::: "memory")
#define PG8_WAIT_L(n) asm volatile("s_waitcnt lgkmcnt(" #n ")" ::: "memory")
#define PG8_BAR __builtin_amdgcn_s_barrier()
#define PG8_SCHED __builtin_amdgcn_sched_barrier(0)
    Unit cur, nxt; int ui = 0;
    if (!S.next(0, cur)) return;
    f32x4 acc[2][2][4][2];
#pragma unroll
    for (int a = 0; a < 2; ++a)
#pragma unroll
        for (int b = 0; b < 2; ++b)
#pragma unroll
            for (int m = 0; m < 4; ++m)
#pragma unroll
                for (int n = 0; n < 2; ++n) acc[a][b][m][n] = (f32x4){0.f, 0.f, 0.f, 0.f};
    bf16x8 At[4][2], B0[2][2], B1[2][2];
    const char* cA = (const char*)g.A + (size_t)((unsigned)cur.pm * tstep); const char* cB = (const char*)g.Bt + (size_t)((unsigned)cur.pn * tstep);
    S.a_ready(cur);
    if constexpr (SP2) {
        PG8_STAGE(PG8_SB(0, 0), cB, voffB); PG8_STAGE(PG8_SB(0, 1), cB + hstep, voffB); PG8_STAGE(PG8_SA(0, 0), cA, voffA); PG8_STAGE(PG8_SA(0, 1), cA + hstep, voffA);
        if (wr == 1) PG8_BAR;
        PG8_WAIT_V(2); PG8_BAR;
        PG8_STAGE(PG8_SB(1, 0), cB + kstep, voffB); PG8_STAGE(PG8_SA(1, 0), cA + kstep, voffA); PG8_STAGE(PG8_SB(1, 1), cB + hstep + kstep, voffB);
        PG8_WAIT_V(6); PG8_BAR;
    } else {
        PG8_STAGE(PG8_SB(0, 0), cB, voffB); PG8_STAGE(PG8_SA(0, 0), cA, voffA); PG8_STAGE(PG8_SB(0, 1), cB + hstep, voffB); PG8_STAGE(PG8_SA(0, 1), cA + hstep, voffA);
        if (wr == 1) PG8_BAR;
        PG8_WAIT_V(4); PG8_BAR;
        PG8_STAGE(PG8_SB(1, 0), cB + kstep, voffB); PG8_STAGE(PG8_SA(1, 0), cA + kstep, voffA); PG8_STAGE(PG8_SB(1, 1), cB + hstep + kstep, voffB);
        PG8_WAIT_V(6); PG8_BAR;
    }
    for (;;) {
        const bool has_next = S.next(ui + 1, nxt);
        const char* nA = has_next ? (const char*)g.A + (size_t)((unsigned)nxt.pm * tstep) : cA; const char* nB = has_next ? (const char*)g.Bt + (size_t)((unsigned)nxt.pn * tstep) : cB;
        _Pragma("unroll 1") for (int t = 0; t < nt; t += 2) {
            const bool last = (t == nt - 2);
            const char* a1 = cA + (size_t)((unsigned)(t + 1) * kstep);
            const char* a2 = last ? nA : cA + (size_t)((unsigned)(t + 2) * kstep); const char* b2 = last ? nB : cB + (size_t)((unsigned)(t + 2) * kstep);
            const char* a3 = a2 + kstep; const char* b3 = b2 + kstep;
            const char* a1h = a1 + hstep; const char* a2h = a2 + hstep; const char* b2h = b2 + hstep; const char* b3h = b3 + hstep;
            asm volatile("" : "+s"(a1h), "+s"(a2), "+s"(a2h), "+s"(b2), "+s"(b2h), "+s"(a3), "+s"(b3), "+s"(b3h));
            if (last && has_next) S.a_ready(nxt);
            if constexpr (SP2) {
            PG8_LDB(B0, 0, 0); PG8_LDB(B1, 0, 1); PG8_SCHED; PG8_LDA(At, 0, 0); PG8_STAGE(PG8_SA(1, 1), a1h, voffA);
            PG8_WAIT_V(8); PG8_WAIT_L(0); PG8_BAR; PG8_MMA(0, 0, At, B0); PG8_MMA(0, 1, At, B1); PG8_BAR; PG8_SCHED;
            PG8_LDA(At, 0, 1); PG8_STAGE(PG8_SB(0, 0), b2, voffB); PG8_STAGE(PG8_SB(0, 1), b2h, voffB); PG8_STAGE(PG8_SA(0, 0), a2, voffA);
            PG8_WAIT_V(8); PG8_WAIT_L(0); PG8_BAR; PG8_MMA(1, 0, At, B0); PG8_MMA(1, 1, At, B1); PG8_BAR; PG8_SCHED;
            PG8_LDB(B0, 1, 0); PG8_LDB(B1, 1, 1); PG8_SCHED; PG8_LDA(At, 1, 0); PG8_STAGE(PG8_SA(0, 1), a2h, voffA);
            PG8_WAIT_V(8); PG8_WAIT_L(0); PG8_BAR; PG8_MMA(0, 0, At, B0); PG8_MMA(0, 1, At, B1); PG8_BAR; PG8_SCHED;
            PG8_LDA(At, 1, 1); PG8_STAGE(PG8_SB(1, 0), b3, voffB); PG8_STAGE(PG8_SB(1, 1), b3h, voffB); PG8_STAGE(PG8_SA(1, 0), a3, voffA);
            PG8_WAIT_V(8); PG8_WAIT_L(0); PG8_BAR; PG8_MMA(1, 0, At, B0); PG8_MMA(1, 1, At, B1); PG8_BAR; PG8_SCHED;
            } else {
            PG8_LDB(B0, 0, 0); PG8_SCHED; PG8_LDA(At, 0, 0); PG8_STAGE(PG8_SA(1, 1), a1h, voffA);
            PG8_WAIT_L(8); PG8_BAR; PG8_WAIT_L(0); PG8_MMA(0, 0, At, B0); PG8_BAR; PG8_SCHED;
            PG8_LDB(B1, 0, 1); PG8_STAGE(PG8_SB(0, 0), b2, voffB);
            PG8_BAR; PG8_WAIT_L(0); PG8_MMA(0, 1, At, B1); PG8_BAR;
            PG8_LDA(At, 0, 1); PG8_STAGE(PG8_SA(0, 0), a2, voffA);
            PG8_BAR; PG8_WAIT_L(0); PG8_MMA(1, 0, At, B0); PG8_BAR; PG8_SCHED;
            PG8_STAGE(PG8_SB(0, 1), b2h, voffB);
            PG8_WAIT_V(6); PG8_BAR; PG8_MMA(1, 1, At, B1); PG8_BAR;
            PG8_LDB(B0, 1, 0); PG8_SCHED; PG8_LDA(At, 1, 0); PG8_STAGE(PG8_SA(0, 1), a2h, voffA);
            PG8_WAIT_L(8); PG8_BAR; PG8_WAIT_L(0); PG8_MMA(0, 0, At, B0); PG8_BAR; PG8_SCHED;
            PG8_LDB(B1, 1, 1); PG8_STAGE(PG8_SB(1, 0), b3, voffB);
            PG8_BAR; PG8_WAIT_L(0); PG8_MMA(0, 1, At, B1); PG8_BAR;
            PG8_LDA(At, 1, 1); PG8_STAGE(PG8_SA(1, 0), a3, voffA);
            PG8_BAR; PG8_WAIT_L(0); PG8_MMA(1, 0, At, B0); PG8_BAR; PG8_SCHED;
            PG8_STAGE(PG8_SB(1, 1), b3h, voffB);
            PG8_WAIT_V(6); PG8_BAR; PG8_MMA(1, 1, At, B1); PG8_BAR;
            }
        }
#ifdef PROBE_G
        unsigned long long tk_ = 0; if (wid == 0) tk_ = __builtin_amdgcn_s_memrealtime();
#endif
        if constexpr (ALIGN_EPI) { if (wr == 0) PG8_BAR; }
        if constexpr (!Epi::AFTER_DRAIN) { int l2_; asm volatile("v_mbcnt_lo_u32_b32 %0, -1, 0\n\tv_mbcnt_hi_u32_b32 %0, -1, %0" : "=v"(l2_)); const int fr_o = l2_ & 15, fq_o = l2_ >> 4;
            Unit cu_ = cur; asm volatile("" : "+s"(cu_.pm), "+s"(cu_.pn));
            E(acc, cu_, wr, wc, fr_o, fq_o); S.done(cur); }
#ifdef PROBE_G
        if (wid == 0 && lane == 0 && *(volatile PG8_LAS unsigned*)(lds + 147456 + 4 * 61) != 0u) *(volatile PG8_LAS unsigned*)(lds + 147456 + 4 * 60) += (unsigned)(__builtin_amdgcn_s_memrealtime() - tk_);
#endif
        if (!has_next) break;
#pragma unroll
        for (int a = 0; a < 2; ++a)
#pragma unroll
            for (int b = 0; b < 2; ++b)
#pragma unroll
                for (int m = 0; m < 4; ++m)
#pragma unroll
                    for (int n = 0; n < 2; ++n) acc[a][b][m][n] = (f32x4){0.f, 0.f, 0.f, 0.f};
        cur = nxt; cA = nA; cB = nB; ++ui;
        if constexpr (ALIGN_EPI) { if (wr == 1) PG8_BAR; }
    }
    PG8_WAIT_V(0);
    if constexpr (!ALIGN_EPI) { if (wr == 0) PG8_BAR; }
    PG8_BAR;
    if constexpr (Epi::AFTER_DRAIN) { E.fused(acc, cur, wr, wc, fr, fq, lds, wid, lane); S.done(cur); }
#undef PG8_SA
#undef PG8_SB
#undef PG8_STAGE
#undef PG8_LDA
#undef PG8_LDB
#undef PG8_MMA
#undef PG8_WAIT_V
#undef PG8_WAIT_L
#undef PG8_BAR
#undef PG8_SCHED
}
}
#define GAS __attribute__((address_space(1)))
#define LAS __attribute__((address_space(3)))
typedef unsigned short bf16;
typedef unsigned v4u __attribute__((ext_vector_type(4)));
typedef float f32x4 __attribute__((ext_vector_type(4)));
typedef short bf16x8 __attribute__((ext_vector_type(8)));
typedef GAS unsigned gu32;
typedef GAS unsigned long long gu64;
#define RLX_AGENT __ATOMIC_RELAXED, __HIP_MEMORY_SCOPE_AGENT
#define LDS_WAIT() asm volatile("s_waitcnt lgkmcnt(0)" ::: "memory")
#define VM_WAIT() asm volatile("s_waitcnt vmcnt(0)" ::: "memory")
__device__ __forceinline__ unsigned long long rt() { return __builtin_amdgcn_s_memrealtime(); }
__device__ __forceinline__ unsigned f2bf(float f) { unsigned u = __builtin_bit_cast(unsigned, f); return (u + 0x7fffu + ((u >> 16) & 1u)) >> 16; }
__device__ __forceinline__ unsigned pk2(float lo, float hi) { return f2bf(lo) | (f2bf(hi) << 16); }
#define XB_TMO      128
#define XB_XCNT(j)  (256  + 64 * (j))
#define XB_XSUB(j)  (1280 + 64 * (j))
#define XB_XGEN(j)  (2304 + 64 * (j))
#define XB_TOP      3328
#define XB_TOPGEN   3392
#define XCD_BAR_WORDS 3456
#define XB_SPIN_CAP (1u << 18)

__device__ __forceinline__ unsigned xb_ld(unsigned* p)              { return __hip_atomic_load(p, __ATOMIC_RELAXED, __HIP_MEMORY_SCOPE_AGENT); }
__device__ __forceinline__ unsigned xb_add(unsigned* p, unsigned v) { return __hip_atomic_fetch_add(p, v, __ATOMIC_RELAXED, __HIP_MEMORY_SCOPE_AGENT); }
__device__ __forceinline__ unsigned xb_xcc_id() { return (unsigned)__builtin_amdgcn_s_getreg((3 << 11) | 20) & 0xFu; }
#define XB_SPIN(cond, bar) do { unsigned _sp = 0; while (cond) { __builtin_amdgcn_s_sleep(1); \
    if ((++_sp & 255u) == 0u) { if (xb_ld(&(bar)[XB_TMO])) break; if (_sp > XB_SPIN_CAP) { atomicAdd(&(bar)[XB_TMO], 1u); break; } } } } while (0)

struct XcdBarrier {
    unsigned* bar; unsigned x;
    volatile LAS unsigned* st;
};

__device__ __forceinline__ XcdBarrier xcd_barrier_post(unsigned* bar, volatile LAS unsigned* st, bool t0) {
    XcdBarrier b; b.bar = bar; b.x = xb_xcc_id(); b.st = st;
    if (t0) (void)xb_add(&bar[XB_XCNT(b.x)], 1u);
    return b;
}
__device__ __forceinline__ void xcd_barrier_complete(unsigned* bar, unsigned x, unsigned& nloc, unsigned& nx) {
    const unsigned G = gridDim.x * gridDim.y * gridDim.z;
    unsigned sum, cnt, mine, sp = 0u;
    for (;;) {
        sum = 0u; cnt = 0u; mine = 0u;
#pragma unroll
        for (unsigned j = 0; j < 16; ++j) { const unsigned c = xb_ld(&bar[XB_XCNT(j)]); sum += c; cnt += (c > 0u) ? 1u : 0u; mine = (j == x) ? c : mine; }
        if (sum == G) break;
        __builtin_amdgcn_s_sleep(1);
        if ((++sp & 255u) == 0u) { if (xb_ld(&bar[XB_TMO])) break; if (sp > XB_SPIN_CAP) { atomicAdd(&bar[XB_TMO], 1u); break; } }
    }
    nloc = mine > 0u ? mine : 1u; nx = cnt > 0u ? cnt : 1u;
}

__device__ __forceinline__ void xcd_barrier(const XcdBarrier& b, bool t0) {
    asm volatile("s_waitcnt vmcnt(0)" ::: "memory");
    __syncthreads();
    if (t0) {
        unsigned* bar = b.bar;
        __builtin_amdgcn_s_waitcnt(0);
        unsigned nloc = b.st[0], nx = b.st[1];
        if (nloc == 0u) { xcd_barrier_complete(bar, b.x, nloc, nx); b.st[0] = nloc; b.st[1] = nx; }
        const unsigned old = xb_add(&bar[XB_XSUB(b.x)], 1u);
        const unsigned gen = old / nloc;
        if (old + 1u == (gen + 1u) * nloc) {
            __builtin_amdgcn_fence(__ATOMIC_RELEASE, "agent");
            asm volatile("s_waitcnt vmcnt(0)" ::: "memory");
            const unsigned og = xb_add(&bar[XB_TOP], 1u);
            const unsigned tg = og / nx;
            if (og + 1u == (tg + 1u) * nx) xb_add(&bar[XB_TOPGEN], 1u);
            else XB_SPIN(xb_ld(&bar[XB_TOPGEN]) == tg, bar);
            __builtin_amdgcn_fence(__ATOMIC_ACQUIRE, "agent");
            xb_add(&bar[XB_XGEN(b.x)], 1u);
            asm volatile("s_waitcnt vmcnt(0)" ::: "memory");
        } else {
            XB_SPIN(xb_ld(&bar[XB_XGEN(b.x)]) == gen, bar);
            __builtin_amdgcn_fence(__ATOMIC_ACQUIRE, "agent");
            asm volatile("s_waitcnt vmcnt(0)" ::: "memory");
        }
    }
    __syncthreads();
}
#ifndef Y_FP8
#define Y_FP8 1
#endif
#ifndef MOE_FP8_G1
#define MOE_FP8_G1 1
#endif
#ifndef MOE_FP8_G2
#define MOE_FP8_G2 1
#endif

constexpr int NB = 2, SEQ = 8192, D = 1024, M = NB * SEQ;
constexpr int NPROJ = 3584, IN_COLS = 3592;
constexpr int NE = 32, TOPK = 4, DFF = 1024;
constexpr int NROWS_MAX = M * TOPK + NE * 256;
constexpr int MAXRT = NROWS_MAX / 256;
constexpr float EPS = 1e-6f;
constexpr int PC_Q = 0, PC_K = 512, PC_V = 1024, PC_G = 1536, PC_Z = 2048, PC_X = 2560;
constexpr int NCHUNK = M / 64;
constexpr int NWAVES = 8, NTHR = 512;

constexpr size_t MiB = 1u << 20;
constexpr size_t WS_CTL = 0, CTL_ZERO_BYTES = 32768;
constexpr size_t WS_MODP = 1 * MiB;
constexpr size_t WS_MODF = WS_MODP + 512 * 1024;
constexpr size_t WS_BLKCNT = WS_MODF + 256 * 1024;
constexpr size_t WS_DT = 2 * MiB;
constexpr size_t WS_TOK = 3 * MiB;
constexpr size_t WS_WIN = 4 * MiB, WS_WOUT = 11 * MiB, WS_W1 = 16 * MiB, WS_W2 = 144 * MiB;
constexpr size_t WS_H = 208 * MiB, WS_P = 240 * MiB, WS_LF = 352 * MiB, WS_MIX = 384 * MiB, WS_X1 = 416 * MiB;
constexpr size_t WS_XG = 480 * MiB, WS_ACT = 624 * MiB, WS_END = 768 * MiB;
constexpr int CW_TMO = 0, CW_BAR = 4096;

constexpr int RING_BYTES = 131072, AUX_OFF = RING_BYTES  , MISC_OFF = 147456, LDS_BYTES = 151552;

struct Args { const float* in[23]; float* out; unsigned char* ws; int ph_lo, ph_hi; };
enum { I_X = 0, I_C, I_ADAW, I_ADAB, I_N1W, I_WIN, I_LBL, I_HGNW, I_ALOG, I_DTB, I_SSMD, I_CONVW, I_CONVB, I_SSMNW, I_WOUT, I_N2W, I_RW, I_RB, I_W1, I_B1, I_W2, I_B2, I_FNW };

__device__ __forceinline__ float bf2f(bf16 v) { return __uint_as_float(((unsigned)v) << 16); }
__device__ __forceinline__ float wave_sum(float v) {
#pragma unroll
    for (int o = 1; o < 64; o <<= 1) v += __shfl_xor(v, o);
    return v;
}
__device__ __forceinline__ float wave_max(float v) {
#pragma unroll
    for (int o = 1; o < 64; o <<= 1) v = fmaxf(v, __shfl_xor(v, o));
    return v;
}
__device__ __forceinline__ float sigmoid_f(float x) { return __builtin_amdgcn_rcpf(1.0f + __expf(-x)); }
__device__ __forceinline__ float silu_f(float x) { return x * sigmoid_f(x); }

namespace pg8 {
struct EpiIn {
    static constexpr bool PERM = true, AFTER_DRAIN = false;
    bf16_t* P; float* LF; const float* lbl;
    __device__ __forceinline__ void operator()(const f32x4 (&acc)[2][2][4][2], const Unit& u, int wr, int wc, int fr, int fq) const {
        const int row0 = u.pm * BM + wr * 64 + fr, col0 = u.pn * BM + wc * 32 + 8 * fq;
        const int mode = (u.pn < 2) ? 1 : (u.pn < 4) ? 2 : (u.pn < 6) ? 0 : (u.pn < 10) ? 1 : 0;
        if (mode == 2) {
            float oml[2][8];
#pragma unroll
            for (int bj = 0; bj < 2; ++bj)
#pragma unroll
                for (int j = 0; j < 8; ++j) { const int cf = col0 + bj * HALF + j - 512; const float l0 = lbl[cf], l1 = lbl[512 + cf]; oml[bj][j] = 1.0f - 1.0f / (1.0f + __expf(l1 - l0)); }
#pragma unroll
            for (int ai = 0; ai < 2; ++ai)
#pragma unroll
                for (int m = 0; m < 4; ++m) { const size_t r = (size_t)(row0 + ai * HALF + m * 16);
#pragma unroll
                    for (int bj = 0; bj < 2; ++bj) { float kv[8], lf[8];
#pragma unroll
                        for (int j = 0; j < 8; ++j) { const float f = acc[ai][bj][m][j >> 2][j & 3]; const float k = oml[bj][j] * sigmoid_f(-f); kv[j] = k; lf[j] = __logf(1.0f - k); }
                        u32x4 w; w.x = cvt_pk_bf16(kv[0], kv[1]); w.y = cvt_pk_bf16(kv[2], kv[3]); w.z = cvt_pk_bf16(kv[4], kv[5]); w.w = cvt_pk_bf16(kv[6], kv[7]);
                        *(u32x4*)(P + r * NPROJ + col0 + bj * HALF) = w;
                        float* lp = LF + r * 512 + (col0 + bj * HALF - 512);
                        *(f32x4*)lp = (f32x4){lf[0], lf[1], lf[2], lf[3]}; *(f32x4*)(lp + 4) = (f32x4){lf[4], lf[5], lf[6], lf[7]}; } }
        } else {
#pragma unroll
            for (int ai = 0; ai < 2; ++ai)
#pragma unroll
                for (int m = 0; m < 4; ++m) { bf16_t* rowp = P + (size_t)(row0 + ai * HALF + m * 16) * NPROJ + col0;
#pragma unroll
                    for (int bj = 0; bj < 2; ++bj) { f32x4 v0 = acc[ai][bj][m][0], v1 = acc[ai][bj][m][1];
                        if (mode == 1) {
#pragma unroll
                            for (int j = 0; j < 4; ++j) { v0[j] = silu_f(v0[j]); v1[j] = silu_f(v1[j]); } }
                        u32x4 w; w.x = cvt_pk_bf16(v0[0], v0[1]); w.y = cvt_pk_bf16(v0[2], v0[3]); w.z = cvt_pk_bf16(v1[0], v1[1]); w.w = cvt_pk_bf16(v1[2], v1[3]);
                        *(u32x4*)(rowp + bj * HALF) = w; } }
        }
    }
};
struct EpiOut {
    static constexpr bool PERM = true, AFTER_DRAIN = false;
    const float* x; bf16_t* x1; const float* g1;
    __device__ __forceinline__ void operator()(const f32x4 (&acc)[2][2][4][2], const Unit& u, int wr, int wc, int fr, int fq) const {
        const int row0 = u.pm * BM + wr * 64 + fr, col0 = u.pn * BM + wc * 32 + 8 * fq;
        const float* gb = g1 + ((u.pm * BM) >> 13) * 6144 + col0;
        f32x4 gv[2][2];
#pragma unroll
        for (int bj = 0; bj < 2; ++bj)
#pragma unroll
            for (int n = 0; n < 2; ++n) gv[bj][n] = *(const f32x4*)(gb + bj * HALF + 4 * n);
#pragma unroll
        for (int ai = 0; ai < 2; ++ai)
#pragma unroll
            for (int m = 0; m < 4; ++m) { const size_t off = (size_t)(row0 + ai * HALF + m * 16) * D + col0;
#pragma unroll
                for (int bj = 0; bj < 2; ++bj) { const f32x4 x0 = *(const f32x4*)(x + off + bj * HALF), x1v = *(const f32x4*)(x + off + bj * HALF + 4);
                    const f32x4 v0 = x0 + gv[bj][0] * acc[ai][bj][m][0], v1 = x1v + gv[bj][1] * acc[ai][bj][m][1];
                    u32x4 w; w.x = cvt_pk_bf16(v0[0], v0[1]); w.y = cvt_pk_bf16(v0[2], v0[3]); w.z = cvt_pk_bf16(v1[0], v1[1]); w.w = cvt_pk_bf16(v1[2], v1[3]);
                    *(u32x4*)(x1 + off + bj * HALF) = w; } }
    }
};
__device__ __forceinline__ float sat8(float x) { return __builtin_amdgcn_fmed3f(x, -448.0f, 448.0f); }
__device__ __forceinline__ unsigned pk4_fp8(float a, float b, float c, float d) { int w = 0; w = __builtin_amdgcn_cvt_pk_fp8_f32(sat8(a), sat8(b), w, false); w = __builtin_amdgcn_cvt_pk_fp8_f32(sat8(c), sat8(d), w, true); return (unsigned)w; }
template <bool F8IN, bool F8> struct EpiW1 {
    static constexpr bool PERM = true, AFTER_DRAIN = false;
    void* ACT; const float* b1;
    __device__ __forceinline__ void operator()(const f32x4 (&acc)[2][2][4][2], const Unit& u, int wr, int wc, int fr, int fq) const {
        const int e = u.pn >> 3, pn = u.pn & 7;
        const int row0 = u.pm * BM + wr * 64 + fr, cj = pn * 128 + wc * 32 + 8 * fq;
        const float* bg = b1 + e * 2048 + cj; const float sc = F8IN ? (1.0f / 1024.0f) : 1.0f;
#pragma unroll
        for (int ai = 0; ai < 2; ++ai)
#pragma unroll
            for (int m = 0; m < 4; ++m) {
                asm volatile("" ::: "memory");
                const f32x4 bg0 = *(const f32x4*)bg, bg1 = *(const f32x4*)(bg + 4), bl0 = *(const f32x4*)(bg + 1024), bl1 = *(const f32x4*)(bg + 1028);
                f32x4 g0 = acc[ai][0][m][0] * sc + bg0, g1 = acc[ai][0][m][1] * sc + bg1, l0 = acc[ai][1][m][0] * sc + bl0, l1 = acc[ai][1][m][1] * sc + bl1;
                float o[8];
                const float osc = F8 ? 4.0f : 1.0f;
#pragma unroll
                for (int j = 0; j < 4; ++j) {
                    float g = fminf(g0[j], 7.0f), l = __builtin_amdgcn_fmed3f(l0[j], -7.0f, 7.0f); o[j] = (g * osc) * __builtin_amdgcn_rcpf(1.0f + __builtin_amdgcn_exp2f(g * (-1.702f * 1.44269504f))) * (l + 1.0f);
                    g = fminf(g1[j], 7.0f); l = __builtin_amdgcn_fmed3f(l1[j], -7.0f, 7.0f); o[4 + j] = (g * osc) * __builtin_amdgcn_rcpf(1.0f + __builtin_amdgcn_exp2f(g * (-1.702f * 1.44269504f))) * (l + 1.0f); }
                const size_t off = (size_t)(row0 + ai * HALF + m * 16) * DFF + cj;
                if (F8) { typedef unsigned u32x2 __attribute__((ext_vector_type(2))); u32x2 w; int w0 = 0, w1 = 0;
                    w0 = __builtin_amdgcn_cvt_pk_fp8_f32(o[0], o[1], w0, false); w0 = __builtin_amdgcn_cvt_pk_fp8_f32(o[2], o[3], w0, true); w1 = __builtin_amdgcn_cvt_pk_fp8_f32(o[4], o[5], w1, false); w1 = __builtin_amdgcn_cvt_pk_fp8_f32(o[6], o[7], w1, true);
                    w.x = (unsigned)w0; w.y = (unsigned)w1; *(u32x2*)((unsigned char*)ACT + off) = w; }
                else { u32x4 w; w.x = cvt_pk_bf16(o[0], o[1]); w.y = cvt_pk_bf16(o[2], o[3]); w.z = cvt_pk_bf16(o[4], o[5]); w.w = cvt_pk_bf16(o[6], o[7]);
                    *(u32x4*)((bf16_t*)ACT + off) = w; } }
    }
};
template <bool Y8> struct EpiW2 {
    static constexpr bool PERM = true, AFTER_DRAIN = false;
    void* Y; const float* b2; float sc;
    __device__ __forceinline__ void operator()(const f32x4 (&acc)[2][2][4][2], const Unit& u, int wr, int wc, int fr, int fq) const {
        const int e = u.pn >> 2, pn = u.pn & 3;
        const int row0 = u.pm * BM + wr * 64 + fr, col0 = pn * BM + wc * 32 + 8 * fq;
        const float* bb = b2 + e * 1024 + col0;
        f32x4 bv[2][2];
#pragma unroll
        for (int bj = 0; bj < 2; ++bj) { bv[bj][0] = *(const f32x4*)(bb + bj * HALF); bv[bj][1] = *(const f32x4*)(bb + bj * HALF + 4); }
#pragma unroll
        for (int ai = 0; ai < 2; ++ai)
#pragma unroll
            for (int m = 0; m < 4; ++m) { const size_t off = (size_t)(row0 + ai * HALF + m * 16) * D + col0;
#pragma unroll
                for (int bj = 0; bj < 2; ++bj) { const f32x4 v0 = acc[ai][bj][m][0] * sc + bv[bj][0], v1 = acc[ai][bj][m][1] * sc + bv[bj][1];
                    if (Y8) { typedef unsigned u32x2 __attribute__((ext_vector_type(2))); u32x2 w; w.x = pk4_fp8(v0[0] * 8.f, v0[1] * 8.f, v0[2] * 8.f, v0[3] * 8.f); w.y = pk4_fp8(v1[0] * 8.f, v1[1] * 8.f, v1[2] * 8.f, v1[3] * 8.f);
                        *(u32x2*)((unsigned char*)Y + off + bj * HALF) = w; }
                    else { u32x4 w; w.x = cvt_pk_bf16(v0[0], v0[1]); w.y = cvt_pk_bf16(v0[2], v0[3]); w.z = cvt_pk_bf16(v1[0], v1[1]); w.w = cvt_pk_bf16(v1[2], v1[3]);
                        *(u32x4*)((bf16_t*)Y + off + bj * HALF) = w; } } }
    }
};
struct InProjOrder {
    int c;
    __device__ __forceinline__ bool next(int i, Unit& u) const { const int pn = (c >> 6) + 4 * i; if (pn >= NPROJ / BM) return false; u.pm = c & 63; u.pn = pn; return true; }
    __device__ __forceinline__ void a_ready(const Unit&) const {}
    __device__ __forceinline__ void done(const Unit&) const {}
};
struct MoeOrder {
    const PG8_LAS int* rt2e; int NT, nwg, G, c;
    __device__ __forceinline__ bool next(int i, Unit& u) const {
        const int L = i * G + c; if (L >= nwg) return false;
        int wgid = L; { const int q = nwg / NXCD, r = nwg % NXCD, xcd = wgid % NXCD, off = wgid / NXCD; wgid = (xcd < r ? xcd * (q + 1) : r * (q + 1) + (xcd - r) * q) + off; }
        const int rt = wgid / NT, pn = wgid % NT; const int e = __builtin_amdgcn_readfirstlane(rt2e[rt]);
        u.pm = rt; u.pn = e * NT + pn; return true;
    }
    __device__ __forceinline__ void a_ready(const Unit&) const {}
    __device__ __forceinline__ void done(const Unit&) const {}
};
}

using pg8::pk4_fp8;
__device__ __forceinline__ void transpose_item(const float* __restrict__ W, int ldw, int k0, int c0, bf16* WT, int drow0, LAS float* scr, int lane) {
#pragma unroll 8
    for (int i = 0; i < 32; ++i) { const int kk = 2 * i + (lane >> 5); scr[kk * 33 + (lane & 31)] = W[(size_t)(k0 + kk) * ldw + c0 + (lane & 31)]; }
    LDS_WAIT(); asm volatile("" ::: "memory");
    const int c = lane & 7;
#pragma unroll
    for (int j = 0; j < 4; ++j) { const int n = (lane >> 3) + 8 * j; const LAS float* s = scr + (8 * c) * 33 + n;
        v4u o; o.x = pk2(s[0 * 33], s[1 * 33]); o.y = pk2(s[2 * 33], s[3 * 33]); o.z = pk2(s[4 * 33], s[5 * 33]); o.w = pk2(s[6 * 33], s[7 * 33]);
        *(GAS v4u*)(WT + (size_t)(drow0 + n) * 1024 + k0 + 8 * c) = o; }
    LDS_WAIT(); asm volatile("" ::: "memory");
}
__device__ __forceinline__ void transpose_item8(const float* __restrict__ W, int ldw, int k0, int c0, unsigned char* WT, int drow0, float scale, LAS float* scr, int lane) {
#pragma unroll 8
    for (int i = 0; i < 32; ++i) { const int kk = 2 * i + (lane >> 5); scr[kk * 33 + (lane & 31)] = W[(size_t)(k0 + kk) * ldw + c0 + (lane & 31)]; }
    LDS_WAIT(); asm volatile("" ::: "memory");
    const int n = lane >> 1, hf = lane & 1; const LAS float* s = scr + (32 * hf) * 33 + n;
    v4u o0, o1;
    o0.x = pk4_fp8(s[0 * 33] * scale, s[1 * 33] * scale, s[2 * 33] * scale, s[3 * 33] * scale); o0.y = pk4_fp8(s[4 * 33] * scale, s[5 * 33] * scale, s[6 * 33] * scale, s[7 * 33] * scale);
    o0.z = pk4_fp8(s[8 * 33] * scale, s[9 * 33] * scale, s[10 * 33] * scale, s[11 * 33] * scale); o0.w = pk4_fp8(s[12 * 33] * scale, s[13 * 33] * scale, s[14 * 33] * scale, s[15 * 33] * scale);
    o1.x = pk4_fp8(s[16 * 33] * scale, s[17 * 33] * scale, s[18 * 33] * scale, s[19 * 33] * scale); o1.y = pk4_fp8(s[20 * 33] * scale, s[21 * 33] * scale, s[22 * 33] * scale, s[23 * 33] * scale);
    o1.z = pk4_fp8(s[24 * 33] * scale, s[25 * 33] * scale, s[26 * 33] * scale, s[27 * 33] * scale); o1.w = pk4_fp8(s[28 * 33] * scale, s[29 * 33] * scale, s[30 * 33] * scale, s[31 * 33] * scale);
    GAS v4u* dst = (GAS v4u*)(WT + (size_t)(drow0 + n) * 1024 + k0 + 32 * hf); dst[0] = o0; dst[1] = o1;
    LDS_WAIT(); asm volatile("" ::: "memory");
}
template <bool F8> __device__ __forceinline__ void p0_item(const float* __restrict__ W, int ldw, int k0, int c0, unsigned char* WT, int drow0, int rowb, float scale, LAS unsigned char* T, int tid, int wave, int lane) {
    constexpr int NB = F8 ? 2 : 1, TS = 516;
    const int l32 = lane & 31, hf = lane >> 5;
#pragma unroll 1
    for (int batch = 0; batch < NB; ++batch) {
        const int kb = batch * 256 + wave * 32;
        f32x4 v[4][4];
#pragma unroll
        for (int i = 0; i < 4; ++i)
#pragma unroll
            for (int j = 0; j < 4; ++j) v[i][j] = __builtin_nontemporal_load((const f32x4*)(W + (size_t)(k0 + kb + 4 * (2 * i + hf) + j) * ldw + c0 + 4 * l32));
#pragma unroll
        for (int i = 0; i < 4; ++i) { const int kk = kb + 4 * (2 * i + hf);
#pragma unroll
            for (int c = 0; c < 4; ++c) { LAS unsigned char* tp = T + (4 * l32 + c) * TS + (F8 ? kk : 2 * kk);
                if (F8) *(LAS unsigned*)tp = pk4_fp8(v[i][0][c] * scale, v[i][1][c] * scale, v[i][2][c] * scale, v[i][3][c] * scale);
                else { *(LAS unsigned*)tp = pk2(v[i][0][c], v[i][1][c]); *(LAS unsigned*)(tp + 4) = pk2(v[i][2][c], v[i][3][c]); } } }
    }
    __syncthreads();
#pragma unroll
    for (int i = 0; i < 8; ++i) { const int piece = tid + NTHR * i, n = piece >> 5, c = piece & 31; const LAS unsigned* tp = (const LAS unsigned*)(T + n * TS + 16 * c);
        v4u o; o.x = tp[0]; o.y = tp[1]; o.z = tp[2]; o.w = tp[3];
        *(GAS v4u*)(WT + (size_t)(drow0 + n) * rowb + (F8 ? k0 : 2 * k0) + 16 * c) = o; }
    __syncthreads();
}
constexpr int KB1 = MOE_FP8_G1 ? 2 : 4, KB2 = MOE_FP8_G2 ? 2 : 4, I_E1 = NE * 16 * KB1, I_E2 = NE * 8 * KB2, N_EXP_ITEMS = I_E1 + I_E2;
constexpr int N_BG_ITEMS = 0;
__device__ __forceinline__ void p0_expert_item(const Args& a, LAS unsigned char* lds, int it, int tid, int wave, int lane) {
    unsigned char* ws = a.ws;
    if (it < I_E1) { const int e = it / (16 * KB1), r2 = it % (16 * KB1), nb = r2 / KB1, kb = r2 % KB1, c0 = 128 * nb;
        const int drow = e * 2048 + ((c0 < 1024) ? (256 * (c0 >> 7)) : (256 * ((c0 - 1024) >> 7) + 128));
        p0_item<MOE_FP8_G1 != 0>(a.in[I_W1] + (size_t)e * 1024 * 2048, 2048, (MOE_FP8_G1 ? 512 : 256) * kb, c0, ws + WS_W1, drow, MOE_FP8_G1 ? 1024 : 2048, 128.0f, lds, tid, wave, lane); }
    else { const int r = it - I_E1, e = r / (8 * KB2), r2 = r % (8 * KB2), nb = r2 / KB2, kb = r2 % KB2;
        p0_item<MOE_FP8_G2 != 0>(a.in[I_W2] + (size_t)e * 1024 * 1024, 1024, (MOE_FP8_G2 ? 512 : 256) * kb, 128 * nb, ws + WS_W2, e * 1024 + 128 * nb, MOE_FP8_G2 ? 1024 : 2048, 128.0f, lds, tid, wave, lane); }
}
struct P0Src { const float* W; int ldw, k0, c0, drow; unsigned char* WT; };
__device__ __forceinline__ P0Src p0_expert_src(const Args& a, int it) {
    P0Src s;
    if (it < I_E1) { const int e = it / (16 * KB1), r2 = it % (16 * KB1), nb = r2 / KB1, kb = r2 % KB1, c0 = 128 * nb;
        s.W = a.in[I_W1] + (size_t)e * 1024 * 2048; s.ldw = 2048; s.k0 = 512 * kb; s.c0 = c0; s.drow = e * 2048 + ((c0 < 1024) ? (256 * (c0 >> 7)) : (256 * ((c0 - 1024) >> 7) + 128)); s.WT = a.ws + WS_W1; }
    else { const int r = it - I_E1, e = r / (8 * KB2), r2 = r % (8 * KB2), nb = r2 / KB2, kb = r2 % KB2;
        s.W = a.in[I_W2] + (size_t)e * 1024 * 1024; s.ldw = 1024; s.k0 = 512 * kb; s.c0 = 128 * nb; s.drow = e * 1024 + 128 * nb; s.WT = a.ws + WS_W2; }
    return s;
}
__device__ __forceinline__ void p0_load_batch(f32x4 (&v)[4][4], const P0Src& s, int batch, int wave, int lane) {
    const int l32 = lane & 31, hf = lane >> 5, kb = batch * 256 + wave * 32;
#pragma unroll
    for (int i = 0; i < 4; ++i)
#pragma unroll
        for (int j = 0; j < 4; ++j) v[i][j] = __builtin_nontemporal_load((const f32x4*)(s.W + (size_t)(s.k0 + kb + 4 * (2 * i + hf) + j) * s.ldw + s.c0 + 4 * l32));
}
__device__ __forceinline__ void p0_pack_batch8(const f32x4 (&v)[4][4], int batch, LAS unsigned char* T, int wave, int lane) {
    const int l32 = lane & 31, hf = lane >> 5, kb = batch * 256 + wave * 32;
#pragma unroll
    for (int i = 0; i < 4; ++i) { const int kk = kb + 4 * (2 * i + hf);
#pragma unroll
        for (int c = 0; c < 4; ++c) { const int n = 4 * l32 + c; *(LAS unsigned*)(T + n * 516 + 4 * ((kk >> 2) ^ ((n >> 5) & 3))) = pk4_fp8(v[i][0][c] * 128.0f, v[i][1][c] * 128.0f, v[i][2][c] * 128.0f, v[i][3][c] * 128.0f); } }
}
__device__ __forceinline__ void p0_expert_items_pipelined(const Args& a, LAS unsigned char* T, int bid, int G, int n_items, int tid, int wave, int lane) {
    if (bid >= n_items) return;
    f32x4 vA[4][4], vB[4][4];
    P0Src cur = p0_expert_src(a, bid);
    p0_load_batch(vA, cur, 0, wave, lane);
#pragma unroll 1
    for (int it = bid; it < n_items; it += G) {
        p0_load_batch(vB, cur, 1, wave, lane);
        p0_pack_batch8(vA, 0, T, wave, lane);
        const int nx = it + G; const P0Src nxt = p0_expert_src(a, nx < n_items ? nx : it);
        if (nx < n_items) p0_load_batch(vA, nxt, 0, wave, lane);
        p0_pack_batch8(vB, 1, T, wave, lane);
        __syncthreads();
#pragma unroll
        for (int i = 0; i < 8; ++i) { const int piece = tid + NTHR * i, n = piece >> 5, c = piece & 31, sw = (n >> 5) & 3; const LAS unsigned* tp = (const LAS unsigned*)(T + n * 516 + 16 * c);
            v4u o; o.x = tp[0 ^ sw]; o.y = tp[1 ^ sw]; o.z = tp[2 ^ sw]; o.w = tp[3 ^ sw];
            *(GAS v4u*)(cur.WT + (size_t)(cur.drow + n) * 1024 + cur.k0 + 16 * c) = o; }
        __syncthreads();
        cur = nxt;
    }
}
#ifndef DEFER_EXPERT_CVT
#define DEFER_EXPERT_CVT 1
#endif
#ifndef CVT_IN_A
#define CVT_IN_A 0
#endif
__device__ __forceinline__ void deferred_cvt_items(const Args& a, LAS unsigned char* lds, int bid, int G, int h, int tid, int wave, int lane) {
    if (!(DEFER_EXPERT_CVT && G == 256)) return;
    constexpr int PER = N_EXP_ITEMS / 256;
    const int j0 = h ? CVT_IN_A : 0, j1 = h ? PER : CVT_IN_A;
    if (MOE_FP8_G1 && MOE_FP8_G2) { if (j1 > j0) p0_expert_items_pipelined(a, lds, bid + 256 * j0, 256, 256 * j1, tid, wave, lane); }
    else for (int j = j0; j < j1; ++j) p0_expert_item(a, lds, bid + 256 * j, tid, wave, lane);
}
__device__ __forceinline__ void p0_bg_items(const Args& a, LAS unsigned char* lds, int bid, int G, int tid, int wave, int lane) {
    if (G == 256 && bid >= 128) { for (int j = 0; j < N_BG_ITEMS / 128; ++j) p0_expert_item(a, lds, N_EXP_ITEMS - N_BG_ITEMS + (bid - 128) + 128 * j, tid, wave, lane); }
}
__device__ __forceinline__ void p0_prologue(const Args& a, LAS unsigned char* lds, int bid, int G, int tid, int wave, int lane) {
    unsigned char* ws = a.ws;
    {
      for (int it = (G == 256) ? ((bid >= 144 && wave < 2) ? (bid - 144) * 2 + wave : 192) : ((wave == 0) ? bid : 192); it < 192; it += (G == 256 ? 192 : G)) {
        const int nc = it % 24, kc = it / 24, n = nc * 256 + 4 * lane;
        const float* W = a.in[I_ADAW]; const float* c = a.in[I_C];
        f32x4 a0 = {0.f, 0.f, 0.f, 0.f}, a1 = {0.f, 0.f, 0.f, 0.f};
#pragma unroll 8
        for (int kk = 0; kk < 128; ++kk) { const int k = kc * 128 + kk; const f32x4 w = __builtin_nontemporal_load((const f32x4*)(W + (size_t)k * 6144 + n));
            const float c0 = silu_f(c[k]), c1 = silu_f(c[1024 + k]); a0 += c0 * w; a1 += c1 * w; }
        float* mp = (float*)(ws + WS_MODP);
        *(f32x4*)(mp + (size_t)(kc * 2 + 0) * 6144 + n) = a0; *(f32x4*)(mp + (size_t)(kc * 2 + 1) * 6144 + n) = a1;
      } }
    constexpr int I_IN = 28 * 4, I_OUT = 8 * 4;
    const int n_p0 = (G == 256) ? (N_EXP_ITEMS - N_BG_ITEMS) : N_EXP_ITEMS;
    if (!(DEFER_EXPERT_CVT && G == 256)) {
    if (MOE_FP8_G1 && MOE_FP8_G2) p0_expert_items_pipelined(a, lds, bid, G, n_p0, tid, wave, lane);
    else for (int it = bid; it < n_p0; it += G) p0_expert_item(a, lds, it, tid, wave, lane);
    }
    for (int it = bid; it < I_IN + I_OUT; it += G) {
        if (it < I_IN) { const int nb = it >> 2, kb = it & 3; p0_item<false>(a.in[I_WIN], IN_COLS, 256 * kb, 128 * nb, ws + WS_WIN, 128 * nb, 2048, 1.0f, lds, tid, wave, lane); }
        else { const int r = it - I_IN, nb = r >> 2, kb = r & 3; p0_item<false>(a.in[I_WOUT], D, 256 * kb, 128 * nb, ws + WS_WOUT, 128 * nb, 2048, 1.0f, lds, tid, wave, lane); }
    }
}

__device__ __forceinline__ void load_mod_AS(LAS float* A, LAS float* S, const float* normw, const float* src, int nparts, const float* bias, int b, int shift_off, int tid) {
    for (int k = tid; k < 1024; k += NTHR) {
        float sh = bias ? bias[shift_off + k] : 0.f, sc = bias ? bias[shift_off + 1024 + k] : 0.f;
        for (int p = 0; p < nparts; ++p) { const float* q = src + (size_t)(p * 2 + b) * 6144 + shift_off; sh += q[k]; sc += q[1024 + k]; }
        A[k] = normw[k] * (1.0f + sc); S[k] = sh;
    }
}
__device__ __forceinline__ float softplus_f(float x) { return fmaxf(x, 0.f) + log1pf(__expf(-fabsf(x))); }

__device__ __forceinline__ void p1_norm(const Args& a, LAS unsigned char* lds, int bid, int G, int tid, int wave, int lane) {
    unsigned char* ws = a.ws;
    LAS float* A1 = (LAS float*)(lds); LAS float* S1 = A1 + 1024; LAS float* WDT = S1 + 1024;
    const float* modp = (const float*)(ws + WS_MODP);
    for (int idx = bid * NTHR + tid; idx < 2 * 6144; idx += G * NTHR) { const int b = idx / 6144, n = idx % 6144; float s = a.in[I_ADAB][n];
        for (int p = 0; p < 8; ++p) s += modp[(size_t)(p * 2 + b) * 6144 + n];
        ((float*)(ws + WS_MODF))[idx] = s; }
    for (int idx = tid; idx < 8192; idx += NTHR) { const int k = idx >> 3, jj = idx & 7; WDT[jj * 1024 + k] = a.in[I_WIN][(size_t)k * IN_COLS + NPROJ + jj]; }
    const float* x = a.in[I_X]; bf16* H = (bf16*)(ws + WS_H); float* DT = (float*)(ws + WS_DT);
    for (int c = bid; c < NCHUNK; c += G) {
        const int b = c >> 7;
        __syncthreads();
        load_mod_AS(A1, S1, a.in[I_N1W], modp, 8, a.in[I_ADAB], b, 0, tid);
        __syncthreads();
        f32x4 vn[4];
        { const GAS f32x4* xr = (const GAS f32x4*)(x + (size_t)(c * 64 + wave * 8) * D) + lane;
#pragma unroll
          for (int j = 0; j < 4; ++j) vn[j] = __builtin_nontemporal_load((const f32x4*)xr + 64 * j); }
#pragma unroll 1
        for (int r = 0; r < 8; ++r) {
            const int m = c * 64 + wave * 8 + r;
            f32x4 v[4]; float ss = 0.f;
#pragma unroll
            for (int j = 0; j < 4; ++j) { v[j] = vn[j]; ss += (v[j].x * v[j].x + v[j].y * v[j].y) + (v[j].z * v[j].z + v[j].w * v[j].w); }
            if (r < 7) { const GAS f32x4* xr = (const GAS f32x4*)(x + (size_t)(m + 1) * D) + lane;
#pragma unroll
                for (int j = 0; j < 4; ++j) vn[j] = __builtin_nontemporal_load((const f32x4*)xr + 64 * j); }
            const float rstd = rsqrtf(wave_sum(ss) * (1.0f / D) + EPS);
            float dacc[8];
#pragma unroll
            for (int jj = 0; jj < 8; ++jj) dacc[jj] = 0.f;
            GAS unsigned long long* o8 = (GAS unsigned long long*)(H + (size_t)m * D) + lane;
#pragma unroll
            for (int j = 0; j < 4; ++j) {
                const f32x4 av = *(const LAS f32x4*)(A1 + 256 * j + 4 * lane), sv = *(const LAS f32x4*)(S1 + 256 * j + 4 * lane);
                const f32x4 h = v[j] * rstd * av + sv;
                o8[64 * j] = (unsigned long long)pk2(h.x, h.y) | ((unsigned long long)pk2(h.z, h.w) << 32);
#pragma unroll
                for (int jj = 0; jj < 8; ++jj) { const f32x4 w = *(const LAS f32x4*)(WDT + jj * 1024 + 256 * j + 4 * lane); dacc[jj] += (h.x * w.x + h.y * w.y) + (h.z * w.z + h.w * w.w); }
            }
            { const bool u5 = (lane & 32) != 0, u4 = (lane & 16) != 0, u3 = (lane & 8) != 0; float p4[4], p2[2], p1;
#pragma unroll
              for (int i = 0; i < 4; ++i) { const float lo = dacc[i], hi = dacc[i + 4]; p4[i] = (u5 ? hi : lo) + __shfl_xor(u5 ? lo : hi, 32); }
#pragma unroll
              for (int i = 0; i < 2; ++i) { const float lo = p4[i], hi = p4[i + 2]; p2[i] = (u4 ? hi : lo) + __shfl_xor(u4 ? lo : hi, 16); }
              { const float lo = p2[0], hi = p2[1]; p1 = (u3 ? hi : lo) + __shfl_xor(u3 ? lo : hi, 8); }
              p1 += __shfl_xor(p1, 4); p1 += __shfl_xor(p1, 2); p1 += __shfl_xor(p1, 1);
              const int col = lane >> 3;
              if ((lane & 7) == 0) DT[(size_t)m * 8 + col] = softplus_f(p1 + a.in[I_DTB][col]); }
        }
    }
}

__device__ __forceinline__ void hgrn_naive(const Args& a, LAS unsigned char* lds, int bh, int tid, int wave, int lane) {
    unsigned char* ws = a.ws;
    const int b = bh >> 2, h = bh & 3, j = tid & 127, kq = tid >> 7;
    LAS float* FE = (LAS float*)lds; LAS float* KK = FE + 2048; LAS float* QQ = KK + 2048; LAS float* VV = QQ + 2048; LAS float* RED = VV + 2048;
    const bf16* P = (const bf16*)(ws + WS_P); const float* LF = (const float*)(ws + WS_LF); bf16* MIX = (bf16*)(ws + WS_MIX);
    const float* nw = a.in[I_HGNW];
    float S[32];
#pragma unroll
    for (int i = 0; i < 32; ++i) S[i] = 0.f;
    for (int t0 = 0; t0 < SEQ; t0 += 16) {
        for (int idx = tid; idx < 2048; idx += NTHR) { const int tt = idx >> 7, k = idx & 127; const size_t row = (size_t)b * SEQ + t0 + tt;
            FE[idx] = __expf(LF[row * 512 + h * 128 + k]); KK[idx] = bf2f(P[row * NPROJ + PC_K + h * 128 + k]);
            QQ[idx] = bf2f(P[row * NPROJ + PC_Q + h * 128 + k]); VV[idx] = bf2f(P[row * NPROJ + PC_V + h * 128 + k]); }
        __syncthreads();
#pragma unroll 1
        for (int tt = 0; tt < 16; ++tt) {
            const float vj = VV[tt * 128 + j]; float p = 0.f;
#pragma unroll
            for (int i4 = 0; i4 < 8; ++i4) {
                const f32x4 f4 = *(const LAS f32x4*)(FE + tt * 128 + 32 * kq + 4 * i4), k4 = *(const LAS f32x4*)(KK + tt * 128 + 32 * kq + 4 * i4), q4 = *(const LAS f32x4*)(QQ + tt * 128 + 32 * kq + 4 * i4);
#pragma unroll
                for (int c = 0; c < 4; ++c) { S[4 * i4 + c] = f4[c] * S[4 * i4 + c] + k4[c] * vj; p += S[4 * i4 + c] * q4[c]; }
            }
            RED[(kq * 16 + tt) * 128 + j] = p;
        }
        __syncthreads();
#pragma unroll
        for (int r = 0; r < 2; ++r) { const int tt = 2 * wave + r; const size_t row = (size_t)b * SEQ + t0 + tt;
            float o0 = 0.f, o1 = 0.f;
#pragma unroll
            for (int q = 0; q < 4; ++q) { o0 += RED[(q * 16 + tt) * 128 + lane]; o1 += RED[(q * 16 + tt) * 128 + 64 + lane]; }
            const float rstd = rsqrtf(wave_sum(o0 * o0 + o1 * o1) * (1.0f / 128.0f) + EPS);
            MIX[row * D + h * 128 + lane] = (bf16)f2bf(o0 * rstd * nw[lane] * bf2f(P[row * NPROJ + PC_G + h * 128 + lane]));
            MIX[row * D + h * 128 + 64 + lane] = (bf16)f2bf(o1 * rstd * nw[64 + lane] * bf2f(P[row * NPROJ + PC_G + h * 128 + 64 + lane])); }
    }
}
__device__ __forceinline__ void ssd_naive(const Args& a, LAS unsigned char* lds, int bg, int tid, int wave, int lane) {
    unsigned char* ws = a.ws;
    const int b = bg >> 1, g = bg & 1, p = tid & 63, hl = wave >> 1, nh = wave & 1;
    LAS float* XS = (LAS float*)lds; LAS float* BM = XS + 4096; LAS float* CM = BM + 2048; LAS float* DTL = CM + 2048; LAS float* DEC = DTL + 64; LAS float* RED = DEC + 64;
    const bf16* P = (const bf16*)(ws + WS_P); const float* DT = (const float*)(ws + WS_DT); bf16* MIX = (bf16*)(ws + WS_MIX);
    const float* cw = a.in[I_CONVW]; const float* cb = a.in[I_CONVB];
    float hS[64];
#pragma unroll
    for (int i = 0; i < 64; ++i) hS[i] = 0.f;
    for (int t0 = 0; t0 < SEQ; t0 += 16) {
        for (int idx = tid; idx < 16 * 512; idx += NTHR) { const int tt = idx >> 9, cc = idx & 511, t = t0 + tt;
            const int ch = (cc < 256) ? (g * 256 + cc) : (cc < 384) ? (512 + g * 128 + (cc - 256)) : (768 + g * 128 + (cc - 384));
            float v = cb[ch];
#pragma unroll
            for (int w = 0; w < 4; ++w) { const int ts = t - 3 + w; if (ts >= 0) v += bf2f(P[((size_t)b * SEQ + ts) * NPROJ + PC_X + ch]) * cw[w * 1024 + ch]; }
            v = silu_f(v);
            if (cc < 256) XS[tt * 256 + cc] = v; else if (cc < 384) BM[tt * 128 + cc - 256] = v; else CM[tt * 128 + cc - 384] = v; }
        if (tid < 64) { const int tt = tid >> 2, hh = tid & 3; const float dtv = DT[((size_t)b * SEQ + t0 + tt) * 8 + g * 4 + hh]; DTL[tid] = dtv; DEC[tid] = __expf(-dtv * __expf(a.in[I_ALOG][g * 4 + hh])); }
        __syncthreads();
#pragma unroll 1
        for (int tt = 0; tt < 16; ++tt) {
            const float dec = DEC[tt * 4 + hl], xdt = XS[tt * 256 + hl * 64 + p] * DTL[tt * 4 + hl]; float y = 0.f;
#pragma unroll
            for (int i4 = 0; i4 < 16; ++i4) { const f32x4 B4 = *(const LAS f32x4*)(BM + tt * 128 + nh * 64 + 4 * i4), C4 = *(const LAS f32x4*)(CM + tt * 128 + nh * 64 + 4 * i4);
#pragma unroll
                for (int c = 0; c < 4; ++c) { hS[4 * i4 + c] = dec * hS[4 * i4 + c] + xdt * B4[c]; y += hS[4 * i4 + c] * C4[c]; } }
            RED[(nh * 16 + tt) * 256 + hl * 64 + p] = y;
        }
        __syncthreads();
#pragma unroll
        for (int r = 0; r < 2; ++r) { const int tt = 2 * wave + r; const size_t row = (size_t)b * SEQ + t0 + tt;
            float yv[4], ss = 0.f;
#pragma unroll
            for (int i = 0; i < 4; ++i) { const int c = lane + 64 * i; float y = RED[tt * 256 + c] + RED[(16 + tt) * 256 + c] + a.in[I_SSMD][g * 4 + i] * XS[tt * 256 + c];
                y *= bf2f(P[row * NPROJ + PC_Z + g * 256 + c]); yv[i] = y; ss += y * y; }
            const float rstd = rsqrtf(wave_sum(ss) * (1.0f / 256.0f) + EPS);
#pragma unroll
            for (int i = 0; i < 4; ++i) { const int c = lane + 64 * i; MIX[row * D + 512 + g * 256 + c] = (bf16)f2bf(yv[i] * rstd * a.in[I_SSMNW][g * 256 + c]); }
        }
        __syncthreads();
    }
}


typedef float f32x16 __attribute__((ext_vector_type(16)));
constexpr size_t WS_UHG = 480 * MiB, WS_SHG = 496 * MiB, WS_USSD = 512 * MiB, WS_SSSD = 544 * MiB, WS_DK = 560 * MiB, WS_DEC = 561 * MiB;
constexpr int LDA = 136, LDT = 72;

__device__ __forceinline__ int crow(int i, int hh) { return (i & 3) + 8 * (i >> 2) + 4 * hh; }
__device__ __forceinline__ void mma32(f32x16& acc, const LAS bf16* A, int lda, const LAS bf16* Bt, int ldb, int nsteps, int lane) {
    const LAS bf16* ap = A + (lane & 31) * lda + 8 * (lane >> 5);
    const LAS bf16* bp = Bt + (lane & 31) * ldb + 8 * (lane >> 5);
    for (int s = 0; s < nsteps; ++s) {
        const bf16x8 av = *(const LAS bf16x8*)(ap + 16 * s), bv = *(const LAS bf16x8*)(bp + 16 * s);
        acc = __builtin_amdgcn_mfma_f32_32x32x16_bf16(av, bv, acc, 0, 0, 0);
    }
}
__device__ __forceinline__ f32x16 zero16() { f32x16 z;
#pragma unroll
    for (int i = 0; i < 16; ++i) z[i] = 0.f; return z; }
__device__ __forceinline__ void st8(LAS bf16* p, float a, float b, float c, float d) { *(LAS unsigned long long*)p = (unsigned long long)pk2(a, b) | ((unsigned long long)pk2(c, d) << 32); }
__device__ __forceinline__ void st16x(LAS bf16* p, const float* v) {
    v4u a, b; a.x = pk2(v[0], v[1]); a.y = pk2(v[2], v[3]); a.z = pk2(v[4], v[5]); a.w = pk2(v[6], v[7]); b.x = pk2(v[8], v[9]); b.y = pk2(v[10], v[11]); b.z = pk2(v[12], v[13]); b.w = pk2(v[14], v[15]);
    *(LAS v4u*)p = a; *(LAS v4u*)(p + 8) = b; }

__device__ __forceinline__ float bfw(unsigned w, int hi) { return __uint_as_float(hi ? (w & 0xffff0000u) : (w << 16)); }
constexpr int HG_QS = 0, HG_KS = 17408, HG_KDT = 34816, HG_VT = 53248, HG_ST = 71680, HG_ATT = 106496, HG_QT = 115712, HG_EBM = 117760, HG_EBL = 118272;
constexpr int HG_VRAW = 118784;
struct HgWide { v4u q[2], k[2], v[2]; float lf[16]; };
template <bool FULL> __device__ __forceinline__ void hg_load(const Args& a, HgWide& r, int b, int h, int t0, int tid) {
    const bf16* P = (const bf16*)(a.ws + WS_P) + ((size_t)b * SEQ + t0) * NPROJ + h * 128;
#pragma unroll
    for (int i = 0; i < 2; ++i) { const int piece = tid + NTHR * i; const unsigned o = (unsigned)(piece >> 4) * NPROJ + 8u * (unsigned)(piece & 15);
        r.k[i] = *(const v4u*)(P + o + PC_K); r.v[i] = *(const v4u*)(P + o + PC_V); if (FULL) r.q[i] = *(const v4u*)(P + o + PC_Q); }
    const int k = tid & 127, tq = tid >> 7;
    const float* LF = (const float*)(a.ws + WS_LF) + ((size_t)b * SEQ + t0 + 16 * tq) * 512 + h * 128;
#pragma unroll
    for (int i = 0; i < 16; ++i) r.lf[i] = LF[(unsigned)i * 512 + (unsigned)k];
}
template <bool FULL> __device__ __forceinline__ float hg_stage(const HgWide& r, LAS unsigned char* lds, int tid) {
    LAS bf16* QS = (LAS bf16*)(lds + HG_QS); LAS bf16* KS = (LAS bf16*)(lds + HG_KS); LAS bf16* KDT = (LAS bf16*)(lds + HG_KDT); LAS bf16* VT = (LAS bf16*)(lds + HG_VT); LAS bf16* VR = (LAS bf16*)(lds + HG_VRAW);
    LAS float* QT = (LAS float*)(lds + HG_QT); LAS float* EBM = (LAS float*)(lds + HG_EBM); LAS float* EBL = (LAS float*)(lds + HG_EBL);
#pragma unroll
    for (int i = 0; i < 2; ++i) { const int piece = tid + NTHR * i; const int o = (piece >> 4) * LDA + 8 * (piece & 15);
        *(LAS v4u*)(KS + o) = r.k[i]; *(LAS v4u*)(VR + o) = r.v[i]; if (FULL) *(LAS v4u*)(QS + o) = r.q[i]; }
    const int k = tid & 127, tq = tid >> 7;
    float cum[16]; float run = 0.f;
#pragma unroll
    for (int i = 0; i < 16; ++i) { run += r.lf[i]; cum[i] = run; }
    QT[tq * 128 + k] = run;
    __syncthreads();
    const float q0 = QT[k], q1 = QT[128 + k], q2 = QT[256 + k], q3 = QT[384 + k];
    const float off = (tq > 0 ? q0 : 0.f) + (tq > 1 ? q1 : 0.f) + (tq > 2 ? q2 : 0.f), bmid = q0 + q1, blast = (q0 + q1) + (q2 + q3);
    float kd[16], vv[16];
#pragma unroll
    for (int i = 0; i < 16; ++i) { const float bt = off + cum[i]; const int e = (16 * tq + i) * LDA + k; const float kk = bf2f(KS[e]); vv[i] = bf2f(VR[e]); kd[i] = kk * __expf(blast - bt);
        if (FULL) { QS[e] = (bf16)f2bf(bf2f(QS[e]) * __expf(bt - bmid)); KS[e] = (bf16)f2bf(kk * __expf(bmid - bt)); } }
    st16x(KDT + k * LDT + 16 * tq, kd); st16x(VT + k * LDT + 16 * tq, vv);
    if (tq == 0) { EBL[k] = __expf(blast); if (FULL) EBM[k] = __expf(bmid); }
    __syncthreads();
    return blast;
}
__device__ __forceinline__ void hg_update(f32x16 (&S)[2], LAS unsigned char* lds, int wave, int lane) {
    const LAS bf16* KDT = (const LAS bf16*)(lds + HG_KDT); const LAS bf16* VT = (const LAS bf16*)(lds + HG_VT); const LAS float* EBL = (const LAS float*)(lds + HG_EBL);
    const int kt = wave >> 1, hh = lane >> 5;
#pragma unroll
    for (int g = 0; g < 4; ++g) { const f32x4 e = *(const LAS f32x4*)(EBL + 32 * kt + 8 * g + 4 * hh);
#pragma unroll
        for (int j = 0; j < 2; ++j) { S[j][4 * g + 0] *= e.x; S[j][4 * g + 1] *= e.y; S[j][4 * g + 2] *= e.z; S[j][4 * g + 3] *= e.w; } }
#pragma unroll
    for (int j = 0; j < 2; ++j) mma32(S[j], KDT + 32 * kt * LDT, LDT, VT + 32 * (2 * (wave & 1) + j) * LDT, LDT, 4, lane);
}
__device__ __forceinline__ void hg_passA(const Args& a, LAS unsigned char* lds, int u, int tid, int wave, int lane) {
    const int bh = u >> 5, seg = u & 31, b = bh >> 2, h = bh & 3, kt = wave >> 1, hh = lane >> 5, r = lane & 31;
    f32x16 S[2]; S[0] = zero16(); S[1] = zero16();
    float dsum = 0.f;
    HgWide cur; hg_load<false>(a, cur, b, h, seg * 256, tid);
#pragma unroll 1
    for (int c = 0; c < 4; ++c) {
        dsum += hg_stage<false>(cur, lds, tid);
        if (c < 3) hg_load<false>(a, cur, b, h, seg * 256 + 64 * (c + 1), tid);
        hg_update(S, lds, wave, lane);
    }
    float* U = (float*)(a.ws + WS_UHG) + (size_t)u * 16384;
#pragma unroll
    for (int j = 0; j < 2; ++j)
#pragma unroll
        for (int i = 0; i < 16; ++i) U[(32 * kt + crow(i, hh)) * 128 + 32 * (2 * (wave & 1) + j) + r] = S[j][i];
    if (tid < 128) ((float*)(a.ws + WS_DK))[u * 128 + tid] = __expf(dsum);
}
__device__ __forceinline__ void hg_passC(const Args& a, LAS unsigned char* lds, int u, int tid, int wave, int lane) {
    const int bh = u >> 5, seg = u & 31, b = bh >> 2, h = bh & 3, kt = wave >> 1, hh = lane >> 5, r = lane & 31;
    LAS bf16* QS = (LAS bf16*)(lds + HG_QS); LAS bf16* KS = (LAS bf16*)(lds + HG_KS); LAS bf16* VT = (LAS bf16*)(lds + HG_VT);
    LAS bf16* ST = (LAS bf16*)(lds + HG_ST); LAS bf16* ATT = (LAS bf16*)(lds + HG_ATT); LAS float* EBM = (LAS float*)(lds + HG_EBM); LAS float* O = (LAS float*)(lds + HG_ST);
    const bf16* P = (const bf16*)(a.ws + WS_P); bf16* MIX = (bf16*)(a.ws + WS_MIX); const float* nw = a.in[I_HGNW];
    f32x16 S[2];
    { const float* SI = (const float*)(a.ws + WS_SHG) + (size_t)u * 16384;
#pragma unroll
      for (int j = 0; j < 2; ++j)
#pragma unroll
        for (int i = 0; i < 16; ++i) S[j][i] = SI[(32 * kt + crow(i, hh)) * 128 + 32 * (2 * (wave & 1) + j) + r]; }
    HgWide cur; hg_load<true>(a, cur, b, h, seg * 256, tid);
#pragma unroll 1
    for (int c = 0; c < 4; ++c) {
        const int t0 = seg * 256 + 64 * c;
        hg_stage<true>(cur, lds, tid);
        if (c < 3) hg_load<true>(a, cur, b, h, t0 + 64, tid);
#pragma unroll
        for (int g = 0; g < 4; ++g) { const int kb = 32 * kt + 8 * g + 4 * hh; const f32x4 e = *(const LAS f32x4*)(EBM + kb);
#pragma unroll
            for (int j = 0; j < 2; ++j) st8(ST + (32 * (2 * (wave & 1) + j) + r) * LDA + kb, S[j][4 * g] * e.x, S[j][4 * g + 1] * e.y, S[j][4 * g + 2] * e.z, S[j][4 * g + 3] * e.w); }
        if (wave < 3) { const int ti = (wave + 1) >> 1, si = wave >> 1;
            f32x16 at = zero16(); mma32(at, QS + 32 * ti * LDA, LDA, KS + 32 * si * LDA, LDA, 8, lane);
#pragma unroll
            for (int i = 0; i < 16; ++i) { const int t = 32 * ti + crow(i, hh), s = 32 * si + r; ATT[t * LDT + s] = (bf16)f2bf(s <= t ? at[i] : 0.f); } }
        __syncthreads();
        const int ti = wave >> 2, vj = wave & 3;
        f32x16 o = zero16();
        mma32(o, ATT + 32 * ti * LDT, LDT, VT + 32 * vj * LDT, LDT, 2 * (ti + 1), lane);
        mma32(o, QS + 32 * ti * LDA, LDA, ST + 32 * vj * LDA, LDA, 8, lane);
        hg_update(S, lds, wave, lane);
        __syncthreads();
#pragma unroll
        for (int i = 0; i < 16; ++i) O[(32 * ti + crow(i, hh)) * 132 + 32 * vj + r] = o[i];
        __syncthreads();
        { const int tt = tid >> 3, c16 = tid & 7; const size_t row = (size_t)b * SEQ + t0 + tt;
          float o[16]; float ss = 0.f;
#pragma unroll
          for (int q = 0; q < 4; ++q) { const f32x4 v = *(const LAS f32x4*)(O + tt * 132 + 16 * c16 + 4 * q); o[4 * q] = v.x; o[4 * q + 1] = v.y; o[4 * q + 2] = v.z; o[4 * q + 3] = v.w; ss += (v.x * v.x + v.y * v.y) + (v.z * v.z + v.w * v.w); }
          ss += __shfl_xor(ss, 1); ss += __shfl_xor(ss, 2); ss += __shfl_xor(ss, 4);
          const float rstd = rsqrtf(ss * (1.0f / 128.0f) + EPS);
          const bf16* gp = P + row * NPROJ + PC_G + h * 128 + 16 * c16; const v4u g0 = __builtin_nontemporal_load((const v4u*)gp), g1 = __builtin_nontemporal_load((const v4u*)(gp + 8)); const unsigned gw[8] = {g0.x, g0.y, g0.z, g0.w, g1.x, g1.y, g1.z, g1.w};
          unsigned ow[8];
#pragma unroll
          for (int j = 0; j < 8; ++j) ow[j] = pk2(o[2 * j] * rstd * nw[16 * c16 + 2 * j] * bfw(gw[j], 0), o[2 * j + 1] * rstd * nw[16 * c16 + 2 * j + 1] * bfw(gw[j], 1));
          bf16* mp = MIX + row * D + h * 128 + 16 * c16; *(v4u*)mp = (v4u){ow[0], ow[1], ow[2], ow[3]}; *(v4u*)(mp + 8) = (v4u){ow[4], ow[5], ow[6], ow[7]}; }
    }
    __syncthreads();
}

constexpr int SD_ACUM = 104448, SD_DTV = 106496, SD_SSQ = 108544, SD_CB = 109568;
__device__ __forceinline__ void ssd_scan_dt(const Args& a, LAS unsigned char* lds, size_t row0, int g, int wave, int lane) {
    LAS float* ACUM = (LAS float*)(lds + SD_ACUM); LAS float* DTV = (LAS float*)(lds + SD_DTV);
    if (wave < 4) { const float* DT = (const float*)(a.ws + WS_DT); const float A = -__expf(a.in[I_ALOG][g * 4 + wave]);
        const float d0 = DT[(row0 + 2 * lane) * 8 + g * 4 + wave], d1 = DT[(row0 + 2 * lane + 1) * 8 + g * 4 + wave];
        const float p0 = d0 * A, p1 = p0 + d1 * A; float incl = p1;
#pragma unroll
        for (int o = 1; o < 64; o <<= 1) { const float t = __shfl_up(incl, o); if (lane >= o) incl += t; }
        const float excl = incl - p1;
        ACUM[wave * 128 + 2 * lane] = excl + p0; ACUM[wave * 128 + 2 * lane + 1] = incl; DTV[wave * 128 + 2 * lane] = d0; DTV[wave * 128 + 2 * lane + 1] = d1; }
}
template <int NT> __device__ __forceinline__ void conv_run(const Args& a, int b, int tp0, int ch, float (&out)[NT]) {
    const bf16* Pb = (const bf16*)(a.ws + WS_P) + (size_t)b * SEQ * NPROJ + PC_X;
    const float w0 = a.in[I_CONVW][ch], w1 = a.in[I_CONVW][1024 + ch], w2 = a.in[I_CONVW][2048 + ch], w3 = a.in[I_CONVW][3072 + ch], cb = a.in[I_CONVB][ch];
    const unsigned o0 = (unsigned)tp0 * NPROJ + (unsigned)ch;
    float x0 = (tp0 >= 3) ? bf2f(Pb[o0 - 3u * NPROJ]) : 0.f, x1 = (tp0 >= 2) ? bf2f(Pb[o0 - 2u * NPROJ]) : 0.f, x2 = (tp0 >= 1) ? bf2f(Pb[o0 - 1u * NPROJ]) : 0.f;
#pragma unroll
    for (int i = 0; i < NT; ++i) { const float x3 = bf2f(Pb[o0 + (unsigned)i * NPROJ]); out[i] = silu_f(cb + w0 * x0 + w1 * x1 + w2 * x2 + w3 * x3); x0 = x1; x1 = x2; x2 = x3; }
}
#ifdef PROBE_A
#define SUBSTAMP(k) do { if (blockIdx.x == 0 && threadIdx.x == 0) { const unsigned long long t_ = __builtin_amdgcn_s_memrealtime(); volatile LAS unsigned* M_ = (volatile LAS unsigned*)(lds + MISC_OFF); M_[16 + 2 * (k)] = (unsigned)t_; M_[17 + 2 * (k)] = (unsigned)(t_ >> 32); } } while (0)
#else
#define SUBSTAMP(k) do { } while (0)
#endif
template <bool NATURAL, bool NT = false, int NTOK = 8> __device__ __forceinline__ void conv8x8(const Args& a, int b, int tp0, int ch0, LAS bf16* dst, const float* sc) {
    const bf16* Pb = (const bf16*)(a.ws + WS_P) + (size_t)b * SEQ * NPROJ + PC_X + ch0;
    const float* cw = a.in[I_CONVW] + ch0; const float* cbp = a.in[I_CONVB] + ch0;
    float w[4][8], bias[8];
#pragma unroll
    for (int q = 0; q < 4; ++q) { const f32x4 lo = *(const f32x4*)(cw + q * 1024), hi = *(const f32x4*)(cw + q * 1024 + 4);
        w[q][0] = lo.x; w[q][1] = lo.y; w[q][2] = lo.z; w[q][3] = lo.w; w[q][4] = hi.x; w[q][5] = hi.y; w[q][6] = hi.z; w[q][7] = hi.w; }
    { const f32x4 lo = *(const f32x4*)cbp, hi = *(const f32x4*)(cbp + 4); bias[0] = lo.x; bias[1] = lo.y; bias[2] = lo.z; bias[3] = lo.w; bias[4] = hi.x; bias[5] = hi.y; bias[6] = hi.z; bias[7] = hi.w; }
    v4u raw[NTOK + 3];
#pragma unroll
    for (int i = 0; i < NTOK + 3; ++i) { const int tp = tp0 - 3 + i; const v4u* rp = (const v4u*)(Pb + (size_t)(unsigned)(tp < 0 ? 0 : tp) * NPROJ); raw[i] = (tp >= 0) ? (NT ? __builtin_nontemporal_load(rp) : *rp) : (v4u){0u, 0u, 0u, 0u}; }
    unsigned pkT[8][NTOK / 2];
#pragma unroll
    for (int tok = 0; tok < NTOK; ++tok) { float o[8];
#pragma unroll
        for (int c = 0; c < 8; ++c) { float v = bias[c];
#pragma unroll
            for (int q = 0; q < 4; ++q) v += w[q][c] * bfw(raw[tok + q][c >> 1], c & 1);
            o[c] = silu_f(v); }
        if (NATURAL) { v4u ov; ov.x = pk2(o[0], o[1]); ov.y = pk2(o[2], o[3]); ov.z = pk2(o[4], o[5]); ov.w = pk2(o[6], o[7]); *(LAS v4u*)(dst + tok * LDA) = ov; }
        else {
#pragma unroll
            for (int c = 0; c < 8; ++c) { const unsigned hb = f2bf(o[c] * sc[tok]); pkT[c][tok >> 1] = (tok & 1) ? (pkT[c][tok >> 1] | (hb << 16)) : hb; } } }
    if (!NATURAL) {
#pragma unroll
        for (int c = 0; c < 8; ++c) {
            if (NTOK == 8) { v4u ov; ov.x = pkT[c][0]; ov.y = pkT[c][1]; ov.z = pkT[c][NTOK == 8 ? 2 : 0]; ov.w = pkT[c][NTOK == 8 ? 3 : 0]; *(LAS v4u*)(dst + c * LDA) = ov; }
            else *(LAS unsigned long long*)(dst + c * LDA) = (unsigned long long)pkT[c][0] | ((unsigned long long)pkT[c][1] << 32); } }
}
constexpr int SC_CM = 0, SC_BM = 34816, SC_XT = 69632, SC_SIN = 87040, SC_YS = 104448, SC_ACUM = 139264, SC_DTV = 141312;
__device__ __forceinline__ void ssd_scan_dt_at(const Args& a, LAS unsigned char* lds, int acum_off, int dtv_off, size_t row0, int g, int wave, int lane) {
    LAS float* ACUM = (LAS float*)(lds + acum_off); LAS float* DTV = (LAS float*)(lds + dtv_off);
    if (wave < 4) { const float* DT = (const float*)(a.ws + WS_DT); const float A = -__expf(a.in[I_ALOG][g * 4 + wave]);
        const float d0 = DT[(row0 + 2 * lane) * 8 + g * 4 + wave], d1 = DT[(row0 + 2 * lane + 1) * 8 + g * 4 + wave];
        const float p0 = d0 * A, p1 = p0 + d1 * A; float incl = p1;
#pragma unroll
        for (int o = 1; o < 64; o <<= 1) { const float t = __shfl_up(incl, o); if (lane >= o) incl += t; }
        const float excl = incl - p1;
        ACUM[wave * 128 + 2 * lane] = excl + p0; ACUM[wave * 128 + 2 * lane + 1] = incl; DTV[wave * 128 + 2 * lane] = d0; DTV[wave * 128 + 2 * lane + 1] = d1; }
}
__device__ __forceinline__ void ssd_passA(const Args& a, LAS unsigned char* lds, int u, int tid, int wave, int lane) {
    const int bg = u >> 6, c = u & 63, b = bg >> 1, g = bg & 1, t0 = c * 128; const size_t row0 = (size_t)b * SEQ + t0;
    LAS bf16* XDT = (LAS bf16*)lds; LAS bf16* BMT = (LAS bf16*)(lds + 69632); LAS float* ACUM = (LAS float*)(lds + SD_ACUM); LAS float* DTV = (LAS float*)(lds + SD_DTV);
    ssd_scan_dt(a, lds, row0, g, wave, lane);
    __syncthreads();
#pragma unroll 1
    for (int task = tid; task < 768; task += NTHR) {
        int task_o = task; asm volatile("" : "+v"(task_o));
        const int cg = task_o >> 4, tb = task_o & 15; float sc[8];
        if (cg < 32) { const int hd = cg >> 3; const float al = ACUM[hd * 128 + 127];
#pragma unroll
            for (int i = 0; i < 8; ++i) sc[i] = DTV[hd * 128 + 8 * tb + i] * __expf(al - ACUM[hd * 128 + 8 * tb + i]);
            conv8x8<false>(a, b, t0 + 8 * tb, g * 256 + 8 * cg, XDT + (8 * cg) * LDA + 8 * tb, sc); }
        else {
#pragma unroll
            for (int i = 0; i < 8; ++i) sc[i] = 1.0f;
            conv8x8<false>(a, b, t0 + 8 * tb, 512 + g * 128 + 8 * (cg - 32), BMT + (8 * (cg - 32)) * LDA + 8 * tb, sc); }
    }
    __syncthreads();
    const int hd = wave >> 1, pt = wave & 1, hh = lane >> 5, r = lane & 31;
    float* U = (float*)(a.ws + WS_USSD) + (size_t)u * 32768;
#pragma unroll
    for (int nt = 0; nt < 4; ++nt) { f32x16 acc = zero16(); mma32(acc, XDT + (hd * 64 + 32 * pt) * LDA, LDA, BMT + 32 * nt * LDA, LDA, 8, lane);
#pragma unroll
        for (int i = 0; i < 16; ++i) U[(hd * 64 + 32 * pt + crow(i, hh)) * 128 + 32 * nt + r] = acc[i]; }
    if (tid < 4) ((float*)(a.ws + WS_DEC))[u * 4 + tid] = __expf(ACUM[tid * 128 + 127]);
    __syncthreads();
}
constexpr int S2_CM = 0, S2_CBT = 34816, S2_BUF = 55296, S2_BUFSZ = 34816, S2_BM = S2_BUF + S2_BUFSZ, S2_YS = 124928, S2_ACUM = 143360, S2_DTV = 145408;
__device__ __forceinline__ void ssd_stage_head(const Args& a, LAS unsigned char* lds, int u, int b, int g, int t0, int hd, int buf, int tid256, const float* ones) {
    LAS bf16* XT = (LAS bf16*)(lds + S2_BUF + buf * S2_BUFSZ); LAS bf16* SIN = XT + 64 * LDA;
    const int c8 = tid256 & 7, tb = tid256 >> 3;
    conv8x8<false, false, 4>(a, b, t0 + 4 * tb, g * 256 + hd * 64 + 8 * c8, XT + (8 * c8) * LDA + 4 * tb, ones);
    const v4u* src = (const v4u*)((const bf16*)(a.ws + WS_SSSD) + (size_t)u * 32768) + (unsigned)(hd * 64 * 16);
#pragma unroll
    for (int j = 0; j < 4; ++j) { const int piece = tid256 + 256 * j, pr = piece >> 4, c = piece & 15; *(LAS v4u*)(SIN + pr * LDA + 8 * c) = __builtin_nontemporal_load(src + piece); }
}
__device__ __forceinline__ void ssd_passC(const Args& a, LAS unsigned char* lds, int u, int tid, int wave, int lane) {
    const int bg = u >> 6, c = u & 63, b = bg >> 1, g = bg & 1, t0 = c * 128; const size_t row0 = (size_t)b * SEQ + t0;
    LAS bf16* CM = (LAS bf16*)(lds + S2_CM); LAS bf16* BM = (LAS bf16*)(lds + S2_BM); LAS unsigned char* CBT = lds + S2_CBT;
    LAS bf16* YS = (LAS bf16*)(lds + S2_YS); LAS float* ACUM = (LAS float*)(lds + S2_ACUM); LAS float* DTV = (LAS float*)(lds + S2_DTV);
    const bf16* P = (const bf16*)(a.ws + WS_P); bf16* MIX = (bf16*)(a.ws + WS_MIX);
    float ones[4];
#pragma unroll
    for (int i = 0; i < 4; ++i) ones[i] = 1.0f;
    ssd_scan_dt_at(a, lds, S2_ACUM, S2_DTV, row0, g, wave, lane);
    { const int c8 = tid & 31, tb = tid >> 5;
      conv8x8<true>(a, b, t0 + 8 * tb, (c8 < 16) ? (512 + g * 128 + 8 * c8) : (768 + g * 128 + 8 * (c8 - 16)), ((c8 < 16) ? (BM + 8 * c8) : (CM + 8 * (c8 - 16))) + 8 * tb * LDA, nullptr); }
    __syncthreads();
    for (int idx = wave; idx < 10; idx += NWAVES) { const int ti = (idx >= 6) ? 3 : (idx >= 3) ? 2 : (idx >= 1) ? 1 : 0, si = idx - ti * (ti + 1) / 2;
        f32x16 cbT = zero16(); mma32(cbT, BM + 32 * si * LDA, LDA, CM + 32 * ti * LDA, LDA, 8, lane);
        v4u o0, o1; o0.x = pk2(cbT[0], cbT[1]); o0.y = pk2(cbT[2], cbT[3]); o0.z = pk2(cbT[4], cbT[5]); o0.w = pk2(cbT[6], cbT[7]); o1.x = pk2(cbT[8], cbT[9]); o1.y = pk2(cbT[10], cbT[11]); o1.z = pk2(cbT[12], cbT[13]); o1.w = pk2(cbT[14], cbT[15]);
        *(LAS v4u*)(CBT + idx * 2048 + lane * 32) = o0; *(LAS v4u*)(CBT + idx * 2048 + lane * 32 + 16) = o1; }
    if (tid < 256) ssd_stage_head(a, lds, u, b, g, t0, 0, 0, tid, ones);
    __syncthreads();
    const int ti = (wave < 4) ? (wave >> 1) : (3 - ((wave - 4) >> 1)), pj = wave & 1;
    const int et = tid >> 2, epq = tid & 3;
    float ssq = 0.f;
    const bf16* Pz = P + (row0 + et) * NPROJ + PC_Z + g * 256 + 16 * epq;
    bf16* Mo = MIX + (row0 + et) * D + 512 + g * 256 + 16 * epq;
    SUBSTAMP(15);
#pragma unroll 1
    for (int hd = 0; hd < 4; ++hd) {
        int tid_o = tid; asm volatile("" : "+v"(tid_o));
        const int lane = tid_o & 63, hh = lane >> 5, r = lane & 31;
        const LAS bf16* XT = (const LAS bf16*)(lds + S2_BUF + (hd & 1) * S2_BUFSZ); const LAS bf16* SIN = XT + 64 * LDA;
        const v4u z0 = __builtin_nontemporal_load((const v4u*)(Pz + hd * 64)), z1 = __builtin_nontemporal_load((const v4u*)(Pz + hd * 64 + 8));
        const float Dh = a.in[I_SSMD][g * 4 + hd];
        f32x16 yi = zero16(), yo = zero16();
        const int t = 32 * ti + r; const float at = ACUM[hd * 128 + t];
        for (int si = 0; si <= ti; ++si) {
            const LAS unsigned char* cp = CBT + (ti * (ti + 1) / 2 + si) * 2048 + lane * 32; const v4u c0 = *(const LAS v4u*)cp, c1 = *(const LAS v4u*)(cp + 16);
            const unsigned cw[8] = {c0.x, c0.y, c0.z, c0.w, c1.x, c1.y, c1.z, c1.w};
            float sv[16];
#pragma unroll
            for (int gq = 0; gq < 4; ++gq) { const int s0 = 32 * si + 8 * gq + 4 * hh;
                const f32x4 a4 = *(const LAS f32x4*)(ACUM + hd * 128 + s0), d4 = *(const LAS f32x4*)(DTV + hd * 128 + s0);
#pragma unroll
                for (int q = 0; q < 4; ++q) { const int i = 4 * gq + q, s = s0 + q; float v = (s <= t) ? bfw(cw[i >> 1], i & 1) * __expf(at - a4[q]) * d4[q] : 0.f; sv[i] = (s == t) ? v + Dh : v; } }
#pragma unroll
            for (int st = 0; st < 2; ++st) {
                v4u av;
                asm volatile("v_cvt_pk_bf16_f32 %0, %4, %5\n\tv_cvt_pk_bf16_f32 %1, %6, %7\n\tv_cvt_pk_bf16_f32 %2, %8, %9\n\tv_cvt_pk_bf16_f32 %3, %10, %11\n\ts_nop 1"
                             : "=&v"(av.x), "=&v"(av.y), "=&v"(av.z), "=&v"(av.w)
                             : "v"(sv[8 * st]), "v"(sv[8 * st + 1]), "v"(sv[8 * st + 2]), "v"(sv[8 * st + 3]), "v"(sv[8 * st + 4]), "v"(sv[8 * st + 5]), "v"(sv[8 * st + 6]), "v"(sv[8 * st + 7]));
                const LAS bf16* bp = XT + (32 * pj + r) * LDA + 32 * si + 16 * st + 4 * hh;
                const unsigned long long b0 = *(const LAS unsigned long long*)bp, b1 = *(const LAS unsigned long long*)(bp + 8);
                v4u bv; bv.x = (unsigned)b0; bv.y = (unsigned)(b0 >> 32); bv.z = (unsigned)b1; bv.w = (unsigned)(b1 >> 32);
                yi = __builtin_amdgcn_mfma_f32_32x32x16_bf16(__builtin_bit_cast(bf16x8, av), __builtin_bit_cast(bf16x8, bv), yi, 0, 0, 0);
            }
        }
        mma32(yo, CM + 32 * ti * LDA, LDA, SIN + 32 * pj * LDA, LDA, 8, lane);
#pragma unroll
        for (int i = 0; i < 16; ++i) { const int tt = 32 * ti + crow(i, hh); YS[tt * 72 + 32 * pj + r] = (bf16)f2bf(yi[i] + __expf(ACUM[hd * 128 + tt]) * yo[i]); }
        if (tid_o < 256 && hd < 3) ssd_stage_head(a, lds, u, b, g, t0, hd + 1, (hd + 1) & 1, tid_o, ones);
        __syncthreads();
        if (hd == 1) SUBSTAMP(20);
        { const LAS v4u* yp = (const LAS v4u*)(YS + et * 72 + 16 * epq); const v4u y0 = yp[0], y1 = yp[1];
          const unsigned yw[8] = {y0.x, y0.y, y0.z, y0.w, y1.x, y1.y, y1.z, y1.w}, zw[8] = {z0.x, z0.y, z0.z, z0.w, z1.x, z1.y, z1.z, z1.w};
          float y[16];
#pragma unroll
          for (int j = 0; j < 16; ++j) { y[j] = bfw(yw[j >> 1], j & 1) * bfw(zw[j >> 1], j & 1); ssq += y[j] * y[j]; }
          v4u o0, o1; o0.x = pk2(y[0], y[1]); o0.y = pk2(y[2], y[3]); o0.z = pk2(y[4], y[5]); o0.w = pk2(y[6], y[7]); o1.x = pk2(y[8], y[9]); o1.y = pk2(y[10], y[11]); o1.z = pk2(y[12], y[13]); o1.w = pk2(y[14], y[15]);
          *(v4u*)(Mo + hd * 64) = o0; *(v4u*)(Mo + hd * 64 + 8) = o1; }
        __syncthreads();
        SUBSTAMP(16 + hd);
    }
    ssq += __shfl_xor(ssq, 1); ssq += __shfl_xor(ssq, 2);
    const float rstd = rsqrtf(ssq * (1.0f / 256.0f) + EPS);
    const float* nw = a.in[I_SSMNW] + g * 256 + 16 * epq;
    v4u rb[8];
#pragma unroll
    for (int hd = 0; hd < 4; ++hd) { rb[2 * hd] = *(const v4u*)(Mo + hd * 64); rb[2 * hd + 1] = *(const v4u*)(Mo + hd * 64 + 8); }
#pragma unroll
    for (int hd = 0; hd < 4; ++hd) {
        const unsigned iw[8] = {rb[2 * hd].x, rb[2 * hd].y, rb[2 * hd].z, rb[2 * hd].w, rb[2 * hd + 1].x, rb[2 * hd + 1].y, rb[2 * hd + 1].z, rb[2 * hd + 1].w};
        float wv[16];
#pragma unroll
        for (int q = 0; q < 4; ++q) { const f32x4 v = *(const f32x4*)(nw + hd * 64 + 4 * q); wv[4 * q] = v.x; wv[4 * q + 1] = v.y; wv[4 * q + 2] = v.z; wv[4 * q + 3] = v.w; }
        unsigned ow[8];
#pragma unroll
        for (int j = 0; j < 8; ++j) ow[j] = pk2(bfw(iw[j], 0) * rstd * wv[2 * j], bfw(iw[j], 1) * rstd * wv[2 * j + 1]);
        *(v4u*)(Mo + hd * 64) = (v4u){ow[0], ow[1], ow[2], ow[3]}; *(v4u*)(Mo + hd * 64 + 8) = (v4u){ow[4], ow[5], ow[6], ow[7]};
    }
    __syncthreads();
}
__device__ __forceinline__ void mix_scan(const Args& a, int bid, int G, int tid) {
    typedef float f32x2 __attribute__((ext_vector_type(2)));
    for (int gt = bid * NTHR + tid; gt < 131072; gt += G * NTHR) {
        if (gt < 65536) { const int bh = gt >> 13, e2 = gt & 8191, k = e2 >> 6;
            const f32x2* U = (const f32x2*)(a.ws + WS_UHG) + (size_t)bh * 32 * 8192 + e2; f32x2* SI = (f32x2*)(a.ws + WS_SHG) + (size_t)bh * 32 * 8192 + e2; const float* DK = (const float*)(a.ws + WS_DK) + bh * 32 * 128 + k;
            f32x2 cur = {0.f, 0.f};
#pragma unroll 16
            for (int uu = 0; uu < 32; ++uu) { SI[(size_t)uu * 8192] = cur; cur = cur * DK[uu * 128] + __builtin_nontemporal_load(U + (size_t)uu * 8192); }
        } else { const int q = gt - 65536, bg = q >> 14, e2 = q & 16383, hd = e2 >> 12;
            const f32x2* U = (const f32x2*)(a.ws + WS_USSD) + (size_t)bg * 64 * 16384 + e2; unsigned* SI = (unsigned*)(a.ws + WS_SSSD) + (size_t)bg * 64 * 16384 + e2; const float* DEC = (const float*)(a.ws + WS_DEC) + bg * 64 * 4 + hd;
            f32x2 cur = {0.f, 0.f};
#pragma unroll 16
            for (int cc = 0; cc < 64; ++cc) { SI[(size_t)cc * 16384] = pk2(cur.x, cur.y); cur = cur * DEC[cc * 4] + __builtin_nontemporal_load(U + (size_t)cc * 16384); }
        }
    }
}

template <int HALF, int MASK> __device__ __forceinline__ void tr_step(float (&p)[32], int lane) {
    const bool up = (lane & MASK) != 0;
#pragma unroll
    for (int i = 0; i < HALF; ++i) { const float lo = p[i], hi = p[i + HALF]; const float send = up ? lo : hi, keep = up ? hi : lo; p[i] = keep + __shfl_xor(send, MASK); }
}
__device__ __forceinline__ void top4_store(float v, int lane, LAS int* SEL, LAS float* SELG, int ent) {
    float tv[4]; int ti[4];
#pragma unroll
    for (int k = 0; k < 4; ++k) { const float mx = wave_max(v); const unsigned long long bal = __ballot(v == mx); const int e = __builtin_ctzll(bal) >> 1;
        tv[k] = mx; ti[k] = e; v = ((lane >> 1) == e) ? -INFINITY : v; }
    const float e1 = __expf(tv[1] - tv[0]), e2 = __expf(tv[2] - tv[0]), e3 = __expf(tv[3] - tv[0]), inv = 1.0f / (1.0f + e1 + e2 + e3);
    if (lane < 4) { SEL[ent + lane] = (lane == 0) ? ti[0] : (lane == 1) ? ti[1] : (lane == 2) ? ti[2] : ti[3];
        SELG[ent + lane] = ((lane == 0) ? 1.0f : (lane == 1) ? e1 : (lane == 2) ? e2 : e3) * inv; }
}
constexpr int RT_WB = 0, RT_HB = 66048, RT_PITCH = 1032;
__device__ __forceinline__ void p5_router(const Args& a, LAS unsigned char* lds, int bid, int G, int tid, int wave, int lane) {
    unsigned char* ws = a.ws;
    LAS bf16* WB = (LAS bf16*)(lds + RT_WB); LAS bf16* HB = (LAS bf16*)(lds + RT_HB); LAS float* PART = (LAS float*)(lds + RT_HB);
    LAS float* A2 = (LAS float*)(lds + AUX_OFF + 1024); LAS float* S2 = A2 + 1024;
    LAS float* SELG = (LAS float*)(S2 + 1024); LAS float* LOGIT = SELG + 256;
    LAS int* SEL = (LAS int*)(lds + MISC_OFF + 2048); LAS int* LSL = SEL + 256;
    const float* modf = (const float*)(ws + WS_MODF);
    { const f32x4* rw4 = (const f32x4*)a.in[I_RW];
#pragma unroll 4
      for (int it = 0; it < 16; ++it) { const int q = tid + NTHR * it, k = q >> 3, e0 = (q & 7) * 4; const f32x4 w = rw4[q];
          WB[(e0 + 0) * RT_PITCH + k] = (bf16)f2bf(w.x); WB[(e0 + 1) * RT_PITCH + k] = (bf16)f2bf(w.y); WB[(e0 + 2) * RT_PITCH + k] = (bf16)f2bf(w.z); WB[(e0 + 3) * RT_PITCH + k] = (bf16)f2bf(w.w); } }
    const bf16* x1 = (const bf16*)(ws + WS_X1); bf16* H = (bf16*)(ws + WS_H);
    int* tok_e = (int*)(ws + WS_TOK); int* tok_ls = tok_e + M * 4; float* tok_g = (float*)(tok_ls + M * 4);
    int* blkcnt = (int*)(ws + WS_BLKCNT);
    for (int c = bid; c < NCHUNK; c += G) {
        const int b = c >> 7;
        __syncthreads();
        load_mod_AS(A2, S2, a.in[I_N2W], modf, 1, nullptr, b, 3 * 1024, tid);
        __syncthreads();
        unsigned long long hb[8][4];
        unsigned long long rwa[4];
        { const GAS unsigned long long* xa = (const GAS unsigned long long*)(x1 + (size_t)(c * 64 + wave * 8) * D) + lane;
#pragma unroll
          for (int j = 0; j < 4; ++j) rwa[j] = xa[64 * j]; }
#pragma unroll
        for (int r = 0; r < 8; ++r) {
            const int m0 = c * 64 + wave * 8 + r;
            f32x4 va[4]; float sa = 0.f;
#pragma unroll
            for (int j = 0; j < 4; ++j) { const unsigned long long wa = rwa[j];
                va[j] = (f32x4){bfw((unsigned)wa, 0), bfw((unsigned)wa, 1), bfw((unsigned)(wa >> 32), 0), bfw((unsigned)(wa >> 32), 1)};
                sa += (va[j].x * va[j].x + va[j].y * va[j].y) + (va[j].z * va[j].z + va[j].w * va[j].w); }
            if (r < 7) { const GAS unsigned long long* xa = (const GAS unsigned long long*)(x1 + (size_t)(m0 + 1) * D) + lane;
#pragma unroll
                for (int j = 0; j < 4; ++j) rwa[j] = xa[64 * j]; }
            const float ra = rsqrtf(wave_sum(sa) * (1.0f / D) + EPS);
#pragma unroll
            for (int j = 0; j < 4; ++j) {
                const f32x4 av = *(const LAS f32x4*)(A2 + 256 * j + 4 * lane), sv = *(const LAS f32x4*)(S2 + 256 * j + 4 * lane);
                const f32x4 h = va[j] * ra * av + sv;
#if MOE_FP8_G1
                ((GAS unsigned*)((unsigned char*)H + (size_t)m0 * D))[lane + 64 * j] = pk4_fp8(h.x * 8.f, h.y * 8.f, h.z * 8.f, h.w * 8.f);
#else
                ((GAS unsigned long long*)(H + (size_t)m0 * D))[lane + 64 * j] = (unsigned long long)pk2(h.x, h.y) | ((unsigned long long)pk2(h.z, h.w) << 32);
#endif
                hb[r][j] = (unsigned long long)pk2(h.x, h.y) | ((unsigned long long)pk2(h.z, h.w) << 32);
            }
        }
#pragma unroll
        for (int pass = 0; pass < 2; ++pass) {
            if ((wave >> 2) == pass) {
#pragma unroll
                for (int r = 0; r < 8; ++r)
#pragma unroll
                    for (int j = 0; j < 4; ++j) *(LAS unsigned long long*)(HB + ((wave & 3) * 8 + r) * RT_PITCH + 256 * j + 4 * lane) = hb[r][j]; }
            __syncthreads();
            f32x16 acc = zero16(); mma32(acc, HB + 128 * wave, RT_PITCH, WB + 128 * wave, RT_PITCH, 8, lane);
            __syncthreads();
#pragma unroll
            for (int i = 0; i < 16; ++i) PART[wave * 1024 + crow(i, lane >> 5) * 32 + (lane & 31)] = acc[i];
            __syncthreads();
#pragma unroll
            for (int q = 0; q < 2; ++q) { const int el = tid + NTHR * q; float sacc = 0.f;
#pragma unroll
                for (int w = 0; w < 8; ++w) sacc += PART[w * 1024 + el];
                LOGIT[(el >> 5) * 33 + (el & 31)] = sacc + a.in[I_RB][el & 31]; }
            __syncthreads();
            if (tid < 32) {
                float v[32];
#pragma unroll
                for (int e = 0; e < 32; ++e) v[e] = LOGIT[tid * 33 + e];
                float tv[4]; int ti[4];
#pragma unroll
                for (int k = 0; k < 4; ++k) { float best = v[0]; int bi = 0;
#pragma unroll
                    for (int e = 1; e < 32; ++e) { const bool gt = v[e] > best; best = gt ? v[e] : best; bi = gt ? e : bi; }
                    tv[k] = best; ti[k] = bi;
#pragma unroll
                    for (int e = 0; e < 32; ++e) v[e] = (e == bi) ? -INFINITY : v[e]; }
                const float e1 = __expf(tv[1] - tv[0]), e2 = __expf(tv[2] - tv[0]), e3 = __expf(tv[3] - tv[0]), inv = 1.0f / (1.0f + e1 + e2 + e3);
                const int ent = (32 * pass + tid) * 4;
                SEL[ent] = ti[0]; SEL[ent + 1] = ti[1]; SEL[ent + 2] = ti[2]; SEL[ent + 3] = ti[3];
                SELG[ent] = inv; SELG[ent + 1] = e1 * inv; SELG[ent + 2] = e2 * inv; SELG[ent + 3] = e3 * inv; }
        }
        __syncthreads();
        if (tid < 256 + 32) {
            const int mye = (tid < 256) ? SEL[tid] : (tid - 256), lim = (tid < 256) ? tid : 256; int cnt = 0;
#pragma unroll 4
            for (int j4 = 0; j4 < 64; ++j4) { const LAS int* sp = SEL + 4 * j4; const int s0 = sp[0], s1 = sp[1], s2 = sp[2], s3 = sp[3];
                cnt += (s0 == mye && 4 * j4 < lim) + (s1 == mye && 4 * j4 + 1 < lim) + (s2 == mye && 4 * j4 + 2 < lim) + (s3 == mye && 4 * j4 + 3 < lim); }
            if (tid < 256) LSL[tid] = cnt; else blkcnt[c * 32 + tid - 256] = cnt; }
        __syncthreads();
        if (tid < 256) { const size_t o = (size_t)c * 256 + tid; tok_e[o] = SEL[tid]; tok_ls[o] = LSL[tid]; tok_g[o] = SELG[tid]; }
    }
}

__device__ __forceinline__ void moe_tables(const Args& a, LAS unsigned char* lds, int c, int tid, int wave, int lane) {
    LAS int* TS = (LAS int*)(lds + MISC_OFF + 256); LAS int* RT2E = TS + 64; LAS int* BASE = (LAS int*)(lds + AUX_OFF); LAS int* PART = BASE + 64;
    const int* blkcnt = (const int*)(a.ws + WS_BLKCNT);
    { const int e = tid & 31, part = tid >> 5; int tot = 0, bs = 0;
#pragma unroll
      for (int i = 0; i < 16; ++i) { const int cc = part * 16 + i; const int v = blkcnt[cc * 32 + e]; tot += v; bs += (cc < c) ? v : 0; }
      PART[part * 32 + e] = tot; PART[512 + part * 32 + e] = bs; }
    __syncthreads();
    if (wave == 0) {
        int total = 0, base = 0;
        if (lane < 32) {
#pragma unroll
            for (int p = 0; p < 16; ++p) { total += PART[p * 32 + lane]; base += PART[512 + p * 32 + lane]; } }
        const int tiles = (lane < 32) ? ((total + 255) >> 8) : 0;
        int incl = tiles;
#pragma unroll
        for (int o = 1; o < 32; o <<= 1) { const int t = __shfl_up(incl, o); if (lane >= o) incl += t; }
        const int start = incl - tiles;
        if (lane < 32) { TS[lane] = start; BASE[lane] = start * 256 + base; for (int t = start; t < incl; ++t) RT2E[t] = lane; }
        if (lane == 31) TS[32] = incl;
    }
    __syncthreads();
}
__device__ __forceinline__ void p6_gather(const Args& a, LAS unsigned char* lds, int bid, int G, int tid, int wave, int lane) {
    unsigned char* ws = a.ws;
    LAS int* BASE = (LAS int*)(lds + AUX_OFF);
    const int* tok_e = (const int*)(ws + WS_TOK); const int* tok_ls = tok_e + M * 4; int* tok_pos = (int*)(ws + WS_TOK) + 3 * M * 4;
    const bf16* H = (const bf16*)(ws + WS_H); bf16* XG = (bf16*)(ws + WS_XG);
    if (bid >= NCHUNK) moe_tables(a, lds, NCHUNK, tid, wave, lane);
    for (int c = bid; c < NCHUNK; c += G) {
        __syncthreads();
        moe_tables(a, lds, c, tid, wave, lane);
        LAS int* POS = BASE + 1152;
        if (tid < 256) { const size_t o = (size_t)c * 256 + tid; const int pos = BASE[tok_e[o]] + tok_ls[o]; POS[tid] = pos; tok_pos[o] = pos; }
        __syncthreads();
#if MOE_FP8_G1
        { const unsigned char* Hc = (const unsigned char*)H + (size_t)(c * 64) * D; v4u rw[8];
#pragma unroll
          for (int t = 0; t < 8; ++t) rw[t] = ((const GAS v4u*)(Hc + (size_t)(wave * 8 + t) * D))[lane];
#pragma unroll
          for (int t = 0; t < 8; ++t)
#pragma unroll
            for (int k = 0; k < 4; ++k) ((GAS v4u*)((unsigned char*)XG + (size_t)POS[(wave * 8 + t) * 4 + k] * D))[lane] = rw[t]; }
#else
        for (int i = wave; i < 256; i += NWAVES) { const int pos = POS[i];
            const GAS v4u* src = (const GAS v4u*)(H + (size_t)(c * 64 + (i >> 2)) * D); GAS v4u* dst = (GAS v4u*)(XG + (size_t)pos * D);
            dst[lane] = src[lane]; dst[64 + lane] = src[64 + lane]; }
#endif
    }
}

__device__ __forceinline__ void p9_final(const Args& a, int bid, int G, int wave, int lane) {
    unsigned char* ws = a.ws;
    const bf16* x1 = (const bf16*)(ws + WS_X1); const bf16* Y = (const bf16*)(ws + WS_XG);
    const float* tok_g = (const float*)(ws + WS_TOK) + 2 * M * 4; const int* tok_pos = (const int*)(ws + WS_TOK) + 3 * M * 4;
    const float* modf = (const float*)(ws + WS_MODF); const float* fnw = a.in[I_FNW]; float* out = a.out;
    const int gw = bid * NWAVES + wave, NGW = G * NWAVES;
    int pos_n[4]; float gk_n[4];
    if (gw < M) {
#pragma unroll
        for (int k = 0; k < 4; ++k) { pos_n[k] = tok_pos[(size_t)gw * 4 + k]; gk_n[k] = tok_g[(size_t)gw * 4 + k]; } }
#pragma unroll 1
    for (int m = gw; m < M; m += NGW) {
        const int b = m >> 13; const float* g2 = modf + b * 6144 + 5 * 1024;
        int posv[4]; float gkv[4];
#pragma unroll
        for (int k = 0; k < 4; ++k) { posv[k] = pos_n[k]; gkv[k] = gk_n[k]; }
        if (m + NGW < M) {
#pragma unroll
            for (int k = 0; k < 4; ++k) { pos_n[k] = tok_pos[(size_t)(m + NGW) * 4 + k]; gk_n[k] = tok_g[(size_t)(m + NGW) * 4 + k]; } }
        f32x4 mo[4];
#pragma unroll
        for (int j = 0; j < 4; ++j) mo[j] = (f32x4){0.f, 0.f, 0.f, 0.f};
#pragma unroll
        for (int k = 0; k < 4; ++k) { const int pos = posv[k];
#if Y_FP8
            const float gk = gkv[k] * 0.125f;
            const GAS unsigned* yr = (const GAS unsigned*)((const unsigned char*)Y + (size_t)pos * D) + lane;
#pragma unroll
            for (int j = 0; j < 4; ++j) { const int w = (int)__builtin_nontemporal_load((const unsigned*)yr + 64 * j); typedef float f32x2 __attribute__((ext_vector_type(2)));
                const f32x2 lo = __builtin_amdgcn_cvt_pk_f32_fp8(w, false), hi = __builtin_amdgcn_cvt_pk_f32_fp8(w, true);
                mo[j].x += gk * lo.x; mo[j].y += gk * lo.y; mo[j].z += gk * hi.x; mo[j].w += gk * hi.y; }
#else
            const float gk = gkv[k];
            const GAS unsigned long long* yr = (const GAS unsigned long long*)(Y + (size_t)pos * D) + lane;
#pragma unroll
            for (int j = 0; j < 4; ++j) { const unsigned long long w = yr[64 * j]; const unsigned lo = (unsigned)w, hi = (unsigned)(w >> 32);
                mo[j].x += gk * __uint_as_float(lo << 16); mo[j].y += gk * __uint_as_float(lo & 0xffff0000u); mo[j].z += gk * __uint_as_float(hi << 16); mo[j].w += gk * __uint_as_float(hi & 0xffff0000u); }
#endif
        }
        const GAS unsigned long long* xr = (const GAS unsigned long long*)(x1 + (size_t)m * D) + lane;
        f32x4 v[4]; float ss = 0.f;
#pragma unroll
        for (int j = 0; j < 4; ++j) { const f32x4 gv = *(const f32x4*)(g2 + 256 * j + 4 * lane); const unsigned long long xw = __builtin_nontemporal_load((const unsigned long long*)xr + 64 * j);
            v[j] = (f32x4){bfw((unsigned)xw, 0), bfw((unsigned)xw, 1), bfw((unsigned)(xw >> 32), 0), bfw((unsigned)(xw >> 32), 1)} + gv * mo[j]; ss += (v[j].x * v[j].x + v[j].y * v[j].y) + (v[j].z * v[j].z + v[j].w * v[j].w); }
        const float rstd = rsqrtf(wave_sum(ss) * (1.0f / D) + EPS);
        GAS f32x4* orow = (GAS f32x4*)(out + (size_t)m * D) + lane;
#pragma unroll
        for (int j = 0; j < 4; ++j) { const f32x4 wv = *(const f32x4*)(fnw + 256 * j + 4 * lane); __builtin_nontemporal_store(v[j] * rstd * wv, (f32x4*)(out + (size_t)m * D) + lane + 64 * j); }
    }
}

#ifndef REP_MASK
#define REP_MASK 0
#endif
#define NREP(k) (((REP_MASK) >> (k)) & 1 ? 2 : 1)
#define REPB(k, rr) do { if ((rr) + 1 < NREP(k) && multi) { if ((k) >= 9) { LANE_TID(); xcd_barrier(bar, tid == 0); } else xcd_barrier(bar, tid == 0); } } while (0)
#ifndef SKEW_TICKS
#define SKEW_TICKS 0
#endif
#define PHASE_SKEW() do { if (SKEW_TICKS > 0) { const unsigned long long t0_ = __builtin_amdgcn_s_memrealtime(), w_ = (unsigned long long)(bid & 3) * SKEW_TICKS; while (__builtin_amdgcn_s_memrealtime() - t0_ < w_) __builtin_amdgcn_s_sleep(2); } } while (0)
#ifndef HG_CHUNKED
#define HG_CHUNKED 1
#endif
#ifndef SSD_CHUNKED
#define SSD_CHUNKED 1
#endif
constexpr int NPHASE = 12;
__global__ void __launch_bounds__(NTHR, 2) mk_fwd(Args args) {
    extern __shared__ __attribute__((aligned(16))) unsigned char lds_raw[];
    LAS unsigned char* lds = (LAS unsigned char*)lds_raw;
    const int tid = threadIdx.x, lane = tid & 63, wave = __builtin_amdgcn_readfirstlane(tid >> 6); __builtin_assume(wave >= 0 && wave < 8);
#define LANE_TID() int lane; asm volatile("v_mbcnt_lo_u32_b32 %0, -1, 0\n\tv_mbcnt_hi_u32_b32 %0, -1, %0" : "=v"(lane)); __builtin_assume(lane >= 0 && lane < 64); const int tid = wave * 64 + lane; (void)tid
    const int G = gridDim.x, bid = blockIdx.x;
    unsigned char* ws = args.ws;
    gu32* ctl = (gu32*)(ws + WS_CTL);
    volatile LAS unsigned* MISC = (volatile LAS unsigned*)(lds + MISC_OFF);
    if (tid < 64) MISC[tid] = 0u;
    __syncthreads();
    const int lo = args.ph_lo, hi = args.ph_hi;
    const bool multi = (hi - lo) > 1;
    XcdBarrier bar; bar.bar = (unsigned*)(ctl + CW_BAR); bar.x = 0; bar.st = nullptr;
    if (multi) bar = xcd_barrier_post((unsigned*)(ctl + CW_BAR), MISC + 8, tid == 0);
#define IN(k) (lo <= (k) && (k) < hi)
#ifdef PROBE_A
#ifndef PROBE_BUSY
#define PROBE_BUSY 0
#endif
#define STAMP(k) do { int tid_s; if ((k) >= 9) { LANE_TID(); tid_s = tid; } else tid_s = tid; if (tid_s == 0) { const unsigned long long t_ = __builtin_amdgcn_s_memrealtime(); MISC[16 + 2 * (k)] = (unsigned)t_; MISC[17 + 2 * (k)] = (unsigned)(t_ >> 32); } } while (0)
#define ARRIVE(k) do { int tid_s; if ((k) >= 9) { LANE_TID(); tid_s = tid; } else tid_s = tid; if (tid_s == 0 && (k) == PROBE_A) { const unsigned long long t_ = __builtin_amdgcn_s_memrealtime(); const unsigned long long s_ = ((unsigned long long)MISC[17 + 2 * (k)] << 32) | MISC[16 + 2 * (k)]; \
    const unsigned busy = (unsigned)(t_ - s_); atomicMax((unsigned*)ctl + 3000, busy); atomicAdd((unsigned*)ctl + 3064, busy); } } while (0)
#else
#define STAMP(k) do { } while (0)
#define ARRIVE(k) do { } while (0)
#endif
#define SEAM(k) do { ARRIVE(k); if (IN(k) && IN((k) + 1)) { if ((k) >= 8) { LANE_TID(); xcd_barrier(bar, tid == 0); } else xcd_barrier(bar, tid == 0); } STAMP((k) + 1); } while (0)

    STAMP(0);
    if (IN(0)) { for (int rr_ = 0; rr_ < NREP(0); ++rr_) { p0_prologue(args, lds, bid, G, tid, wave, lane);  REPB(0, rr_); } } SEAM(0);
    if (IN(1)) { for (int rr_ = 0; rr_ < NREP(1); ++rr_) { p1_norm(args, lds, bid, G, tid, wave, lane);  REPB(1, rr_); } } SEAM(1);
    if (IN(2)) { for (int rr_ = 0; rr_ < NREP(2); ++rr_) {
        pg8::Gemm g{(const pg8::bf16_t*)(ws + WS_H), (const pg8::bf16_t*)(ws + WS_WIN), M, NPROJ, D}; pg8::StaticOrder S; S.init(M, NPROJ, G, bid);
        pg8::EpiIn E{(pg8::bf16_t*)(ws + WS_P), (float*)(ws + WS_LF), args.in[I_LBL]};
#ifdef PROBE_G
        if (threadIdx.x == 0) MISC[61] = (PROBE_G == 2) ? 1u : 0u; __syncthreads();
#endif
        pg8::gemm_phase<pg8::EpiIn, pg8::StaticOrder, true, true>(lds, g, S, E, wave);
        __syncthreads(); p0_bg_items(args, lds, bid, G, tid, wave, lane);
     REPB(2, rr_); } } SEAM(2);
    if (IN(3)) { for (int rr_ = 0; rr_ < NREP(3); ++rr_) {
        const int cpos = bid % 3;
        if (cpos == 0) { int tq5_ = tid; asm volatile("" : "+v"(tq5_)); deferred_cvt_items(args, lds, bid, G, 0, tq5_, wave, tq5_ & 63); }
        for (int u = bid; u < 256; u += G) {
            __syncthreads();
#if HG_CHUNKED
            { int tq1_ = tid; asm volatile("" : "+v"(tq1_)); hg_passA(args, lds, u, tq1_, wave, tq1_ & 63); }
            STAMP(14);
#endif
            __syncthreads();
            if (cpos == 1 && u == bid) { int tq6_ = tid; asm volatile("" : "+v"(tq6_)); deferred_cvt_items(args, lds, bid, G, 0, tq6_, wave, tq6_ & 63); }
            __syncthreads();
#if SSD_CHUNKED
            { int tq2_ = tid; asm volatile("" : "+v"(tq2_)); ssd_passA(args, lds, u, tq2_, wave, tq2_ & 63); }
#endif
        }
        __syncthreads();
        if (cpos == 2) { int tq7_ = tid; asm volatile("" : "+v"(tq7_)); deferred_cvt_items(args, lds, bid, G, 0, tq7_, wave, tq7_ & 63); }
     REPB(3, rr_); } } SEAM(3);
    if (IN(4)) { for (int rr_ = 0; rr_ < NREP(4); ++rr_) { mix_scan(args, bid, G, tid);  REPB(4, rr_); } } SEAM(4);
    if (IN(5)) { for (int rr_ = 0; rr_ < NREP(5); ++rr_) {
        const int cpos = bid % 3;
        if (cpos == 0) { int tq8_ = tid; asm volatile("" : "+v"(tq8_)); deferred_cvt_items(args, lds, bid, G, 1, tq8_, wave, tq8_ & 63); }
        const bool ssd_first = ((bid >> 3) & 1) != 0;
        for (int u = bid; u < 256; u += G) {
#pragma unroll 1
            for (int step = 0; step < 2; ++step) {
                __syncthreads();
                if ((step == 0) != ssd_first) {
#if HG_CHUNKED
                    int tq3_ = tid; asm volatile("" : "+v"(tq3_)); hg_passC(args, lds, u, tq3_, wave, tq3_ & 63);
                    STAMP(13);
#endif
                } else {
#if SSD_CHUNKED
                    int tq4_ = tid; asm volatile("" : "+v"(tq4_)); ssd_passC(args, lds, u, tq4_, wave, tq4_ & 63);
#endif
                }
                __syncthreads();
                if (step == 0 && cpos == 1 && u == bid) { int tq9_ = tid; asm volatile("" : "+v"(tq9_)); deferred_cvt_items(args, lds, bid, G, 1, tq9_, wave, tq9_ & 63); }
            }
        }
        __syncthreads();
        if (cpos == 2) { int tq10_ = tid; asm volatile("" : "+v"(tq10_)); deferred_cvt_items(args, lds, bid, G, 1, tq10_, wave, tq10_ & 63); }
     REPB(5, rr_); } } SEAM(5);
    if (IN(6)) { for (int rr_ = 0; rr_ < NREP(6); ++rr_) {
        pg8::Gemm g{(const pg8::bf16_t*)(ws + WS_MIX), (const pg8::bf16_t*)(ws + WS_WOUT), M, D, D}; pg8::StaticOrder S; S.init(M, D, G, bid);
        pg8::EpiOut E{args.in[I_X], (pg8::bf16_t*)(ws + WS_X1), (const float*)(ws + WS_MODF) + 2 * 1024};
#ifdef PROBE_G
        if (threadIdx.x == 0) MISC[61] = (PROBE_G == 6) ? 1u : 0u; __syncthreads();
#endif
        pg8::gemm_phase<pg8::EpiOut, pg8::StaticOrder, true, true>(lds, g, S, E, wave);
     REPB(6, rr_); } } SEAM(6);
    if (IN(7)) { for (int rr_ = 0; rr_ < NREP(7); ++rr_) { p5_router(args, lds, bid, G, tid, wave, lane);  REPB(7, rr_); } } SEAM(7);
    if (IN(8)) { for (int rr_ = 0; rr_ < NREP(8); ++rr_) { p6_gather(args, lds, bid, G, tid, wave, lane);  REPB(8, rr_); } } SEAM(8);
    if (IN(9) || IN(10)) {
        if (!IN(8)) { LANE_TID(); moe_tables(args, lds, NCHUNK, tid, wave, lane); }
        const PG8_LAS int* TS = (const PG8_LAS int*)(lds + MISC_OFF + 256);
        const int R = __builtin_amdgcn_readfirstlane(TS[32]);
        int kmoe1 = MOE_FP8_G1 ? D / 2 : D, kmoe2 = MOE_FP8_G2 ? D / 2 : D; asm volatile("" : "+s"(kmoe1), "+s"(kmoe2));
        if (IN(9)) { for (int rr_ = 0; rr_ < NREP(9); ++rr_) { LANE_TID();
            pg8::Gemm g{(const pg8::bf16_t*)(ws + WS_XG), (const pg8::bf16_t*)(ws + WS_W1), R * 256, 2048, kmoe1};
            PHASE_SKEW();
            pg8::MoeOrder S{TS + 64, 8, R * 8, G, bid};
            pg8::EpiW1<MOE_FP8_G1 != 0, MOE_FP8_G2 != 0> E{(void*)(ws + WS_ACT), args.in[I_B1]};
#ifdef PROBE_G
        if (threadIdx.x == 0) MISC[61] = (PROBE_G == 9) ? 1u : 0u; __syncthreads();
#endif
            pg8::gemm_phase<pg8::EpiW1<MOE_FP8_G1 != 0, MOE_FP8_G2 != 0>, pg8::MoeOrder, true, true, MOE_FP8_G1 != 0>(lds, g, S, E, wave);
         REPB(9, rr_); } }
        SEAM(9);
        if (IN(10)) { for (int rr_ = 0; rr_ < NREP(10); ++rr_) { LANE_TID();
            pg8::Gemm g{(const pg8::bf16_t*)(ws + WS_ACT), (const pg8::bf16_t*)(ws + WS_W2), R * 256, 1024, kmoe2};
            PHASE_SKEW();
            pg8::MoeOrder S{TS + 64, 4, R * 4, G, bid};
            pg8::EpiW2<Y_FP8 != 0> E{(void*)(ws + WS_XG), args.in[I_B2], MOE_FP8_G2 ? (1.0f / 512.0f) : 1.0f};
#ifdef PROBE_G
        if (threadIdx.x == 0) MISC[61] = (PROBE_G == 10) ? 1u : 0u; __syncthreads();
#endif
            pg8::gemm_phase<pg8::EpiW2<Y_FP8 != 0>, pg8::MoeOrder, true, true, MOE_FP8_G2 != 0>(lds, g, S, E, wave);
         REPB(10, rr_); } }
    }
    SEAM(10);
    if (IN(11)) { for (int rr_ = 0; rr_ < NREP(11); ++rr_) { LANE_TID(); p9_final(args, bid, G, wave, lane);  REPB(11, rr_); } }
#ifdef PROBE_A
    STAMP(12);
    int lpr_; asm volatile("v_mbcnt_lo_u32_b32 %0, -1, 0\n\tv_mbcnt_hi_u32_b32 %0, -1, %0" : "=v"(lpr_)); if (bid == 0 && wave == 0 && lpr_ == 0) {
        const unsigned long long mx = __hip_atomic_load((unsigned*)ctl + 3000, __ATOMIC_RELAXED, __HIP_MEMORY_SCOPE_AGENT);
        const unsigned long long sp = ((((unsigned long long)MISC[17 + 2 * (PROBE_A + 1)] << 32) | MISC[16 + 2 * (PROBE_A + 1)]) - (((unsigned long long)MISC[17 + 2 * PROBE_A] << 32) | MISC[16 + 2 * PROBE_A]));
#ifndef PROBE_B
#define PROBE_B (PROBE_A + 1)
#endif
        const unsigned long long sp2 = ((((unsigned long long)MISC[17 + 2 * (PROBE_B)] << 32) | MISC[16 + 2 * (PROBE_B)]) - (((unsigned long long)MISC[17 + 2 * PROBE_A] << 32) | MISC[16 + 2 * PROBE_A]));
#ifdef PROBE_G
        const unsigned long long wait = 64ull * (unsigned long long)MISC[60], t0 = __builtin_amdgcn_s_memrealtime();
#else
        (void)sp; const unsigned long long wait = 64ull * (PROBE_BUSY ? mx : sp2), t0 = __builtin_amdgcn_s_memrealtime();
#endif
        while (__builtin_amdgcn_s_memrealtime() - t0 < wait) __builtin_amdgcn_s_sleep(4);
    }
#endif
#undef IN
#undef SEAM
}

#ifndef MK_N_LAUNCHES
#define MK_N_LAUNCHES 1
#endif
extern "C" void kernel_launch(void* const* d_in, const int* in_sizes, int n_in, void* d_out, int out_size, void* d_ws, size_t ws_size, hipStream_t stream) {
    static int grid = 0;
    if (grid == 0) {
        if (n_in != 23 || out_size != M * D || ws_size < WS_END) { fprintf(stderr, "kernel_launch: unexpected shapes (n_in %d out %d ws %zu)\n", n_in, out_size, ws_size); grid = -1; return; }
        int dev = 0, cus = 0;
        if (hipGetDevice(&dev) != hipSuccess || hipDeviceGetAttribute(&cus, hipDeviceAttributeMultiprocessorCount, dev) != hipSuccess) { grid = -1; return; }
        if (hipFuncSetAttribute((const void*)mk_fwd, hipFuncAttributeMaxDynamicSharedMemorySize, LDS_BYTES) != hipSuccess) { fprintf(stderr, "kernel_launch: hipFuncSetAttribute failed\n"); grid = -1; return; }
        int per_cu = 0;
        if (hipOccupancyMaxActiveBlocksPerMultiprocessor(&per_cu, (const void*)mk_fwd, NTHR, LDS_BYTES) != hipSuccess || per_cu < 1) fprintf(stderr, "kernel_launch: occupancy query says %d\n", per_cu);
        (void)hipGetLastError();
        grid = cus;
    }
    if (grid < 0) return;
    (void)hipMemsetAsync((char*)d_ws + WS_CTL, 0, CTL_ZERO_BYTES, stream);
    Args a{};
    for (int i = 0; i < 23; ++i) a.in[i] = (const float*)d_in[i];
    a.out = (float*)d_out; a.ws = (unsigned char*)d_ws;
    if (MK_N_LAUNCHES == 1) { a.ph_lo = 0; a.ph_hi = NPHASE; hipLaunchKernelGGL(mk_fwd, dim3(grid), dim3(NTHR), LDS_BYTES, stream, a); }
    else for (int p = 0; p < NPHASE; ++p) { a.ph_lo = p; a.ph_hi = p + 1; hipLaunchKernelGGL(mk_fwd, dim3(grid), dim3(NTHR), LDS_BYTES, stream, a); }
}
```
